# Optimizing an MI355X kernel written in HIP

```python
import math
import jax, jax.numpy as jnp
from jax import lax
import numpy as np

D_MODEL = 1024
BATCH = 2
SEQ = 8192
DEPTH = 2

GRID_W = 64
CTX_LEN = 256
EPS = 1e-6

DA_HEADS = 4
DA_QK = 64
DA_V = 2 * DA_QK
DA_WIDTH = DA_HEADS * DA_V
ROPE_THETA = 10000.0
Q_BLOCK = 128

SSD_HEADS = 4
SSD_HEAD_DIM = 64
SSD_WIDTH = SSD_HEADS * SSD_HEAD_DIM
SSD_GROUPS = 2
SSD_STATE = 64
SSD_CONV = 3
SSD_CONV_CH = SSD_WIDTH + 2 * SSD_GROUPS * SSD_STATE
SSD_CHUNK = 128

GLA_HEADS = 4
GLA_DK = 32
GLA_DV = 64
GLA_KEY_WIDTH = GLA_HEADS * GLA_DK
GLA_WIDTH = GLA_HEADS * GLA_DV
GLA_RANK = 16
GLA_NORMALIZER = 16.0
GLA_CHUNK = 64

MIX_WIDTH = DA_WIDTH + SSD_WIDTH + GLA_WIDTH

IN_SIZES = (
    DA_HEADS * 2 * DA_QK,
    DA_HEADS * 2 * DA_QK,
    DA_WIDTH,
    SSD_WIDTH,
    SSD_CONV_CH,
    2 * SSD_HEADS,
    GLA_KEY_WIDTH,
    GLA_KEY_WIDTH,
    GLA_WIDTH,
    GLA_WIDTH,
    2 * GLA_RANK,
)
IN_WIDTH = 3112

N_EXPERTS = 32
TOP_K = 4
D_EXPERT = 1024
SWIGLU_LIMIT = 7.0
SWIGLU_ALPHA = 1.702
MOE_BLOCK = 128

kernel_name = "hybrid_diffattn_ssd_gla_moe_block"


def _rms(xf):
    return xf * lax.rsqrt(jnp.mean(xf * xf, axis=-1, keepdims=True) + EPS)


def rms_norm(x, w):
    return (_rms(x.astype(jnp.float32)) * w.astype(jnp.float32)).astype(x.dtype)


def split_cols(p):
    outs = []
    start = 0
    for n in IN_SIZES:
        outs.append(p[..., start:start + n])
        start += n
    return outs


def rope_1d(x, pos):
    f = x.shape[-1] // 2
    inv = ROPE_THETA ** (-jnp.arange(f, dtype=jnp.float32) / f)
    ang = pos.astype(jnp.float32)[:, None] * inv
    cos = jnp.cos(ang)[:, None, None, :]
    sin = jnp.sin(ang)[:, None, None, :]
    xf = x.astype(jnp.float32)
    x1, x2 = xf[..., :f], xf[..., f:]
    return jnp.concatenate([x1 * cos - x2 * sin, x2 * cos + x1 * sin], axis=-1).astype(x.dtype)


def axial_rope(x, row, col):
    half = x.shape[-1] // 2
    return jnp.concatenate([rope_1d(x[..., :half], row), rope_1d(x[..., half:], col)], axis=-1)


def diff_softmax_attend(q, k, v, lam):
    s = jnp.einsum('bqhmd,bkhmd->bhmqk', q, k, preferred_element_type=jnp.float32) * (DA_QK ** -0.5)
    p = jax.nn.softmax(s, axis=-1)
    pd = p[:, :, 0] - lam * p[:, :, 1]
    return jnp.einsum('bhqk,bkhe->bqhe', pd.astype(v.dtype), v)


def diff_attention_latent(q, k_all, v_all, lam):
    Bsz, S = q.shape[0], q.shape[1]
    nb = S // Q_BLOCK
    qb = jnp.moveaxis(q.reshape(Bsz, nb, Q_BLOCK, DA_HEADS, 2, DA_QK), 1, 0)
    ob = lax.map(lambda qi: diff_softmax_attend(qi, k_all, v_all, lam), qb)
    return jnp.moveaxis(ob, 0, 1).reshape(Bsz, S, DA_HEADS, DA_V)


def centred_dwconv(x, w, b):
    K = w.shape[0]
    y = lax.conv_general_dilated(x, w[:, None, :].astype(x.dtype), window_strides=(1,),
                                 padding=[(K // 2, K // 2)],
                                 dimension_numbers=('NWC', 'WIO', 'NWC'),
                                 feature_group_count=x.shape[-1])
    return y + b.astype(x.dtype)


def ssd_chunked(x, dt, A, Bm, Cm, h0):
    Bsz, L, H, P = x.shape
    G, N = Bm.shape[2], Bm.shape[3]
    Q = SSD_CHUNK
    nc = L // Q
    rep = H // G
    Bh = jnp.repeat(Bm, rep, axis=2).reshape(Bsz, nc, Q, H, N)
    Ch = jnp.repeat(Cm, rep, axis=2).reshape(Bsz, nc, Q, H, N)
    xc = x.reshape(Bsz, nc, Q, H, P)
    dtc = dt.reshape(Bsz, nc, Q, H)
    acs = jnp.cumsum(dtc * A, axis=2)
    seg = acs[:, :, :, None, :] - acs[:, :, None, :, :]
    lower = jnp.tril(jnp.ones((Q, Q), dtype=bool))[None, None, :, :, None]
    decay = jnp.exp(jnp.where(lower, seg, -jnp.inf))
    scores = jnp.einsum('bcihn,bcjhn->bcijh', Ch, Bh) * decay * dtc[:, :, None, :, :]
    y = jnp.einsum('bcijh,bcjhp->bcihp', scores, xc)
    w_end = jnp.exp(acs[:, :, -1:, :] - acs) * dtc
    states = jnp.einsum('bcjh,bcjhn,bcjhp->bchpn', w_end, Bh, xc)
    chunk_decay = jnp.exp(acs[:, :, -1, :])

    def step(h, inp):
        s, d = inp
        return h * d[:, :, None, None] + s, h

    hT, h_in = lax.scan(step, h0, (jnp.moveaxis(states, 1, 0), jnp.moveaxis(chunk_decay, 1, 0)))
    h_in = jnp.moveaxis(h_in, 0, 1)
    y = y + jnp.einsum('bcihn,bcih,bchpn->bcihp', Ch, jnp.exp(acs), h_in)
    return y.reshape(Bsz, L, H, P), hT


def ssd_sequence(xbc, dt_raw, conv_w, conv_b, a_log, dt_bias, d_skip, h0):
    Bsz, L = xbc.shape[0], xbc.shape[1]
    GN = SSD_GROUPS * SSD_STATE
    xbc = jax.nn.silu(centred_dwconv(xbc, conv_w, conv_b)).astype(jnp.float32)
    xs = xbc[..., :SSD_WIDTH].reshape(Bsz, L, SSD_HEADS, SSD_HEAD_DIM)
    Bm = xbc[..., SSD_WIDTH:SSD_WIDTH + GN].reshape(Bsz, L, SSD_GROUPS, SSD_STATE)
    Cm = xbc[..., SSD_WIDTH + GN:].reshape(Bsz, L, SSD_GROUPS, SSD_STATE)
    dt = jax.nn.softplus(dt_raw.astype(jnp.float32).reshape(Bsz, L, 2, SSD_HEADS) + dt_bias.astype(jnp.float32))
    A = -jnp.exp(a_log.astype(jnp.float32))
    fl = lambda t: jnp.flip(t, axis=1)
    y_f, h_f = ssd_chunked(xs, dt[:, :, 0], A[0], Bm, Cm, h0[0])
    y_b, h_b = ssd_chunked(fl(xs), fl(dt[:, :, 1]), A[1], fl(Bm), fl(Cm), h0[1])
    y = y_f + fl(y_b) + d_skip.astype(jnp.float32)[:, None] * xs
    return y.reshape(Bsz, L, SSD_WIDTH), (h_f, h_b)


def ssd_gated_norm(y, z, w):
    g = y * jax.nn.silu(z.astype(jnp.float32))
    gs = _rms(g.reshape(*g.shape[:-1], SSD_GROUPS, SSD_WIDTH // SSD_GROUPS)).reshape(g.shape)
    return (gs * w.astype(jnp.float32)).astype(z.dtype)


def gla_chunked(q, k, v, gk, h0):
    Bsz, L, H, dk = q.shape
    dv = v.shape[-1]
    Q = GLA_CHUNK
    nc = L // Q
    qc = q.reshape(Bsz, nc, Q, H, dk)
    kc = k.reshape(Bsz, nc, Q, H, dk)
    vc = v.reshape(Bsz, nc, Q, H, dv)
    b = jnp.cumsum(gk.reshape(Bsz, nc, Q, H, dk), axis=2)
    q_t = qc * jnp.exp(b)
    k_t = kc * jnp.exp(-b)
    lower = jnp.tril(jnp.ones((Q, Q), dtype=bool))
    att = jnp.where(lower, jnp.einsum('bcihd,bcjhd->bchij', q_t, k_t), 0.0)
    o = jnp.einsum('bchij,bcjhv->bcihv', att, vc)
    k_end = kc * jnp.exp(b[:, :, -1:] - b)
    states = jnp.einsum('bcjhd,bcjhv->bchdv', k_end, vc)
    chunk_decay = jnp.exp(b[:, :, -1])

    def step(h, inp):
        s, d = inp
        return h * d[..., None] + s, h

    hT, h_in = lax.scan(step, h0, (jnp.moveaxis(states, 1, 0), jnp.moveaxis(chunk_decay, 1, 0)))
    h_in = jnp.moveaxis(h_in, 0, 1)
    o = o + jnp.einsum('bcihd,bchdv->bcihv', q_t, h_in)
    return o.reshape(Bsz, L, H, dv), hT


def gla_sequence(q, k, v, code, gk_up, gk_b, h0):
    Bsz, L = q.shape[0], q.shape[1]
    f32 = jnp.float32
    q = q.astype(f32).reshape(Bsz, L, GLA_HEADS, GLA_DK) * (GLA_DK ** -0.5)
    k = k.astype(f32).reshape(Bsz, L, GLA_HEADS, GLA_DK)
    v = v.astype(f32).reshape(Bsz, L, GLA_HEADS, GLA_DV)
    code = code.astype(f32).reshape(Bsz, L, 2, GLA_RANK)
    gk = jax.nn.log_sigmoid(jnp.einsum('bldr,drk->bldk', code, gk_up.astype(f32)) + gk_b.astype(f32)) / GLA_NORMALIZER
    gk = gk.reshape(Bsz, L, 2, GLA_HEADS, GLA_DK)
    fl = lambda t: jnp.flip(t, axis=1)
    o_f, s_f = gla_chunked(q, k, v, gk[:, :, 0], h0[0])
    o_b, s_b = gla_chunked(fl(q), fl(k), fl(v), fl(gk[:, :, 1]), h0[1])
    return o_f + fl(o_b), (s_f, s_b)


def gla_finish(o, g, w):
    Bsz, L = o.shape[0], o.shape[1]
    on = _rms(o) * w.astype(jnp.float32)
    gg = jax.nn.silu(g.astype(jnp.float32).reshape(Bsz, L, GLA_HEADS, GLA_DV))
    return (on * gg).reshape(Bsz, L, GLA_WIDTH).astype(g.dtype)


def moe_ffn(h, w_router, b_router, w_gate_up, b_gate_up, w_down, b_down):
    T, D = h.shape
    logits = jnp.dot(h, w_router).astype(jnp.float32) + b_router.astype(jnp.float32)
    top_v, top_i = lax.top_k(logits, TOP_K)
    gates = jax.nn.softmax(top_v, axis=-1)
    TK = T * TOP_K
    flat_e = top_i.reshape(-1).astype(jnp.int32)
    flat_tok = jnp.arange(TK, dtype=jnp.int32) // TOP_K
    order = jnp.argsort(flat_e)
    sorted_e = flat_e[order]
    sorted_tok = flat_tok[order]
    sorted_gate = gates.reshape(-1)[order]
    counts = jnp.bincount(flat_e, length=N_EXPERTS).astype(jnp.int32)
    starts = jnp.cumsum(counts) - counts
    padded = (counts + MOE_BLOCK - 1) // MOE_BLOCK * MOE_BLOCK
    pad_ends = jnp.cumsum(padded)
    pad_starts = pad_ends - padded
    dest = pad_starts[sorted_e] + (jnp.arange(TK, dtype=jnp.int32) - starts[sorted_e])
    n_blocks = -(-TK // MOE_BLOCK) + N_EXPERTS
    P = n_blocks * MOE_BLOCK
    row_tok = jnp.full((P,), T, dtype=jnp.int32).at[dest].set(sorted_tok)
    h_pad = jnp.concatenate([h, jnp.zeros((1, D), h.dtype)], axis=0)
    xb = h_pad[row_tok].reshape(n_blocks, MOE_BLOCK, D)
    block_e = jnp.minimum(jnp.searchsorted(pad_ends, jnp.arange(n_blocks, dtype=jnp.int32) * MOE_BLOCK, side='right'), N_EXPERTS - 1)

    def expert_block(args):
        xblk, e = args
        gu = xblk @ w_gate_up[e] + b_gate_up[e]
        glu = jnp.minimum(gu[:, :D_EXPERT], SWIGLU_LIMIT)
        lin = jnp.clip(gu[:, D_EXPERT:], -SWIGLU_LIMIT, SWIGLU_LIMIT)
        act = glu * jax.nn.sigmoid(SWIGLU_ALPHA * glu) * (lin + 1.0)
        return act @ w_down[e] + b_down[e]

    yb = lax.map(expert_block, (xb, block_e)).reshape(P, D)
    y_assign = yb[dest] * sorted_gate[:, None].astype(yb.dtype)
    return jax.ops.segment_sum(y_assign, sorted_tok, num_segments=T)


def setup_inputs(seed: int = 0) -> dict:
    key = jax.random.key(seed)
    ks = iter(jax.random.split(key, 32))
    L, D = DEPTH, D_MODEL

    def nrm(shape, scale):
        return jax.random.normal(next(ks), shape, jnp.float32) * scale

    u = jax.random.uniform(next(ks), (L, 2, SSD_HEADS), jnp.float32)
    dt0 = jnp.exp(u * (math.log(0.1) - math.log(0.001)) + math.log(0.001))
    ssd_dt_bias = dt0 + jnp.log(-jnp.expm1(-dt0))
    ssd_a_log = jnp.log(jax.random.uniform(next(ks), (L, 2, SSD_HEADS), jnp.float32, minval=1.0, maxval=16.0))
    return {
        "x": nrm((BATCH, SEQ, D), 1.0),
        "c": nrm((BATCH, D), 1.0),
        "ctx": nrm((BATCH, CTX_LEN, D), 1.0),
        "c_ctx": nrm((D,), 1.0),
        "w_ada": nrm((L, D, 6 * D), 0.5 * D ** -0.5),
        "b_ada": nrm((L, 6 * D), 0.01),
        "norm1_w": 1.0 + nrm((L, D), 0.02),
        "w_in": nrm((L, D, IN_WIDTH), D ** -0.5),
        "da_lambda": nrm((L, 4, DA_QK), 0.1),
        "da_subln_w": 1.0 + nrm((L, DA_V), 0.02),
        "ssd_conv_w": nrm((L, SSD_CONV, SSD_CONV_CH), SSD_CONV ** -0.5),
        "ssd_conv_b": nrm((L, SSD_CONV_CH), 0.01),
        "ssd_a_log": ssd_a_log,
        "ssd_dt_bias": ssd_dt_bias,
        "ssd_d": 1.0 + nrm((L, SSD_HEADS), 0.02),
        "ssd_norm_w": 1.0 + nrm((L, SSD_WIDTH), 0.02),
        "gla_gk_up": nrm((L, 2, GLA_RANK, GLA_KEY_WIDTH), GLA_RANK ** -0.5),
        "gla_gk_b": nrm((L, 2, GLA_KEY_WIDTH), 0.01),
        "gla_norm_w": 1.0 + nrm((L, GLA_DV), 0.02),
        "w_out": nrm((L, MIX_WIDTH, D), MIX_WIDTH ** -0.5),
        "norm2_w": 1.0 + nrm((L, D), 0.02),
        "w_router": nrm((L, D, N_EXPERTS), D ** -0.5),
        "b_router": nrm((L, N_EXPERTS), 0.01),
        "w_gate_up": nrm((L, N_EXPERTS, D, 2 * D_EXPERT), D ** -0.5),
        "b_gate_up": nrm((L, N_EXPERTS, 2 * D_EXPERT), 0.01),
        "w_down": nrm((L, N_EXPERTS, D_EXPERT, D), D_EXPERT ** -0.5),
        "b_down": nrm((L, N_EXPERTS, D), 0.01),
        "final_norm_w": 1.0 + nrm((D,), 0.02),
    }


def reference(x, c, ctx, c_ctx, w_ada, b_ada, norm1_w, w_in, da_lambda, da_subln_w,
              ssd_conv_w, ssd_conv_b, ssd_a_log, ssd_dt_bias, ssd_d, ssd_norm_w,
              gla_gk_up, gla_gk_b, gla_norm_w, w_out, norm2_w, w_router, b_router,
              w_gate_up, b_gate_up, w_down, b_down, final_norm_w):
    f32 = jnp.float32
    Bsz, S, D = x.shape
    Lc = ctx.shape[1]
    ROWS = S // GRID_W
    row = jnp.repeat(jnp.arange(ROWS, dtype=jnp.int32), GRID_W)
    col = jnp.arange(S, dtype=jnp.int32) % GRID_W
    zero_ssd = jnp.zeros((Bsz, SSD_HEADS, SSD_HEAD_DIM, SSD_STATE), f32)
    zero_gla = jnp.zeros((Bsz, GLA_HEADS, GLA_DK, GLA_DV), f32)

    for l in range(DEPTH):
        last = l == DEPTH - 1
        lambda_init = 0.8 - 0.6 * math.exp(-0.3 * l)
        mod = jax.nn.silu(c) @ w_ada[l] + b_ada[l]
        mod_c = jax.nn.silu(c_ctx) @ w_ada[l] + b_ada[l]
        sh1, sc1, g1, sh2, sc2, g2 = [m[:, None, :] for m in jnp.split(mod, 6, axis=-1)]
        sh1c, sc1c, g1c, sh2c, sc2c, g2c = jnp.split(mod_c, 6)

        h = rms_norm(x, norm1_w[l]) * (1.0 + sc1) + sh1
        hc = rms_norm(ctx, norm1_w[l]) * (1.0 + sc1c) + sh1c
        pl = split_cols(h @ w_in[l])
        pc = split_cols(hc @ w_in[l])

        lp = da_lambda[l].astype(f32)
        lam = jnp.exp(jnp.sum(lp[0] * lp[1])) - jnp.exp(jnp.sum(lp[2] * lp[3])) + lambda_init
        q_l = axial_rope(pl[0].reshape(Bsz, S, DA_HEADS, 2, DA_QK), row, col)
        k_l = axial_rope(pl[1].reshape(Bsz, S, DA_HEADS, 2, DA_QK), row, col)
        v_l = pl[2].reshape(Bsz, S, DA_HEADS, DA_V)
        q_c = pc[0].reshape(Bsz, Lc, DA_HEADS, 2, DA_QK)
        k_c = pc[1].reshape(Bsz, Lc, DA_HEADS, 2, DA_QK)
        v_c = pc[2].reshape(Bsz, Lc, DA_HEADS, DA_V)
        k_all = jnp.concatenate([k_c, k_l], axis=1)
        v_all = jnp.concatenate([v_c, v_l], axis=1)
        o_a = diff_attention_latent(q_l, k_all, v_all, lam)
        a_l = (rms_norm(o_a, da_subln_w[l]) * (1.0 - lambda_init)).reshape(Bsz, S, DA_WIDTH).astype(x.dtype)

        y_c, st_c = ssd_sequence(pc[4], pc[5], ssd_conv_w[l], ssd_conv_b[l], ssd_a_log[l],
                                 ssd_dt_bias[l], ssd_d[l], (zero_ssd, zero_ssd))
        y_l, _ = ssd_sequence(pl[4], pl[5], ssd_conv_w[l], ssd_conv_b[l], ssd_a_log[l],
                              ssd_dt_bias[l], ssd_d[l], st_c)
        s_l = ssd_gated_norm(y_l, pl[3], ssd_norm_w[l]).astype(x.dtype)

        o_gc, gs_c = gla_sequence(pc[6], pc[7], pc[8], pc[10], gla_gk_up[l], gla_gk_b[l], (zero_gla, zero_gla))
        o_gl, _ = gla_sequence(pl[6], pl[7], pl[8], pl[10], gla_gk_up[l], gla_gk_b[l], gs_c)
        c_l = gla_finish(o_gl, pl[9], gla_norm_w[l]).astype(x.dtype)

        mix_l = jnp.concatenate([a_l, s_l, c_l], axis=-1)
        x = x + g1 * (mix_l @ w_out[l])

        if not last:
            o_ac = diff_softmax_attend(q_c, k_c, v_c, lam)
            a_c = (rms_norm(o_ac, da_subln_w[l]) * (1.0 - lambda_init)).reshape(Bsz, Lc, DA_WIDTH).astype(ctx.dtype)
            s_c = ssd_gated_norm(y_c, pc[3], ssd_norm_w[l]).astype(ctx.dtype)
            c_c = gla_finish(o_gc, pc[9], gla_norm_w[l]).astype(ctx.dtype)
            mix_c = jnp.concatenate([a_c, s_c, c_c], axis=-1)
            ctx = ctx + g1c * (mix_c @ w_out[l])

            h2 = rms_norm(x, norm2_w[l]) * (1.0 + sc2) + sh2
            h2c = rms_norm(ctx, norm2_w[l]) * (1.0 + sc2c) + sh2c
            tokens = jnp.concatenate([h2.reshape(Bsz * S, D), h2c.reshape(Bsz * Lc, D)], axis=0)
            ff = moe_ffn(tokens, w_router[l], b_router[l], w_gate_up[l], b_gate_up[l], w_down[l], b_down[l])
            x = x + g2 * ff[:Bsz * S].reshape(Bsz, S, D)
            ctx = ctx + g2c * ff[Bsz * S:].reshape(Bsz, Lc, D)
        else:
            h2 = rms_norm(x, norm2_w[l]) * (1.0 + sc2) + sh2
            ff = moe_ffn(h2.reshape(Bsz * S, D), w_router[l], b_router[l], w_gate_up[l], b_gate_up[l], w_down[l], b_down[l])
            x = x + g2 * ff.reshape(Bsz, S, D)

    return rms_norm(x, final_norm_w)
```

```cpp
#include <hip/hip_runtime.h>
#include <cstdio>
#include <cstdint>

#ifndef MK_N_LAUNCHES
#define MK_N_LAUNCHES 1
#endif

#define GAS __attribute__((address_space(1)))
#define LAS __attribute__((address_space(3)))
typedef unsigned short bf16_t;
typedef short bf16x8 __attribute__((ext_vector_type(8)));
typedef short s16x4 __attribute__((ext_vector_type(4)));
typedef float f32x2 __attribute__((ext_vector_type(2)));
typedef float f32x4 __attribute__((ext_vector_type(4)));
typedef float f32x16 __attribute__((ext_vector_type(16)));
typedef unsigned u32x2 __attribute__((ext_vector_type(2)));
typedef unsigned u32x4 __attribute__((ext_vector_type(4)));

constexpr int DM = 1024, NB = 2, SEQ = 8192, LCTX = 256, NLAYER = 2;
constexpr int TLAT = NB * SEQ, TCTX = NB * LCTX, TALL = TLAT + TCTX;
constexpr int INW = 3112, INWP = 3328;
constexpr int C_Q = 0, C_K = 512, C_V = 1024, C_Z = 1536, C_XBC = 1792, C_DT = 2304, C_GQ = 2312, C_GK = 2440, C_GV = 2568, C_GG = 2824, C_CODE = 3080;
constexpr int NE = 32, DE = 1024;
constexpr int LISTCAP = TALL, MAXRT = 296, XB_ROWS = MAXRT * 256;
constexpr float EPS = 1e-6f;

constexpr size_t MiB = 1u << 20;
constexpr size_t WS_CTL = 0, CTL_ZERO_BYTES = 128 * 1024;
constexpr int CW_BAR = 4096, CW_CNT = 16384, CW_KMAX = 16384 + 64;
constexpr size_t WS_MOD = 1 * MiB, WS_ROPE = 1 * MiB + 256 * 1024, WS_SCAL = WS_ROPE + 16 * 1024, WS_CDS = WS_SCAL + 4096, WS_CDG = WS_SCAL + 32768, WS_WRT = WS_SCAL + 320 * 1024;
constexpr size_t WS_WIN = 2 * MiB, WS_WOUT = 15 * MiB, WS_WGU = 32 * MiB, WS_WDN = 288 * MiB;
constexpr size_t WS_H = 416 * MiB, WS_PROJ = 449 * MiB, WS_XBC = 557 * MiB, WS_DT = 574 * MiB, WS_AV = 575 * MiB, WS_GKV = 576 * MiB;
constexpr size_t WS_YDIR = 593 * MiB, WS_ODIR = 626 * MiB, WS_MIX = 659 * MiB, WS_XW = 692 * MiB, WS_LIST = 758 * MiB, WS_GATE = 761 * MiB, WS_RMAP = 762 * MiB;
constexpr size_t WS_HINS = 763 * MiB, WS_HING = 781 * MiB;
constexpr size_t WS_XB = 763 * MiB, WS_ACT = 911 * MiB, WS_YK = 1059 * MiB, WS_END = 1191 * MiB;

constexpr int RING_OFF = 0, RING_BYTES = 131072;
constexpr int MISC_OFF = RING_BYTES;
constexpr int TAB_OFF = RING_BYTES + 256;
constexpr int RT_OFF = RING_BYTES + 4096;
constexpr int LDS_BYTES = RING_BYTES + 12288;
constexpr int PTAB_OFF = LDS_BYTES - 256;
constexpr int NWAVES = 8;

__device__ __forceinline__ float bf2f(unsigned short b) { return __uint_as_float(((unsigned)b) << 16); }
typedef __bf16 bf16x2_t __attribute__((ext_vector_type(2)));
__device__ __forceinline__ unsigned pk2(float lo, float hi) { const f32x2 v = {lo, hi}; const bf16x2_t b = __builtin_convertvector(v, bf16x2_t); return __builtin_bit_cast(unsigned, b); }
__device__ __forceinline__ unsigned f2bf(float f) { return pk2(f, f) & 0xffffu; }
__device__ __forceinline__ float siluf(float x) { return x * __builtin_amdgcn_rcpf(1.0f + __expf(-x)); }
__device__ __forceinline__ float softplusf(float x) { return x > 20.f ? x : __logf(1.0f + __expf(x)); }
__device__ __forceinline__ float logsigmoidf(float x) { return fminf(x, 0.f) - __logf(1.0f + __expf(-fabsf(x))); }
template <int CTRL> __device__ __forceinline__ float dpp_perm(float x) {
    return __builtin_bit_cast(float, __builtin_amdgcn_mov_dpp(__builtin_bit_cast(int, x), CTRL, 0xf, 0xf, true)); }
template <int CTRL, int ROWMASK, bool BC> __device__ __forceinline__ float dpp_or0(float x) {
    return __builtin_bit_cast(float, __builtin_amdgcn_update_dpp(0, __builtin_bit_cast(int, x), CTRL, ROWMASK, 0xf, BC)); }
__device__ __forceinline__ float row16_allsum(float v) {
    v += dpp_perm<0xB1>(v); v += dpp_perm<0x4E>(v); v += dpp_perm<0x141>(v); v += dpp_perm<0x140>(v); return v; }
__device__ __forceinline__ float sum32(float v) {
    v = row16_allsum(v); const int iv = __builtin_bit_cast(int, v);
    const float s0 = __builtin_bit_cast(float, __builtin_amdgcn_readlane(iv, 0)), s1 = __builtin_bit_cast(float, __builtin_amdgcn_readlane(iv, 16));
    const float s2 = __builtin_bit_cast(float, __builtin_amdgcn_readlane(iv, 32)), s3 = __builtin_bit_cast(float, __builtin_amdgcn_readlane(iv, 48));
    return (threadIdx.x & 32) ? s2 + s3 : s0 + s1; }
__device__ __forceinline__ float wave_sum(float v) {
    v = row16_allsum(v); const int iv = __builtin_bit_cast(int, v);
    return (__builtin_bit_cast(float, __builtin_amdgcn_readlane(iv, 0)) + __builtin_bit_cast(float, __builtin_amdgcn_readlane(iv, 16))) +
           (__builtin_bit_cast(float, __builtin_amdgcn_readlane(iv, 32)) + __builtin_bit_cast(float, __builtin_amdgcn_readlane(iv, 48))); }
__device__ __forceinline__ float wave_scan(float x, int lane, bool rev) {
    float v = x;
    v += dpp_or0<0x111, 0xf, true>(v); v += dpp_or0<0x112, 0xf, true>(v); v += dpp_or0<0x114, 0xf, true>(v); v += dpp_or0<0x118, 0xf, true>(v);
    v += dpp_or0<0x142, 0xa, false>(v);
    v += dpp_or0<0x143, 0xc, false>(v);
    if (!rev) return v;
    const float tot = __builtin_bit_cast(float, __builtin_amdgcn_readlane(__builtin_bit_cast(int, v), 63));
    return (tot - v) + x;
}
__device__ __forceinline__ void unpack8(const u32x4 w, float (&f)[8]) {
    f[0] = __uint_as_float(w.x << 16); f[1] = __uint_as_float(w.x & 0xffff0000u); f[2] = __uint_as_float(w.y << 16); f[3] = __uint_as_float(w.y & 0xffff0000u);
    f[4] = __uint_as_float(w.z << 16); f[5] = __uint_as_float(w.z & 0xffff0000u); f[6] = __uint_as_float(w.w << 16); f[7] = __uint_as_float(w.w & 0xffff0000u);
}
__device__ __forceinline__ u32x4 pack8(const float (&f)[8]) { u32x4 w; w.x = pk2(f[0], f[1]); w.y = pk2(f[2], f[3]); w.z = pk2(f[4], f[5]); w.w = pk2(f[6], f[7]); return w; }
#define LDS_WAIT() asm volatile("s_waitcnt lgkmcnt(0)" ::: "memory")
#define LDS_BARRIER() asm volatile("s_waitcnt lgkmcnt(0)\n\ts_barrier" ::: "memory")
__device__ __forceinline__ int fresh_tid() { int t = threadIdx.x; asm volatile("" : "+v"(t)); return t; }

namespace pg8 {
#define PG8_LAS __attribute__((address_space(3)))
constexpr int BM = 256, BK = 64, HALF = 128, HTB = HALF * BK * 2, STAGE_BYTES = 8 * HTB, NXCD = 8, WGM = 8;
__host__ __device__ __forceinline__ int lds_byte(int r, int c) { const int st = (r >> 4) * 2 + (c >> 5), rr = r & 15, cc = c & 31, ob = rr * 64 + cc * 2; return st * 1024 + (ob ^ (((ob >> 9) & 1) << 5)); }
__host__ __device__ __forceinline__ void stage_rc(int b, int& R, int& C) { const int st = b / 1024, sb = b % 1024, swz = sb ^ (((sb >> 9) & 1) << 5); R = (st >> 1) * 16 + swz / 64; C = (st & 1) * 32 + (swz % 64) / 2; }
__host__ __device__ __forceinline__ int perm32(int rho) { const int n = rho >> 4, i = rho & 15; return 8 * (i >> 2) + 4 * n + (i & 3); }

struct Unit { int pm, pn, e; };
struct Gemm { const bf16_t* A; const bf16_t* Bt; int M, N, K; size_t estride; };

struct StaticOrder {
    static constexpr bool GATHER = false;
    int nM, nN, nwg, G, c;
    __host__ __device__ void init(int M, int N, int G_, int c_) { nM = M / BM; nN = N / BM; nwg = nM * nN; G = G_; c = c_; }
    __host__ __device__ bool next(int i, Unit& u) const {
        const long L = (long)i * G + c; if (L >= nwg) return false;
        int wgid = (int)L; { const int q = nwg / NXCD, r = nwg % NXCD, xcd = wgid % NXCD, off = wgid / NXCD; wgid = (xcd < r ? xcd * (q + 1) : r * (q + 1) + (xcd - r) * q) + off; }
        const int nig = WGM * nN, gid = wgid / nig, fm = gid * WGM, gsz = (nM - fm) < WGM ? (nM - fm) : WGM;
        u.pm = fm + ((wgid % nig) % gsz); u.pn = (wgid % nig) / gsz; u.e = 0; return true;
    }
    __device__ __forceinline__ const int* row_src(const Unit&, int) const { return nullptr; }
    __device__ __forceinline__ void a_ready(const Unit&) const {}
    __device__ __forceinline__ void done(const Unit&) const {}
};
template <bool GATHER_> struct MoeOrderT {
    static constexpr bool GATHER = GATHER_;
    const PG8_LAS int* tile_e; const PG8_LAS int* pstart; const PG8_LAS int* cntl; const int* list; int nrt, nN, lgN, G, cv;
    __device__ __forceinline__ bool next(int i, Unit& u) const {
        const int L = i * G + cv; if (L >= nrt * nN) return false;
        const int rt = L >> lgN; u.pm = rt; u.pn = L & (nN - 1); u.e = __builtin_amdgcn_readfirstlane(tile_e[rt]); return true;
    }
    __device__ __forceinline__ const int* row_src(const Unit& u, int r) const {
        const int ps = pstart[u.e], c = cntl[u.e]; int pos = u.pm * BM + r - ps; pos = pos < c ? pos : c - 1;
        return list + (size_t)u.e * LISTCAP + pos;
    }
    __device__ __forceinline__ int row_tok4(const Unit& u, int r) const {
        const int ps = pstart[u.e], c = cntl[u.e]; const int pos = u.pm * BM + r - ps;
        return pos < c ? list[(size_t)u.e * LISTCAP + pos] : -1;
    }
    __device__ __forceinline__ void a_ready(const Unit&) const {}
    __device__ __forceinline__ void done(const Unit&) const {}
};

__device__ __forceinline__ unsigned cvt_pk_bf16(float lo, float hi) { unsigned r; asm volatile("v_cvt_pk_bf16_f32 %0, %1, %2" : "=v"(r) : "v"(lo), "v"(hi)); return r; }

struct NoPre {};
struct EpiBf16 {
    static constexpr bool PERM = true, AFTER_DRAIN = false;
    typedef NoPre Pre; __device__ __forceinline__ void prefetch(Pre&, const Unit&, int, int, int, int) const {}
    bf16_t* O; int ldc;
    const float* ropet; int rope_pm;
    __device__ __forceinline__ void operator()(const f32x4 (&acc)[2][2][4][2], const Unit& u, int wr, int wc, int fr, int fq, const Pre&) const {
        const int row0 = u.pm * BM + wr * 64 + fr, col0 = u.pn * BM + wc * 32 + 8 * fq;
        if (ropet != nullptr && u.pn < 4 && u.pm < rope_pm) {
            const int t_ = fresh_tid(), fr_ = t_ & 15, fq_ = (t_ >> 4) & 3; const bool hiL = fq_ >= 2; const int half = wc & 1;
#pragma unroll
            for (int ai = 0; ai < 2; ++ai)
#pragma unroll
                for (int m = 0; m < 4; ++m) { const int row = u.pm * BM + wr * 64 + fr_ + ai * HALF + m * 16, sq = row & (SEQ - 1), pos = half ? (sq & 63) : (sq >> 6);
                    const f32x4* tp = (const f32x4*)(ropet + (size_t)(pos * 16 + 8 * (fq_ & 1)) * 2);
                    f32x4 cs[4];
#pragma unroll
                    for (int q = 0; q < 4; ++q) cs[q] = tp[q];
                    float A[8], B[8];
#pragma unroll
                    for (int i = 0; i < 8; ++i) { const float c = cs[i >> 1][(i & 1) * 2], sn = cs[i >> 1][(i & 1) * 2 + 1]; A[i] = hiL ? sn : c; B[i] = hiL ? c : -sn; }
                    bf16_t* rowp = O + (size_t)row * ldc + u.pn * BM + wc * 32 + 8 * fq_;
#pragma unroll
                    for (int bj = 0; bj < 2; ++bj) { float o8[8];
#pragma unroll
                        for (int i = 0; i < 8; ++i) { const float v = acc[ai][bj][m][i >> 2][i & 3];
                            auto r = __builtin_amdgcn_permlane32_swap(__float_as_uint(v), __float_as_uint(v), false, false);
                            o8[i] = __uint_as_float(r[0]) * A[i] + __uint_as_float(r[1]) * B[i]; }
                        u32x4 w; w.x = cvt_pk_bf16(o8[0], o8[1]); w.y = cvt_pk_bf16(o8[2], o8[3]); w.z = cvt_pk_bf16(o8[4], o8[5]); w.w = cvt_pk_bf16(o8[6], o8[7]);
                        *(u32x4*)(rowp + bj * HALF) = w; } }
            return; }
#pragma unroll
        for (int ai = 0; ai < 2; ++ai)
#pragma unroll
            for (int m = 0; m < 4; ++m) { bf16_t* rowp = O + (size_t)(row0 + ai * HALF + m * 16) * ldc + col0;
#pragma unroll
                for (int bj = 0; bj < 2; ++bj) { const f32x4 v0 = acc[ai][bj][m][0], v1 = acc[ai][bj][m][1];
                    u32x4 w; w.x = cvt_pk_bf16(v0[0], v0[1]); w.y = cvt_pk_bf16(v0[2], v0[3]); w.z = cvt_pk_bf16(v1[0], v1[1]); w.w = cvt_pk_bf16(v1[2], v1[3]);
                    *(u32x4*)(rowp + bj * HALF) = w; } }
    }
};
struct EpiRes {
    static constexpr bool PERM = false, AFTER_DRAIN = false;
    typedef NoPre Pre; __device__ __forceinline__ void prefetch(Pre&, const Unit&, int, int, int, int) const {}
    const float* baseL; const float* baseC; const bf16_t* baseB; bf16_t* out; const float* gate; int gstride;
    __device__ __forceinline__ void operator()(const f32x4 (&acc)[2][2][4][2], const Unit& u, int wr, int wc, int fr, int fq, const Pre&) const {
        const int rowt = u.pm * BM; const int bidx = rowt < SEQ ? 0 : (rowt < TLAT ? 1 : 2);
        const float* base = rowt < TLAT ? baseL + (size_t)rowt * DM : baseC + (size_t)(rowt - TLAT) * DM;
        const int t_ = fresh_tid(), fr_ = t_ & 15, fq_ = (t_ >> 4) & 3;
        (void)fr; (void)fq;
        const int rl = wr * 64 + fr_, col0 = u.pn * BM + wc * 32 + 4 * fq_;
        const float* gp = gate + (size_t)bidx * gstride + col0;
        f32x4 gv[2][2];
#pragma unroll
        for (int bj = 0; bj < 2; ++bj)
#pragma unroll
            for (int n = 0; n < 2; ++n) gv[bj][n] = *(const f32x4*)(gp + bj * HALF + n * 16);
        if (baseB) {
#pragma unroll
            for (int ai = 0; ai < 2; ++ai)
#pragma unroll
                for (int mp = 0; mp < 2; ++mp) { u32x2 bw[2][2][2];
#pragma unroll
                    for (int mm = 0; mm < 2; ++mm)
#pragma unroll
                        for (int bj = 0; bj < 2; ++bj)
#pragma unroll
                            for (int n = 0; n < 2; ++n) bw[mm][bj][n] = *(const u32x2*)(baseB + (size_t)rowt * DM + (size_t)(rl + ai * HALF + (2 * mp + mm) * 16) * DM + col0 + bj * HALF + n * 16);
                    __builtin_amdgcn_sched_barrier(0);
#pragma unroll
                    for (int mm = 0; mm < 2; ++mm) { const int m = 2 * mp + mm; bf16_t* op = out + (size_t)rowt * DM + (size_t)(rl + ai * HALF + m * 16) * DM + col0;
#pragma unroll
                        for (int bj = 0; bj < 2; ++bj)
#pragma unroll
                            for (int n = 0; n < 2; ++n) { const u32x2 w = bw[mm][bj][n];
                                const f32x4 bs = (f32x4){__uint_as_float(w.x << 16), __uint_as_float(w.x & 0xffff0000u), __uint_as_float(w.y << 16), __uint_as_float(w.y & 0xffff0000u)};
                                const f32x4 v = bs + gv[bj][n] * acc[ai][bj][m][n];
                                u32x2 o; o.x = cvt_pk_bf16(v[0], v[1]); o.y = cvt_pk_bf16(v[2], v[3]); *(u32x2*)(op + bj * HALF + n * 16) = o; } } }
        } else {
#pragma unroll
            for (int ai = 0; ai < 2; ++ai)
#pragma unroll
                for (int m = 0; m < 4; ++m) { f32x4 bf[2][2];
#pragma unroll
                    for (int bj = 0; bj < 2; ++bj)
#pragma unroll
                        for (int n = 0; n < 2; ++n) bf[bj][n] = *(const f32x4*)(base + (size_t)(rl + ai * HALF + m * 16) * DM + col0 + bj * HALF + n * 16);
                    __builtin_amdgcn_sched_barrier(0);
                    bf16_t* op = out + (size_t)rowt * DM + (size_t)(rl + ai * HALF + m * 16) * DM + col0;
#pragma unroll
                    for (int bj = 0; bj < 2; ++bj)
#pragma unroll
                        for (int n = 0; n < 2; ++n) { const f32x4 v = bf[bj][n] + gv[bj][n] * acc[ai][bj][m][n];
                            u32x2 o; o.x = cvt_pk_bf16(v[0], v[1]); o.y = cvt_pk_bf16(v[2], v[3]); *(u32x2*)(op + bj * HALF + n * 16) = o; } }
        }
    }
};
struct EpiAct {
    static constexpr bool PERM = true, AFTER_DRAIN = false;
    bf16_t* O; const float* bias;
    struct Pre { f32x4 b[4]; };
    __device__ __forceinline__ void prefetch(Pre& p, const Unit& u, int wr, int wc, int fr, int fq) const {
        const float* bp = bias + (size_t)u.e * 2048 + u.pn * HALF + wc * 32 + 8 * fq;
        p.b[0] = *(const f32x4*)(bp); p.b[1] = *(const f32x4*)(bp + 4); p.b[2] = *(const f32x4*)(bp + 1024); p.b[3] = *(const f32x4*)(bp + 1028); }
    __device__ __forceinline__ void operator()(const f32x4 (&acc)[2][2][4][2], const Unit& u, int wr, int wc, int fr, int fq, const Pre& p) const {
        const int row0 = u.pm * BM + wr * 64 + fr, col0 = u.pn * HALF + wc * 32 + 8 * fq;
        const f32x4 bg0 = p.b[0], bg1 = p.b[1], bl0 = p.b[2] + 1.0f, bl1 = p.b[3] + 1.0f;
#pragma unroll
        for (int ai = 0; ai < 2; ++ai)
#pragma unroll
            for (int m = 0; m < 4; ++m) { bf16_t* rowp = O + (size_t)(row0 + ai * HALF + m * 16) * DE + col0;
                float a[8];
#pragma unroll
                for (int n = 0; n < 2; ++n) { const f32x4 g = acc[ai][0][m][n] + (n ? bg1 : bg0), li = acc[ai][1][m][n] + (n ? bl1 : bl0);
#pragma unroll
                    for (int j = 0; j < 4; ++j) { const float gl = fminf(g[j], 7.0f), ln1 = __builtin_amdgcn_fmed3f(li[j], -6.0f, 8.0f); a[n * 4 + j] = gl * __builtin_amdgcn_rcpf(1.0f + __builtin_amdgcn_exp2f(-1.702f * 1.4426950408889634f * gl)) * ln1; } }
                u32x4 w; w.x = cvt_pk_bf16(a[0], a[1]); w.y = cvt_pk_bf16(a[2], a[3]); w.z = cvt_pk_bf16(a[4], a[5]); w.w = cvt_pk_bf16(a[6], a[7]);
                *(u32x4*)rowp = w; }
    }
};
struct EpiDown {
    static constexpr bool PERM = true, AFTER_DRAIN = false;
    bf16_t* Y; const float* bias; const MoeOrderT<false>* S; const float* gatev;
    struct Pre { int t4[8]; };
    __device__ __forceinline__ void prefetch(Pre& p, const Unit& u, int wr, int wc, int fr, int fq) const {
#pragma unroll
        for (int i = 0; i < 8; ++i) p.t4[i] = S->row_tok4(u, wr * 64 + fr + (i >> 2) * HALF + (i & 3) * 16); }
    __device__ __forceinline__ void operator()(const f32x4 (&acc)[2][2][4][2], const Unit& u, int wr, int wc, int fr, int fq, const Pre& p) const {
        const int row0 = u.pm * BM + wr * 64 + fr, col0 = u.pn * BM + wc * 32 + 8 * fq;
        const float* bp = bias + (size_t)u.e * DM + col0;
        f32x4 bv[2][2];
#pragma unroll
        for (int bj = 0; bj < 2; ++bj) { bv[bj][0] = *(const f32x4*)(bp + bj * HALF); bv[bj][1] = *(const f32x4*)(bp + bj * HALF + 4); }
        int t4[8]; float gt[8];
#pragma unroll
        for (int i = 0; i < 8; ++i) t4[i] = p.t4[i];
#pragma unroll
        for (int i = 0; i < 8; ++i) gt[i] = gatev[t4[i] >= 0 ? t4[i] : 0];
#pragma unroll
        for (int ai = 0; ai < 2; ++ai)
#pragma unroll
            for (int m = 0; m < 4; ++m) { const int tok4 = t4[ai * 4 + m];
                if (tok4 >= 0) { const float g1 = gt[ai * 4 + m]; bf16_t* rowp = Y + (size_t)tok4 * DM + col0;
#pragma unroll
                    for (int bj = 0; bj < 2; ++bj) { const f32x4 v0 = (acc[ai][bj][m][0] + bv[bj][0]) * g1, v1 = (acc[ai][bj][m][1] + bv[bj][1]) * g1;
                        u32x4 w; w.x = cvt_pk_bf16(v0[0], v0[1]); w.y = cvt_pk_bf16(v0[2], v0[3]); w.z = cvt_pk_bf16(v1[0], v1[1]); w.w = cvt_pk_bf16(v1[2], v1[3]);
                        *(u32x4*)(rowp + bj * HALF) = w; } } }
    }
};

template <class Epi, class Sched, bool ALIGN_EPI = false, bool SP2 = false>
__device__ __forceinline__ void gemm_phase(PG8_LAS unsigned char* lds, const Gemm g, const Sched& S, const Epi& E) {
    const int tid = fresh_tid(), wid = __builtin_amdgcn_readfirstlane(tid >> 6), lane = tid & 63, wr = wid >> 2, wc = wid & 3, fr = lane & 15, fq = lane >> 4;
    const int K = g.K, nt = K / BK;
    unsigned voffA[2], voffB[2];
#pragma unroll
    for (int i = 0; i < 2; ++i) { int R, C; stage_rc(tid * 16 + i * 8192, R, C); const int Rb = Epi::PERM ? ((R & ~31) + perm32(R & 31)) : R;
        voffA[i] = (unsigned)(R * K + C) * 2u; voffB[i] = (unsigned)(Rb * K + C) * 2u; }
    unsigned Rr[2], Cb2[2];
#pragma unroll
    for (int i = 0; i < 2; ++i) { int R, C; stage_rc(tid * 16 + i * 8192, R, C); Rr[i] = (unsigned)R; Cb2[i] = (unsigned)C * 2u; }
    unsigned tC4[2][2], tN4[2][2];
    const size_t kstep = (size_t)(BK * 2);
    const size_t hstep = (size_t)HALF * K * 2;
    const size_t tstep = 2 * hstep;
    const unsigned ldsw = (unsigned)wid * 1024u;
    const int aoff = lds_byte(wr * 64 + fr, fq * 8), boff = lds_byte(wc * 32 + fr, fq * 8);
#define PG8_SA(b, h) (((b) * 2 + (h)) * HTB)
#define PG8_SB(b, h) ((4 + (b) * 2 + (h)) * HTB)
#define PG8_STAGE(bufoff, gbase, voff) do { _Pragma("unroll") for (int _i = 0; _i < 2; ++_i) \
        __builtin_amdgcn_global_load_lds((const unsigned*)((const char*)(gbase) + (voff)[_i]), (PG8_LAS unsigned*)(lds + (bufoff) + ldsw + _i * 8192), 16, 0, 0); } while (0)
#define PG8_STAGE_A(bufoff, kbyte, h, isnext) do { if constexpr (Sched::GATHER) { unsigned vo_[2]; _Pragma("unroll") for (int _i = 0; _i < 2; ++_i) { asm volatile("" : "+v"(tN4[h][_i])); \
            const unsigned t4_ = (isnext) ? tN4[h][_i] : tC4[h][_i]; vo_[_i] = (t4_ >> 2) * (unsigned)(K * 2) + Cb2[_i]; } PG8_STAGE(bufoff, (const char*)g.A + (kbyte), vo_); } \
        else { PG8_STAGE(bufoff, ((isnext) ? nA : cA) + (kbyte) + (h) * hstep, voffA); } } while (0)
#define PG8_LOOKUP(dst, unit) do { _Pragma("unroll") for (int _h = 0; _h < 2; ++_h) _Pragma("unroll") for (int _i = 0; _i < 2; ++_i) { const int* p_ = S.row_src(unit, _h * HALF + (int)Rr[_i]); \
        asm volatile("global_load_dword %0, %1, off" : "=v"(dst[_h][_i]) : "v"(p_) : "memory"); } } while (0)
#define PG8_LDA(dst, b, h) do { _Pragma("unroll") for (int m = 0; m < 4; ++m) _Pragma("unroll") for (int k = 0; k < 2; ++k) dst[m][k] = *(const PG8_LAS bf16x8*)(lds + PG8_SA(b, h) + aoff + m * 2048 + k * 1024); } while (0)
#define PG8_LDB(dst, b, h) do { _Pragma("unroll") for (int n = 0; n < 2; ++n) _Pragma("unroll") for (int k = 0; k < 2; ++k) dst[n][k] = *(const PG8_LAS bf16x8*)(lds + PG8_SB(b, h) + boff + n * 2048 + k * 1024); } while (0)
#define PG8_MMA(ai, bj, At, Bt) do { __builtin_amdgcn_s_setprio(1); _Pragma("unroll") for (int m = 0; m < 4; ++m) _Pragma("unroll") for (int n = 0; n < 2; ++n) _Pragma("unroll") for (int k = 0; k < 2; ++k) \
        acc[ai][bj][m][n] = __builtin_amdgcn_mfma_f32_16x16x32_bf16(Bt[n][k], At[m][k], acc[ai][bj][m][n], 0, 0, 0); __builtin_amdgcn_s_setprio(0); } while (0)
#define PG8_WAIT_V(n) asm volatile("s_waitcnt vmcnt(" #n ")" ::: "memory")
#define PG8_WAIT_L(n) asm volatile("s_waitcnt lgkmcnt(" #n ")" ::: "memory")
#define PG8_BAR __builtin_amdgcn_s_barrier()
#define PG8_SCHED __builtin_amdgcn_sched_barrier(0)
    Unit cur, nxt; int ui = 0;
    if (!S.next(0, cur)) return;
    f32x4 acc[2][2][4][2];
#pragma unroll
    for (int a = 0; a < 2; ++a)
#pragma unroll
        for (int b = 0; b < 2; ++b)
#pragma unroll
            for (int m = 0; m < 4; ++m)
#pragma unroll
                for (int n = 0; n < 2; ++n) acc[a][b][m][n] = (f32x4){0.f, 0.f, 0.f, 0.f};
    bf16x8 At[4][2], B0[2][2], B1[2][2];
    const char* cA = (const char*)g.A + (size_t)cur.pm * tstep; const char* cB = (const char*)g.Bt + (size_t)cur.e * g.estride + (size_t)cur.pn * tstep;
    S.a_ready(cur);
    static_assert(SP2, "only the two-super-phase K-loop is kept in this file");
    const char* nA = cA;
    if constexpr (Sched::GATHER) { PG8_LOOKUP(tC4, cur); asm volatile("s_waitcnt vmcnt(0)" ::: "memory");
#pragma unroll
        for (int _h = 0; _h < 2; ++_h)
#pragma unroll
            for (int _i = 0; _i < 2; ++_i) { asm volatile("" : "+v"(tC4[_h][_i])); tN4[_h][_i] = tC4[_h][_i]; } }
    {
        PG8_STAGE(PG8_SB(0, 0), cB, voffB); PG8_STAGE(PG8_SB(0, 1), cB + hstep, voffB); PG8_STAGE_A(PG8_SA(0, 0), 0, 0, false); PG8_STAGE_A(PG8_SA(0, 1), 0, 1, false);
        if (wr == 1) PG8_BAR;
        PG8_WAIT_V(2); PG8_BAR;
        PG8_STAGE(PG8_SB(1, 0), cB + kstep, voffB); PG8_STAGE_A(PG8_SA(1, 0), kstep, 0, false); PG8_STAGE(PG8_SB(1, 1), cB + hstep + kstep, voffB);
        PG8_WAIT_V(6); PG8_BAR;
    }
    for (;;) {
        const bool has_next = S.next(ui + 1, nxt);
        nA = has_next ? (const char*)g.A + (size_t)nxt.pm * tstep : cA; const char* nB = has_next ? (const char*)g.Bt + (size_t)nxt.e * g.estride + (size_t)nxt.pn * tstep : cB;
        if constexpr (Sched::GATHER) { if (has_next) PG8_LOOKUP(tN4, nxt); }
        typename Epi::Pre pre; E.prefetch(pre, cur, wr, wc, fr, fq);
        for (int t = 0; t < nt; t += 2) {
            const bool last = (t == nt - 2);
            const size_t k1 = (size_t)(t + 1) * kstep, k2 = last ? 0 : (size_t)(t + 2) * kstep, k3 = k2 + kstep;
            const char* b2 = (last ? nB : cB) + k2; const char* b3 = b2 + kstep;
            if (last && has_next) S.a_ready(nxt);
            PG8_LDB(B0, 0, 0); PG8_LDB(B1, 0, 1); PG8_SCHED; PG8_LDA(At, 0, 0); PG8_STAGE_A(PG8_SA(1, 1), k1, 1, false);
            PG8_WAIT_V(8); PG8_WAIT_L(0); PG8_BAR; PG8_MMA(0, 0, At, B0); PG8_MMA(0, 1, At, B1); PG8_BAR; PG8_SCHED;
            PG8_LDA(At, 0, 1); PG8_STAGE(PG8_SB(0, 0), b2, voffB); PG8_STAGE(PG8_SB(0, 1), b2 + hstep, voffB); PG8_STAGE_A(PG8_SA(0, 0), k2, 0, last);
            PG8_WAIT_V(8); PG8_WAIT_L(0); PG8_BAR; PG8_MMA(1, 0, At, B0); PG8_MMA(1, 1, At, B1); PG8_BAR; PG8_SCHED;
            PG8_LDB(B0, 1, 0); PG8_LDB(B1, 1, 1); PG8_SCHED; PG8_LDA(At, 1, 0); PG8_STAGE_A(PG8_SA(0, 1), k2, 1, last);
            PG8_WAIT_V(8); PG8_WAIT_L(0); PG8_BAR; PG8_MMA(0, 0, At, B0); PG8_MMA(0, 1, At, B1); PG8_BAR; PG8_SCHED;
            PG8_LDA(At, 1, 1); PG8_STAGE(PG8_SB(1, 0), b3, voffB); PG8_STAGE(PG8_SB(1, 1), b3 + hstep, voffB); PG8_STAGE_A(PG8_SA(1, 0), k3, 0, last);
            PG8_WAIT_V(8); PG8_WAIT_L(0); PG8_BAR; PG8_MMA(1, 0, At, B0); PG8_MMA(1, 1, At, B1); PG8_BAR; PG8_SCHED;
        }
        if constexpr (ALIGN_EPI) { if (wr == 0) PG8_BAR; }
        if constexpr (!Epi::AFTER_DRAIN) { E(acc, cur, wr, wc, fr, fq, pre); S.done(cur); }
        if (!has_next) break;
#pragma unroll
        for (int a = 0; a < 2; ++a)
#pragma unroll
            for (int b = 0; b < 2; ++b)
#pragma unroll
                for (int m = 0; m < 4; ++m)
#pragma unroll
                    for (int n = 0; n < 2; ++n) acc[a][b][m][n] = (f32x4){0.f, 0.f, 0.f, 0.f};
        cur = nxt; cA = nA; cB = nB; ++ui;
        if constexpr (Sched::GATHER) {
#pragma unroll
            for (int _h = 0; _h < 2; ++_h)
#pragma unroll
                for (int _i = 0; _i < 2; ++_i) tC4[_h][_i] = tN4[_h][_i]; }
        if constexpr (ALIGN_EPI) { if (wr == 1) PG8_BAR; }
    }
    PG8_WAIT_V(0);
    if constexpr (!ALIGN_EPI) { if (wr == 0) PG8_BAR; }
    PG8_BAR;
#undef PG8_SA
#undef PG8_SB
#undef PG8_STAGE
#undef PG8_STAGE_A
#undef PG8_LOOKUP
#undef PG8_LDA
#undef PG8_LDB
#undef PG8_MMA
#undef PG8_WAIT_V
#undef PG8_WAIT_L
#undef PG8_BAR
#undef PG8_SCHED
}
}

namespace att {
constexpr float SCALE = 0.125f;
constexpr int SHM_V = 64 * 128 * 2, SHM_K = 64 * 128 * 2;
#define KSWZ(row, colB) ((row) * 256 + ((colB) ^ (((row) & 7) << 4)))
#define SBAR() __builtin_amdgcn_sched_barrier(0)
__device__ __forceinline__ int crow(int r, int hi) { return (r & 3) + 8 * (r >> 2) + 4 * hi; }
__device__ __forceinline__ unsigned cvtpk(float lo, float hi) { unsigned r; asm volatile("v_cvt_pk_bf16_f32 %0, %1, %2" : "=v"(r) : "v"(lo), "v"(hi)); return r; }
__device__ __forceinline__ bf16x8 ld8(const bf16_t* p) { return *reinterpret_cast<const bf16x8*>(p); }

__device__ __forceinline__ void partialSM(f32x16& p0) {
#pragma unroll
    for (int r = 0; r < 16; ++r) p0[r] = __builtin_amdgcn_exp2f(p0[r]);
}
__device__ __forceinline__ void finishSM(f32x16& p0, f32x16& p1, float& l_reg, bf16x8& pa0, bf16x8& pa1, bf16x8& pa2, bf16x8& pa3) {
#pragma unroll
    for (int r = 0; r < 16; ++r) p1[r] = __builtin_amdgcn_exp2f(p1[r]);
    float ps = 0;
#pragma unroll
    for (int r = 0; r < 16; ++r) ps += p0[r];
#pragma unroll
    for (int r = 0; r < 16; ++r) ps += p1[r];
    l_reg += ps;
#define PK4(P, BASE, OUT) do { u32x4 w = {cvtpk(P[BASE + 0], P[BASE + 1]), cvtpk(P[BASE + 2], P[BASE + 3]), cvtpk(P[BASE + 4], P[BASE + 5]), cvtpk(P[BASE + 6], P[BASE + 7])}; \
    OUT = *reinterpret_cast<bf16x8*>(&w); } while (0)
    PK4(p0, 0, pa0); PK4(p0, 8, pa1); PK4(p1, 0, pa2); PK4(p1, 8, pa3);
#undef PK4
}
__device__ __forceinline__ void qkt(f32x16& p0, f32x16& p1, const char* Ks, const bf16x8* qr, int r32, int hi, int mp, float nm) {
#pragma unroll
    for (int r = 0; r < 16; ++r) { p0[r] = nm; p1[r] = nm; }
    bf16x8 b0n, b1n;
    { const int cb = ((mp * 4 + 0) * 16 + hi * 8) * 2; b0n = *reinterpret_cast<const bf16x8*>(Ks + KSWZ(r32, cb)); b1n = *reinterpret_cast<const bf16x8*>(Ks + KSWZ(32 + r32, cb)); }
#pragma unroll
    for (int d0 = 0; d0 < 4; ++d0) { const bf16x8 b0 = b0n, b1 = b1n;
        if (d0 < 3) { const int cb = ((mp * 4 + d0 + 1) * 16 + hi * 8) * 2; b0n = *reinterpret_cast<const bf16x8*>(Ks + KSWZ(r32, cb)); b1n = *reinterpret_cast<const bf16x8*>(Ks + KSWZ(32 + r32, cb)); }
        __builtin_amdgcn_sched_barrier(0);
        p0 = __builtin_amdgcn_mfma_f32_32x32x16_bf16(b0, qr[d0], p0, 0, 0, 0);
        p1 = __builtin_amdgcn_mfma_f32_32x32x16_bf16(b1, qr[d0], p1, 0, 0, 0); }
}
__device__ __forceinline__ int v_st(int k, int c) { const int kk = k; return ((kk >> 3) * 4 + (c >> 5)) * 512 + ((kk & 7) * 32 + (c & 31)) * 2; }
__device__ __forceinline__ int v_rd_base(int lane) { return ((lane & 3) << 3) | (((lane >> 2) & 3) << 6) | (((lane >> 4) & 1) << 5) | (((lane >> 5) & 1) << 8); }
constexpr int v_rd_off(int d0, int ks, int half) { return d0 * 512 + ks * 4096 + half * 2048; }
template <int OFF> __device__ __forceinline__ s16x4 tr_read(int vb) {
    s16x4 r; asm volatile("ds_read_b64_tr_b16 %0, %1 offset:%2" : "=&v"(r) : "v"(vb), "i"(OFF) : "memory"); return r;
}
template <int D0, bool EXPS> __device__ __forceinline__ void pv_one(f32x16& od, int vb, bf16x8 pa0, bf16x8 pa1, bf16x8 pa2, bf16x8 pa3, f32x16& pn) {
    const s16x4 l0 = tr_read<v_rd_off(D0, 0, 0)>(vb), h0 = tr_read<v_rd_off(D0, 0, 1)>(vb), l1 = tr_read<v_rd_off(D0, 1, 0)>(vb), h1 = tr_read<v_rd_off(D0, 1, 1)>(vb);
    const s16x4 l2 = tr_read<v_rd_off(D0, 2, 0)>(vb), h2 = tr_read<v_rd_off(D0, 2, 1)>(vb), l3 = tr_read<v_rd_off(D0, 3, 0)>(vb), h3 = tr_read<v_rd_off(D0, 3, 1)>(vb);
    asm volatile("s_waitcnt lgkmcnt(0)" ::: "memory"); SBAR();
#define PK(L, H) (bf16x8){L[0], L[1], L[2], L[3], H[0], H[1], H[2], H[3]}
    od = __builtin_amdgcn_mfma_f32_32x32x16_bf16(pa0, PK(l0, h0), od, 0, 0, 0);
    od = __builtin_amdgcn_mfma_f32_32x32x16_bf16(pa1, PK(l1, h1), od, 0, 0, 0);
    od = __builtin_amdgcn_mfma_f32_32x32x16_bf16(pa2, PK(l2, h2), od, 0, 0, 0);
    od = __builtin_amdgcn_mfma_f32_32x32x16_bf16(pa3, PK(l3, h3), od, 0, 0, 0);
#undef PK
    if constexpr (EXPS) {
#pragma unroll
        for (int r = 4 * D0; r < 4 * D0 + 4; ++r) pn[r] = __builtin_amdgcn_exp2f(pn[r]); }
}
template <bool EXPS> __device__ __forceinline__ void pv_d0(f32x16* o, int vb, bf16x8 pa0, bf16x8 pa1, bf16x8 pa2, bf16x8 pa3, f32x16& pn) {
    pv_one<0, EXPS>(o[0], vb, pa0, pa1, pa2, pa3, pn); pv_one<1, EXPS>(o[1], vb, pa0, pa1, pa2, pa3, pn); pv_one<2, EXPS>(o[2], vb, pa0, pa1, pa2, pa3, pn); pv_one<3, EXPS>(o[3], vb, pa0, pa1, pa2, pa3, pn);
}

__device__ __forceinline__ void attn_unit(const bf16_t* __restrict__ proj, bf16_t* __restrict__ mix, const float* __restrict__ subw, float lam, float osc,
                                          const unsigned* __restrict__ kmax2, int b, int h, int qrow0, int nkeys, char* lds) {
    const int tid = fresh_tid(), wid = tid >> 6, lane = tid & 63, r32 = lane & 31, hi = lane >> 5, mp = wid >> 2, wq = wid & 3;
    constexpr int SLOT = SHM_V + SHM_K;
    float* ws = (float*)(lds + 3 * SLOT) + wid * 64; float* li_l = ws;
    float l_reg = 0; f32x16 o[4] = {}; bf16x8 qr[4];
    const int wu = __builtin_amdgcn_readfirstlane(wid);
    unsigned offV[2], offK[2];
#pragma unroll
    for (int q = 0; q < 2; ++q) { const int pc = 2 * wu + q;
        { const int key = 8 * (pc >> 1) + ((lane >> 2) & 7), col = 32 * (2 * (pc & 1) + (lane >> 5)) + (lane & 3) * 8; offV[q] = (unsigned)(key * INWP + col + C_V); }
        { const int row = 4 * pc + (lane >> 4), col = ((lane & 15) ^ (row & 7)) * 8; offK[q] = (unsigned)(row * INWP + col + C_K); } }
    const int vb0 = (int)(uintptr_t)lds + v_rd_base(lane);
    LAS unsigned char* lds3 = (LAS unsigned char*)(unsigned)(uintptr_t)lds;
    const int ctx_row0 = TLAT + b * LCTX, lat_row0 = b * SEQ - LCTX;
#define DMA_TILE(k0, so) do { const bf16_t* tb_ = proj + (size_t)((k0) < LCTX ? ctx_row0 + (k0) : lat_row0 + (k0)) * INWP + h * 128; \
    _Pragma("unroll") for (int q_ = 0; q_ < 2; ++q_) { \
        __builtin_amdgcn_global_load_lds((const unsigned*)(tb_ + offV[q_]), (LAS unsigned*)(lds3 + (so) + (2 * wu + q_) * 1024), 16, 0, 0); \
        __builtin_amdgcn_global_load_lds((const unsigned*)(tb_ + offK[q_]), (LAS unsigned*)(lds3 + (so) + SHM_V + (2 * wu + q_) * 1024), 16, 0, 0); } } while (0)
    f32x16 pA0, pA1, pB0, pB1; bf16x8 pa0, pa1, pa2, pa3; const int NT = nkeys / 64;
    int sl_prev = 0, sl_cur = 0, sl_next = SLOT;
#define ROT() do { sl_prev = sl_cur; sl_cur = sl_next; sl_next = (sl_next == 2 * SLOT) ? 0 : sl_next + SLOT; } while (0)
    DMA_TILE(0, 0); DMA_TILE(64, SLOT);
    const bf16_t* Qw = proj + (size_t)(qrow0 + wq * 32 + r32) * INWP + C_Q + h * 128 + mp * 64 + hi * 8;
    float qss = 0.f;
    bf16x8 qraw[4];
#pragma unroll
    for (int d0 = 0; d0 < 4; ++d0) qraw[d0] = ld8(Qw + d0 * 16);
    const float km2 = __uint_as_float(kmax2[h * 2 + mp]);
    __builtin_amdgcn_sched_barrier(0);
#pragma unroll
    for (int d0 = 0; d0 < 4; ++d0) { float f[8]; const bf16x8 raw = qraw[d0]; unpack8(*reinterpret_cast<const u32x4*>(&raw), f);
        constexpr float C = SCALE * 1.4426950408889634f;
        u32x4 w; w.x = cvtpk(f[0] * C, f[1] * C); w.y = cvtpk(f[2] * C, f[3] * C); w.z = cvtpk(f[4] * C, f[5] * C); w.w = cvtpk(f[6] * C, f[7] * C);
        float g[8]; unpack8(w, g);
#pragma unroll
        for (int e = 0; e < 8; ++e) qss += g[e] * g[e];
        qr[d0] = *reinterpret_cast<const bf16x8*>(&w); }
    qss += __shfl_xor(qss, 32);
    const float nm = -1.002f * sqrtf(qss) * sqrtf(km2);
    asm volatile("s_waitcnt vmcnt(0)" ::: "memory"); __syncthreads();
    qkt(pA0, pA1, lds + SHM_V, qr, r32, hi, mp, nm); partialSM(pA0);
    ROT();
#define ITER(PC0, PC1, PP0, PP1, j) do { if ((j) + 1 < NT) DMA_TILE(((j) + 1) * 64, sl_next); \
        SBAR(); qkt(PC0, PC1, lds + sl_cur + SHM_V, qr, r32, hi, mp, nm); \
        finishSM(PP0, PP1, l_reg, pa0, pa1, pa2, pa3); SBAR(); \
        pv_d0<true>(o, vb0 + sl_prev, pa0, pa1, pa2, pa3, PC0); \
        asm volatile("s_waitcnt vmcnt(0)" ::: "memory");     \
        __syncthreads(); ROT(); } while (0)
    for (int j = 1; j + 1 < NT; j += 2) { ITER(pB0, pB1, pA0, pA1, j); ITER(pA0, pA1, pB0, pB1, j + 1); }
    ITER(pB0, pB1, pA0, pA1, NT - 1);
    finishSM(pB0, pB1, l_reg, pa0, pa1, pa2, pa3); SBAR();
    pv_d0<false>(o, vb0 + sl_prev, pa0, pa1, pa2, pa3, pA0);
#undef ITER
#undef ROT
#undef DMA_TILE
    asm volatile("s_waitcnt vmcnt(0)" ::: "memory");
    l_reg += __shfl_xor(l_reg, 32);
    if (hi == 0) li_l[r32] = (mp ? lam : 1.0f) / l_reg;
    asm volatile("s_waitcnt lgkmcnt(0)" ::: "memory");
#pragma unroll
    for (int r = 0; r < 16; ++r) { const float f = li_l[crow(r, hi)];
#pragma unroll
        for (int d0 = 0; d0 < 4; ++d0) o[d0][r] *= f; }
    LDS_BARRIER();
    float* ex = (float*)lds;
    bf16_t* ot = (bf16_t*)(lds + 65536);
    if (mp == 1) {
#pragma unroll
        for (int r = 0; r < 16; ++r)
#pragma unroll
            for (int d0 = 0; d0 < 4; ++d0) ex[(wq * 32 + crow(r, hi)) * 128 + d0 * 32 + r32] = o[d0][r];
    }
    LDS_BARRIER();
    if (mp == 0) {
        const int t2 = fresh_tid(), r32 = t2 & 31, hi = (t2 >> 5) & 1, wq = (t2 >> 6) & 3;
        float wcol[4];
#pragma unroll
        for (int d0 = 0; d0 < 4; ++d0) wcol[d0] = subw[d0 * 32 + r32] * osc;
#pragma unroll
        for (int r = 0; r < 16; ++r) {
            float ss = 0.f;
#pragma unroll
            for (int d0 = 0; d0 < 4; ++d0) { o[d0][r] -= ex[(wq * 32 + crow(r, hi)) * 128 + d0 * 32 + r32]; ss += o[d0][r] * o[d0][r]; }
            ss = sum32(ss);
            const float rn = rsqrtf(ss * (1.0f / 128.0f) + EPS);
            bf16_t* op = ot + (wq * 32 + crow(r, hi)) * 136 + r32;
#pragma unroll
            for (int d0 = 0; d0 < 4; ++d0) op[d0 * 32] = (bf16_t)f2bf(o[d0][r] * rn * wcol[d0]);
        }
    }
    LDS_BARRIER();
    { const int t3 = fresh_tid();
#pragma unroll
      for (int it = 0; it < 4; ++it) { const int idx = t3 + 512 * it, row = idx >> 4, pc = idx & 15;
          *(u32x4*)(mix + (size_t)(qrow0 + row) * DM + h * 128 + pc * 8) = *(const u32x4*)(ot + row * 136 + pc * 8); } }
    LDS_BARRIER();
}
}


namespace ck {
template <int K>
__device__ __forceinline__ f32x16 mma32(const bf16_t* A, int lda, const bf16_t* B, int ldb, f32x16 acc, int r32, int hi) {
#pragma unroll
    for (int k0 = 0; k0 < K; k0 += 16) {
        const bf16x8 a = *(const bf16x8*)(A + r32 * lda + k0 + 8 * hi), b = *(const bf16x8*)(B + r32 * ldb + k0 + 8 * hi);
        acc = __builtin_amdgcn_mfma_f32_32x32x16_bf16(a, b, acc, 0, 0, 0); }
    return acc;
}
__device__ __forceinline__ int crow(int r, int hi) { return (r & 3) + 8 * (r >> 2) + 4 * hi; }
struct P { bf16_t* proj; bf16_t* xbcs; float* dtv; float* cumv; float* gkv; bf16_t* ssd_st; bf16_t* gla_st; float* cds; float* cdg; bf16_t* mix; const f32x2* ropet;
           const float *convw, *convb, *dtb, *alog, *gkup, *gkb, *ssdd, *ssdnw, *glanw; unsigned* kmax2; bf16_t* hins; bf16_t* hing; };

__device__ __forceinline__ void prep_chunk(const P& p, int ch, unsigned char* lds, int sect, bool dry = false) {
    const int tid = fresh_tid(), lane = tid & 63, wave = __builtin_amdgcn_readfirstlane(tid >> 6), r32 = lane & 31, hi = lane >> 5;
    const int row0 = ch * 64; const bool lat = row0 < TLAT;
    float* dtl = (float*)lds; float* al = dtl + 512; float* cuml = al + 512; float* wgt = cuml + 512; float* tot = wgt + 512;
    bf16_t* XwT = (bf16_t*)(lds + 16384);
    bf16_t* BT = (bf16_t*)(lds + 90112);
    if (lat && !dry && (sect & 1)) {
#pragma unroll 1
        for (int hb = 0; hb < 2; ++hb) {
            u32x4 a1[4], a2[4]; f32x4 tb[4][4];
#pragma unroll
            for (int q = 0; q < 4; ++q) { const int idx = tid + 512 * (hb * 4 + q);
                const int jg = idx & 1, half = (idx >> 1) & 1, mp = (idx >> 2) & 1, hh = (idx >> 3) & 3, qk = (idx >> 5) & 1, tok = idx >> 6;
                const int row = row0 + tok, s = row & (SEQ - 1), pos = half ? (s & 63) : (s >> 6);
                const bf16_t* p1 = p.proj + (size_t)row * INWP + qk * 512 + hh * 128 + mp * 64 + half * 32 + jg * 8;
                a1[q] = *(const u32x4*)p1; a2[q] = *(const u32x4*)(p1 + 16);
                const f32x4* tp = (const f32x4*)(p.ropet + pos * 16 + jg * 8);
#pragma unroll
                for (int e = 0; e < 4; ++e) tb[q][e] = tp[e]; }
#pragma unroll
            for (int q = 0; q < 4; ++q) { const int idx = tid + 512 * (hb * 4 + q);
                const int jg = idx & 1, half = (idx >> 1) & 1, mp = (idx >> 2) & 1, hh = (idx >> 3) & 3, qk = (idx >> 5) & 1, tok = idx >> 6;
                bf16_t* p1 = p.proj + (size_t)(row0 + tok) * INWP + qk * 512 + hh * 128 + mp * 64 + half * 32 + jg * 8;
                float x1[8], x2[8], o1[8], o2[8]; unpack8(a1[q], x1); unpack8(a2[q], x2);
#pragma unroll
                for (int e = 0; e < 4; ++e) { const f32x4 cs = tb[q][e];
                    o1[2 * e] = x1[2 * e] * cs.x - x2[2 * e] * cs.y; o2[2 * e] = x2[2 * e] * cs.x + x1[2 * e] * cs.y;
                    o1[2 * e + 1] = x1[2 * e + 1] * cs.z - x2[2 * e + 1] * cs.w; o2[2 * e + 1] = x2[2 * e + 1] * cs.z + x1[2 * e + 1] * cs.w; }
                *(u32x4*)p1 = pack8(o1); *(u32x4*)(p1 + 16) = pack8(o2); }
        }
    }
    const int spos = lat ? ((row0 + lane) & (SEQ - 1)) : ((row0 + lane - TLAT) & (LCTX - 1)), slen = lat ? SEQ : LCTX;
    if (sect & 2) {
    u32x4 c0[4], cm[4], cp[4];
    const bf16_t* cbase = p.proj + (size_t)(row0 + lane) * INWP + C_XBC;
    const int dm = spos > 0 ? -INWP : 0, dp = spos < slen - 1 ? INWP : 0;
#pragma unroll
    for (int q = 0; q < 4; ++q) { const bf16_t* pp = cbase + (wave + 8 * q) * 8; c0[q] = *(const u32x4*)pp; cm[q] = *(const u32x4*)(pp + dm); cp[q] = *(const u32x4*)(pp + dp); }
    { const int tok = tid >> 3, i = tid & 7, row = row0 + tok;
      const float x = bf2f(p.proj[(size_t)row * INWP + C_DT + i]) + p.dtb[i];
      const float dt = softplusf(x), A = -expf(p.alog[i]);
      dtl[tid] = dt; al[tid] = dt * A; p.dtv[(size_t)row * 8 + i] = dt; }
    unsigned* kml = (unsigned*)(tot + 8);
    if (tid < 8) kml[tid] = 0u;
    LDS_BARRIER();
    { const int tok = tid >> 3, hm = tid & 7; const bf16_t* kp = p.proj + (size_t)(row0 + tok) * INWP + C_K + hm * 64; float ss = 0.f;
#pragma unroll
      for (int q = 0; q < 8; ++q) { float f[8]; unpack8(*(const u32x4*)(kp + q * 8), f);
#pragma unroll
          for (int e = 0; e < 8; ++e) ss += f[e] * f[e]; }
      atomicMax(&kml[hm], __float_as_uint(ss)); }
    { const int i = wave, dir = i >> 2; const float c = wave_scan(al[lane * 8 + i], lane, dir != 0);
      cuml[lane * 8 + i] = c; if (lane == (dir ? 0 : 63)) { tot[i] = c; p.cds[ch * 8 + i] = __expf(c); } }
    LDS_BARRIER();
    if (tid < 8) atomicMax(p.kmax2 + (lat ? (row0 >> 13) : ((row0 - TLAT) >> 8)) * 8 + tid, kml[tid]);
    { const int tok = tid >> 3, i = tid & 7, row = row0 + tok; const float cmv = cuml[tid];
      wgt[tid] = __expf(tot[i] - cmv) * dtl[tid]; p.cumv[(size_t)row * 8 + i] = cmv; }
    LDS_BARRIER();
#pragma unroll
    for (int hb = 0; hb < 2; ++hb) {
        u32x4 n0[4], nm[4], np[4];
        if (hb == 0) {
#pragma unroll
            for (int q = 0; q < 4; ++q) { const bf16_t* pp = cbase + (wave + 8 * (4 + q)) * 8; n0[q] = *(const u32x4*)pp; nm[q] = *(const u32x4*)(pp + dm); np[q] = *(const u32x4*)(pp + dp); } }
#pragma unroll
        for (int q = 0; q < 4; ++q) { const int cg = wave + 8 * (hb * 4 + q), row = row0 + lane;
            float xm[8], x0[8], xp[8], o[8];
            unpack8(c0[q], x0); unpack8(cm[q], xm); unpack8(cp[q], xp);
            const float zm = spos > 0 ? 1.f : 0.f, zp = spos < slen - 1 ? 1.f : 0.f;
#pragma unroll
            for (int e = 0; e < 8; ++e) { const int c = cg * 8 + e; o[e] = siluf(p.convb[c] + p.convw[c] * (xm[e] * zm) + p.convw[512 + c] * x0[e] + p.convw[1024 + c] * (xp[e] * zp)); }
            const u32x4 pk = pack8(o);
            *(u32x4*)(p.xbcs + (size_t)row * 512 + cg * 8) = pk;
            if (cg < 32) { float ob[8]; unpack8(pk, ob); const float wf = wgt[lane * 8 + (cg >> 3)], wb = wgt[lane * 8 + 4 + (cg >> 3)];
#pragma unroll
                for (int e = 0; e < 8; ++e) { XwT[(cg * 8 + e) * 72 + lane] = (bf16_t)f2bf(ob[e] * wf); XwT[(256 + cg * 8 + e) * 72 + lane] = (bf16_t)f2bf(ob[e] * wb); } }
            else if (cg < 48) { const unsigned wv[4] = {pk.x, pk.y, pk.z, pk.w};
#pragma unroll
                for (int e = 0; e < 8; ++e) BT[((cg - 32) * 8 + e) * 72 + lane] = (bf16_t)((wv[e >> 1] >> ((e & 1) * 16)) & 0xffffu); } }
        if (hb == 0) {
#pragma unroll
            for (int q = 0; q < 4; ++q) { c0[q] = n0[q]; cm[q] = nm[q]; cp[q] = np[q]; } }
    }
    LDS_BARRIER();
#pragma unroll 1
    for (int q = 0; q < 4; ++q) {
        const int t = wave * 4 + q, dir = t >> 4, hh = (t >> 2) & 3, pt = (t >> 1) & 1, nt = t & 1;
        f32x16 acc = {};
        acc = mma32<64>(XwT + (dir * 256 + hh * 64 + pt * 32) * 72, 72, BT + ((hh >> 1) * 64 + nt * 32) * 72, 72, acc, r32, hi);
        bf16_t* dst = p.ssd_st + ((size_t)(ch * 2 + dir) * 4 + hh) * 4096 + nt * 32 + r32;
#pragma unroll
        for (int r = 0; r < 16; ++r) dst[(pt * 32 + crow(r, hi)) * 64] = (bf16_t)f2bf(acc[r]);
    }
    LDS_BARRIER();
    }
    if (sect & 12) {
    float* gkd = (float*)lds; float* bendl = (float*)(lds + 33792); bf16_t* KeT = (bf16_t*)(lds + 34816); bf16_t* VT = (bf16_t*)(lds + 71680);
    u32x4 vpk[4], kpk[2], cd[2][2];
    const bf16_t* rowp = p.proj + (size_t)(row0 + lane) * INWP;
#pragma unroll
    for (int it = 0; it < 4; ++it) vpk[it] = *(const u32x4*)(rowp + C_GV + (wave + 8 * it) * 8);
#pragma unroll
    for (int it = 0; it < 2; ++it) kpk[it] = *(const u32x4*)(rowp + C_GK + (wave + 8 * it) * 8);
    { const bf16_t* cpp = p.proj + (size_t)(row0 + (tid >> 3)) * INWP + C_CODE;
#pragma unroll
      for (int d = 0; d < 2; ++d) { cd[d][0] = *(const u32x4*)(cpp + d * 16); cd[d][1] = *(const u32x4*)(cpp + d * 16 + 8); } }
#pragma unroll
    for (int it = 0; it < 4; ++it) { const int vg = wave + 8 * it; const unsigned wv[4] = {vpk[it].x, vpk[it].y, vpk[it].z, vpk[it].w};
#pragma unroll
        for (int e = 0; e < 8; ++e) VT[(vg * 8 + e) * 72 + lane] = (bf16_t)((wv[e >> 1] >> ((e & 1) * 16)) & 0xffffu); }
#pragma unroll
    for (int dir = 0; dir < 2; ++dir) {
        if (!(sect & (4 << dir))) continue;
        { const int tok = tid >> 3, s8 = tid & 7, c0 = s8 * 16;
          float code[16]; { float t8[8]; unpack8(cd[dir][0], t8);
#pragma unroll
              for (int e = 0; e < 8; ++e) code[e] = t8[e];
              unpack8(cd[dir][1], t8);
#pragma unroll
              for (int e = 0; e < 8; ++e) code[8 + e] = t8[e]; }
          const float* up = p.gkup + (size_t)dir * 16 * 128 + c0; const float* gb = p.gkb + dir * 128 + c0;
#pragma unroll 1
          for (int q = 0; q < 4; ++q) { f32x4 a = *(const f32x4*)(gb + 4 * q); f32x4 w[16];
#pragma unroll
              for (int r = 0; r < 16; ++r) w[r] = *(const f32x4*)(up + r * 128 + 4 * q);
              __builtin_amdgcn_sched_barrier(0);
#pragma unroll
              for (int r = 0; r < 16; ++r) a += w[r] * code[r];
              f32x4 o; o.x = logsigmoidf(a.x) * 0.0625f; o.y = logsigmoidf(a.y) * 0.0625f; o.z = logsigmoidf(a.z) * 0.0625f; o.w = logsigmoidf(a.w) * 0.0625f;
              *(f32x4*)(gkd + tok * 132 + c0 + 4 * q) = o; } }
        LDS_BARRIER();
#pragma unroll 4
        for (int q = 0; q < 16; ++q) { const int c = wave * 16 + q; const float acc = wave_scan(gkd[lane * 132 + c], lane, dir != 0);
            gkd[lane * 132 + c] = acc; if (lane == (dir ? 0 : 63)) { bendl[c] = acc; p.cdg[ch * 256 + dir * 128 + c] = __expf(acc); } }
        LDS_BARRIER();
        for (int it = 0; it < 4; ++it) { const int idx = tid + 512 * it, tok = idx >> 5, q4 = idx & 31;
            *(f32x4*)(p.gkv + (size_t)(row0 + tok) * 256 + dir * 128 + q4 * 4) = *(const f32x4*)(gkd + tok * 132 + q4 * 4); }
#pragma unroll
        for (int it = 0; it < 2; ++it) { const int kg = wave + 8 * it;
            float kv[8]; unpack8(kpk[it], kv);
            const f32x4 b0 = *(const f32x4*)(gkd + lane * 132 + kg * 8), b1 = *(const f32x4*)(gkd + lane * 132 + kg * 8 + 4);
            const f32x4 e0 = *(const f32x4*)(bendl + kg * 8), e1 = *(const f32x4*)(bendl + kg * 8 + 4);
            const float bb[8] = {b0.x, b0.y, b0.z, b0.w, b1.x, b1.y, b1.z, b1.w}, be[8] = {e0.x, e0.y, e0.z, e0.w, e1.x, e1.y, e1.z, e1.w};
#pragma unroll
            for (int e = 0; e < 8; ++e) KeT[(dir * 128 + kg * 8 + e) * 72 + lane] = (bf16_t)f2bf(kv[e] * __expf(be[e] - bb[e])); }
        LDS_BARRIER();
    }
#pragma unroll 1
    for (int q = 0; q < 2; ++q) {
        const int t = wave * 2 + q, dir = t >> 3, hh = (t >> 1) & 3, vt = t & 1;
        if (!(sect & (4 << dir))) continue;
        f32x16 acc = {};
        acc = mma32<64>(VT + (hh * 64 + vt * 32) * 72, 72, KeT + (dir * 128 + hh * 32) * 72, 72, acc, r32, hi);
        bf16_t* dst = p.gla_st + ((size_t)(ch * 2 + dir) * 4 + hh) * 2048 + r32;
#pragma unroll
        for (int r = 0; r < 16; ++r) dst[(vt * 32 + crow(r, hi)) * 32] = (bf16_t)f2bf(acc[r]);
    }
    LDS_BARRIER();
    }
}

__device__ __forceinline__ void scan_phase(const P& p, int bx) {
    const int tid = fresh_tid();
    if (tid >= 384) return;
    const int e0 = bx * 384 + tid; const bool ssd = e0 < 65536; const int e = ssd ? e0 : e0 - 65536;
    const int b = ssd ? e >> 15 : e >> 14, dir = ssd ? (e >> 14) & 1 : (e >> 13) & 1, hh = ssd ? (e >> 12) & 3 : (e >> 11) & 3, el = ssd ? e & 4095 : e & 2047;
    const bf16_t* st = ssd ? p.ssd_st : p.gla_st; bf16_t* ho = ssd ? p.hins : p.hing; const int esz = ssd ? 4096 : 2048;
    const float* dcp = ssd ? p.cds + dir * 4 + hh : p.cdg + dir * 128 + hh * 32 + (el & 31); const int dst = ssd ? 8 : 256;
    float hst = 0.f;
#pragma unroll 1
    for (int kb = 0; kb < 132; kb += 22) {
        float sv[22], dv[22]; int ci[22];
#pragma unroll
        for (int u = 0; u < 22; ++u) { const int k = kb + u; ci[u] = k < 4 ? 256 + 4 * b + (dir ? 3 - k : k) : 128 * b + (dir ? 127 - (k - 4) : (k - 4));
            sv[u] = bf2f(st[((size_t)(ci[u] * 2 + dir) * 4 + hh) * esz + el]); dv[u] = dcp[ci[u] * dst]; }
#pragma unroll
        for (int u = 0; u < 22; ++u) { ho[((size_t)(ci[u] * 2 + dir) * 4 + hh) * esz + el] = (bf16_t)f2bf(hst); hst = hst * dv[u] + sv[u]; }
    }
}

__device__ __forceinline__ void finish_chunk(const P& p, int ch, unsigned char* lds, int sect) {
    const int tid = fresh_tid(), lane = tid & 63, wave = __builtin_amdgcn_readfirstlane(tid >> 6), r32 = lane & 31, hi = lane >> 5;
    const int row0 = ch * 64;
    float* cml = (float*)lds; float* dtl = cml + 512; float* psum = dtl + 512;
    const float cm0_ = p.cumv[(size_t)row0 * 8 + tid], dt0_ = p.dtv[(size_t)row0 * 8 + tid]; bool first_ = true;
    bf16_t* Cn = (bf16_t*)(lds + 8192); bf16_t* Bn = (bf16_t*)(lds + 17408); bf16_t* XT = (bf16_t*)(lds + 26624); bf16_t* Mb = (bf16_t*)(lds + 45056); bf16_t* hin = (bf16_t*)(lds + 63488); bf16_t* Zs = (bf16_t*)(lds + 100352);
    const int hl = wave >> 2, rt = (wave >> 1) & 1, ct = wave & 1;
#pragma unroll 1
    for (int g = 0; g < 2; ++g) {
        if (!(sect & (1 << g))) continue;
        { u32x4 sA[2], sZ[2], sX[2], sH[4];
#pragma unroll
          for (int it = 0; it < 2; ++it) { const int idx = tid + 512 * it, arr = idx >> 9, r = idx & 511, tok = r >> 3, pc = r & 7;
              sA[it] = *(const u32x4*)(p.xbcs + (size_t)(row0 + tok) * 512 + (arr ? 384 : 256) + g * 64 + pc * 8); }
#pragma unroll
          for (int it = 0; it < 2; ++it) { const int idx = tid + 512 * it, tok = idx >> 4, pc = idx & 15;
              sZ[it] = *(const u32x4*)(p.proj + (size_t)(row0 + tok) * INWP + C_Z + g * 128 + pc * 8); }
#pragma unroll
          for (int it = 0; it < 2; ++it) { const int idx = tid + 512 * it, tok = idx & 63, cg = idx >> 6;
              sX[it] = *(const u32x4*)(p.xbcs + (size_t)(row0 + tok) * 512 + g * 128 + cg * 8); }
#pragma unroll
          for (int it = 0; it < 4; ++it) { const int idx = tid + 512 * it, dq = idx >> 9, r = idx & 511, pp = r >> 3, q8 = r & 7;
              sH[it] = *(const u32x4*)(p.hins + ((size_t)(ch * 2 + (dq >> 1)) * 4 + 2 * g + (dq & 1)) * 4096 + pp * 64 + q8 * 8); }
          __builtin_amdgcn_sched_barrier(0);
          if (first_) { cml[tid] = cm0_; dtl[tid] = dt0_; first_ = false; }
#pragma unroll
          for (int it = 0; it < 2; ++it) { const int idx = tid + 512 * it, arr = idx >> 9, r = idx & 511, tok = r >> 3, pc = r & 7;
              *(u32x4*)((arr ? Cn : Bn) + tok * 72 + pc * 8) = sA[it]; }
#pragma unroll
          for (int it = 0; it < 2; ++it) { const int idx = tid + 512 * it, tok = idx >> 4, pc = idx & 15;
              *(u32x4*)(Zs + tok * 136 + pc * 8) = sZ[it]; }
#pragma unroll
          for (int it = 0; it < 2; ++it) { const int idx = tid + 512 * it, tok = idx & 63, cg = idx >> 6;
              const u32x4 pk = sX[it]; const unsigned wv[4] = {pk.x, pk.y, pk.z, pk.w};
#pragma unroll
              for (int e = 0; e < 8; ++e) XT[(cg * 8 + e) * 72 + tok] = (bf16_t)((wv[e >> 1] >> ((e & 1) * 16)) & 0xffffu); }
#pragma unroll
          for (int it = 0; it < 4; ++it) { const int idx = tid + 512 * it, dq = idx >> 9, r = idx & 511, pp = r >> 3, q8 = r & 7;
              *(u32x4*)(hin + (dq * 64 + pp) * 72 + q8 * 8) = sH[it]; } }
        LDS_BARRIER();
        const int hh = 2 * g + hl;
        { f32x16 acc = {}; acc = mma32<64>(Cn + rt * 32 * 72, 72, Bn + ct * 32 * 72, 72, acc, r32, hi);
          const int j = ct * 32 + r32; const float cfj = cml[j * 8 + hh], cbj = cml[j * 8 + 4 + hh], dfj = dtl[j * 8 + hh], dbj = dtl[j * 8 + 4 + hh];
#pragma unroll
          for (int r = 0; r < 16; ++r) { const int i = rt * 32 + crow(r, hi); const float cfi = cml[i * 8 + hh], cbi = cml[i * 8 + 4 + hh];
              const float lf = (j <= i) ? __expf(cfi - cfj) * dfj : 0.f, lb = (j >= i) ? __expf(cbi - cbj) * dbj : 0.f;
              Mb[(hl * 64 + i) * 72 + j] = (bf16_t)f2bf(acc[r] * (lf + lb)); } }
        LDS_BARRIER();
        { const int c = hh * 64 + ct * 32 + r32; const float dsk = p.ssdd[hh], wn = p.ssdnw[c];
          f32x16 y;
          { f32x16 t = {}; t = mma32<64>(Cn + rt * 32 * 72, 72, hin + ((0 * 2 + hl) * 64 + ct * 32) * 72, 72, t, r32, hi);
#pragma unroll
            for (int r = 0; r < 16; ++r) y[r] = __expf(cml[(rt * 32 + crow(r, hi)) * 8 + hh]) * t[r]; }
          { f32x16 t = {}; t = mma32<64>(Cn + rt * 32 * 72, 72, hin + ((1 * 2 + hl) * 64 + ct * 32) * 72, 72, t, r32, hi);
#pragma unroll
            for (int r = 0; r < 16; ++r) y[r] += __expf(cml[(rt * 32 + crow(r, hi)) * 8 + 4 + hh]) * t[r]; }
          y = mma32<64>(Mb + (hl * 64 + rt * 32) * 72, 72, XT + (hl * 64 + ct * 32) * 72, 72, y, r32, hi);
          const bf16_t* xcol = XT + (hl * 64 + ct * 32 + r32) * 72;
          bf16_t* zcol = Zs + hl * 64 + ct * 32 + r32;
#pragma unroll
          for (int r = 0; r < 16; ++r) { const int i = rt * 32 + crow(r, hi);
              y[r] = (y[r] + dsk * bf2f(xcol[i])) * siluf(bf2f(zcol[i * 136]));
              const float s = sum32(y[r] * y[r]); if (r32 == 0) psum[i * 8 + hl * 2 + ct] = s; }
          LDS_BARRIER();
#pragma unroll
          for (int r = 0; r < 16; ++r) { const int i = rt * 32 + crow(r, hi);
              const float rn = rsqrtf(((psum[i * 8] + psum[i * 8 + 1]) + (psum[i * 8 + 2] + psum[i * 8 + 3])) * (1.0f / 128.0f) + EPS);
              zcol[i * 136] = (bf16_t)f2bf(y[r] * rn * wn); } }
        LDS_BARRIER();
        for (int it = 0; it < 2; ++it) { const int idx = tid + 512 * it, tok = idx >> 4, pc = idx & 15;
            *(u32x4*)(p.mix + (size_t)(row0 + tok) * DM + 512 + g * 128 + pc * 8) = *(const u32x4*)(Zs + tok * 136 + pc * 8); }
        LDS_BARRIER();
    }
    float* bfl = (float*)lds; bf16_t* att = (bf16_t*)lds; float* psg = (float*)(lds + 34816);
    bf16_t* Qf = (bf16_t*)(lds + 36864); bf16_t* Kf = (bf16_t*)(lds + 57344); bf16_t* VTg = (bf16_t*)(lds + 77824); bf16_t* hing = (bf16_t*)(lds + 96256);
#pragma unroll 1
    for (int hp = 0; hp < 2; ++hp) {
        if (!(sect & (4 << hp))) continue;
        u32x4 qk4[4];
        { f32x4 sB[4]; u32x4 sV[2], sH[2];
#pragma unroll
          for (int it = 0; it < 4; ++it) { const int idx = tid + 512 * it, tok = idx >> 5, r = idx & 31, dir = r >> 4, q4 = r & 15;
              sB[it] = *(const f32x4*)(p.gkv + (size_t)(row0 + tok) * 256 + dir * 128 + hp * 64 + q4 * 4); }
#pragma unroll
          for (int it = 0; it < 2; ++it) { const int idx = tid + 512 * it, tok = idx & 63, vg = idx >> 6;
              sV[it] = *(const u32x4*)(p.proj + (size_t)(row0 + tok) * INWP + C_GV + hp * 128 + vg * 8); }
#pragma unroll
          for (int it = 0; it < 2; ++it) { const int idx = tid + 512 * it, dq = idx >> 8, r = idx & 255, vv = r >> 2, q8 = r & 3;
              sH[it] = *(const u32x4*)(p.hing + ((size_t)(ch * 2 + (dq >> 1)) * 4 + 2 * hp + (dq & 1)) * 2048 + vv * 32 + q8 * 8); }
          { const int tok = tid >> 3, s_ = tid & 7, h2 = (s_ >> 1) & 1, half = s_ & 1; const size_t row = (size_t)(row0 + tok); const int hcol = (2 * hp + h2) * 32 + half * 16;
            qk4[0] = *(const u32x4*)(p.proj + row * INWP + C_GQ + hcol); qk4[1] = *(const u32x4*)(p.proj + row * INWP + C_GQ + hcol + 8);
            qk4[2] = *(const u32x4*)(p.proj + row * INWP + C_GK + hcol); qk4[3] = *(const u32x4*)(p.proj + row * INWP + C_GK + hcol + 8); }
          __builtin_amdgcn_sched_barrier(0);
#pragma unroll
          for (int it = 0; it < 4; ++it) { const int idx = tid + 512 * it, tok = idx >> 5, r = idx & 31, dir = r >> 4, q4 = r & 15;
              *(f32x4*)(bfl + tok * 132 + dir * 64 + q4 * 4) = sB[it]; }
#pragma unroll
          for (int it = 0; it < 2; ++it) { const int idx = tid + 512 * it, tok = idx & 63, vg = idx >> 6;
              const u32x4 pk = sV[it]; const unsigned wv[4] = {pk.x, pk.y, pk.z, pk.w};
#pragma unroll
              for (int e = 0; e < 8; ++e) VTg[(vg * 8 + e) * 72 + tok] = (bf16_t)((wv[e >> 1] >> ((e & 1) * 16)) & 0xffffu); }
#pragma unroll
          for (int it = 0; it < 2; ++it) { const int idx = tid + 512 * it, dq = idx >> 8, r = idx & 255, vv = r >> 2, q8 = r & 3;
              *(u32x4*)(hing + (dq * 64 + vv) * 40 + q8 * 8) = sH[it]; } }
        LDS_BARRIER();
        { const int tok = tid >> 3, s = tid & 7, dir = s >> 2, h2 = (s >> 1) & 1, half = s & 1;
          float qv[16], kv[16];
          { float t8[8]; unpack8(qk4[0], t8);
#pragma unroll
            for (int e = 0; e < 8; ++e) qv[e] = t8[e];
            unpack8(qk4[1], t8);
#pragma unroll
            for (int e = 0; e < 8; ++e) qv[8 + e] = t8[e];
            unpack8(qk4[2], t8);
#pragma unroll
            for (int e = 0; e < 8; ++e) kv[e] = t8[e];
            unpack8(qk4[3], t8);
#pragma unroll
            for (int e = 0; e < 8; ++e) kv[8 + e] = t8[e]; }
          const float* bp = bfl + tok * 132 + dir * 64 + h2 * 32 + half * 16;
          float oq[16], ok[16];
#pragma unroll
          for (int q = 0; q < 4; ++q) { const f32x4 bv = *(const f32x4*)(bp + 4 * q); const float bb[4] = {bv.x, bv.y, bv.z, bv.w};
#pragma unroll
              for (int e = 0; e < 4; ++e) { const float ex = __expf(bb[e]), exi = __expf(-bb[e]); oq[q * 4 + e] = qv[q * 4 + e] * ex * 0.17677669529663687f; ok[q * 4 + e] = kv[q * 4 + e] * exi; } }
          bf16_t* qd = Qf + ((dir * 2 + h2) * 64 + tok) * 40 + half * 16; bf16_t* kd = Kf + ((dir * 2 + h2) * 64 + tok) * 40 + half * 16;
          u32x4 w; w.x = pk2(oq[0], oq[1]); w.y = pk2(oq[2], oq[3]); w.z = pk2(oq[4], oq[5]); w.w = pk2(oq[6], oq[7]); *(u32x4*)qd = w;
          w.x = pk2(oq[8], oq[9]); w.y = pk2(oq[10], oq[11]); w.z = pk2(oq[12], oq[13]); w.w = pk2(oq[14], oq[15]); *(u32x4*)(qd + 8) = w;
          w.x = pk2(ok[0], ok[1]); w.y = pk2(ok[2], ok[3]); w.z = pk2(ok[4], ok[5]); w.w = pk2(ok[6], ok[7]); *(u32x4*)kd = w;
          w.x = pk2(ok[8], ok[9]); w.y = pk2(ok[10], ok[11]); w.z = pk2(ok[12], ok[13]); w.w = pk2(ok[14], ok[15]); *(u32x4*)(kd + 8) = w; }
        LDS_BARRIER();
        { f32x16 af = {}, ab = {};
          af = mma32<32>(Qf + ((0 * 2 + hl) * 64 + rt * 32) * 40, 40, Kf + ((0 * 2 + hl) * 64 + ct * 32) * 40, 40, af, r32, hi);
          ab = mma32<32>(Qf + ((1 * 2 + hl) * 64 + rt * 32) * 40, 40, Kf + ((1 * 2 + hl) * 64 + ct * 32) * 40, 40, ab, r32, hi);
          const int j = ct * 32 + r32;
#pragma unroll
          for (int r = 0; r < 16; ++r) { const int i = rt * 32 + crow(r, hi);
              att[(hl * 64 + i) * 72 + j] = (bf16_t)f2bf(((j <= i) ? af[r] : 0.f) + ((j >= i) ? ab[r] : 0.f)); } }
        LDS_BARRIER();
        { f32x16 acc = {};
          bf16_t ggr[16];
          { const int c_ = (2 * hp + hl) * 64 + ct * 32 + r32;
#pragma unroll
            for (int r = 0; r < 16; ++r) ggr[r] = p.proj[(size_t)(row0 + rt * 32 + crow(r, hi)) * INWP + C_GG + c_]; }
          acc = mma32<64>(att + (hl * 64 + rt * 32) * 72, 72, VTg + (hl * 64 + ct * 32) * 72, 72, acc, r32, hi);
          acc = mma32<32>(Qf + ((0 * 2 + hl) * 64 + rt * 32) * 40, 40, hing + ((0 * 2 + hl) * 64 + ct * 32) * 40, 40, acc, r32, hi);
          acc = mma32<32>(Qf + ((1 * 2 + hl) * 64 + rt * 32) * 40, 40, hing + ((1 * 2 + hl) * 64 + ct * 32) * 40, 40, acc, r32, hi);
          const int hh = 2 * hp + hl, v = ct * 32 + r32, c = hh * 64 + v; const float wn = p.glanw[v];
#pragma unroll
          for (int r = 0; r < 16; ++r) { const int i = rt * 32 + crow(r, hi); const float s = sum32(acc[r] * acc[r]); if (r32 == 0) psg[i * 4 + hl * 2 + ct] = s; }
          LDS_BARRIER();
#pragma unroll
          for (int r = 0; r < 16; ++r) { const int i = rt * 32 + crow(r, hi); const size_t row = (size_t)(row0 + i);
              const float rn = rsqrtf((psg[i * 4 + hl * 2] + psg[i * 4 + hl * 2 + 1]) * (1.0f / 64.0f) + EPS);
              const float gg = bf2f(ggr[r]);
              p.mix[row * DM + 768 + c] = (bf16_t)f2bf(acc[r] * rn * wn * siluf(gg)); } }
        LDS_BARRIER();
    }
}
}

#define XB_TMO      128
#define XB_XCNT(j)  (256  + 64 * (j))
#define XB_XSUB(j)  (1280 + 64 * (j))
#define XB_XGEN(j)  (2304 + 64 * (j))
#define XB_TOP      3328
#define XB_TOPGEN   3392
#define XCD_BAR_WORDS 3456
#define XB_SPIN_CAP (1u << 20)
__device__ __forceinline__ unsigned xb_ld(unsigned* p)              { return __hip_atomic_load(p, __ATOMIC_RELAXED, __HIP_MEMORY_SCOPE_AGENT); }
__device__ __forceinline__ unsigned xb_add(unsigned* p, unsigned v) { return __hip_atomic_fetch_add(p, v, __ATOMIC_RELAXED, __HIP_MEMORY_SCOPE_AGENT); }
__device__ __forceinline__ unsigned xb_xcc_id() { return (unsigned)__builtin_amdgcn_s_getreg((3 << 11) | 20) & 0xFu; }
#define XB_SPIN(cond, bar) do { unsigned _sp = 0; while (cond) { __builtin_amdgcn_s_sleep(1); \
    if ((++_sp & 255u) == 0u) { if (xb_ld(&(bar)[XB_TMO])) break; if (_sp > XB_SPIN_CAP) { atomicAdd(&(bar)[XB_TMO], 1u); break; } } } } while (0)
struct XcdBarrier { unsigned* bar; unsigned x; volatile LAS unsigned* st; };
__device__ __forceinline__ XcdBarrier xcd_barrier_post(unsigned* bar, volatile LAS unsigned* st) {
    XcdBarrier b; b.bar = bar; b.x = xb_xcc_id(); b.st = st;
    if (threadIdx.x == 0) (void)xb_add(&bar[XB_XCNT(b.x)], 1u);
    return b;
}
__device__ __forceinline__ void xcd_barrier_complete(unsigned* bar, unsigned x, unsigned& nloc, unsigned& nx) {
    const unsigned G = gridDim.x * gridDim.y * gridDim.z;
    unsigned sum, cnt, mine, sp = 0u;
    for (;;) {
        sum = 0u; cnt = 0u; mine = 0u;
#pragma unroll
        for (unsigned j = 0; j < 16; ++j) { const unsigned c = xb_ld(&bar[XB_XCNT(j)]); sum += c; cnt += (c > 0u) ? 1u : 0u; mine = (j == x) ? c : mine; }
        if (sum == G) break;
        __builtin_amdgcn_s_sleep(1);
        if ((++sp & 255u) == 0u) { if (xb_ld(&bar[XB_TMO])) break; if (sp > XB_SPIN_CAP) { atomicAdd(&bar[XB_TMO], 1u); break; } }
    }
    nloc = mine > 0u ? mine : 1u; nx = cnt > 0u ? cnt : 1u;
}
__device__ __forceinline__ void xcd_barrier(const XcdBarrier& b) {
    asm volatile("s_waitcnt vmcnt(0)" ::: "memory");
    __syncthreads();
    if (threadIdx.x == 0) {
        GAS unsigned* barg_ = (GAS unsigned*)b.bar; asm volatile("" : "+s"(barg_)); unsigned* bar = (unsigned*)barg_;
        __builtin_amdgcn_s_waitcnt(0);
        unsigned nloc = b.st[0], nx = b.st[1];
        if (nloc == 0u) { xcd_barrier_complete(bar, b.x, nloc, nx); b.st[0] = nloc; b.st[1] = nx; }
        const unsigned old = xb_add(&bar[XB_XSUB(b.x)], 1u);
        const unsigned gen = old / nloc;
        if (old + 1u == (gen + 1u) * nloc) {
            __builtin_amdgcn_fence(__ATOMIC_RELEASE, "agent");
            asm volatile("s_waitcnt vmcnt(0)" ::: "memory");
            const unsigned og = xb_add(&bar[XB_TOP], 1u);
            const unsigned tg = og / nx;
            if (og + 1u == (tg + 1u) * nx) xb_add(&bar[XB_TOPGEN], 1u);
            else XB_SPIN(xb_ld(&bar[XB_TOPGEN]) == tg, bar);
            __builtin_amdgcn_fence(__ATOMIC_ACQUIRE, "agent");
            xb_add(&bar[XB_XGEN(b.x)], 1u);
            asm volatile("s_waitcnt vmcnt(0)" ::: "memory");
        } else {
            XB_SPIN(xb_ld(&bar[XB_XGEN(b.x)]) == gen, bar);
            __builtin_amdgcn_fence(__ATOMIC_ACQUIRE, "agent");
            asm volatile("s_waitcnt vmcnt(0)" ::: "memory");
        }
    }
    __syncthreads();
}

struct Args { const float* in[28]; float* out; unsigned char* ws; int ph_lo, ph_hi; };
enum { I_X = 0, I_C, I_CTX, I_CCTX, I_WADA, I_BADA, I_N1W, I_WIN, I_DALAM, I_SUBW, I_CONVW, I_CONVB, I_ALOG, I_DTB, I_SSDD, I_SSDNW, I_GKUP, I_GKB, I_GLANW, I_WOUT, I_N2W,
       I_WR, I_BR, I_WGU, I_BGU, I_WDN, I_BDN, I_FNW };

__device__ __forceinline__ void transpose_item(const float* __restrict__ W, int K, int Nsrc, bf16_t* __restrict__ WT, int n0, int dst_row0, int k0, unsigned* scr, int lane) {
    const bool ok = (n0 + lane) < Nsrc; const float* src = W + (size_t)k0 * Nsrc + n0 + lane;
#pragma unroll
    for (int hb = 0; hb < 2; ++hb) { float v[32];
#pragma unroll
        for (int i = 0; i < 32; ++i) v[i] = ok ? __builtin_nontemporal_load(src + (size_t)(hb * 32 + i) * Nsrc) : 0.f;
#pragma unroll
        for (int i = 0; i < 16; ++i) scr[lane * 33 + hb * 16 + i] = pk2(v[2 * i], v[2 * i + 1]); }
    LDS_WAIT();
    const int c = lane & 7;
#pragma unroll
    for (int j = 0; j < 8; ++j) { const int nn = (lane >> 3) + 8 * j; const unsigned* t = scr + nn * 33 + 4 * c;
        u32x4 o; o.x = t[0]; o.y = t[1]; o.z = t[2]; o.w = t[3];
        __builtin_nontemporal_store(o, (u32x4*)(WT + (size_t)(dst_row0 + nn) * K + k0 + 8 * c)); }
    LDS_WAIT();
}

__device__ __forceinline__ void norm_mod_store(const f32x4 (&v)[4], const float* __restrict__ nw, const float* __restrict__ sh, const float* __restrict__ sc, bf16_t* __restrict__ orow, int lane) {
    float ss = 0.f;
#pragma unroll
    for (int j = 0; j < 4; ++j) ss += (v[j].x * v[j].x + v[j].y * v[j].y) + (v[j].z * v[j].z + v[j].w * v[j].w);
    const float r = rsqrtf(wave_sum(ss) * (1.0f / DM) + EPS);
#pragma unroll
    for (int j = 0; j < 4; ++j) { const int c = 4 * lane + 256 * j;
        const f32x4 w = *(const f32x4*)(nw + c), a = *(const f32x4*)(sc + c), b = *(const f32x4*)(sh + c);
        const f32x4 y = (v[j] * r) * w * (a + 1.0f) + b;
        u32x2 o; o.x = pk2(y.x, y.y); o.y = pk2(y.z, y.w); *(u32x2*)(orow + c) = o; }
}

__device__ __forceinline__ int moe_tables(const unsigned* cnt, int* tile_e, int* pstart, int* cntl) {
    const int t = fresh_tid();
    if (t < NE) { int c = (int)cnt[t]; if (c > LISTCAP) c = LISTCAP; cntl[t] = c; }
    LDS_BARRIER();
    if (t <= NE) { int acc = 0; for (int e = 0; e < t; ++e) acc += ((cntl[e] + 255) >> 8) << 8; pstart[t] = acc;
        if (t < NE) { const int nt = (cntl[t] + 255) >> 8; for (int q = 0; q < nt; ++q) tile_e[(acc >> 8) + q] = t; } }
    LDS_BARRIER();
    return __builtin_amdgcn_readfirstlane(pstart[NE] >> 8);
}

__device__ __forceinline__ const float* inp_ptr(const unsigned char* ldsl, int i) {
    const unsigned long long v = ((const unsigned long long*)(ldsl + PTAB_OFF))[i];
    const unsigned lo = __builtin_amdgcn_readfirstlane((unsigned)v), hi = __builtin_amdgcn_readfirstlane((unsigned)(v >> 32));
    return (const float*)(const GAS float*)(((unsigned long long)hi << 32) | lo);
}

__device__ __forceinline__ void titem_load(f32x4 (&v)[16], const float* mbase, unsigned off, int pitchB, int lane) {
    const __amdgpu_buffer_rsrc_t rs = __builtin_amdgcn_make_buffer_rsrc((void*)mbase, 0, 0x7fffffff, 0x00020000);
    const int vo = (lane >> 4) * 2 * pitchB + (lane & 15) * 16;
#pragma unroll
    for (int i = 0; i < 16; ++i) v[i] = __builtin_bit_cast(f32x4, __builtin_amdgcn_raw_buffer_load_b128(rs, vo, (int)off + ((i >> 1) * 8 + (i & 1)) * pitchB, 2));
}
__device__ __forceinline__ void titem_store(const f32x4 (&v)[16], bf16_t* __restrict__ dst, unsigned* scr, int lane) {
    { unsigned* wp = scr + (lane & 15) * 4 * 33 + (lane >> 4);
#pragma unroll
      for (int i = 0; i < 8; ++i)
#pragma unroll
          for (int nn = 0; nn < 4; ++nn) wp[nn * 33 + 4 * i] = pk2(v[2 * i][nn], v[2 * i + 1][nn]); }
    LDS_WAIT();
    const int c = lane & 7;
#pragma unroll
    for (int j = 0; j < 8; ++j) { const int nn = (lane >> 3) + 8 * j; const unsigned* t = scr + nn * 33 + 4 * c;
        u32x4 o; o.x = t[0]; o.y = t[1]; o.z = t[2]; o.w = t[3];
        __builtin_nontemporal_store(o, (u32x4*)(dst + (size_t)nn * DM + 8 * c)); }
    LDS_WAIT();
}
__device__ __forceinline__ void moe_item(int it, int l, const float* wgu, const float* wdn, bf16_t* bgu, bf16_t* bdn, const float*& mbase, unsigned& off, int& pitchB, bf16_t*& dst) {
    constexpr int I_GU = 16 * 32, I_DN = 16 * 16, N_GU = 32 * I_GU;
    if (it < N_GU) { const int e = it / I_GU, r = it % I_GU, kb = r / 32, n0 = (r % 32) * 64;
        const int drow = n0 < 1024 ? (n0 >> 7) * 256 + (n0 & 127) : ((n0 - 1024) >> 7) * 256 + 128 + ((n0 - 1024) & 127);
        mbase = wgu + (size_t)l * NE * DM * 2048; off = (unsigned)((e * DM + kb * 64) * 2048 + n0) * 4u; pitchB = 2048 * 4;
        dst = bgu + (size_t)(l * NE + e) * 2048 * DM + (size_t)drow * DM + kb * 64; }
    else { const int q = it - N_GU, e = q / I_DN, r = q % I_DN, kb = r / 16, n0 = (r % 16) * 64;
        mbase = wdn + (size_t)l * NE * DE * DM; off = (unsigned)((e * DE + kb * 64) * DM + n0) * 4u; pitchB = DM * 4;
        dst = bdn + (size_t)(l * NE + e) * DM * DE + (size_t)n0 * DE + kb * 64; }
}

__device__ __forceinline__ void ctx_outproj_block(const bf16_t* __restrict__ mixc, const bf16_t* __restrict__ wout, const float* __restrict__ base, bf16_t* __restrict__ out,
                                                  const float* __restrict__ gate, int blk, unsigned char* lds) {
    const int tid = fresh_tid(), lane = tid & 63, wave = __builtin_amdgcn_readfirstlane(tid >> 6), r32 = lane & 31, hi = lane >> 5;
    const int rb = blk >> 4, cb = blk & 15;
    const bf16_t* Ap = mixc + (size_t)(rb * 32 + r32) * DM + wave * 128 + 8 * hi;
    const bf16_t* Bp = wout + (size_t)(cb * 64 + r32) * DM + wave * 128 + 8 * hi;
    bf16x8 af[8], b0f[8], b1f[8];
#pragma unroll
    for (int ks = 0; ks < 8; ++ks) { af[ks] = *(const bf16x8*)(Ap + ks * 16); b0f[ks] = *(const bf16x8*)(Bp + ks * 16); b1f[ks] = *(const bf16x8*)(Bp + (size_t)32 * DM + ks * 16); }
    f32x16 a0 = {}, a1 = {};
#pragma unroll
    for (int ks = 0; ks < 8; ++ks) { a0 = __builtin_amdgcn_mfma_f32_32x32x16_bf16(af[ks], b0f[ks], a0, 0, 0, 0); a1 = __builtin_amdgcn_mfma_f32_32x32x16_bf16(af[ks], b1f[ks], a1, 0, 0, 0); }
    float* red = (float*)lds;
#pragma unroll
    for (int r = 0; r < 16; ++r) { red[((wave * 2 + 0) * 16 + r) * 64 + lane] = a0[r]; red[((wave * 2 + 1) * 16 + r) * 64 + lane] = a1[r]; }
    LDS_BARRIER();
#pragma unroll
    for (int q = 0; q < 4; ++q) { const int idx = tid + 512 * q, t = idx >> 10, r = (idx >> 6) & 15, ln = idx & 63; float sum = 0.f;
#pragma unroll
        for (int w = 0; w < 8; ++w) sum += red[((w * 2 + t) * 16 + r) * 64 + ln];
        const int row = rb * 32 + (r & 3) + 8 * (r >> 2) + 4 * (ln >> 5), col = cb * 64 + t * 32 + (ln & 31);
        out[(size_t)row * DM + col] = (bf16_t)f2bf(base[(size_t)row * DM + col] + gate[col] * sum); }
    LDS_BARRIER();
}

#ifndef GSPLIT
#define GSPLIT 144
#endif
constexpr int PH_PRO = 0, PH_NORM0 = 1, PH_L0 = 2, NPH_LAYER = 9, NPH = PH_L0 + NLAYER * NPH_LAYER;

__global__ void __launch_bounds__(NWAVES * 64, 2) fwd(Args args) {
    extern __shared__ __attribute__((aligned(16))) unsigned char lds[];
    const int G = gridDim.x, bx = blockIdx.x;
    const int vcu = (G % 8 == 0) ? (bx % 8) * (G / 8) + bx / 8 : bx;
    const int NGW = G * NWAVES;
#define PH_TID() const int tid = fresh_tid(), lane = tid & 63, wave = __builtin_amdgcn_readfirstlane(tid >> 6), gw = vcu * NWAVES + wave; (void)lane; (void)wave; (void)gw; \
    GAS unsigned char* wsg_ = (GAS unsigned char*)ws0; asm volatile("" : "+s"(wsg_)); unsigned char* ws = (unsigned char*)wsg_; \
    LAS const unsigned char* ldl_ = (LAS const unsigned char*)lds; asm volatile("" : "+v"(ldl_)); const unsigned char* ldsl = (const unsigned char*)ldl_
    unsigned char* const ws0 = args.ws;
#define G_ctl   ((unsigned*)(ws + WS_CTL))
#define G_modb  ((float*)(ws + WS_MOD))
#define G_ropet ((f32x2*)(ws + WS_ROPE))
#define G_scal  ((float*)(ws + WS_SCAL))
#define G_wb_in ((bf16_t*)(ws + WS_WIN))
#define G_wb_out ((bf16_t*)(ws + WS_WOUT))
#define G_wb_gu ((bf16_t*)(ws + WS_WGU))
#define G_wb_dn ((bf16_t*)(ws + WS_WDN))
#define G_hbuf  ((bf16_t*)(ws + WS_H))
#define G_proj  ((bf16_t*)(ws + WS_PROJ))
#define G_xbcs  ((bf16_t*)(ws + WS_XBC))
#define G_dtv   ((float*)(ws + WS_DT))
#define G_av    ((float*)(ws + WS_AV))
#define G_gkv   ((float*)(ws + WS_GKV))
#define G_ydir  ((bf16_t*)(ws + WS_YDIR))
#define G_odir  ((bf16_t*)(ws + WS_ODIR))
#define G_mix   ((bf16_t*)(ws + WS_MIX))
#define G_xw    ((bf16_t*)(ws + WS_XW))
#define G_list  ((int*)(ws + WS_LIST))
#define G_gatev ((float*)(ws + WS_GATE))
#define G_actb  ((bf16_t*)(ws + WS_ACT))
#define G_yk    ((bf16_t*)(ws + WS_YK))

    volatile LAS unsigned* MISC = (volatile LAS unsigned*)((LAS unsigned char*)lds + MISC_OFF);
    for (int u = threadIdx.x; u < 64; u += NWAVES * 64) MISC[u] = 0u;
    if (threadIdx.x < 28) ((const float**)(lds + PTAB_OFF))[threadIdx.x] = args.in[threadIdx.x];
#define INP(i) inp_ptr(ldsl, (i))
    __syncthreads();
    const int lo = args.ph_lo, hi = args.ph_hi;
    XcdBarrier bar; bar.bar = (unsigned*)(ws0 + WS_CTL) + CW_BAR; bar.x = 0; bar.st = nullptr;
    if (hi - lo > 1) bar = xcd_barrier_post((unsigned*)(ws0 + WS_CTL) + CW_BAR, MISC + 8);
#ifndef PH_MASK
#define PH_MASK 0xFFF
#endif
#define KIND(k) ((k) < PH_L0 ? (k) : 2 + ((k) - PH_L0) % NPH_LAYER)
#define IN(k) (lo <= (k) && (k) < hi)
#define INK(k, kind) (((PH_MASK >> (kind)) & 1) && IN(k))
#ifndef DUP_MASK
#define DUP_MASK 0
#endif
#define REPS(kind) for (int rep_ = 0; rep_ < 1 + ((DUP_MASK >> (kind)) & 1); ++rep_)
#ifndef BAR_REPS
#define BAR_REPS 1
#endif
#define SEAM(k) do { if (IN(k) && IN((k) + 1)) for (int br_ = 0; br_ < BAR_REPS; ++br_) xcd_barrier(bar); } while (0)

    if (INK(PH_PRO, 0)) REPS(0) { PH_TID();
        unsigned* scr = (unsigned*)(lds + RING_OFF + wave * 16384);
        constexpr int I_IN = 16 * 52, I_OUT = 16 * 16;
        constexpr int N_IN = 2 * I_IN, N_OUT = 2 * I_OUT, NITEMS = N_IN + N_OUT;
        for (int it = gw; it < NITEMS; it += NGW) {
            int r = it;
            if (r < N_IN) { const int l = r / I_IN; r %= I_IN; const int kb = r / 52, nb = r % 52;
                transpose_item(INP(I_WIN) + (size_t)l * DM * INW, DM, INW, G_wb_in + (size_t)l * INWP * DM, nb * 64, nb * 64, kb * 64, scr, lane); continue; }
            r -= N_IN;
            { const int l = r / I_OUT; r %= I_OUT; const int kb = r / 16, nb = r % 16;
                transpose_item(INP(I_WOUT) + (size_t)l * DM * DM, DM, DM, G_wb_out + (size_t)l * DM * DM, nb * 64, nb * 64, kb * 64, scr, lane); }
        }
        __syncthreads();
        for (int it = bx; it < 48; it += G) {
            const int l = it / 24, j0 = (it % 24) * 256;
            float* sc = (float*)(lds + RING_OFF);
            float* red = sc + 3072;
            for (int i = tid; i < 3072; i += 512) { const int v = i >> 10, k = i & 1023; const float cv = v < 2 ? INP(I_C)[v * DM + k] : INP(I_CCTX)[k]; sc[i] = siluf(cv); }
            __syncthreads();
            const int ks = tid >> 6;
            f32x4 a0 = {0.f, 0.f, 0.f, 0.f}, a1 = a0, a2 = a0;
            const float* wp = INP(I_WADA) + (size_t)l * DM * 6144 + j0 + 4 * lane;
            for (int k = ks * 128; k < ks * 128 + 128; ++k) { const f32x4 w = *(const f32x4*)(wp + (size_t)k * 6144); a0 += w * sc[k]; a1 += w * sc[1024 + k]; a2 += w * sc[2048 + k]; }
            *(f32x4*)(red + (ks * 3 + 0) * 256 + 4 * lane) = a0; *(f32x4*)(red + (ks * 3 + 1) * 256 + 4 * lane) = a1; *(f32x4*)(red + (ks * 3 + 2) * 256 + 4 * lane) = a2;
            __syncthreads();
            for (int i = tid; i < 768; i += 512) { const int v = i >> 8, jj = i & 255; float s = INP(I_BADA)[l * 6144 + j0 + jj];
                for (int q = 0; q < 8; ++q) s += red[(q * 3 + v) * 256 + jj];
                G_modb[(size_t)(l * 3 + v) * 6144 + j0 + jj] = s; }
            __syncthreads();
        }
        if (bx == (50 % G) || bx == (51 % G)) { const int l = bx == (50 % G) ? 0 : 1; float* wrt = (float*)(ws + WS_WRT) + l * 32768; const float* wr = INP(I_WR) + (size_t)l * 32768;
            for (int i = tid; i < 32768; i += 512) wrt[(i & 31) * 1024 + (i >> 5)] = wr[i]; }
        if (bx == (48 % G)) {
            for (int i = tid; i < 2048; i += 512) { const int pos = i >> 4, j = i & 15; const float inv = exp2f(-0.25f * (float)j * 3.3219280948873623f);
                const float ang = (float)pos * inv; G_ropet[i] = (f32x2){cosf(ang), sinf(ang)}; }
        }
        if (bx == (49 % G) && tid < NLAYER) {
            const float* lp = INP(I_DALAM) + tid * 256; float s01 = 0.f, s23 = 0.f;
            for (int i = 0; i < 64; ++i) { s01 += lp[i] * lp[64 + i]; s23 += lp[128 + i] * lp[192 + i]; }
            const float li = 0.8f - 0.6f * expf(-0.3f * (float)tid);
            G_scal[tid * 2 + 0] = expf(s01) - expf(s23) + li; G_scal[tid * 2 + 1] = 1.0f - li;
        }
    }
    SEAM(PH_PRO);
    if (INK(PH_NORM0, 1)) { PH_TID();
        for (int row = gw; row < TALL; row += NGW) {
            const int bidx = row < SEQ ? 0 : (row < TLAT ? 1 : 2);
            const float* xr = row < TLAT ? INP(I_X) + (size_t)row * DM : INP(I_CTX) + (size_t)(row - TLAT) * DM;
            f32x4 v[4];
#pragma unroll
            for (int j = 0; j < 4; ++j) v[j] = *(const f32x4*)(xr + 4 * lane + 256 * j);
            const float* mp = G_modb + (size_t)bidx * 6144;
            norm_mod_store(v, INP(I_N1W), mp, mp + 1024, G_hbuf + (size_t)row * DM, lane);
        }
    }
    SEAM(PH_NORM0);

    for (int l = 0; l < NLAYER; ++l) {
        const int P = PH_L0 + l * NPH_LAYER;
        const bool last = (l == NLAYER - 1);
#define modl (G_modb + (size_t)l * 3 * 6144)
        if (INK(P + 0, 2)) REPS(2) { PH_TID();
            int bxp = bx; asm volatile("" : "+s"(bxp));
            const bool split = G > GSPLIT; const int Gg = split ? GSPLIT : G;
            if (bxp < Gg) {
            pg8::Gemm g{G_hbuf, G_wb_in + (size_t)l * INWP * DM, TALL, INWP, DM, 0};
            pg8::StaticOrder S; S.init(TALL, INWP, Gg, bxp);
            pg8::EpiBf16 E{G_proj, INWP, (const float*)G_ropet, TLAT / 256};
            pg8::gemm_phase<pg8::EpiBf16, pg8::StaticOrder, true, true>((LAS unsigned char*)lds + RING_OFF, g, S, E);
            }
            if (bxp >= Gg || !split) {
                const int lane = fresh_tid() & 63;
                unsigned* scr = (unsigned*)(lds + RING_OFF + wave * 16384);
                constexpr int NIT = 32 * (16 * 32 + 16 * 16);
                const int ncw = (split ? G - GSPLIT : G) * NWAVES; int it = (split ? bxp - GSPLIT : bxp) * NWAVES + wave;
                const float* wgu = INP(I_WGU); const float* wdn = INP(I_WDN);
                if (it < NIT) {
                    f32x4 va[16], vb[16]; const float* mb; unsigned off; int pb; bf16_t* da; bf16_t* db;
                    moe_item(it, l, wgu, wdn, G_wb_gu, G_wb_dn, mb, off, pb, da); titem_load(va, mb, off, pb, lane);
                    for (;;) {
                        int nx = it + ncw;
                        moe_item(nx < NIT ? nx : NIT - 1, l, wgu, wdn, G_wb_gu, G_wb_dn, mb, off, pb, db); titem_load(vb, mb, off, pb, lane);
                        titem_store(va, da, scr, lane);
                        if (nx >= NIT) break;
                        it = nx; nx = it + ncw;
                        moe_item(nx < NIT ? nx : NIT - 1, l, wgu, wdn, G_wb_gu, G_wb_dn, mb, off, pb, da); titem_load(va, mb, off, pb, lane);
                        titem_store(vb, db, scr, lane);
                        if (nx >= NIT) break;
                        it = nx;
                    }
                }
            }
        }
        SEAM(P + 0);
#define CP_INIT()         ck::P cp; \
        cp.proj = G_proj; cp.xbcs = G_xbcs; cp.dtv = G_dtv; cp.cumv = G_av; cp.gkv = G_gkv; cp.ssd_st = G_ydir; cp.gla_st = G_odir; cp.cds = (float*)(ws + WS_CDS); cp.cdg = (float*)(ws + WS_CDG); cp.mix = G_mix; cp.ropet = G_ropet; \
        cp.convw = INP(I_CONVW) + l * 3 * 512; cp.convb = INP(I_CONVB) + l * 512; cp.dtb = INP(I_DTB) + l * 8; cp.alog = INP(I_ALOG) + l * 8; \
        cp.gkup = INP(I_GKUP) + (size_t)l * 2 * 16 * 128; cp.gkb = INP(I_GKB) + l * 2 * 128; cp.ssdd = INP(I_SSDD) + l * 4; cp.ssdnw = INP(I_SSDNW) + l * 256; cp.glanw = INP(I_GLANW) + l * 64; cp.kmax2 = G_ctl + CW_KMAX + l * 16; cp.hins = (bf16_t*)(ws + WS_HINS); cp.hing = (bf16_t*)(ws + WS_HING);
        if (INK(P + 1, 3)) REPS(3) { PH_TID(); CP_INIT();
            for (int ui = 0; ui < 2; ++ui) { int ch, sect;
                if (ui == 0) { if (bx >= TLAT / 64) continue; ch = bx; sect = 14; }
                else { if ((bx & 7) != 4 || (bx >> 3) >= 24) continue; const int u = bx >> 3; ch = TLAT / 64 + u / 3; sect = 2 << (u % 3); }
#ifndef PREP_DUP_SECT
#define PREP_DUP_SECT 15
#endif
                ck::prep_chunk(cp, ch, lds + RING_OFF, rep_ > 0 ? (sect & PREP_DUP_SECT) : sect, rep_ > 0); }
        }
        SEAM(P + 1);
        if (INK(P + 2, 4)) { PH_TID(); CP_INIT();
            for (int vb = bx; vb < 256; vb += G) ck::scan_phase(cp, vb);
        }
        SEAM(P + 2);
        if (INK(P + 3, 5)) REPS(5) { PH_TID(); CP_INIT();
            const float lam = __uint_as_float(__builtin_amdgcn_readfirstlane(__float_as_uint(G_scal[l * 2 + 0]))), osc = __uint_as_float(__builtin_amdgcn_readfirstlane(__float_as_uint(G_scal[l * 2 + 1])));
            const float* subw = INP(I_SUBW) + l * 128;
#ifndef ATT_DUP_PART
#define ATT_DUP_PART 3
#endif
#ifndef NO_ATT
            if (rep_ == 0 || (ATT_DUP_PART & 1)) for (int i = 0; i < 3; ++i) {
                int bh, qrow0, nkeys;
                if (i < 2) { bh = bx & 7; const int qb = i * 32 + (bx >> 3); qrow0 = (bh >> 2) * SEQ + qb * 128; nkeys = LCTX + SEQ; if ((bx >> 3) >= 32) continue; }
                else { if (last || (bx & 15) != 2 || (bx >> 4) >= 16) continue; const int u = bx >> 4; bh = u >> 1; qrow0 = TLAT + (bh >> 2) * LCTX + (u & 1) * 128; nkeys = LCTX; }
                att::attn_unit(G_proj, G_mix, subw, lam, osc, G_ctl + CW_KMAX + l * 16 + (bh >> 2) * 8, bh >> 2, bh & 3, qrow0, nkeys, (char*)lds + RING_OFF);
            }
#endif
#ifndef NO_FIN
            if (rep_ == 0 || (ATT_DUP_PART & 2)) for (int ui = 0; ui < 2; ++ui) { int ch, sect;
                if (ui == 0) { if (bx >= TLAT / 64) continue; ch = bx; sect = 15; }
                else { if (last || (bx & 7) != 4) continue; const int u = bx >> 3; ch = TLAT / 64 + (u >> 2); sect = 1 << (u & 3); }
                ck::finish_chunk(cp, ch, lds + RING_OFF, sect); }
#endif
        }
        SEAM(P + 3);
        if (INK(P + 4, 6)) REPS(6) { PH_TID();
            const int M = TLAT;
            pg8::Gemm g{G_mix, G_wb_out + (size_t)l * DM * DM, M, DM, DM, 0};
            pg8::StaticOrder S; S.init(M, DM, G, bx);
            pg8::EpiRes E{INP(I_X), INP(I_CTX), l == 0 ? (const bf16_t*)nullptr : (const bf16_t*)G_xw, G_xw, modl + 2 * 1024, 6144};
            pg8::gemm_phase<pg8::EpiRes, pg8::StaticOrder, true, true>((LAS unsigned char*)lds + RING_OFF, g, S, E);
            if (!last && bx < 256) ctx_outproj_block(G_mix + (size_t)TLAT * DM, G_wb_out + (size_t)l * DM * DM, INP(I_CTX), G_xw + (size_t)TLAT * DM, modl + 2 * 6144 + 2 * 1024, bx, lds + RING_OFF);
        }
        SEAM(P + 4);
        if (INK(P + 5, 7)) REPS(7) { PH_TID(); const bool dry = rep_ > 0;
            const int ntok = last ? TLAT : TALL, TPW = ntok / G;
            float* wT = (float*)(lds + RING_OFF);
            int* selE = (int*)(lds + RT_OFF); int* selP = selE + 272; int* lcnt = selP + 272; int* basep = lcnt + 32;
            { const float* wrt = (const float*)(ws + WS_WRT) + l * 32768;
              for (int i = tid; i < 8192; i += 512) *(f32x4*)(wT + 4 * i) = *(const f32x4*)(wrt + 4 * i); }
            if (tid < 32 && !dry) lcnt[tid] = 0;
            LDS_BARRIER();
            const int tok0 = bx * TPW;
            const float* n2w = INP(I_N2W) + l * DM;
            if (TPW * G == ntok && TPW <= 68 && (TPW & 1) == 0) {
            float* wsc = (float*)(lds + RT_OFF + 2560) + wave * 80;
            const float brl = INP(I_BR)[l * NE + (lane >> 1)];
            u32x2 rawn[2][4];
#pragma unroll
            for (int t = 0; t < 2; ++t)
#pragma unroll
                for (int j = 0; j < 4; ++j) rawn[t][j] = *(const u32x2*)(G_xw + (size_t)(tok0 + wave * 2 + t) * DM + 4 * lane + 256 * j);
            for (int tl = wave * 2; tl < TPW; tl += 2 * NWAVES) {
                const int row0 = tok0 + tl;
                f32x4 v[2][4]; float ss[2] = {0.f, 0.f};
#pragma unroll
                for (int t = 0; t < 2; ++t)
#pragma unroll
                    for (int j = 0; j < 4; ++j) { const u32x2 w = rawn[t][j];
                        v[t][j] = (f32x4){__uint_as_float(w.x << 16), __uint_as_float(w.x & 0xffff0000u), __uint_as_float(w.y << 16), __uint_as_float(w.y & 0xffff0000u)};
                        ss[t] += (v[t][j].x * v[t][j].x + v[t][j].y * v[t][j].y) + (v[t][j].z * v[t][j].z + v[t][j].w * v[t][j].w); }
                { ss[0] = wave_sum(ss[0]); ss[1] = wave_sum(ss[1]); }
                { f32x4 wn[4];
#pragma unroll
                  for (int j = 0; j < 4; ++j) wn[j] = *(const f32x4*)(n2w + 4 * lane + 256 * j);
#pragma unroll
                  for (int t = 0; t < 2; ++t) { const int row = row0 + t, bidx = row < SEQ ? 0 : (row < TLAT ? 1 : 2); const float* mp = modl + (size_t)bidx * 6144;
                    const float r = rsqrtf(ss[t] * (1.0f / DM) + EPS);
                    f32x4 ma[4], mb[4];
#pragma unroll
                    for (int j = 0; j < 4; ++j) { const int c = 4 * lane + 256 * j; ma[j] = *(const f32x4*)(mp + 4 * 1024 + c); mb[j] = *(const f32x4*)(mp + 3 * 1024 + c); }
                    __builtin_amdgcn_sched_barrier(0);
#pragma unroll
                    for (int j = 0; j < 4; ++j) { const int c = 4 * lane + 256 * j;
                        v[t][j] = (v[t][j] * r) * wn[j] * (ma[j] + 1.0f) + mb[j];
                        u32x2 o; o.x = pk2(v[t][j].x, v[t][j].y); o.y = pk2(v[t][j].z, v[t][j].w); *(u32x2*)(G_hbuf + (size_t)row * DM + c) = o; } } }
                if (tl + 2 * NWAVES < TPW) {
#pragma unroll
                    for (int t = 0; t < 2; ++t)
#pragma unroll
                        for (int j = 0; j < 4; ++j) rawn[t][j] = *(const u32x2*)(G_xw + (size_t)(row0 + 2 * NWAVES + t) * DM + 4 * lane + 256 * j); }
                float pa[32], pb[32];
                { f32x2 vv[4][4];
#pragma unroll
                  for (int j = 0; j < 4; ++j) { vv[j][0] = (f32x2){v[0][j].x, v[1][j].x}; vv[j][1] = (f32x2){v[0][j].y, v[1][j].y}; vv[j][2] = (f32x2){v[0][j].z, v[1][j].z}; vv[j][3] = (f32x2){v[0][j].w, v[1][j].w}; }
                  f32x4 wb[2][8];
#pragma unroll
                  for (int q = 0; q < 8; ++q) wb[0][q] = *(const f32x4*)(wT + (q >> 2) * 1024 + 4 * lane + 256 * (q & 3));
#pragma unroll
                  for (int bt = 0; bt < 16; ++bt) {
                      if (bt + 1 < 16) {
#pragma unroll
                          for (int q = 0; q < 8; ++q) wb[(bt + 1) & 1][q] = *(const f32x4*)(wT + (2 * (bt + 1) + (q >> 2)) * 1024 + 4 * lane + 256 * (q & 3)); }
#pragma unroll
                      for (int ee = 0; ee < 2; ++ee) { f32x2 acc = {0.f, 0.f};
#pragma unroll
                          for (int j = 0; j < 4; ++j) { const f32x4 w = wb[bt & 1][ee * 4 + j];
                              acc = __builtin_elementwise_fma(vv[j][0], (f32x2){w.x, w.x}, acc); acc = __builtin_elementwise_fma(vv[j][1], (f32x2){w.y, w.y}, acc);
                              acc = __builtin_elementwise_fma(vv[j][2], (f32x2){w.z, w.z}, acc); acc = __builtin_elementwise_fma(vv[j][3], (f32x2){w.w, w.w}, acc); }
                          pa[2 * bt + ee] = acc.x; pb[2 * bt + ee] = acc.y; } } }
                float qa[16], qb[16], ra[8], rb[8], sa_[4], sb_[4], ta[2], tb[2];
#pragma unroll
                for (int i = 0; i < 16; ++i) { auto r0 = __builtin_amdgcn_permlane32_swap(__float_as_uint(pa[i]), __float_as_uint(pa[16 + i]), false, false);
                    auto r1 = __builtin_amdgcn_permlane32_swap(__float_as_uint(pb[i]), __float_as_uint(pb[16 + i]), false, false);
                    qa[i] = __uint_as_float(r0[0]) + __uint_as_float(r0[1]); qb[i] = __uint_as_float(r1[0]) + __uint_as_float(r1[1]); }
                { const bool up = (lane & 16) != 0;
#pragma unroll
                  for (int i = 0; i < 8; ++i) { const float s0 = up ? qa[i] : qa[8 + i], k0 = up ? qa[8 + i] : qa[i], s1 = up ? qb[i] : qb[8 + i], k1 = up ? qb[8 + i] : qb[i];
                      ra[i] = k0 + __shfl_xor(s0, 16); rb[i] = k1 + __shfl_xor(s1, 16); } }
                { const bool up = (lane & 8) != 0;
#pragma unroll
                  for (int i = 0; i < 4; ++i) { const float s0 = up ? ra[i] : ra[4 + i], k0 = up ? ra[4 + i] : ra[i], s1 = up ? rb[i] : rb[4 + i], k1 = up ? rb[4 + i] : rb[i];
                      sa_[i] = k0 + dpp_perm<0x128>(s0); sb_[i] = k1 + dpp_perm<0x128>(s1); } }
                { const bool up = (lane & 4) != 0;
#pragma unroll
                  for (int i = 0; i < 2; ++i) { const float s0 = up ? sa_[i] : sa_[2 + i], k0 = up ? sa_[2 + i] : sa_[i], s1 = up ? sb_[i] : sb_[2 + i], k1 = up ? sb_[2 + i] : sb_[i];
                      ta[i] = k0 + dpp_perm<0x1B>(dpp_perm<0x141>(s0)); tb[i] = k1 + dpp_perm<0x1B>(dpp_perm<0x141>(s1)); } }
                float la, lb;
                { const bool up = (lane & 2) != 0; const float s0 = up ? ta[0] : ta[1], k0 = up ? ta[1] : ta[0], s1 = up ? tb[0] : tb[1], k1 = up ? tb[1] : tb[0];
                  la = k0 + dpp_perm<0x4E>(s0); lb = k1 + dpp_perm<0x4E>(s1); }
                la += dpp_perm<0xB1>(la); lb += dpp_perm<0xB1>(lb);
                if ((lane & 1) == 0) { wsc[lane >> 1] = la + brl; wsc[32 + (lane >> 1)] = lb + brl; }
                LDS_WAIT();
                const int t = lane >> 5, e = lane & 31; const float* lg = wsc + t * 32; const float mine = lg[e]; int rank = 0;
#pragma unroll
                for (int q = 0; q < 8; ++q) { const f32x4 o4 = *(const f32x4*)(lg + 4 * q); const float ov[4] = {o4.x, o4.y, o4.z, o4.w};
#pragma unroll
                    for (int i = 0; i < 4; ++i) { const int j = 4 * q + i; rank += (ov[i] > mine || (ov[i] == mine && j < e)) ? 1 : 0; } }
                if (rank < 4) wsc[64 + t * 4 + rank] = mine;
                LDS_WAIT();
                if (rank < 4) { const f32x4 sv = *(const f32x4*)(wsc + 64 + t * 4);
                    const float e0 = __expf(sv.x - sv.x), e1 = __expf(sv.y - sv.x), e2 = __expf(sv.z - sv.x), e3 = __expf(sv.w - sv.x);
                    const float gk = __expf(mine - sv.x) / ((e0 + e1) + (e2 + e3));
                    const int lp = dry ? 0 : atomicAdd(&lcnt[e], 1);
                    if (!dry) { selE[(tl + t) * 4 + rank] = e; selP[(tl + t) * 4 + rank] = lp; } G_gatev[(size_t)(row0 + t) * 4 + rank] = gk; }
                LDS_WAIT();
            }
            }
            LDS_BARRIER();
            if (tid < 32 && !dry) basep[tid] = (int)atomicAdd(&G_ctl[CW_CNT + l * 32 + tid], (unsigned)lcnt[tid]);
            LDS_BARRIER();
            if (!dry) for (int i = tid; i < TPW * 4; i += 512) { const int e = selE[i]; const int pos = basep[e] + selP[i]; if (pos < LISTCAP) G_list[(size_t)e * LISTCAP + pos] = tok0 * 4 + i; }
        }
        SEAM(P + 5);
        if (INK(P + 6, 9)) REPS(9) { PH_TID();
            int* tile_e = (int*)(lds + TAB_OFF); int* pstart = tile_e + 304; int* cntl = pstart + 40;
            const int nrt = moe_tables(G_ctl + CW_CNT + l * 32, tile_e, pstart, cntl);
            pg8::Gemm g{G_hbuf, G_wb_gu + (size_t)l * NE * 2048 * DM, nrt * 256, 2048, DM, (size_t)2048 * DM * 2};
            pg8::MoeOrderT<true> S{(const LAS int*)((LAS unsigned char*)lds + TAB_OFF), (const LAS int*)((LAS unsigned char*)lds + TAB_OFF) + 304, (const LAS int*)((LAS unsigned char*)lds + TAB_OFF) + 344, G_list, nrt, 8, 3, G, vcu};
            pg8::EpiAct E{G_actb, INP(I_BGU) + (size_t)l * NE * 2048};
            pg8::gemm_phase<pg8::EpiAct, pg8::MoeOrderT<true>, true, true>((LAS unsigned char*)lds + RING_OFF, g, S, E);
        }
        SEAM(P + 6);
        if (INK(P + 7, 10)) REPS(10) { PH_TID();
            int* tile_e = (int*)(lds + TAB_OFF); int* pstart = tile_e + 304; int* cntl = pstart + 40;
            const int nrt = (IN(P + 6) && ((PH_MASK >> 9) & 1)) ? __builtin_amdgcn_readfirstlane(pstart[NE] >> 8) : moe_tables(G_ctl + CW_CNT + l * 32, tile_e, pstart, cntl);
            pg8::Gemm g{G_actb, G_wb_dn + (size_t)l * NE * DM * DE, nrt * 256, DM, DE, (size_t)DM * DE * 2};
            pg8::MoeOrderT<false> S{(const LAS int*)((LAS unsigned char*)lds + TAB_OFF), (const LAS int*)((LAS unsigned char*)lds + TAB_OFF) + 304, (const LAS int*)((LAS unsigned char*)lds + TAB_OFF) + 344, G_list, nrt, 4, 2, G, vcu};
            pg8::EpiDown E{G_yk, INP(I_BDN) + (size_t)l * NE * DM, &S, G_gatev};
            pg8::gemm_phase<pg8::EpiDown, pg8::MoeOrderT<false>, true, true>((LAS unsigned char*)lds + RING_OFF, g, S, E);
        }
        SEAM(P + 7);
        if (INK(P + 8, 11)) REPS(11) { PH_TID(); const bool dry = rep_ > 0;
            const int ntok = last ? TLAT : TALL;
            f32x4 nwv[4];
            { const float* nwp = last ? INP(I_FNW) : INP(I_N1W) + (l + 1) * DM;
#pragma unroll
              for (int q = 0; q < 4; ++q) nwv[q] = *(const f32x4*)(nwp + 8 * lane + 512 * (q >> 1) + 4 * (q & 1)); }
            for (int rowa = gw; rowa < ntok; rowa += 2 * NGW) {
                f32x4 v[2][4]; int rw[2]; bool ok[2];
#pragma unroll
                for (int t = 0; t < 2; ++t) { const int rr = rowa + t * NGW; ok[t] = rr < ntok; rw[t] = ok[t] ? rr : rowa; }
                u32x4 yv[2][2][4]; u32x4 xr[2][2];
#pragma unroll
                for (int t = 0; t < 2; ++t)
#pragma unroll
                    for (int jj = 0; jj < 2; ++jj) { const int c = 8 * lane + 512 * jj;
#pragma unroll
                        for (int k = 0; k < 4; ++k) yv[t][jj][k] = *(const u32x4*)(G_yk + ((size_t)rw[t] * 4 + k) * DM + c);
                        xr[t][jj] = *(const u32x4*)(G_xw + (size_t)rw[t] * DM + c); }
#pragma unroll
                for (int t = 0; t < 2; ++t) { const int row = rw[t], bidx = row < SEQ ? 0 : (row < TLAT ? 1 : 2); const float* mp = modl + (size_t)bidx * 6144;
                    const float* mn = G_modb + (size_t)((last ? l : l + 1) * 3 + bidx) * 6144;
                    f32x4 g2[4];
#pragma unroll
                    for (int q = 0; q < 4; ++q) g2[q] = *(const f32x4*)(mp + 5 * 1024 + 8 * lane + 512 * (q >> 1) + 4 * (q & 1));
                    __builtin_amdgcn_sched_barrier(0);
                    const float gsc = (dry && !last) ? 0.f : 1.f;
#pragma unroll
                    for (int jj = 0; jj < 2; ++jj) { const int c = 8 * lane + 512 * jj; float ff[8] = {0.f, 0.f, 0.f, 0.f, 0.f, 0.f, 0.f, 0.f};
#pragma unroll
                        for (int k = 0; k < 4; ++k) { float f8[8]; unpack8(yv[t][jj][k], f8);
#pragma unroll
                            for (int e = 0; e < 8; ++e) ff[e] += f8[e]; }
                        const f32x4 g2a = g2[jj * 2] * gsc, g2b = g2[jj * 2 + 1] * gsc;
                        float x8[8]; unpack8(xr[t][jj], x8);
                        v[t][jj * 2] = (f32x4){x8[0], x8[1], x8[2], x8[3]} + g2a * (f32x4){ff[0], ff[1], ff[2], ff[3]}; v[t][jj * 2 + 1] = (f32x4){x8[4], x8[5], x8[6], x8[7]} + g2b * (f32x4){ff[4], ff[5], ff[6], ff[7]};
                        if (!last && !dry && ok[t]) { const float o8[8] = {v[t][jj * 2].x, v[t][jj * 2].y, v[t][jj * 2].z, v[t][jj * 2].w, v[t][jj * 2 + 1].x, v[t][jj * 2 + 1].y, v[t][jj * 2 + 1].z, v[t][jj * 2 + 1].w};
                            *(u32x4*)(G_xw + (size_t)row * DM + c) = pack8(o8); } }
                    f32x4 ma[4], mb[4];
#pragma unroll
                    for (int q = 0; q < 4; ++q) { const int c = 8 * lane + 512 * (q >> 1) + 4 * (q & 1); ma[q] = *(const f32x4*)(mn + 1024 + c); mb[q] = *(const f32x4*)(mn + c); }
                    __builtin_amdgcn_sched_barrier(0);
                    float ss = 0.f;
#pragma unroll
                    for (int j = 0; j < 4; ++j) ss += (v[t][j].x * v[t][j].x + v[t][j].y * v[t][j].y) + (v[t][j].z * v[t][j].z + v[t][j].w * v[t][j].w);
                    const float r = rsqrtf(wave_sum(ss) * (1.0f / DM) + EPS);
                    if (ok[t]) {
                        if (!last) {
#pragma unroll
                            for (int jj = 0; jj < 2; ++jj) { const int c = 8 * lane + 512 * jj; float o8[8];
#pragma unroll
                                for (int hh = 0; hh < 2; ++hh) { const int q = jj * 2 + hh;
                                    const f32x4 y = (v[t][q] * r) * nwv[q] * (ma[q] + 1.0f) + mb[q]; o8[4 * hh] = y.x; o8[4 * hh + 1] = y.y; o8[4 * hh + 2] = y.z; o8[4 * hh + 3] = y.w; }
                                *(u32x4*)(G_hbuf + (size_t)row * DM + c) = pack8(o8); }
                        } else {
#pragma unroll
                            for (int jj = 0; jj < 2; ++jj) { const int c = 8 * lane + 512 * jj;
#pragma unroll
                                for (int hh = 0; hh < 2; ++hh) *(f32x4*)(args.out + (size_t)row * DM + c + 4 * hh) = (v[t][jj * 2 + hh] * r) * nwv[jj * 2 + hh]; }
                        }
                    }
                }
            }
        }
        SEAM(P + 8);
    }
#undef IN
#undef SEAM
}

extern "C" void kernel_launch(void* const* d_in, const int* in_sizes, int n_in, void* d_out, int out_size, void* d_ws, size_t ws_size, hipStream_t stream) {
    static int grid = 0;
    if (grid == 0) {
        if (n_in != 28 || out_size != TLAT * DM || ws_size < WS_END) { fprintf(stderr, "kernel_launch: unexpected shapes: n_in %d out %d ws %zu (need %zu)\n", n_in, out_size, ws_size, (size_t)WS_END); grid = -1; return; }
        int dev = 0, cus = 0, per_cu = 0;
        if (hipGetDevice(&dev) != hipSuccess || hipDeviceGetAttribute(&cus, hipDeviceAttributeMultiprocessorCount, dev) != hipSuccess) { grid = -1; return; }
        if (hipFuncSetAttribute((const void*)fwd, hipFuncAttributeMaxDynamicSharedMemorySize, LDS_BYTES) != hipSuccess) { fprintf(stderr, "kernel_launch: hipFuncSetAttribute failed\n"); grid = -1; return; }
        if (hipOccupancyMaxActiveBlocksPerMultiprocessor(&per_cu, (const void*)fwd, NWAVES * 64, LDS_BYTES) != hipSuccess || per_cu < 1) fprintf(stderr, "kernel_launch: occupancy query reports %d\n", per_cu);
        (void)hipGetLastError();
        grid = cus;
        if (grid != 256) fprintf(stderr, "kernel_launch: %d CUs (built for 256)\n", grid);
    }
    if (grid < 0) return;
    if (hipMemsetAsync((char*)d_ws + WS_CTL, 0, CTL_ZERO_BYTES, stream) != hipSuccess) return;
    Args a{};
    for (int i = 0; i < 28; ++i) a.in[i] = (const float*)d_in[i];
    a.out = (float*)d_out; a.ws = (unsigned char*)d_ws;
#if MK_N_LAUNCHES == 1
    a.ph_lo = 0; a.ph_hi = NPH;
    hipLaunchKernelGGL(fwd, dim3(grid), dim3(NWAVES * 64), LDS_BYTES, stream, a);
#else
    for (int p = 0; p < NPH; ++p) { a.ph_lo = p; a.ph_hi = p + 1; hipLaunchKernelGGL(fwd, dim3(grid), dim3(NWAVES * 64), LDS_BYTES, stream, a); }
#endif
    const hipError_t le = hipPeekAtLastError();
    if (le != hipSuccess) fprintf(stderr, "kernel_launch: launch failed: %s\n", hipGetErrorName(le));
}
```

```cpp
#include <hip/hip_runtime.h>
#include <cstdio>
#include <cstdint>

#ifndef MK_N_LAUNCHES
#define MK_N_LAUNCHES 1
#endif

#define GAS __attribute__((address_space(1)))
#define LAS __attribute__((address_space(3)))
typedef unsigned short bf16_t;
typedef short bf16x8 __attribute__((ext_vector_type(8)));
typedef short s16x4 __attribute__((ext_vector_type(4)));
typedef float f32x2 __attribute__((ext_vector_type(2)));
typedef float f32x4 __attribute__((ext_vector_type(4)));
typedef float f32x16 __attribute__((ext_vector_type(16)));
typedef unsigned u32x2 __attribute__((ext_vector_type(2)));
typedef unsigned u32x4 __attribute__((ext_vector_type(4)));

constexpr int DM = 1024, NB = 2, SEQ = 8192, LCTX = 256, NLAYER = 2;
constexpr int TLAT = NB * SEQ, TCTX = NB * LCTX, TALL = TLAT + TCTX;
constexpr int INW = 3112, INWP = 3328;
constexpr int C_Q = 0, C_K = 512, C_V = 1024, C_Z = 1536, C_XBC = 1792, C_DT = 2304, C_GQ = 2312, C_GK = 2440, C_GV = 2568, C_GG = 2824, C_CODE = 3080;
constexpr int NE = 32, DE = 1024;
constexpr int LISTCAP = TALL, MAXRT = 296, XB_ROWS = MAXRT * 256;
constexpr float EPS = 1e-6f;

constexpr size_t MiB = 1u << 20;
constexpr size_t WS_CTL = 0, CTL_ZERO_BYTES = 128 * 1024;
constexpr int CW_BAR = 4096, CW_CNT = 16384, CW_KMAX = 16384 + 64;
constexpr size_t WS_MOD = 1 * MiB, WS_ROPE = 1 * MiB + 256 * 1024, WS_SCAL = WS_ROPE + 16 * 1024, WS_CDS = WS_SCAL + 4096, WS_CDG = WS_SCAL + 32768, WS_WRT = WS_SCAL + 320 * 1024;
constexpr size_t WS_WIN = 2 * MiB, WS_WOUT = 15 * MiB, WS_WGU = 32 * MiB, WS_WDN = 288 * MiB;
constexpr size_t WS_H = 416 * MiB, WS_PROJ = 449 * MiB, WS_XBC = 557 * MiB, WS_DT = 574 * MiB, WS_AV = 575 * MiB, WS_GKV = 576 * MiB;
constexpr size_t WS_YDIR = 593 * MiB, WS_ODIR = 626 * MiB, WS_MIX = 659 * MiB, WS_XW = 692 * MiB, WS_LIST = 758 * MiB, WS_GATE = 761 * MiB, WS_RMAP = 762 * MiB;
constexpr size_t WS_HINS = 763 * MiB, WS_HING = 781 * MiB;
constexpr size_t WS_XB = 763 * MiB, WS_ACT = 911 * MiB, WS_YK = 1059 * MiB, WS_END = 1191 * MiB;

constexpr int RING_OFF = 0, RING_BYTES = 131072;
constexpr int MISC_OFF = RING_BYTES;
constexpr int TAB_OFF = RING_BYTES + 256;
constexpr int RT_OFF = RING_BYTES + 4096;
constexpr int LDS_BYTES = RING_BYTES + 12288;
constexpr int PTAB_OFF = LDS_BYTES - 256;
constexpr int NWAVES = 8;

__device__ __forceinline__ float bf2f(unsigned short b) { return __uint_as_float(((unsigned)b) << 16); }
typedef __bf16 bf16x2_t __attribute__((ext_vector_type(2)));
__device__ __forceinline__ unsigned pk2(float lo, float hi) { const f32x2 v = {lo, hi}; const bf16x2_t b = __builtin_convertvector(v, bf16x2_t); return __builtin_bit_cast(unsigned, b); }
__device__ __forceinline__ unsigned f2bf(float f) { return pk2(f, f) & 0xffffu; }
__device__ __forceinline__ float siluf(float x) { return x * __builtin_amdgcn_rcpf(1.0f + __expf(-x)); }
__device__ __forceinline__ float softplusf(float x) { return x > 20.f ? x : __logf(1.0f + __expf(x)); }
__device__ __forceinline__ float logsigmoidf(float x) { return fminf(x, 0.f) - __logf(1.0f + __expf(-fabsf(x))); }
template <int CTRL> __device__ __forceinline__ float dpp_perm(float x) {
    return __builtin_bit_cast(float, __builtin_amdgcn_mov_dpp(__builtin_bit_cast(int, x), CTRL, 0xf, 0xf, true)); }
template <int CTRL, int ROWMASK, bool BC> __device__ __forceinline__ float dpp_or0(float x) {
    return __builtin_bit_cast(float, __builtin_amdgcn_update_dpp(0, __builtin_bit_cast(int, x), CTRL, ROWMASK, 0xf, BC)); }
__device__ __forceinline__ float row16_allsum(float v) {
    v += dpp_perm<0xB1>(v); v += dpp_perm<0x4E>(v); v += dpp_perm<0x141>(v); v += dpp_perm<0x140>(v); return v; }
__device__ __forceinline__ float sum32(float v) {
    v = row16_allsum(v); const int iv = __builtin_bit_cast(int, v);
    const float s0 = __builtin_bit_cast(float, __builtin_amdgcn_readlane(iv, 0)), s1 = __builtin_bit_cast(float, __builtin_amdgcn_readlane(iv, 16));
    const float s2 = __builtin_bit_cast(float, __builtin_amdgcn_readlane(iv, 32)), s3 = __builtin_bit_cast(float, __builtin_amdgcn_readlane(iv, 48));
    return (threadIdx.x & 32) ? s2 + s3 : s0 + s1; }
__device__ __forceinline__ float wave_sum(float v) {
    v = row16_allsum(v); const int iv = __builtin_bit_cast(int, v);
    return (__builtin_bit_cast(float, __builtin_amdgcn_readlane(iv, 0)) + __builtin_bit_cast(float, __builtin_amdgcn_readlane(iv, 16))) +
           (__builtin_bit_cast(float, __builtin_amdgcn_readlane(iv, 32)) + __builtin_bit_cast(float, __builtin_amdgcn_readlane(iv, 48))); }
__device__ __forceinline__ float wave_scan(float x, int lane, bool rev) {
    float v = x;
    v += dpp_or0<0x111, 0xf, true>(v); v += dpp_or0<0x112, 0xf, true>(v); v += dpp_or0<0x114, 0xf, true>(v); v += dpp_or0<0x118, 0xf, true>(v);
    v += dpp_or0<0x142, 0xa, false>(v);
    v += dpp_or0<0x143, 0xc, false>(v);
    if (!rev) return v;
    const float tot = __builtin_bit_cast(float, __builtin_amdgcn_readlane(__builtin_bit_cast(int, v), 63));
    return (tot - v) + x;
}
__device__ __forceinline__ void unpack8(const u32x4 w, float (&f)[8]) {
    f[0] = __uint_as_float(w.x << 16); f[1] = __uint_as_float(w.x & 0xffff0000u); f[2] = __uint_as_float(w.y << 16); f[3] = __uint_as_float(w.y & 0xffff0000u);
    f[4] = __uint_as_float(w.z << 16); f[5] = __uint_as_float(w.z & 0xffff0000u); f[6] = __uint_as_float(w.w << 16); f[7] = __uint_as_float(w.w & 0xffff0000u);
}
__device__ __forceinline__ u32x4 pack8(const float (&f)[8]) { u32x4 w; w.x = pk2(f[0], f[1]); w.y = pk2(f[2], f[3]); w.z = pk2(f[4], f[5]); w.w = pk2(f[6], f[7]); return w; }
#define LDS_WAIT() asm volatile("s_waitcnt lgkmcnt(0)" ::: "memory")
#define LDS_BARRIER() asm volatile("s_waitcnt lgkmcnt(0)\n\ts_barrier" ::: "memory")
__device__ __forceinline__ int fresh_tid() { int t = threadIdx.x; asm volatile("" : "+v"(t)); return t; }

namespace pg8 {
#define PG8_LAS __attribute__((address_space(3)))
constexpr int BM = 256, BK = 64, HALF = 128, HTB = HALF * BK * 2, STAGE_BYTES = 8 * HTB, NXCD = 8, WGM = 8;
__host__ __device__ __forceinline__ int lds_byte(int r, int c) { const int st = (r >> 4) * 2 + (c >> 5), rr = r & 15, cc = c & 31, ob = rr * 64 + cc * 2; return st * 1024 + (ob ^ (((ob >> 9) & 1) << 5)); }
__host__ __device__ __forceinline__ void stage_rc(int b, int& R, int& C) { const int st = b / 1024, sb = b % 1024, swz = sb ^ (((sb >> 9) & 1) << 5); R = (st >> 1) * 16 + swz / 64; C = (st & 1) * 32 + (swz % 64) / 2; }
__host__ __device__ __forceinline__ int perm32(int rho) { const int n = rho >> 4, i = rho & 15; return 8 * (i >> 2) + 4 * n + (i & 3); }

struct Unit { int pm, pn, e; };
struct Gemm { const bf16_t* A; const bf16_t* Bt; int M, N, K; size_t estride; };

struct StaticOrder {
    static constexpr bool GATHER = false;
    int nM, nN, nwg, G, c;
    __host__ __device__ void init(int M, int N, int G_, int c_) { nM = M / BM; nN = N / BM; nwg = nM * nN; G = G_; c = c_; }
    __host__ __device__ bool next(int i, Unit& u) const {
        const long L = (long)i * G + c; if (L >= nwg) return false;
        int wgid = (int)L; { const int q = nwg / NXCD, r = nwg % NXCD, xcd = wgid % NXCD, off = wgid / NXCD; wgid = (xcd < r ? xcd * (q + 1) : r * (q + 1) + (xcd - r) * q) + off; }
        const int nig = WGM * nN, gid = wgid / nig, fm = gid * WGM, gsz = (nM - fm) < WGM ? (nM - fm) : WGM;
        u.pm = fm + ((wgid % nig) % gsz); u.pn = (wgid % nig) / gsz; u.e = 0; return true;
    }
    __device__ __forceinline__ const int* row_src(const Unit&, int) const { return nullptr; }
    __device__ __forceinline__ void a_ready(const Unit&) const {}
    __device__ __forceinline__ void done(const Unit&) const {}
};
template <bool GATHER_> struct MoeOrderT {
    static constexpr bool GATHER = GATHER_;
    const PG8_LAS int* tile_e; const PG8_LAS int* pstart; const PG8_LAS int* cntl; const int* list; int nrt, nN, lgN, G, cv;
    __device__ __forceinline__ bool next(int i, Unit& u) const {
        const int L = i * G + cv; if (L >= nrt * nN) return false;
        const int rt = L >> lgN; u.pm = rt; u.pn = L & (nN - 1); u.e = __builtin_amdgcn_readfirstlane(tile_e[rt]); return true;
    }
    __device__ __forceinline__ const int* row_src(const Unit& u, int r) const {
        const int ps = pstart[u.e], c = cntl[u.e]; int pos = u.pm * BM + r - ps; pos = pos < c ? pos : c - 1;
        return list + (size_t)u.e * LISTCAP + pos;
    }
    __device__ __forceinline__ int row_tok4(const Unit& u, int r) const {
        const int ps = pstart[u.e], c = cntl[u.e]; const int pos = u.pm * BM + r - ps;
        return pos < c ? list[(size_t)u.e * LISTCAP + pos] : -1;
    }
    __device__ __forceinline__ void a_ready(const Unit&) const {}
    __device__ __forceinline__ void done(const Unit&) const {}
};

__device__ __forceinline__ unsigned cvt_pk_bf16(float lo, float hi) { unsigned r; asm volatile("v_cvt_pk_bf16_f32 %0, %1, %2" : "=v"(r) : "v"(lo), "v"(hi)); return r; }

struct NoPre {};
struct EpiBf16 {
    static constexpr bool PERM = true, AFTER_DRAIN = false;
    typedef NoPre Pre; __device__ __forceinline__ void prefetch(Pre&, const Unit&, int, int, int, int) const {}
    bf16_t* O; int ldc;
    const float* ropet; int rope_pm;
    __device__ __forceinline__ void operator()(const f32x4 (&acc)[2][2][4][2], const Unit& u, int wr, int wc, int fr, int fq, const Pre&) const {
        const int row0 = u.pm * BM + wr * 64 + fr, col0 = u.pn * BM + wc * 32 + 8 * fq;
        if (ropet != nullptr && u.pn < 4 && u.pm < rope_pm) {
            const int t_ = fresh_tid(), fr_ = t_ & 15, fq_ = (t_ >> 4) & 3; const bool hiL = fq_ >= 2; const int half = wc & 1;
#pragma unroll
            for (int ai = 0; ai < 2; ++ai)
#pragma unroll
                for (int m = 0; m < 4; ++m) { const int row = u.pm * BM + wr * 64 + fr_ + ai * HALF + m * 16, sq = row & (SEQ - 1), pos = half ? (sq & 63) : (sq >> 6);
                    const f32x4* tp = (const f32x4*)(ropet + (size_t)(pos * 16 + 8 * (fq_ & 1)) * 2);
                    f32x4 cs[4];
#pragma unroll
                    for (int q = 0; q < 4; ++q) cs[q] = tp[q];
                    float A[8], B[8];
#pragma unroll
                    for (int i = 0; i < 8; ++i) { const float c = cs[i >> 1][(i & 1) * 2], sn = cs[i >> 1][(i & 1) * 2 + 1]; A[i] = hiL ? sn : c; B[i] = hiL ? c : -sn; }
                    bf16_t* rowp = O + (size_t)row * ldc + u.pn * BM + wc * 32 + 8 * fq_;
#pragma unroll
                    for (int bj = 0; bj < 2; ++bj) { float o8[8];
#pragma unroll
                        for (int i = 0; i < 8; ++i) { const float v = acc[ai][bj][m][i >> 2][i & 3];
                            auto r = __builtin_amdgcn_permlane32_swap(__float_as_uint(v), __float_as_uint(v), false, false);
                            o8[i] = __uint_as_float(r[0]) * A[i] + __uint_as_float(r[1]) * B[i]; }
                        u32x4 w; w.x = cvt_pk_bf16(o8[0], o8[1]); w.y = cvt_pk_bf16(o8[2], o8[3]); w.z = cvt_pk_bf16(o8[4], o8[5]); w.w = cvt_pk_bf16(o8[6], o8[7]);
                        *(u32x4*)(rowp + bj * HALF) = w; } }
            return; }
#pragma unroll
        for (int ai = 0; ai < 2; ++ai)
#pragma unroll
            for (int m = 0; m < 4; ++m) { bf16_t* rowp = O + (size_t)(row0 + ai * HALF + m * 16) * ldc + col0;
#pragma unroll
                for (int bj = 0; bj < 2; ++bj) { const f32x4 v0 = acc[ai][bj][m][0], v1 = acc[ai][bj][m][1];
                    u32x4 w; w.x = cvt_pk_bf16(v0[0], v0[1]); w.y = cvt_pk_bf16(v0[2], v0[3]); w.z = cvt_pk_bf16(v1[0], v1[1]); w.w = cvt_pk_bf16(v1[2], v1[3]);
                    *(u32x4*)(rowp + bj * HALF) = w; } }
    }
};
struct EpiRes {
    static constexpr bool PERM = false, AFTER_DRAIN = false;
    typedef NoPre Pre; __device__ __forceinline__ void prefetch(Pre&, const Unit&, int, int, int, int) const {}
    const float* baseL; const float* baseC; const bf16_t* baseB; bf16_t* out; const float* gate; int gstride;
    __device__ __forceinline__ void operator()(const f32x4 (&acc)[2][2][4][2], const Unit& u, int wr, int wc, int fr, int fq, const Pre&) const {
        const int rowt = u.pm * BM; const int bidx = rowt < SEQ ? 0 : (rowt < TLAT ? 1 : 2);
        const float* base = rowt < TLAT ? baseL + (size_t)rowt * DM : baseC + (size_t)(rowt - TLAT) * DM;
        const int t_ = fresh_tid(), fr_ = t_ & 15, fq_ = (t_ >> 4) & 3;
        (void)fr; (void)fq;
        const int rl = wr * 64 + fr_, col0 = u.pn * BM + wc * 32 + 4 * fq_;
        const float* gp = gate + (size_t)bidx * gstride + col0;
        f32x4 gv[2][2];
#pragma unroll
        for (int bj = 0; bj < 2; ++bj)
#pragma unroll
            for (int n = 0; n < 2; ++n) gv[bj][n] = *(const f32x4*)(gp + bj * HALF + n * 16);
        if (baseB) {
#pragma unroll
            for (int ai = 0; ai < 2; ++ai)
#pragma unroll
                for (int mp = 0; mp < 2; ++mp) { u32x2 bw[2][2][2];
#pragma unroll
                    for (int mm = 0; mm < 2; ++mm)
#pragma unroll
                        for (int bj = 0; bj < 2; ++bj)
#pragma unroll
                            for (int n = 0; n < 2; ++n) bw[mm][bj][n] = *(const u32x2*)(baseB + (size_t)rowt * DM + (size_t)(rl + ai * HALF + (2 * mp + mm) * 16) * DM + col0 + bj * HALF + n * 16);
                    __builtin_amdgcn_sched_barrier(0);
#pragma unroll
                    for (int mm = 0; mm < 2; ++mm) { const int m = 2 * mp + mm; bf16_t* op = out + (size_t)rowt * DM + (size_t)(rl + ai * HALF + m * 16) * DM + col0;
#pragma unroll
                        for (int bj = 0; bj < 2; ++bj)
#pragma unroll
                            for (int n = 0; n < 2; ++n) { const u32x2 w = bw[mm][bj][n];
                                const f32x4 bs = (f32x4){__uint_as_float(w.x << 16), __uint_as_float(w.x & 0xffff0000u), __uint_as_float(w.y << 16), __uint_as_float(w.y & 0xffff0000u)};
                                const f32x4 v = bs + gv[bj][n] * acc[ai][bj][m][n];
                                u32x2 o; o.x = cvt_pk_bf16(v[0], v[1]); o.y = cvt_pk_bf16(v[2], v[3]); *(u32x2*)(op + bj * HALF + n * 16) = o; } } }
        } else {
#pragma unroll
            for (int ai = 0; ai < 2; ++ai)
#pragma unroll
                for (int m = 0; m < 4; ++m) { f32x4 bf[2][2];
#pragma unroll
                    for (int bj = 0; bj < 2; ++bj)
#pragma unroll
                        for (int n = 0; n < 2; ++n) bf[bj][n] = *(const f32x4*)(base + (size_t)(rl + ai * HALF + m * 16) * DM + col0 + bj * HALF + n * 16);
                    __builtin_amdgcn_sched_barrier(0);
                    bf16_t* op = out + (size_t)rowt * DM + (size_t)(rl + ai * HALF + m * 16) * DM + col0;
#pragma unroll
                    for (int bj = 0; bj < 2; ++bj)
#pragma unroll
                        for (int n = 0; n < 2; ++n) { const f32x4 v = bf[bj][n] + gv[bj][n] * acc[ai][bj][m][n];
                            u32x2 o; o.x = cvt_pk_bf16(v[0], v[1]); o.y = cvt_pk_bf16(v[2], v[3]); *(u32x2*)(op + bj * HALF + n * 16) = o; } }
        }
    }
};
struct EpiAct {
    static constexpr bool PERM = true, AFTER_DRAIN = false;
    bf16_t* O; const float* bias;
    struct Pre { f32x4 b[4]; };
    __device__ __forceinline__ void prefetch(Pre& p, const Unit& u, int wr, int wc, int fr, int fq) const {
        const float* bp = bias + (size_t)u.e * 2048 + u.pn * HALF + wc * 32 + 8 * fq;
        p.b[0] = *(const f32x4*)(bp); p.b[1] = *(const f32x4*)(bp + 4); p.b[2] = *(const f32x4*)(bp + 1024); p.b[3] = *(const f32x4*)(bp + 1028); }
    __device__ __forceinline__ void operator()(const f32x4 (&acc)[2][2][4][2], const Unit& u, int wr, int wc, int fr, int fq, const Pre& p) const {
        const int row0 = u.pm * BM + wr * 64 + fr, col0 = u.pn * HALF + wc * 32 + 8 * fq;
        const f32x4 bg0 = p.b[0], bg1 = p.b[1], bl0 = p.b[2] + 1.0f, bl1 = p.b[3] + 1.0f;
#pragma unroll
        for (int ai = 0; ai < 2; ++ai)
#pragma unroll
            for (int m = 0; m < 4; ++m) { bf16_t* rowp = O + (size_t)(row0 + ai * HALF + m * 16) * DE + col0;
                float a[8];
#pragma unroll
                for (int n = 0; n < 2; ++n) { const f32x4 g = acc[ai][0][m][n] + (n ? bg1 : bg0), li = acc[ai][1][m][n] + (n ? bl1 : bl0);
#pragma unroll
                    for (int j = 0; j < 4; ++j) { const float gl = fminf(g[j], 7.0f), ln1 = __builtin_amdgcn_fmed3f(li[j], -6.0f, 8.0f); a[n * 4 + j] = gl * __builtin_amdgcn_rcpf(1.0f + __builtin_amdgcn_exp2f(-1.702f * 1.4426950408889634f * gl)) * ln1; } }
                u32x4 w; w.x = cvt_pk_bf16(a[0], a[1]); w.y = cvt_pk_bf16(a[2], a[3]); w.z = cvt_pk_bf16(a[4], a[5]); w.w = cvt_pk_bf16(a[6], a[7]);
                *(u32x4*)rowp = w; }
    }
};
struct EpiDown {
    static constexpr bool PERM = true, AFTER_DRAIN = false;
    bf16_t* Y; const float* bias; const MoeOrderT<false>* S; const float* gatev;
    struct Pre { int t4[8]; };
    __device__ __forceinline__ void prefetch(Pre& p, const Unit& u, int wr, int wc, int fr, int fq) const {
#pragma unroll
        for (int i = 0; i < 8; ++i) p.t4[i] = S->row_tok4(u, wr * 64 + fr + (i >> 2) * HALF + (i & 3) * 16); }
    __device__ __forceinline__ void operator()(const f32x4 (&acc)[2][2][4][2], const Unit& u, int wr, int wc, int fr, int fq, const Pre& p) const {
        const int row0 = u.pm * BM + wr * 64 + fr, col0 = u.pn * BM + wc * 32 + 8 * fq;
        const float* bp = bias + (size_t)u.e * DM + col0;
        f32x4 bv[2][2];
#pragma unroll
        for (int bj = 0; bj < 2; ++bj) { bv[bj][0] = *(const f32x4*)(bp + bj * HALF); bv[bj][1] = *(const f32x4*)(bp + bj * HALF + 4); }
        int t4[8]; float gt[8];
#pragma unroll
        for (int i = 0; i < 8; ++i) t4[i] = p.t4[i];
#pragma unroll
        for (int i = 0; i < 8; ++i) gt[i] = gatev[t4[i] >= 0 ? t4[i] : 0];
#pragma unroll
        for (int ai = 0; ai < 2; ++ai)
#pragma unroll
            for (int m = 0; m < 4; ++m) { const int tok4 = t4[ai * 4 + m];
                if (tok4 >= 0) { const float g1 = gt[ai * 4 + m]; bf16_t* rowp = Y + (size_t)tok4 * DM + col0;
#pragma unroll
                    for (int bj = 0; bj < 2; ++bj) { const f32x4 v0 = (acc[ai][bj][m][0] + bv[bj][0]) * g1, v1 = (acc[ai][bj][m][1] + bv[bj][1]) * g1;
                        u32x4 w; w.x = cvt_pk_bf16(v0[0], v0[1]); w.y = cvt_pk_bf16(v0[2], v0[3]); w.z = cvt_pk_bf16(v1[0], v1[1]); w.w = cvt_pk_bf16(v1[2], v1[3]);
                        *(u32x4*)(rowp + bj * HALF) = w; } } }
    }
};

template <class Epi, class Sched, bool ALIGN_EPI = false, bool SP2 = false>
__device__ __forceinline__ void gemm_phase(PG8_LAS unsigned char* lds, const Gemm g, const Sched& S, const Epi& E) {
    const int tid = fresh_tid(), wid = __builtin_amdgcn_readfirstlane(tid >> 6), lane = tid & 63, wr = wid >> 2, wc = wid & 3, fr = lane & 15, fq = lane >> 4;
    const int K = g.K, nt = K / BK;
    unsigned voffA[2], voffB[2];
#pragma unroll
    for (int i = 0; i < 2; ++i) { int R, C; stage_rc(tid * 16 + i * 8192, R, C); const int Rb = Epi::PERM ? ((R & ~31) + perm32(R & 31)) : R;
        voffA[i] = (unsigned)(R * K + C) * 2u; voffB[i] = (unsigned)(Rb * K + C) * 2u; }
    unsigned Rr[2], Cb2[2];
#pragma unroll
    for (int i = 0; i < 2; ++i) { int R, C; stage_rc(tid * 16 + i * 8192, R, C); Rr[i] = (unsigned)R; Cb2[i] = (unsigned)C * 2u; }
    unsigned tC4[2][2], tN4[2][2];
    const size_t kstep = (size_t)(BK * 2);
    const size_t hstep = (size_t)HALF * K * 2;
    const size_t tstep = 2 * hstep;
    const unsigned ldsw = (unsigned)wid * 1024u;
    const int aoff = lds_byte(wr * 64 + fr, fq * 8), boff = lds_byte(wc * 32 + fr, fq * 8);
#define PG8_SA(b, h) (((b) * 2 + (h)) * HTB)
#define PG8_SB(b, h) ((4 + (b) * 2 + (h)) * HTB)
#define PG8_STAGE(bufoff, gbase, voff) do { _Pragma("unroll") for (int _i = 0; _i < 2; ++_i) \
        __builtin_amdgcn_global_load_lds((const unsigned*)((const char*)(gbase) + (voff)[_i]), (PG8_LAS unsigned*)(lds + (bufoff) + ldsw + _i * 8192), 16, 0, 0); } while (0)
#define PG8_STAGE_A(bufoff, kbyte, h, isnext) do { if constexpr (Sched::GATHER) { unsigned vo_[2]; _Pragma("unroll") for (int _i = 0; _i < 2; ++_i) { asm volatile("" : "+v"(tN4[h][_i])); \
            const unsigned t4_ = (isnext) ? tN4[h][_i] : tC4[h][_i]; vo_[_i] = (t4_ >> 2) * (unsigned)(K * 2) + Cb2[_i]; } PG8_STAGE(bufoff, (const char*)g.A + (kbyte), vo_); } \
        else { PG8_STAGE(bufoff, ((isnext) ? nA : cA) + (kbyte) + (h) * hstep, voffA); } } while (0)
#define PG8_LOOKUP(dst, unit) do { _Pragma("unroll") for (int _h = 0; _h < 2; ++_h) _Pragma("unroll") for (int _i = 0; _i < 2; ++_i) { const int* p_ = S.row_src(unit, _h * HALF + (int)Rr[_i]); \
        asm volatile("global_load_dword %0, %1, off" : "=v"(dst[_h][_i]) : "v"(p_) : "memory"); } } while (0)
#define PG8_LDA(dst, b, h) do { _Pragma("unroll") for (int m = 0; m < 4; ++m) _Pragma("unroll") for (int k = 0; k < 2; ++k) dst[m][k] = *(const PG8_LAS bf16x8*)(lds + PG8_SA(b, h) + aoff + m * 2048 + k * 1024); } while (0)
#define PG8_LDB(dst, b, h) do { _Pragma("unroll") for (int n = 0; n < 2; ++n) _Pragma("unroll") for (int k = 0; k < 2; ++k) dst[n][k] = *(const PG8_LAS bf16x8*)(lds + PG8_SB(b, h) + boff + n * 2048 + k * 1024); } while (0)
#define PG8_MMA(ai, bj, At, Bt) do { __builtin_amdgcn_s_setprio(1); _Pragma("unroll") for (int m = 0; m < 4; ++m) _Pragma("unroll") for (int n = 0; n < 2; ++n) _Pragma("unroll") for (int k = 0; k < 2; ++k) \
        acc[ai][bj][m][n] = __builtin_amdgcn_mfma_f32_16x16x32_bf16(Bt[n][k], At[m][k], acc[ai][bj][m][n], 0, 0, 0); __builtin_amdgcn_s_setprio(0); } while (0)
#define PG8_WAIT_V(n) asm volatile("s_waitcnt vmcnt(" #n ")" ::: "memory")
#define PG8_WAIT_L(n) asm volatile("s_waitcnt lgkmcnt(" #n ")" ::: "memory")
#define PG8_BAR __builtin_amdgcn_s_barrier()
#define PG8_SCHED __builtin_amdgcn_sched_barrier(0)
    Unit cur, nxt; int ui = 0;
    if (!S.next(0, cur)) return;
    f32x4 acc[2][2][4][2];
#pragma unroll
    for (int a = 0; a < 2; ++a)
#pragma unroll
        for (int b = 0; b < 2; ++b)
#pragma unroll
            for (int m = 0; m < 4; ++m)
#pragma unroll
                for (int n = 0; n < 2; ++n) acc[a][b][m][n] = (f32x4){0.f, 0.f, 0.f, 0.f};
    bf16x8 At[4][2], B0[2][2], B1[2][2];
    const char* cA = (const char*)g.A + (size_t)cur.pm * tstep; const char* cB = (const char*)g.Bt + (size_t)cur.e * g.estride + (size_t)cur.pn * tstep;
    S.a_ready(cur);
    static_assert(SP2, "only the two-super-phase K-loop is kept in this file");
    const char* nA = cA;
    if constexpr (Sched::GATHER) { PG8_LOOKUP(tC4, cur); asm volatile("s_waitcnt vmcnt(0)" ::: "memory");
#pragma unroll
        for (int _h = 0; _h < 2; ++_h)
#pragma unroll
            for (int _i = 0; _i < 2; ++_i) { asm volatile("" : "+v"(tC4[_h][_i])); tN4[_h][_i] = tC4[_h][_i]; } }
    {
        PG8_STAGE(PG8_SB(0, 0), cB, voffB); PG8_STAGE(PG8_SB(0, 1), cB + hstep, voffB); PG8_STAGE_A(PG8_SA(0, 0), 0, 0, false); PG8_STAGE_A(PG8_SA(0, 1), 0, 1, false);
        if (wr == 1) PG8_BAR;
        PG8_WAIT_V(2); PG8_BAR;
        PG8_STAGE(PG8_SB(1, 0), cB + kstep, voffB); PG8_STAGE_A(PG8_SA(1, 0), kstep, 0, false); PG8_STAGE(PG8_SB(1, 1), cB + hstep + kstep, voffB);
        PG8_WAIT_V(6); PG8_BAR;
    }
    for (;;) {
        const bool has_next = S.next(ui + 1, nxt);
        nA = has_next ? (const char*)g.A + (size_t)nxt.pm * tstep : cA; const char* nB = has_next ? (const char*)g.Bt + (size_t)nxt.e * g.estride + (size_t)nxt.pn * tstep : cB;
        if constexpr (Sched::GATHER) { if (has_next) PG8_LOOKUP(tN4, nxt); }
        typename Epi::Pre pre; E.prefetch(pre, cur, wr, wc, fr, fq);
        for (int t = 0; t < nt; t += 2) {
            const bool last = (t == nt - 2);
            const size_t k1 = (size_t)(t + 1) * kstep, k2 = last ? 0 : (size_t)(t + 2) * kstep, k3 = k2 + kstep;
            const char* b2 = (last ? nB : cB) + k2; const char* b3 = b2 + kstep;
            if (last && has_next) S.a_ready(nxt);
            PG8_LDB(B0, 0, 0); PG8_LDB(B1, 0, 1); PG8_SCHED; PG8_LDA(At, 0, 0); PG8_STAGE_A(PG8_SA(1, 1), k1, 1, false);
            PG8_WAIT_V(8); PG8_WAIT_L(0); PG8_BAR; PG8_MMA(0, 0, At, B0); PG8_MMA(0, 1, At, B1); PG8_BAR; PG8_SCHED;
            PG8_LDA(At, 0, 1); PG8_STAGE(PG8_SB(0, 0), b2, voffB); PG8_STAGE(PG8_SB(0, 1), b2 + hstep, voffB); PG8_STAGE_A(PG8_SA(0, 0), k2, 0, last);
            PG8_WAIT_V(8); PG8_WAIT_L(0); PG8_BAR; PG8_MMA(1, 0, At, B0); PG8_MMA(1, 1, At, B1); PG8_BAR; PG8_SCHED;
            PG8_LDB(B0, 1, 0); PG8_LDB(B1, 1, 1); PG8_SCHED; PG8_LDA(At, 1, 0); PG8_STAGE_A(PG8_SA(0, 1), k2, 1, last);
            PG8_WAIT_V(8); PG8_WAIT_L(0); PG8_BAR; PG8_MMA(0, 0, At, B0); PG8_MMA(0, 1, At, B1); PG8_BAR; PG8_SCHED;
            PG8_LDA(At, 1, 1); PG8_STAGE(PG8_SB(1, 0), b3, voffB); PG8_STAGE(PG8_SB(1, 1), b3 + hstep, voffB); PG8_STAGE_A(PG8_SA(1, 0), k3, 0, last);
            PG8_WAIT_V(8); PG8_WAIT_L(0); PG8_BAR; PG8_MMA(1, 0, At, B0); PG8_MMA(1, 1, At, B1); PG8_BAR; PG8_SCHED;
        }
        if constexpr (ALIGN_EPI) { if (wr == 0) PG8_BAR; }
        if constexpr (!Epi::AFTER_DRAIN) { E(acc, cur, wr, wc, fr, fq, pre); S.done(cur); }
        if (!has_next) break;
#pragma unroll
        for (int a = 0; a < 2; ++a)
#pragma unroll
            for (int b = 0; b < 2; ++b)
#pragma unroll
                for (int m = 0; m < 4; ++m)
#pragma unroll
                    for (int n = 0; n < 2; ++n) acc[a][b][m][n] = (f32x4){0.f, 0.f, 0.f, 0.f};
        cur = nxt; cA = nA; cB = nB; ++ui;
        if constexpr (Sched::GATHER) {
#pragma unroll
            for (int _h = 0; _h < 2; ++_h)
#pragma unroll
                for (int _i = 0; _i < 2; ++_i) tC4[_h][_i] = tN4[_h][_i]; }
        if constexpr (ALIGN_EPI) { if (wr == 1) PG8_BAR; }
    }
    PG8_WAIT_V(0);
    if constexpr (!ALIGN_EPI) { if (wr == 0) PG8_BAR; }
    PG8_BAR;
#undef PG8_SA
#undef PG8_SB
#undef PG8_STAGE
#undef PG8_STAGE_A
#undef PG8_LOOKUP
#undef PG8_LDA
#undef PG8_LDB
#undef PG8_MMA
#undef PG8_WAIT_V
#undef PG8_WAIT_L
#undef PG8_BAR
#undef PG8_SCHED
}
}

namespace att {
constexpr float SCALE = 0.125f;
constexpr int SHM_V = 64 * 128 * 2, SHM_K = 64 * 128 * 2;
#define KSWZ(row, colB) ((row) * 256 + ((colB) ^ (((row) & 7) << 4)))
#define SBAR() __builtin_amdgcn_sched_barrier(0)
__device__ __forceinline__ int crow(int r, int hi) { return (r & 3) + 8 * (r >> 2) + 4 * hi; }
__device__ __forceinline__ unsigned cvtpk(float lo, float hi) { unsigned r; asm volatile("v_cvt_pk_bf16_f32 %0, %1, %2" : "=v"(r) : "v"(lo), "v"(hi)); return r; }
__device__ __forceinline__ bf16x8 ld8(const bf16_t* p) { return *reinterpret_cast<const bf16x8*>(p); }

__device__ __forceinline__ void partialSM(f32x16& p0) {
#pragma unroll
    for (int r = 0; r < 16; ++r) p0[r] = __builtin_amdgcn_exp2f(p0[r]);
}
__device__ __forceinline__ void finishSM(f32x16& p0, f32x16& p1, float& l_reg, bf16x8& pa0, bf16x8& pa1, bf16x8& pa2, bf16x8& pa3) {
#pragma unroll
    for (int r = 0; r < 16; ++r) p1[r] = __builtin_amdgcn_exp2f(p1[r]);
    float ps = 0;
#pragma unroll
    for (int r = 0; r < 16; ++r) ps += p0[r];
#pragma unroll
    for (int r = 0; r < 16; ++r) ps += p1[r];
    l_reg += ps;
#define PK4(P, BASE, OUT) do { u32x4 w = {cvtpk(P[BASE + 0], P[BASE + 1]), cvtpk(P[BASE + 2], P[BASE + 3]), cvtpk(P[BASE + 4], P[BASE + 5]), cvtpk(P[BASE + 6], P[BASE + 7])}; \
    OUT = *reinterpret_cast<bf16x8*>(&w); } while (0)
    PK4(p0, 0, pa0); PK4(p0, 8, pa1); PK4(p1, 0, pa2); PK4(p1, 8, pa3);
#undef PK4
}
__device__ __forceinline__ void qkt(f32x16& p0, f32x16& p1, const char* Ks, const bf16x8* qr, int r32, int hi, int mp, float nm) {
#pragma unroll
    for (int r = 0; r < 16; ++r) { p0[r] = nm; p1[r] = nm; }
    bf16x8 b0n, b1n;
    { const int cb = ((mp * 4 + 0) * 16 + hi * 8) * 2; b0n = *reinterpret_cast<const bf16x8*>(Ks + KSWZ(r32, cb)); b1n = *reinterpret_cast<const bf16x8*>(Ks + KSWZ(32 + r32, cb)); }
#pragma unroll
    for (int d0 = 0; d0 < 4; ++d0) { const bf16x8 b0 = b0n, b1 = b1n;
        if (d0 < 3) { const int cb = ((mp * 4 + d0 + 1) * 16 + hi * 8) * 2; b0n = *reinterpret_cast<const bf16x8*>(Ks + KSWZ(r32, cb)); b1n = *reinterpret_cast<const bf16x8*>(Ks + KSWZ(32 + r32, cb)); }
        __builtin_amdgcn_sched_barrier(0);
        p0 = __builtin_amdgcn_mfma_f32_32x32x16_bf16(b0, qr[d0], p0, 0, 0, 0);
        p1 = __builtin_amdgcn_mfma_f32_32x32x16_bf16(b1, qr[d0], p1, 0, 0, 0); }
}
__device__ __forceinline__ int v_st(int k, int c) { const int kk = k; return ((kk >> 3) * 4 + (c >> 5)) * 512 + ((kk & 7) * 32 + (c & 31)) * 2; }
__device__ __forceinline__ int v_rd_base(int lane) { return ((lane & 3) << 3) | (((lane >> 2) & 3) << 6) | (((lane >> 4) & 1) << 5) | (((lane >> 5) & 1) << 8); }
constexpr int v_rd_off(int d0, int ks, int half) { return d0 * 512 + ks * 4096 + half * 2048; }
template <int OFF> __device__ __forceinline__ s16x4 tr_read(int vb) {
    s16x4 r; asm volatile("ds_read_b64_tr_b16 %0, %1 offset:%2" : "=&v"(r) : "v"(vb), "i"(OFF) : "memory"); return r;
}
template <int D0, bool EXPS> __device__ __forceinline__ void pv_one(f32x16& od, int vb, bf16x8 pa0, bf16x8 pa1, bf16x8 pa2, bf16x8 pa3, f32x16& pn) {
    const s16x4 l0 = tr_read<v_rd_off(D0, 0, 0)>(vb), h0 = tr_read<v_rd_off(D0, 0, 1)>(vb), l1 = tr_read<v_rd_off(D0, 1, 0)>(vb), h1 = tr_read<v_rd_off(D0, 1, 1)>(vb);
    const s16x4 l2 = tr_read<v_rd_off(D0, 2, 0)>(vb), h2 = tr_read<v_rd_off(D0, 2, 1)>(vb), l3 = tr_read<v_rd_off(D0, 3, 0)>(vb), h3 = tr_read<v_rd_off(D0, 3, 1)>(vb);
    asm volatile("s_waitcnt lgkmcnt(0)" ::: "memory"); SBAR();
#define PK(L, H) (bf16x8){L[0], L[1], L[2], L[3], H[0], H[1], H[2], H[3]}
    od = __builtin_amdgcn_mfma_f32_32x32x16_bf16(pa0, PK(l0, h0), od, 0, 0, 0);
    od = __builtin_amdgcn_mfma_f32_32x32x16_bf16(pa1, PK(l1, h1), od, 0, 0, 0);
    od = __builtin_amdgcn_mfma_f32_32x32x16_bf16(pa2, PK(l2, h2), od, 0, 0, 0);
    od = __builtin_amdgcn_mfma_f32_32x32x16_bf16(pa3, PK(l3, h3), od, 0, 0, 0);
#undef PK
    if constexpr (EXPS) {
#pragma unroll
        for (int r = 4 * D0; r < 4 * D0 + 4; ++r) pn[r] = __builtin_amdgcn_exp2f(pn[r]); }
}
template <bool EXPS> __device__ __forceinline__ void pv_d0(f32x16* o, int vb, bf16x8 pa0, bf16x8 pa1, bf16x8 pa2, bf16x8 pa3, f32x16& pn) {
    pv_one<0, EXPS>(o[0], vb, pa0, pa1, pa2, pa3, pn); pv_one<1, EXPS>(o[1], vb, pa0, pa1, pa2, pa3, pn); pv_one<2, EXPS>(o[2], vb, pa0, pa1, pa2, pa3, pn); pv_one<3, EXPS>(o[3], vb, pa0, pa1, pa2, pa3, pn);
}

__device__ __forceinline__ void attn_unit(const bf16_t* __restrict__ proj, bf16_t* __restrict__ mix, const float* __restrict__ subw, float lam, float osc,
                                          const unsigned* __restrict__ kmax2, int b, int h, int qrow0, int nkeys, char* lds) {
    const int tid = fresh_tid(), wid = tid >> 6, lane = tid & 63, r32 = lane & 31, hi = lane >> 5, mp = wid >> 2, wq = wid & 3;
    constexpr int SLOT = SHM_V + SHM_K;
    float* ws = (float*)(lds + 3 * SLOT) + wid * 64; float* li_l = ws;
    float l_reg = 0; f32x16 o[4] = {}; bf16x8 qr[4];
    const int wu = __builtin_amdgcn_readfirstlane(wid);
    unsigned offV[2], offK[2];
#pragma unroll
    for (int q = 0; q < 2; ++q) { const int pc = 2 * wu + q;
        { const int key = 8 * (pc >> 1) + ((lane >> 2) & 7), col = 32 * (2 * (pc & 1) + (lane >> 5)) + (lane & 3) * 8; offV[q] = (unsigned)(key * INWP + col + C_V); }
        { const int row = 4 * pc + (lane >> 4), col = ((lane & 15) ^ (row & 7)) * 8; offK[q] = (unsigned)(row * INWP + col + C_K); } }
    const int vb0 = (int)(uintptr_t)lds + v_rd_base(lane);
    LAS unsigned char* lds3 = (LAS unsigned char*)(unsigned)(uintptr_t)lds;
    const int ctx_row0 = TLAT + b * LCTX, lat_row0 = b * SEQ - LCTX;
#define DMA_TILE(k0, so) do { const bf16_t* tb_ = proj + (size_t)((k0) < LCTX ? ctx_row0 + (k0) : lat_row0 + (k0)) * INWP + h * 128; \
    _Pragma("unroll") for (int q_ = 0; q_ < 2; ++q_) { \
        __builtin_amdgcn_global_load_lds((const unsigned*)(tb_ + offV[q_]), (LAS unsigned*)(lds3 + (so) + (2 * wu + q_) * 1024), 16, 0, 0); \
        __builtin_amdgcn_global_load_lds((const unsigned*)(tb_ + offK[q_]), (LAS unsigned*)(lds3 + (so) + SHM_V + (2 * wu + q_) * 1024), 16, 0, 0); } } while (0)
    f32x16 pA0, pA1, pB0, pB1; bf16x8 pa0, pa1, pa2, pa3; const int NT = nkeys / 64;
    int sl_prev = 0, sl_cur = 0, sl_next = SLOT;
#define ROT() do { sl_prev = sl_cur; sl_cur = sl_next; sl_next = (sl_next == 2 * SLOT) ? 0 : sl_next + SLOT; } while (0)
    DMA_TILE(0, 0); DMA_TILE(64, SLOT);
    const bf16_t* Qw = proj + (size_t)(qrow0 + wq * 32 + r32) * INWP + C_Q + h * 128 + mp * 64 + hi * 8;
    float qss = 0.f;
    bf16x8 qraw[4];
#pragma unroll
    for (int d0 = 0; d0 < 4; ++d0) qraw[d0] = ld8(Qw + d0 * 16);
    const float km2 = __uint_as_float(kmax2[h * 2 + mp]);
    __builtin_amdgcn_sched_barrier(0);
#pragma unroll
    for (int d0 = 0; d0 < 4; ++d0) { float f[8]; const bf16x8 raw = qraw[d0]; unpack8(*reinterpret_cast<const u32x4*>(&raw), f);
        constexpr float C = SCALE * 1.4426950408889634f;
        u32x4 w; w.x = cvtpk(f[0] * C, f[1] * C); w.y = cvtpk(f[2] * C, f[3] * C); w.z = cvtpk(f[4] * C, f[5] * C); w.w = cvtpk(f[6] * C, f[7] * C);
        float g[8]; unpack8(w, g);
#pragma unroll
        for (int e = 0; e < 8; ++e) qss += g[e] * g[e];
        qr[d0] = *reinterpret_cast<const bf16x8*>(&w); }
    qss += __shfl_xor(qss, 32);
    const float nm = -1.002f * sqrtf(qss) * sqrtf(km2);
    asm volatile("s_waitcnt vmcnt(0)" ::: "memory"); __syncthreads();
    qkt(pA0, pA1, lds + SHM_V, qr, r32, hi, mp, nm); partialSM(pA0);
    ROT();
#define ITER(PC0, PC1, PP0, PP1, j) do { if ((j) + 1 < NT) DMA_TILE(((j) + 1) * 64, sl_next); \
        SBAR(); qkt(PC0, PC1, lds + sl_cur + SHM_V, qr, r32, hi, mp, nm); \
        finishSM(PP0, PP1, l_reg, pa0, pa1, pa2, pa3); SBAR(); \
        pv_d0<true>(o, vb0 + sl_prev, pa0, pa1, pa2, pa3, PC0); \
        asm volatile("s_waitcnt vmcnt(0)" ::: "memory");     \
        __syncthreads(); ROT(); } while (0)
    for (int j = 1; j + 1 < NT; j += 2) { ITER(pB0, pB1, pA0, pA1, j); ITER(pA0, pA1, pB0, pB1, j + 1); }
    ITER(pB0, pB1, pA0, pA1, NT - 1);
    finishSM(pB0, pB1, l_reg, pa0, pa1, pa2, pa3); SBAR();
    pv_d0<false>(o, vb0 + sl_prev, pa0, pa1, pa2, pa3, pA0);
#undef ITER
#undef ROT
#undef DMA_TILE
    asm volatile("s_waitcnt vmcnt(0)" ::: "memory");
    l_reg += __shfl_xor(l_reg, 32);
    if (hi == 0) li_l[r32] = (mp ? lam : 1.0f) / l_reg;
    asm volatile("s_waitcnt lgkmcnt(0)" ::: "memory");
#pragma unroll
    for (int r = 0; r < 16; ++r) { const float f = li_l[crow(r, hi)];
#pragma unroll
        for (int d0 = 0; d0 < 4; ++d0) o[d0][r] *= f; }
    __syncthreads();
    float* ex = (float*)lds;
    bf16_t* ot = (bf16_t*)(lds + 65536);
    if (mp == 1) {
#pragma unroll
        for (int r = 0; r < 16; ++r)
#pragma unroll
            for (int d0 = 0; d0 < 4; ++d0) ex[(wq * 32 + crow(r, hi)) * 128 + d0 * 32 + r32] = o[d0][r];
    }
    __syncthreads();
    if (mp == 0) {
        const int t2 = fresh_tid(), r32 = t2 & 31, hi = (t2 >> 5) & 1, wq = (t2 >> 6) & 3;
        float wcol[4];
#pragma unroll
        for (int d0 = 0; d0 < 4; ++d0) wcol[d0] = subw[d0 * 32 + r32] * osc;
#pragma unroll
        for (int r = 0; r < 16; ++r) {
            float ss = 0.f;
#pragma unroll
            for (int d0 = 0; d0 < 4; ++d0) { o[d0][r] -= ex[(wq * 32 + crow(r, hi)) * 128 + d0 * 32 + r32]; ss += o[d0][r] * o[d0][r]; }
            ss = sum32(ss);
            const float rn = rsqrtf(ss * (1.0f / 128.0f) + EPS);
            bf16_t* op = ot + (wq * 32 + crow(r, hi)) * 136 + r32;
#pragma unroll
            for (int d0 = 0; d0 < 4; ++d0) op[d0 * 32] = (bf16_t)f2bf(o[d0][r] * rn * wcol[d0]);
        }
    }
    __syncthreads();
    { const int t3 = fresh_tid();
#pragma unroll
      for (int it = 0; it < 4; ++it) { const int idx = t3 + 512 * it, row = idx >> 4, pc = idx & 15;
          *(u32x4*)(mix + (size_t)(qrow0 + row) * DM + h * 128 + pc * 8) = *(const u32x4*)(ot + row * 136 + pc * 8); } }
    __syncthreads();
}
}


namespace ck {
template <int K>
__device__ __forceinline__ f32x16 mma32(const bf16_t* A, int lda, const bf16_t* B, int ldb, f32x16 acc, int r32, int hi) {
#pragma unroll
    for (int k0 = 0; k0 < K; k0 += 16) {
        const bf16x8 a = *(const bf16x8*)(A + r32 * lda + k0 + 8 * hi), b = *(const bf16x8*)(B + r32 * ldb + k0 + 8 * hi);
        acc = __builtin_amdgcn_mfma_f32_32x32x16_bf16(a, b, acc, 0, 0, 0); }
    return acc;
}
__device__ __forceinline__ int crow(int r, int hi) { return (r & 3) + 8 * (r >> 2) + 4 * hi; }
struct P { bf16_t* proj; bf16_t* xbcs; float* dtv; float* cumv; float* gkv; bf16_t* ssd_st; bf16_t* gla_st; float* cds; float* cdg; bf16_t* mix; const f32x2* ropet;
           const float *convw, *convb, *dtb, *alog, *gkup, *gkb, *ssdd, *ssdnw, *glanw; unsigned* kmax2; bf16_t* hins; bf16_t* hing; };

__device__ __forceinline__ void prep_chunk(const P& p, int ch, unsigned char* lds, int sect, bool dry = false) {
    const int tid = fresh_tid(), lane = tid & 63, wave = __builtin_amdgcn_readfirstlane(tid >> 6), r32 = lane & 31, hi = lane >> 5;
    const int row0 = ch * 64; const bool lat = row0 < TLAT;
    float* dtl = (float*)lds; float* al = dtl + 512; float* cuml = al + 512; float* wgt = cuml + 512; float* tot = wgt + 512;
    bf16_t* XwT = (bf16_t*)(lds + 16384);
    bf16_t* BT = (bf16_t*)(lds + 90112);
    if (lat && !dry && (sect & 1)) {
#pragma unroll 1
        for (int hb = 0; hb < 2; ++hb) {
            u32x4 a1[4], a2[4]; f32x4 tb[4][4];
#pragma unroll
            for (int q = 0; q < 4; ++q) { const int idx = tid + 512 * (hb * 4 + q);
                const int jg = idx & 1, half = (idx >> 1) & 1, mp = (idx >> 2) & 1, hh = (idx >> 3) & 3, qk = (idx >> 5) & 1, tok = idx >> 6;
                const int row = row0 + tok, s = row & (SEQ - 1), pos = half ? (s & 63) : (s >> 6);
                const bf16_t* p1 = p.proj + (size_t)row * INWP + qk * 512 + hh * 128 + mp * 64 + half * 32 + jg * 8;
                a1[q] = *(const u32x4*)p1; a2[q] = *(const u32x4*)(p1 + 16);
                const f32x4* tp = (const f32x4*)(p.ropet + pos * 16 + jg * 8);
#pragma unroll
                for (int e = 0; e < 4; ++e) tb[q][e] = tp[e]; }
#pragma unroll
            for (int q = 0; q < 4; ++q) { const int idx = tid + 512 * (hb * 4 + q);
                const int jg = idx & 1, half = (idx >> 1) & 1, mp = (idx >> 2) & 1, hh = (idx >> 3) & 3, qk = (idx >> 5) & 1, tok = idx >> 6;
                bf16_t* p1 = p.proj + (size_t)(row0 + tok) * INWP + qk * 512 + hh * 128 + mp * 64 + half * 32 + jg * 8;
                float x1[8], x2[8], o1[8], o2[8]; unpack8(a1[q], x1); unpack8(a2[q], x2);
#pragma unroll
                for (int e = 0; e < 4; ++e) { const f32x4 cs = tb[q][e];
                    o1[2 * e] = x1[2 * e] * cs.x - x2[2 * e] * cs.y; o2[2 * e] = x2[2 * e] * cs.x + x1[2 * e] * cs.y;
                    o1[2 * e + 1] = x1[2 * e + 1] * cs.z - x2[2 * e + 1] * cs.w; o2[2 * e + 1] = x2[2 * e + 1] * cs.z + x1[2 * e + 1] * cs.w; }
                *(u32x4*)p1 = pack8(o1); *(u32x4*)(p1 + 16) = pack8(o2); }
        }
    }
    const int spos = lat ? ((row0 + lane) & (SEQ - 1)) : ((row0 + lane - TLAT) & (LCTX - 1)), slen = lat ? SEQ : LCTX;
    if (sect & 2) {
    u32x4 c0[4], cm[4], cp[4];
    const bf16_t* cbase = p.proj + (size_t)(row0 + lane) * INWP + C_XBC;
    const int dm = spos > 0 ? -INWP : 0, dp = spos < slen - 1 ? INWP : 0;
#pragma unroll
    for (int q = 0; q < 4; ++q) { const bf16_t* pp = cbase + (wave + 8 * q) * 8; c0[q] = *(const u32x4*)pp; cm[q] = *(const u32x4*)(pp + dm); cp[q] = *(const u32x4*)(pp + dp); }
    float* cwl = (float*)(lds + 108544);
    { const int i4 = tid * 4; *(f32x4*)(cwl + i4) = (i4 < 512) ? *(const f32x4*)(p.convb + i4) : *(const f32x4*)(p.convw + (i4 - 512)); }
    { const int tok = tid >> 3, i = tid & 7, row = row0 + tok;
      const float x = bf2f(p.proj[(size_t)row * INWP + C_DT + i]) + p.dtb[i];
      const float dt = softplusf(x), A = -expf(p.alog[i]);
      dtl[tid] = dt; al[tid] = dt * A; p.dtv[(size_t)row * 8 + i] = dt; }
    unsigned* kml = (unsigned*)(tot + 8);
    if (tid < 8) kml[tid] = 0u;
    LDS_BARRIER();
    { const int tok = tid >> 3, hm = tid & 7; const bf16_t* kp = p.proj + (size_t)(row0 + tok) * INWP + C_K + hm * 64; float ss = 0.f;
#pragma unroll
      for (int q = 0; q < 8; ++q) { float f[8]; unpack8(*(const u32x4*)(kp + q * 8), f);
#pragma unroll
          for (int e = 0; e < 8; ++e) ss += f[e] * f[e]; }
      atomicMax(&kml[hm], __float_as_uint(ss)); }
    { const int i = wave, dir = i >> 2; const float c = wave_scan(al[lane * 8 + i], lane, dir != 0);
      cuml[lane * 8 + i] = c; if (lane == (dir ? 0 : 63)) { tot[i] = c; p.cds[ch * 8 + i] = __expf(c); } }
    LDS_BARRIER();
    if (tid < 8) atomicMax(p.kmax2 + (lat ? (row0 >> 13) : ((row0 - TLAT) >> 8)) * 8 + tid, kml[tid]);
    { const int tok = tid >> 3, i = tid & 7, row = row0 + tok; const float cmv = cuml[tid];
      wgt[tid] = __expf(tot[i] - cmv) * dtl[tid]; p.cumv[(size_t)row * 8 + i] = cmv; }
    LDS_BARRIER();
#pragma unroll
    for (int hb = 0; hb < 2; ++hb) {
        u32x4 n0[4], nm[4], np[4];
        if (hb == 0) {
#pragma unroll
            for (int q = 0; q < 4; ++q) { const bf16_t* pp = cbase + (wave + 8 * (4 + q)) * 8; n0[q] = *(const u32x4*)pp; nm[q] = *(const u32x4*)(pp + dm); np[q] = *(const u32x4*)(pp + dp); } }
#pragma unroll
        for (int q = 0; q < 4; ++q) { const int cg = wave + 8 * (hb * 4 + q), row = row0 + lane;
            float xm[8], x0[8], xp[8], o[8];
            unpack8(c0[q], x0); unpack8(cm[q], xm); unpack8(cp[q], xp);
            const float zm = spos > 0 ? 1.f : 0.f, zp = spos < slen - 1 ? 1.f : 0.f;
#pragma unroll
            for (int e = 0; e < 8; ++e) { const int c = cg * 8 + e; o[e] = siluf(cwl[c] + cwl[512 + c] * (xm[e] * zm) + cwl[1024 + c] * x0[e] + cwl[1536 + c] * (xp[e] * zp)); }
            const u32x4 pk = pack8(o);
            *(u32x4*)(p.xbcs + (size_t)row * 512 + cg * 8) = pk;
            if (cg < 32) { float ob[8]; unpack8(pk, ob); const float wf = wgt[lane * 8 + (cg >> 3)], wb = wgt[lane * 8 + 4 + (cg >> 3)];
#pragma unroll
                for (int e = 0; e < 8; ++e) { XwT[(cg * 8 + e) * 72 + lane] = (bf16_t)f2bf(ob[e] * wf); XwT[(256 + cg * 8 + e) * 72 + lane] = (bf16_t)f2bf(ob[e] * wb); } }
            else if (cg < 48) { const unsigned wv[4] = {pk.x, pk.y, pk.z, pk.w};
#pragma unroll
                for (int e = 0; e < 8; ++e) BT[((cg - 32) * 8 + e) * 72 + lane] = (bf16_t)((wv[e >> 1] >> ((e & 1) * 16)) & 0xffffu); } }
        if (hb == 0) {
#pragma unroll
            for (int q = 0; q < 4; ++q) { c0[q] = n0[q]; cm[q] = nm[q]; cp[q] = np[q]; } }
    }
    LDS_BARRIER();
#pragma unroll 1
    for (int q = 0; q < 4; ++q) {
        const int t = wave * 4 + q, dir = t >> 4, hh = (t >> 2) & 3, pt = (t >> 1) & 1, nt = t & 1;
        f32x16 acc = {};
        acc = mma32<64>(XwT + (dir * 256 + hh * 64 + pt * 32) * 72, 72, BT + ((hh >> 1) * 64 + nt * 32) * 72, 72, acc, r32, hi);
        bf16_t* dst = p.ssd_st + ((size_t)(ch * 2 + dir) * 4 + hh) * 4096 + nt * 32 + r32;
#pragma unroll
        for (int r = 0; r < 16; ++r) dst[(pt * 32 + crow(r, hi)) * 64] = (bf16_t)f2bf(acc[r]);
    }
    LDS_BARRIER();
    }
    if (sect & 12) {
    float* gkd = (float*)lds; float* bendl = (float*)(lds + 33792); bf16_t* KeT = (bf16_t*)(lds + 34816); bf16_t* VT = (bf16_t*)(lds + 71680);
    u32x4 vpk[4], kpk[2], cd[2][2];
    const bf16_t* rowp = p.proj + (size_t)(row0 + lane) * INWP;
#pragma unroll
    for (int it = 0; it < 4; ++it) vpk[it] = *(const u32x4*)(rowp + C_GV + (wave + 8 * it) * 8);
#pragma unroll
    for (int it = 0; it < 2; ++it) kpk[it] = *(const u32x4*)(rowp + C_GK + (wave + 8 * it) * 8);
    { const bf16_t* cpp = p.proj + (size_t)(row0 + (tid >> 3)) * INWP + C_CODE;
#pragma unroll
      for (int d = 0; d < 2; ++d) { cd[d][0] = *(const u32x4*)(cpp + d * 16); cd[d][1] = *(const u32x4*)(cpp + d * 16 + 8); } }
#pragma unroll
    for (int it = 0; it < 4; ++it) { const int vg = wave + 8 * it; const unsigned wv[4] = {vpk[it].x, vpk[it].y, vpk[it].z, vpk[it].w};
#pragma unroll
        for (int e = 0; e < 8; ++e) VT[(vg * 8 + e) * 72 + lane] = (bf16_t)((wv[e >> 1] >> ((e & 1) * 16)) & 0xffffu); }
#pragma unroll
    for (int dir = 0; dir < 2; ++dir) {
        if (!(sect & (4 << dir))) continue;
        { const int tok = tid >> 3, s8 = tid & 7, c0 = s8 * 16;
          float code[16]; { float t8[8]; unpack8(cd[dir][0], t8);
#pragma unroll
              for (int e = 0; e < 8; ++e) code[e] = t8[e];
              unpack8(cd[dir][1], t8);
#pragma unroll
              for (int e = 0; e < 8; ++e) code[8 + e] = t8[e]; }
          const float* up = p.gkup + (size_t)dir * 16 * 128 + c0; const float* gb = p.gkb + dir * 128 + c0;
#pragma unroll 1
          for (int q = 0; q < 4; ++q) { f32x4 a = *(const f32x4*)(gb + 4 * q); f32x4 w[16];
#pragma unroll
              for (int r = 0; r < 16; ++r) w[r] = *(const f32x4*)(up + r * 128 + 4 * q);
              __builtin_amdgcn_sched_barrier(0);
#pragma unroll
              for (int r = 0; r < 16; ++r) a += w[r] * code[r];
              f32x4 o; o.x = logsigmoidf(a.x) * 0.0625f; o.y = logsigmoidf(a.y) * 0.0625f; o.z = logsigmoidf(a.z) * 0.0625f; o.w = logsigmoidf(a.w) * 0.0625f;
              *(f32x4*)(gkd + tok * 132 + c0 + 4 * q) = o; } }
        LDS_BARRIER();
#pragma unroll 4
        for (int q = 0; q < 16; ++q) { const int c = wave * 16 + q; const float acc = wave_scan(gkd[lane * 132 + c], lane, dir != 0);
            gkd[lane * 132 + c] = acc; if (lane == (dir ? 0 : 63)) { bendl[c] = acc; p.cdg[ch * 256 + dir * 128 + c] = __expf(acc); } }
        LDS_BARRIER();
        for (int it = 0; it < 4; ++it) { const int idx = tid + 512 * it, tok = idx >> 5, q4 = idx & 31;
            *(f32x4*)(p.gkv + (size_t)(row0 + tok) * 256 + dir * 128 + q4 * 4) = *(const f32x4*)(gkd + tok * 132 + q4 * 4); }
#pragma unroll
        for (int it = 0; it < 2; ++it) { const int kg = wave + 8 * it;
            float kv[8]; unpack8(kpk[it], kv);
            const f32x4 b0 = *(const f32x4*)(gkd + lane * 132 + kg * 8), b1 = *(const f32x4*)(gkd + lane * 132 + kg * 8 + 4);
            const f32x4 e0 = *(const f32x4*)(bendl + kg * 8), e1 = *(const f32x4*)(bendl + kg * 8 + 4);
            const float bb[8] = {b0.x, b0.y, b0.z, b0.w, b1.x, b1.y, b1.z, b1.w}, be[8] = {e0.x, e0.y, e0.z, e0.w, e1.x, e1.y, e1.z, e1.w};
#pragma unroll
            for (int e = 0; e < 8; ++e) KeT[(dir * 128 + kg * 8 + e) * 72 + lane] = (bf16_t)f2bf(kv[e] * __expf(be[e] - bb[e])); }
        LDS_BARRIER();
    }
#pragma unroll 1
    for (int q = 0; q < 2; ++q) {
        const int t = wave * 2 + q, dir = t >> 3, hh = (t >> 1) & 3, vt = t & 1;
        if (!(sect & (4 << dir))) continue;
        f32x16 acc = {};
        acc = mma32<64>(VT + (hh * 64 + vt * 32) * 72, 72, KeT + (dir * 128 + hh * 32) * 72, 72, acc, r32, hi);
        bf16_t* dst = p.gla_st + ((size_t)(ch * 2 + dir) * 4 + hh) * 2048 + r32;
#pragma unroll
        for (int r = 0; r < 16; ++r) dst[(vt * 32 + crow(r, hi)) * 32] = (bf16_t)f2bf(acc[r]);
    }
    LDS_BARRIER();
    }
}

__device__ __forceinline__ void scan_phase(const P& p, int bx) {
    const int tid = fresh_tid();
    if (tid >= 384) return;
    const int e0 = bx * 384 + tid; const bool ssd = e0 < 65536; const int e = ssd ? e0 : e0 - 65536;
    const int b = ssd ? e >> 15 : e >> 14, dir = ssd ? (e >> 14) & 1 : (e >> 13) & 1, hh = ssd ? (e >> 12) & 3 : (e >> 11) & 3, el = ssd ? e & 4095 : e & 2047;
    const bf16_t* st = ssd ? p.ssd_st : p.gla_st; bf16_t* ho = ssd ? p.hins : p.hing; const int esz = ssd ? 4096 : 2048;
    const float* dcp = ssd ? p.cds + dir * 4 + hh : p.cdg + dir * 128 + hh * 32 + (el & 31); const int dst = ssd ? 8 : 256;
    float hst = 0.f;
#pragma unroll 1
    for (int kb = 0; kb < 132; kb += 22) {
        float sv[22], dv[22]; int ci[22];
#pragma unroll
        for (int u = 0; u < 22; ++u) { const int k = kb + u; ci[u] = k < 4 ? 256 + 4 * b + (dir ? 3 - k : k) : 128 * b + (dir ? 127 - (k - 4) : (k - 4));
            sv[u] = bf2f(st[((size_t)(ci[u] * 2 + dir) * 4 + hh) * esz + el]); dv[u] = dcp[ci[u] * dst]; }
#pragma unroll
        for (int u = 0; u < 22; ++u) { ho[((size_t)(ci[u] * 2 + dir) * 4 + hh) * esz + el] = (bf16_t)f2bf(hst); hst = hst * dv[u] + sv[u]; }
    }
}

__device__ __forceinline__ void finish_chunk(const P& p, int ch, unsigned char* lds, int sect) {
    const int tid = fresh_tid(), lane = tid & 63, wave = __builtin_amdgcn_readfirstlane(tid >> 6), r32 = lane & 31, hi = lane >> 5;
    const int row0 = ch * 64;
    float* cml = (float*)lds; float* dtl = cml + 512; float* psum = dtl + 512;
    const float cm0_ = p.cumv[(size_t)row0 * 8 + tid], dt0_ = p.dtv[(size_t)row0 * 8 + tid]; bool first_ = true;
    bf16_t* Cn = (bf16_t*)(lds + 8192); bf16_t* Bn = (bf16_t*)(lds + 17408); bf16_t* XT = (bf16_t*)(lds + 26624); bf16_t* Mb = (bf16_t*)(lds + 45056); bf16_t* hin = (bf16_t*)(lds + 63488); bf16_t* Zs = (bf16_t*)(lds + 100352);
    const int hl = wave >> 2, rt = (wave >> 1) & 1, ct = wave & 1;
#pragma unroll 1
    for (int g = 0; g < 2; ++g) {
        if (!(sect & (1 << g))) continue;
        { u32x4 sA[2], sZ[2], sX[2], sH[4];
#pragma unroll
          for (int it = 0; it < 2; ++it) { const int idx = tid + 512 * it, arr = idx >> 9, r = idx & 511, tok = r >> 3, pc = r & 7;
              sA[it] = *(const u32x4*)(p.xbcs + (size_t)(row0 + tok) * 512 + (arr ? 384 : 256) + g * 64 + pc * 8); }
#pragma unroll
          for (int it = 0; it < 2; ++it) { const int idx = tid + 512 * it, tok = idx >> 4, pc = idx & 15;
              sZ[it] = *(const u32x4*)(p.proj + (size_t)(row0 + tok) * INWP + C_Z + g * 128 + pc * 8); }
#pragma unroll
          for (int it = 0; it < 2; ++it) { const int idx = tid + 512 * it, tok = idx & 63, cg = idx >> 6;
              sX[it] = *(const u32x4*)(p.xbcs + (size_t)(row0 + tok) * 512 + g * 128 + cg * 8); }
#pragma unroll
          for (int it = 0; it < 4; ++it) { const int idx = tid + 512 * it, dq = idx >> 9, r = idx & 511, pp = r >> 3, q8 = r & 7;
              sH[it] = *(const u32x4*)(p.hins + ((size_t)(ch * 2 + (dq >> 1)) * 4 + 2 * g + (dq & 1)) * 4096 + pp * 64 + q8 * 8); }
          __builtin_amdgcn_sched_barrier(0);
          if (first_) { cml[tid] = cm0_; dtl[tid] = dt0_; first_ = false; }
#pragma unroll
          for (int it = 0; it < 2; ++it) { const int idx = tid + 512 * it, arr = idx >> 9, r = idx & 511, tok = r >> 3, pc = r & 7;
              *(u32x4*)((arr ? Cn : Bn) + tok * 72 + pc * 8) = sA[it]; }
#pragma unroll
          for (int it = 0; it < 2; ++it) { const int idx = tid + 512 * it, tok = idx >> 4, pc = idx & 15;
              *(u32x4*)(Zs + tok * 136 + pc * 8) = sZ[it]; }
#pragma unroll
          for (int it = 0; it < 2; ++it) { const int idx = tid + 512 * it, tok = idx & 63, cg = idx >> 6;
              const u32x4 pk = sX[it]; const unsigned wv[4] = {pk.x, pk.y, pk.z, pk.w};
#pragma unroll
              for (int e = 0; e < 8; ++e) XT[(cg * 8 + e) * 72 + tok] = (bf16_t)((wv[e >> 1] >> ((e & 1) * 16)) & 0xffffu); }
#pragma unroll
          for (int it = 0; it < 4; ++it) { const int idx = tid + 512 * it, dq = idx >> 9, r = idx & 511, pp = r >> 3, q8 = r & 7;
              *(u32x4*)(hin + (dq * 64 + pp) * 72 + q8 * 8) = sH[it]; } }
        LDS_BARRIER();
        const int hh = 2 * g + hl;
        { f32x16 acc = {}; acc = mma32<64>(Cn + rt * 32 * 72, 72, Bn + ct * 32 * 72, 72, acc, r32, hi);
          const int j = ct * 32 + r32; const float cfj = cml[j * 8 + hh], cbj = cml[j * 8 + 4 + hh], dfj = dtl[j * 8 + hh], dbj = dtl[j * 8 + 4 + hh];
#pragma unroll
          for (int r = 0; r < 16; ++r) { const int i = rt * 32 + crow(r, hi); const float cfi = cml[i * 8 + hh], cbi = cml[i * 8 + 4 + hh];
              const float lf = (j <= i) ? __expf(cfi - cfj) * dfj : 0.f, lb = (j >= i) ? __expf(cbi - cbj) * dbj : 0.f;
              Mb[(hl * 64 + i) * 72 + j] = (bf16_t)f2bf(acc[r] * (lf + lb)); } }
        LDS_BARRIER();
        { const int c = hh * 64 + ct * 32 + r32; const float dsk = p.ssdd[hh], wn = p.ssdnw[c];
          f32x16 y;
          { f32x16 t = {}; t = mma32<64>(Cn + rt * 32 * 72, 72, hin + ((0 * 2 + hl) * 64 + ct * 32) * 72, 72, t, r32, hi);
#pragma unroll
            for (int r = 0; r < 16; ++r) y[r] = __expf(cml[(rt * 32 + crow(r, hi)) * 8 + hh]) * t[r]; }
          { f32x16 t = {}; t = mma32<64>(Cn + rt * 32 * 72, 72, hin + ((1 * 2 + hl) * 64 + ct * 32) * 72, 72, t, r32, hi);
#pragma unroll
            for (int r = 0; r < 16; ++r) y[r] += __expf(cml[(rt * 32 + crow(r, hi)) * 8 + 4 + hh]) * t[r]; }
          y = mma32<64>(Mb + (hl * 64 + rt * 32) * 72, 72, XT + (hl * 64 + ct * 32) * 72, 72, y, r32, hi);
          const bf16_t* xcol = XT + (hl * 64 + ct * 32 + r32) * 72;
          bf16_t* zcol = Zs + hl * 64 + ct * 32 + r32;
#pragma unroll
          for (int r = 0; r < 16; ++r) { const int i = rt * 32 + crow(r, hi);
              y[r] = (y[r] + dsk * bf2f(xcol[i])) * siluf(bf2f(zcol[i * 136]));
              const float s = sum32(y[r] * y[r]); if (r32 == 0) psum[i * 8 + hl * 2 + ct] = s; }
          LDS_BARRIER();
#pragma unroll
          for (int r = 0; r < 16; ++r) { const int i = rt * 32 + crow(r, hi);
              const float rn = rsqrtf(((psum[i * 8] + psum[i * 8 + 1]) + (psum[i * 8 + 2] + psum[i * 8 + 3])) * (1.0f / 128.0f) + EPS);
              zcol[i * 136] = (bf16_t)f2bf(y[r] * rn * wn); } }
        LDS_BARRIER();
        for (int it = 0; it < 2; ++it) { const int idx = tid + 512 * it, tok = idx >> 4, pc = idx & 15;
            *(u32x4*)(p.mix + (size_t)(row0 + tok) * DM + 512 + g * 128 + pc * 8) = *(const u32x4*)(Zs + tok * 136 + pc * 8); }
        LDS_BARRIER();
    }
    float* bfl = (float*)lds; bf16_t* att = (bf16_t*)lds; float* psg = (float*)(lds + 34816);
    bf16_t* Qf = (bf16_t*)(lds + 36864); bf16_t* Kf = (bf16_t*)(lds + 57344); bf16_t* VTg = (bf16_t*)(lds + 77824); bf16_t* hing = (bf16_t*)(lds + 96256);
#pragma unroll 1
    for (int hp = 0; hp < 2; ++hp) {
        if (!(sect & (4 << hp))) continue;
        u32x4 qk4[4];
        { f32x4 sB[4]; u32x4 sV[2], sH[2];
#pragma unroll
          for (int it = 0; it < 4; ++it) { const int idx = tid + 512 * it, tok = idx >> 5, r = idx & 31, dir = r >> 4, q4 = r & 15;
              sB[it] = *(const f32x4*)(p.gkv + (size_t)(row0 + tok) * 256 + dir * 128 + hp * 64 + q4 * 4); }
#pragma unroll
          for (int it = 0; it < 2; ++it) { const int idx = tid + 512 * it, tok = idx & 63, vg = idx >> 6;
              sV[it] = *(const u32x4*)(p.proj + (size_t)(row0 + tok) * INWP + C_GV + hp * 128 + vg * 8); }
#pragma unroll
          for (int it = 0; it < 2; ++it) { const int idx = tid + 512 * it, dq = idx >> 8, r = idx & 255, vv = r >> 2, q8 = r & 3;
              sH[it] = *(const u32x4*)(p.hing + ((size_t)(ch * 2 + (dq >> 1)) * 4 + 2 * hp + (dq & 1)) * 2048 + vv * 32 + q8 * 8); }
          { const int tok = tid >> 3, s_ = tid & 7, h2 = (s_ >> 1) & 1, half = s_ & 1; const size_t row = (size_t)(row0 + tok); const int hcol = (2 * hp + h2) * 32 + half * 16;
            qk4[0] = *(const u32x4*)(p.proj + row * INWP + C_GQ + hcol); qk4[1] = *(const u32x4*)(p.proj + row * INWP + C_GQ + hcol + 8);
            qk4[2] = *(const u32x4*)(p.proj + row * INWP + C_GK + hcol); qk4[3] = *(const u32x4*)(p.proj + row * INWP + C_GK + hcol + 8); }
          __builtin_amdgcn_sched_barrier(0);
#pragma unroll
          for (int it = 0; it < 4; ++it) { const int idx = tid + 512 * it, tok = idx >> 5, r = idx & 31, dir = r >> 4, q4 = r & 15;
              *(f32x4*)(bfl + tok * 132 + dir * 64 + q4 * 4) = sB[it]; }
#pragma unroll
          for (int it = 0; it < 2; ++it) { const int idx = tid + 512 * it, tok = idx & 63, vg = idx >> 6;
              const u32x4 pk = sV[it]; const unsigned wv[4] = {pk.x, pk.y, pk.z, pk.w};
#pragma unroll
              for (int e = 0; e < 8; ++e) VTg[(vg * 8 + e) * 72 + tok] = (bf16_t)((wv[e >> 1] >> ((e & 1) * 16)) & 0xffffu); }
#pragma unroll
          for (int it = 0; it < 2; ++it) { const int idx = tid + 512 * it, dq = idx >> 8, r = idx & 255, vv = r >> 2, q8 = r & 3;
              *(u32x4*)(hing + (dq * 64 + vv) * 40 + q8 * 8) = sH[it]; } }
        LDS_BARRIER();
        { const int tok = tid >> 3, s = tid & 7, dir = s >> 2, h2 = (s >> 1) & 1, half = s & 1;
          float qv[16], kv[16];
          { float t8[8]; unpack8(qk4[0], t8);
#pragma unroll
            for (int e = 0; e < 8; ++e) qv[e] = t8[e];
            unpack8(qk4[1], t8);
#pragma unroll
            for (int e = 0; e < 8; ++e) qv[8 + e] = t8[e];
            unpack8(qk4[2], t8);
#pragma unroll
            for (int e = 0; e < 8; ++e) kv[e] = t8[e];
            unpack8(qk4[3], t8);
#pragma unroll
            for (int e = 0; e < 8; ++e) kv[8 + e] = t8[e]; }
          const float* bp = bfl + tok * 132 + dir * 64 + h2 * 32 + half * 16;
          float oq[16], ok[16];
#pragma unroll
          for (int q = 0; q < 4; ++q) { const f32x4 bv = *(const f32x4*)(bp + 4 * q); const float bb[4] = {bv.x, bv.y, bv.z, bv.w};
#pragma unroll
              for (int e = 0; e < 4; ++e) { const float ex = __expf(bb[e]), exi = __expf(-bb[e]); oq[q * 4 + e] = qv[q * 4 + e] * ex * 0.17677669529663687f; ok[q * 4 + e] = kv[q * 4 + e] * exi; } }
          bf16_t* qd = Qf + ((dir * 2 + h2) * 64 + tok) * 40 + half * 16; bf16_t* kd = Kf + ((dir * 2 + h2) * 64 + tok) * 40 + half * 16;
          u32x4 w; w.x = pk2(oq[0], oq[1]); w.y = pk2(oq[2], oq[3]); w.z = pk2(oq[4], oq[5]); w.w = pk2(oq[6], oq[7]); *(u32x4*)qd = w;
          w.x = pk2(oq[8], oq[9]); w.y = pk2(oq[10], oq[11]); w.z = pk2(oq[12], oq[13]); w.w = pk2(oq[14], oq[15]); *(u32x4*)(qd + 8) = w;
          w.x = pk2(ok[0], ok[1]); w.y = pk2(ok[2], ok[3]); w.z = pk2(ok[4], ok[5]); w.w = pk2(ok[6], ok[7]); *(u32x4*)kd = w;
          w.x = pk2(ok[8], ok[9]); w.y = pk2(ok[10], ok[11]); w.z = pk2(ok[12], ok[13]); w.w = pk2(ok[14], ok[15]); *(u32x4*)(kd + 8) = w; }
        LDS_BARRIER();
        { f32x16 af = {}, ab = {};
          af = mma32<32>(Qf + ((0 * 2 + hl) * 64 + rt * 32) * 40, 40, Kf + ((0 * 2 + hl) * 64 + ct * 32) * 40, 40, af, r32, hi);
          ab = mma32<32>(Qf + ((1 * 2 + hl) * 64 + rt * 32) * 40, 40, Kf + ((1 * 2 + hl) * 64 + ct * 32) * 40, 40, ab, r32, hi);
          const int j = ct * 32 + r32;
#pragma unroll
          for (int r = 0; r < 16; ++r) { const int i = rt * 32 + crow(r, hi);
              att[(hl * 64 + i) * 72 + j] = (bf16_t)f2bf(((j <= i) ? af[r] : 0.f) + ((j >= i) ? ab[r] : 0.f)); } }
        LDS_BARRIER();
        { f32x16 acc = {};
          bf16_t ggr[16];
          { const int c_ = (2 * hp + hl) * 64 + ct * 32 + r32;
#pragma unroll
            for (int r = 0; r < 16; ++r) ggr[r] = p.proj[(size_t)(row0 + rt * 32 + crow(r, hi)) * INWP + C_GG + c_]; }
          acc = mma32<64>(att + (hl * 64 + rt * 32) * 72, 72, VTg + (hl * 64 + ct * 32) * 72, 72, acc, r32, hi);
          acc = mma32<32>(Qf + ((0 * 2 + hl) * 64 + rt * 32) * 40, 40, hing + ((0 * 2 + hl) * 64 + ct * 32) * 40, 40, acc, r32, hi);
          acc = mma32<32>(Qf + ((1 * 2 + hl) * 64 + rt * 32) * 40, 40, hing + ((1 * 2 + hl) * 64 + ct * 32) * 40, 40, acc, r32, hi);
          const int hh = 2 * hp + hl, v = ct * 32 + r32, c = hh * 64 + v; const float wn = p.glanw[v];
#pragma unroll
          for (int r = 0; r < 16; ++r) { const int i = rt * 32 + crow(r, hi); const float s = sum32(acc[r] * acc[r]); if (r32 == 0) psg[i * 4 + hl * 2 + ct] = s; }
          LDS_BARRIER();
#pragma unroll
          for (int r = 0; r < 16; ++r) { const int i = rt * 32 + crow(r, hi); const size_t row = (size_t)(row0 + i);
              const float rn = rsqrtf((psg[i * 4 + hl * 2] + psg[i * 4 + hl * 2 + 1]) * (1.0f / 64.0f) + EPS);
              const float gg = bf2f(ggr[r]);
              p.mix[row * DM + 768 + c] = (bf16_t)f2bf(acc[r] * rn * wn * siluf(gg)); } }
        LDS_BARRIER();
    }
}
}

#define XB_TMO      128
#define XB_XCNT(j)  (256  + 64 * (j))
#define XB_XSUB(j)  (1280 + 64 * (j))
#define XB_XGEN(j)  (2304 + 64 * (j))
#define XB_TOP      3328
#define XB_TOPGEN   3392
#define XCD_BAR_WORDS 3456
#define XB_SPIN_CAP (1u << 20)
__device__ __forceinline__ unsigned xb_ld(unsigned* p)              { return __hip_atomic_load(p, __ATOMIC_RELAXED, __HIP_MEMORY_SCOPE_AGENT); }
__device__ __forceinline__ unsigned xb_add(unsigned* p, unsigned v) { return __hip_atomic_fetch_add(p, v, __ATOMIC_RELAXED, __HIP_MEMORY_SCOPE_AGENT); }
__device__ __forceinline__ unsigned xb_xcc_id() { return (unsigned)__builtin_amdgcn_s_getreg((3 << 11) | 20) & 0xFu; }
#define XB_SPIN(cond, bar) do { unsigned _sp = 0; while (cond) { __builtin_amdgcn_s_sleep(1); \
    if ((++_sp & 255u) == 0u) { if (xb_ld(&(bar)[XB_TMO])) break; if (_sp > XB_SPIN_CAP) { atomicAdd(&(bar)[XB_TMO], 1u); break; } } } } while (0)
struct XcdBarrier { unsigned* bar; unsigned x; volatile LAS unsigned* st; };
__device__ __forceinline__ XcdBarrier xcd_barrier_post(unsigned* bar, volatile LAS unsigned* st) {
    XcdBarrier b; b.bar = bar; b.x = xb_xcc_id(); b.st = st;
    if (threadIdx.x == 0) (void)xb_add(&bar[XB_XCNT(b.x)], 1u);
    return b;
}
__device__ __forceinline__ void xcd_barrier_complete(unsigned* bar, unsigned x, unsigned& nloc, unsigned& nx) {
    const unsigned G = gridDim.x * gridDim.y * gridDim.z;
    unsigned sum, cnt, mine, sp = 0u;
    for (;;) {
        sum = 0u; cnt = 0u; mine = 0u;
#pragma unroll
        for (unsigned j = 0; j < 16; ++j) { const unsigned c = xb_ld(&bar[XB_XCNT(j)]); sum += c; cnt += (c > 0u) ? 1u : 0u; mine = (j == x) ? c : mine; }
        if (sum == G) break;
        __builtin_amdgcn_s_sleep(1);
        if ((++sp & 255u) == 0u) { if (xb_ld(&bar[XB_TMO])) break; if (sp > XB_SPIN_CAP) { atomicAdd(&bar[XB_TMO], 1u); break; } }
    }
    nloc = mine > 0u ? mine : 1u; nx = cnt > 0u ? cnt : 1u;
}
__device__ __forceinline__ void xcd_barrier(const XcdBarrier& b) {
    asm volatile("s_waitcnt vmcnt(0)" ::: "memory");
    __syncthreads();
    if (threadIdx.x == 0) {
        GAS unsigned* barg_ = (GAS unsigned*)b.bar; asm volatile("" : "+s"(barg_)); unsigned* bar = (unsigned*)barg_;
        __builtin_amdgcn_s_waitcnt(0);
        unsigned nloc = b.st[0], nx = b.st[1];
        if (nloc == 0u) { xcd_barrier_complete(bar, b.x, nloc, nx); b.st[0] = nloc; b.st[1] = nx; }
        const unsigned old = xb_add(&bar[XB_XSUB(b.x)], 1u);
        const unsigned gen = old / nloc;
        if (old + 1u == (gen + 1u) * nloc) {
            __builtin_amdgcn_fence(__ATOMIC_RELEASE, "agent");
            asm volatile("s_waitcnt vmcnt(0)" ::: "memory");
            const unsigned og = xb_add(&bar[XB_TOP], 1u);
            const unsigned tg = og / nx;
            if (og + 1u == (tg + 1u) * nx) xb_add(&bar[XB_TOPGEN], 1u);
            else XB_SPIN(xb_ld(&bar[XB_TOPGEN]) == tg, bar);
            __builtin_amdgcn_fence(__ATOMIC_ACQUIRE, "agent");
            xb_add(&bar[XB_XGEN(b.x)], 1u);
            asm volatile("s_waitcnt vmcnt(0)" ::: "memory");
        } else {
            XB_SPIN(xb_ld(&bar[XB_XGEN(b.x)]) == gen, bar);
            __builtin_amdgcn_fence(__ATOMIC_ACQUIRE, "agent");
            asm volatile("s_waitcnt vmcnt(0)" ::: "memory");
        }
    }
    __syncthreads();
}

struct Args { const float* in[28]; float* out; unsigned char* ws; int ph_lo, ph_hi; };
enum { I_X = 0, I_C, I_CTX, I_CCTX, I_WADA, I_BADA, I_N1W, I_WIN, I_DALAM, I_SUBW, I_CONVW, I_CONVB, I_ALOG, I_DTB, I_SSDD, I_SSDNW, I_GKUP, I_GKB, I_GLANW, I_WOUT, I_N2W,
       I_WR, I_BR, I_WGU, I_BGU, I_WDN, I_BDN, I_FNW };

__device__ __forceinline__ void transpose_item(const float* __restrict__ W, int K, int Nsrc, bf16_t* __restrict__ WT, int n0, int dst_row0, int k0, unsigned* scr, int lane) {
    const bool ok = (n0 + lane) < Nsrc; const float* src = W + (size_t)k0 * Nsrc + n0 + lane;
#pragma unroll
    for (int hb = 0; hb < 2; ++hb) { float v[32];
#pragma unroll
        for (int i = 0; i < 32; ++i) v[i] = ok ? __builtin_nontemporal_load(src + (size_t)(hb * 32 + i) * Nsrc) : 0.f;
#pragma unroll
        for (int i = 0; i < 16; ++i) scr[lane * 33 + hb * 16 + i] = pk2(v[2 * i], v[2 * i + 1]); }
    LDS_WAIT();
    const int c = lane & 7;
#pragma unroll
    for (int j = 0; j < 8; ++j) { const int nn = (lane >> 3) + 8 * j; const unsigned* t = scr + nn * 33 + 4 * c;
        u32x4 o; o.x = t[0]; o.y = t[1]; o.z = t[2]; o.w = t[3];
        __builtin_nontemporal_store(o, (u32x4*)(WT + (size_t)(dst_row0 + nn) * K + k0 + 8 * c)); }
    LDS_WAIT();
}

__device__ __forceinline__ void norm_mod_store(const f32x4 (&v)[4], const float* __restrict__ nw, const float* __restrict__ sh, const float* __restrict__ sc, bf16_t* __restrict__ orow, int lane) {
    float ss = 0.f;
#pragma unroll
    for (int j = 0; j < 4; ++j) ss += (v[j].x * v[j].x + v[j].y * v[j].y) + (v[j].z * v[j].z + v[j].w * v[j].w);
    const float r = rsqrtf(wave_sum(ss) * (1.0f / DM) + EPS);
#pragma unroll
    for (int j = 0; j < 4; ++j) { const int c = 4 * lane + 256 * j;
        const f32x4 w = *(const f32x4*)(nw + c), a = *(const f32x4*)(sc + c), b = *(const f32x4*)(sh + c);
        const f32x4 y = (v[j] * r) * w * (a + 1.0f) + b;
        u32x2 o; o.x = pk2(y.x, y.y); o.y = pk2(y.z, y.w); *(u32x2*)(orow + c) = o; }
}

__device__ __forceinline__ int moe_tables(const unsigned* cnt, int* tile_e, int* pstart, int* cntl) {
    const int t = fresh_tid();
    if (t < NE) { int c = (int)cnt[t]; if (c > LISTCAP) c = LISTCAP; cntl[t] = c; }
    __syncthreads();
    if (t <= NE) { int acc = 0; for (int e = 0; e < t; ++e) acc += ((cntl[e] + 255) >> 8) << 8; pstart[t] = acc;
        if (t < NE) { const int nt = (cntl[t] + 255) >> 8; for (int q = 0; q < nt; ++q) tile_e[(acc >> 8) + q] = t; } }
    __syncthreads();
    return __builtin_amdgcn_readfirstlane(pstart[NE] >> 8);
}

__device__ __forceinline__ const float* inp_ptr(const unsigned char* ldsl, int i) {
    const unsigned long long v = ((const unsigned long long*)(ldsl + PTAB_OFF))[i];
    const unsigned lo = __builtin_amdgcn_readfirstlane((unsigned)v), hi = __builtin_amdgcn_readfirstlane((unsigned)(v >> 32));
    return (const float*)(const GAS float*)(((unsigned long long)hi << 32) | lo);
}

__device__ __forceinline__ void titem_load(f32x4 (&v)[16], const float* mbase, unsigned off, int pitchB, int lane) {
    const __amdgpu_buffer_rsrc_t rs = __builtin_amdgcn_make_buffer_rsrc((void*)mbase, 0, 0x7fffffff, 0x00020000);
    const int vo = (lane >> 4) * 2 * pitchB + (lane & 15) * 16;
#pragma unroll
    for (int i = 0; i < 16; ++i) v[i] = __builtin_bit_cast(f32x4, __builtin_amdgcn_raw_buffer_load_b128(rs, vo, (int)off + ((i >> 1) * 8 + (i & 1)) * pitchB, 2));
}
__device__ __forceinline__ void titem_store(const f32x4 (&v)[16], bf16_t* __restrict__ dst, unsigned* scr, int lane) {
    { unsigned* wp = scr + (lane & 15) * 4 * 33 + (lane >> 4);
#pragma unroll
      for (int i = 0; i < 8; ++i)
#pragma unroll
          for (int nn = 0; nn < 4; ++nn) wp[nn * 33 + 4 * i] = pk2(v[2 * i][nn], v[2 * i + 1][nn]); }
    LDS_WAIT();
    const int c = lane & 7;
#pragma unroll
    for (int j = 0; j < 8; ++j) { const int nn = (lane >> 3) + 8 * j; const unsigned* t = scr + nn * 33 + 4 * c;
        u32x4 o; o.x = t[0]; o.y = t[1]; o.z = t[2]; o.w = t[3];
        __builtin_nontemporal_store(o, (u32x4*)(dst + (size_t)nn * DM + 8 * c)); }
    LDS_WAIT();
}
__device__ __forceinline__ void moe_item(int it, int l, const float* wgu, const float* wdn, bf16_t* bgu, bf16_t* bdn, const float*& mbase, unsigned& off, int& pitchB, bf16_t*& dst) {
    constexpr int I_GU = 16 * 32, I_DN = 16 * 16, N_GU = 32 * I_GU;
    if (it < N_GU) { const int e = it / I_GU, r = it % I_GU, kb = r / 32, n0 = (r % 32) * 64;
        const int drow = n0 < 1024 ? (n0 >> 7) * 256 + (n0 & 127) : ((n0 - 1024) >> 7) * 256 + 128 + ((n0 - 1024) & 127);
        mbase = wgu + (size_t)l * NE * DM * 2048; off = (unsigned)((e * DM + kb * 64) * 2048 + n0) * 4u; pitchB = 2048 * 4;
        dst = bgu + (size_t)(l * NE + e) * 2048 * DM + (size_t)drow * DM + kb * 64; }
    else { const int q = it - N_GU, e = q / I_DN, r = q % I_DN, kb = r / 16, n0 = (r % 16) * 64;
        mbase = wdn + (size_t)l * NE * DE * DM; off = (unsigned)((e * DE + kb * 64) * DM + n0) * 4u; pitchB = DM * 4;
        dst = bdn + (size_t)(l * NE + e) * DM * DE + (size_t)n0 * DE + kb * 64; }
}

__device__ __forceinline__ void ctx_outproj_block(const bf16_t* __restrict__ mixc, const bf16_t* __restrict__ wout, const float* __restrict__ base, bf16_t* __restrict__ out,
                                                  const float* __restrict__ gate, int blk, unsigned char* lds) {
    const int tid = fresh_tid(), lane = tid & 63, wave = __builtin_amdgcn_readfirstlane(tid >> 6), r32 = lane & 31, hi = lane >> 5;
    const int rb = blk >> 4, cb = blk & 15;
    const bf16_t* Ap = mixc + (size_t)(rb * 32 + r32) * DM + wave * 128 + 8 * hi;
    const bf16_t* Bp = wout + (size_t)(cb * 64 + r32) * DM + wave * 128 + 8 * hi;
    bf16x8 af[8], b0f[8], b1f[8];
#pragma unroll
    for (int ks = 0; ks < 8; ++ks) { af[ks] = *(const bf16x8*)(Ap + ks * 16); b0f[ks] = *(const bf16x8*)(Bp + ks * 16); b1f[ks] = *(const bf16x8*)(Bp + (size_t)32 * DM + ks * 16); }
    f32x16 a0 = {}, a1 = {};
#pragma unroll
    for (int ks = 0; ks < 8; ++ks) { a0 = __builtin_amdgcn_mfma_f32_32x32x16_bf16(af[ks], b0f[ks], a0, 0, 0, 0); a1 = __builtin_amdgcn_mfma_f32_32x32x16_bf16(af[ks], b1f[ks], a1, 0, 0, 0); }
    float* red = (float*)lds;
#pragma unroll
    for (int r = 0; r < 16; ++r) { red[((wave * 2 + 0) * 16 + r) * 64 + lane] = a0[r]; red[((wave * 2 + 1) * 16 + r) * 64 + lane] = a1[r]; }
    __syncthreads();
#pragma unroll
    for (int q = 0; q < 4; ++q) { const int idx = tid + 512 * q, t = idx >> 10, r = (idx >> 6) & 15, ln = idx & 63; float sum = 0.f;
#pragma unroll
        for (int w = 0; w < 8; ++w) sum += red[((w * 2 + t) * 16 + r) * 64 + ln];
        const int row = rb * 32 + (r & 3) + 8 * (r >> 2) + 4 * (ln >> 5), col = cb * 64 + t * 32 + (ln & 31);
        out[(size_t)row * DM + col] = (bf16_t)f2bf(base[(size_t)row * DM + col] + gate[col] * sum); }
    __syncthreads();
}

#ifndef GSPLIT
#define GSPLIT 144
#endif
constexpr int PH_PRO = 0, PH_NORM0 = 1, PH_L0 = 2, NPH_LAYER = 9, NPH = PH_L0 + NLAYER * NPH_LAYER;

__global__ void __launch_bounds__(NWAVES * 64, 2) fwd(Args args) {
    extern __shared__ __attribute__((aligned(16))) unsigned char lds[];
    const int G = gridDim.x, bx = blockIdx.x;
    const int vcu = (G % 8 == 0) ? (bx % 8) * (G / 8) + bx / 8 : bx;
    const int NGW = G * NWAVES;
#define PH_TID() const int tid = fresh_tid(), lane = tid & 63, wave = __builtin_amdgcn_readfirstlane(tid >> 6), gw = vcu * NWAVES + wave; (void)lane; (void)wave; (void)gw; \
    GAS unsigned char* wsg_ = (GAS unsigned char*)ws0; asm volatile("" : "+s"(wsg_)); unsigned char* ws = (unsigned char*)wsg_; \
    LAS const unsigned char* ldl_ = (LAS const unsigned char*)lds; asm volatile("" : "+v"(ldl_)); const unsigned char* ldsl = (const unsigned char*)ldl_
    unsigned char* const ws0 = args.ws;
#define G_ctl   ((unsigned*)(ws + WS_CTL))
#define G_modb  ((float*)(ws + WS_MOD))
#define G_ropet ((f32x2*)(ws + WS_ROPE))
#define G_scal  ((float*)(ws + WS_SCAL))
#define G_wb_in ((bf16_t*)(ws + WS_WIN))
#define G_wb_out ((bf16_t*)(ws + WS_WOUT))
#define G_wb_gu ((bf16_t*)(ws + WS_WGU))
#define G_wb_dn ((bf16_t*)(ws + WS_WDN))
#define G_hbuf  ((bf16_t*)(ws + WS_H))
#define G_proj  ((bf16_t*)(ws + WS_PROJ))
#define G_xbcs  ((bf16_t*)(ws + WS_XBC))
#define G_dtv   ((float*)(ws + WS_DT))
#define G_av    ((float*)(ws + WS_AV))
#define G_gkv   ((float*)(ws + WS_GKV))
#define G_ydir  ((bf16_t*)(ws + WS_YDIR))
#define G_odir  ((bf16_t*)(ws + WS_ODIR))
#define G_mix   ((bf16_t*)(ws + WS_MIX))
#define G_xw    ((bf16_t*)(ws + WS_XW))
#define G_list  ((int*)(ws + WS_LIST))
#define G_gatev ((float*)(ws + WS_GATE))
#define G_actb  ((bf16_t*)(ws + WS_ACT))
#define G_yk    ((bf16_t*)(ws + WS_YK))

    volatile LAS unsigned* MISC = (volatile LAS unsigned*)((LAS unsigned char*)lds + MISC_OFF);
    for (int u = threadIdx.x; u < 64; u += NWAVES * 64) MISC[u] = 0u;
    if (threadIdx.x < 28) ((const float**)(lds + PTAB_OFF))[threadIdx.x] = args.in[threadIdx.x];
#define INP(i) inp_ptr(ldsl, (i))
    __syncthreads();
    const int lo = args.ph_lo, hi = args.ph_hi;
    XcdBarrier bar; bar.bar = (unsigned*)(ws0 + WS_CTL) + CW_BAR; bar.x = 0; bar.st = nullptr;
    if (hi - lo > 1) bar = xcd_barrier_post((unsigned*)(ws0 + WS_CTL) + CW_BAR, MISC + 8);
#ifndef PH_MASK
#define PH_MASK 0xFFF
#endif
#define KIND(k) ((k) < PH_L0 ? (k) : 2 + ((k) - PH_L0) % NPH_LAYER)
#define IN(k) (lo <= (k) && (k) < hi)
#define INK(k, kind) (((PH_MASK >> (kind)) & 1) && IN(k))
#ifndef DUP_MASK
#define DUP_MASK 0
#endif
#define REPS(kind) for (int rep_ = 0; rep_ < 1 + ((DUP_MASK >> (kind)) & 1); ++rep_)
#ifndef BAR_REPS
#define BAR_REPS 1
#endif
#define SEAM(k) do { if (IN(k) && IN((k) + 1)) for (int br_ = 0; br_ < BAR_REPS; ++br_) xcd_barrier(bar); } while (0)

    if (INK(PH_PRO, 0)) REPS(0) { PH_TID();
        unsigned* scr = (unsigned*)(lds + RING_OFF + wave * 16384);
        constexpr int I_IN = 16 * 52, I_OUT = 16 * 16;
        constexpr int N_IN = 2 * I_IN, N_OUT = 2 * I_OUT, NITEMS = N_IN + N_OUT;
        for (int it = gw; it < NITEMS; it += NGW) {
            int r = it;
            if (r < N_IN) { const int l = r / I_IN; r %= I_IN; const int kb = r / 52, nb = r % 52;
                transpose_item(INP(I_WIN) + (size_t)l * DM * INW, DM, INW, G_wb_in + (size_t)l * INWP * DM, nb * 64, nb * 64, kb * 64, scr, lane); continue; }
            r -= N_IN;
            { const int l = r / I_OUT; r %= I_OUT; const int kb = r / 16, nb = r % 16;
                transpose_item(INP(I_WOUT) + (size_t)l * DM * DM, DM, DM, G_wb_out + (size_t)l * DM * DM, nb * 64, nb * 64, kb * 64, scr, lane); }
        }
        __syncthreads();
        for (int it = bx; it < 48; it += G) {
            const int l = it / 24, j0 = (it % 24) * 256;
            float* sc = (float*)(lds + RING_OFF);
            float* red = sc + 3072;
            for (int i = tid; i < 3072; i += 512) { const int v = i >> 10, k = i & 1023; const float cv = v < 2 ? INP(I_C)[v * DM + k] : INP(I_CCTX)[k]; sc[i] = siluf(cv); }
            __syncthreads();
            const int ks = tid >> 6;
            f32x4 a0 = {0.f, 0.f, 0.f, 0.f}, a1 = a0, a2 = a0;
            const float* wp = INP(I_WADA) + (size_t)l * DM * 6144 + j0 + 4 * lane;
            for (int k = ks * 128; k < ks * 128 + 128; ++k) { const f32x4 w = *(const f32x4*)(wp + (size_t)k * 6144); a0 += w * sc[k]; a1 += w * sc[1024 + k]; a2 += w * sc[2048 + k]; }
            *(f32x4*)(red + (ks * 3 + 0) * 256 + 4 * lane) = a0; *(f32x4*)(red + (ks * 3 + 1) * 256 + 4 * lane) = a1; *(f32x4*)(red + (ks * 3 + 2) * 256 + 4 * lane) = a2;
            __syncthreads();
            for (int i = tid; i < 768; i += 512) { const int v = i >> 8, jj = i & 255; float s = INP(I_BADA)[l * 6144 + j0 + jj];
                for (int q = 0; q < 8; ++q) s += red[(q * 3 + v) * 256 + jj];
                G_modb[(size_t)(l * 3 + v) * 6144 + j0 + jj] = s; }
            __syncthreads();
        }
        if (bx == (50 % G) || bx == (51 % G)) { const int l = bx == (50 % G) ? 0 : 1; float* wrt = (float*)(ws + WS_WRT) + l * 32768; const float* wr = INP(I_WR) + (size_t)l * 32768;
            for (int i = tid; i < 32768; i += 512) wrt[(i & 31) * 1024 + (i >> 5)] = wr[i]; }
        if (bx == (48 % G)) {
            for (int i = tid; i < 2048; i += 512) { const int pos = i >> 4, j = i & 15; const float inv = exp2f(-0.25f * (float)j * 3.3219280948873623f);
                const float ang = (float)pos * inv; G_ropet[i] = (f32x2){cosf(ang), sinf(ang)}; }
        }
        if (bx == (49 % G) && tid < NLAYER) {
            const float* lp = INP(I_DALAM) + tid * 256; float s01 = 0.f, s23 = 0.f;
            for (int i = 0; i < 64; ++i) { s01 += lp[i] * lp[64 + i]; s23 += lp[128 + i] * lp[192 + i]; }
            const float li = 0.8f - 0.6f * expf(-0.3f * (float)tid);
            G_scal[tid * 2 + 0] = expf(s01) - expf(s23) + li; G_scal[tid * 2 + 1] = 1.0f - li;
        }
    }
    SEAM(PH_PRO);
    if (INK(PH_NORM0, 1)) { PH_TID();
        for (int row = gw; row < TALL; row += NGW) {
            const int bidx = row < SEQ ? 0 : (row < TLAT ? 1 : 2);
            const float* xr = row < TLAT ? INP(I_X) + (size_t)row * DM : INP(I_CTX) + (size_t)(row - TLAT) * DM;
            f32x4 v[4];
#pragma unroll
            for (int j = 0; j < 4; ++j) v[j] = *(const f32x4*)(xr + 4 * lane + 256 * j);
            const float* mp = G_modb + (size_t)bidx * 6144;
            norm_mod_store(v, INP(I_N1W), mp, mp + 1024, G_hbuf + (size_t)row * DM, lane);
        }
    }
    SEAM(PH_NORM0);

    for (int l = 0; l < NLAYER; ++l) {
        const int P = PH_L0 + l * NPH_LAYER;
        const bool last = (l == NLAYER - 1);
#define modl (G_modb + (size_t)l * 3 * 6144)
        if (INK(P + 0, 2)) REPS(2) { PH_TID();
            int bxp = bx; asm volatile("" : "+s"(bxp));
            const bool split = G > GSPLIT; const int Gg = split ? GSPLIT : G;
            if (bxp < Gg) {
            pg8::Gemm g{G_hbuf, G_wb_in + (size_t)l * INWP * DM, TALL, INWP, DM, 0};
            pg8::StaticOrder S; S.init(TALL, INWP, Gg, bxp);
            pg8::EpiBf16 E{G_proj, INWP, (const float*)G_ropet, TLAT / 256};
            pg8::gemm_phase<pg8::EpiBf16, pg8::StaticOrder, true, true>((LAS unsigned char*)lds + RING_OFF, g, S, E);
            }
            if (bxp >= Gg || !split) {
                const int lane = fresh_tid() & 63;
                unsigned* scr = (unsigned*)(lds + RING_OFF + wave * 16384);
                constexpr int NIT = 32 * (16 * 32 + 16 * 16);
                const int ncw = (split ? G - GSPLIT : G) * NWAVES; int it = (split ? bxp - GSPLIT : bxp) * NWAVES + wave;
                const float* wgu = INP(I_WGU); const float* wdn = INP(I_WDN);
                if (it < NIT) {
                    f32x4 va[16], vb[16]; const float* mb; unsigned off; int pb; bf16_t* da; bf16_t* db;
                    moe_item(it, l, wgu, wdn, G_wb_gu, G_wb_dn, mb, off, pb, da); titem_load(va, mb, off, pb, lane);
                    for (;;) {
                        int nx = it + ncw;
                        moe_item(nx < NIT ? nx : NIT - 1, l, wgu, wdn, G_wb_gu, G_wb_dn, mb, off, pb, db); titem_load(vb, mb, off, pb, lane);
                        titem_store(va, da, scr, lane);
                        if (nx >= NIT) break;
                        it = nx; nx = it + ncw;
                        moe_item(nx < NIT ? nx : NIT - 1, l, wgu, wdn, G_wb_gu, G_wb_dn, mb, off, pb, da); titem_load(va, mb, off, pb, lane);
                        titem_store(vb, db, scr, lane);
                        if (nx >= NIT) break;
                        it = nx;
                    }
                }
            }
        }
        SEAM(P + 0);
#define CP_INIT()         ck::P cp; \
        cp.proj = G_proj; cp.xbcs = G_xbcs; cp.dtv = G_dtv; cp.cumv = G_av; cp.gkv = G_gkv; cp.ssd_st = G_ydir; cp.gla_st = G_odir; cp.cds = (float*)(ws + WS_CDS); cp.cdg = (float*)(ws + WS_CDG); cp.mix = G_mix; cp.ropet = G_ropet; \
        cp.convw = INP(I_CONVW) + l * 3 * 512; cp.convb = INP(I_CONVB) + l * 512; cp.dtb = INP(I_DTB) + l * 8; cp.alog = INP(I_ALOG) + l * 8; \
        cp.gkup = INP(I_GKUP) + (size_t)l * 2 * 16 * 128; cp.gkb = INP(I_GKB) + l * 2 * 128; cp.ssdd = INP(I_SSDD) + l * 4; cp.ssdnw = INP(I_SSDNW) + l * 256; cp.glanw = INP(I_GLANW) + l * 64; cp.kmax2 = G_ctl + CW_KMAX + l * 16; cp.hins = (bf16_t*)(ws + WS_HINS); cp.hing = (bf16_t*)(ws + WS_HING);
        if (INK(P + 1, 3)) REPS(3) { PH_TID(); CP_INIT();
            for (int ui = 0; ui < 2; ++ui) { int ch, sect;
                if (ui == 0) { if (bx >= TLAT / 64) continue; ch = bx; sect = 14; }
                else { if ((bx & 7) != 4 || (bx >> 3) >= 24) continue; const int u = bx >> 3; ch = TLAT / 64 + u / 3; sect = 2 << (u % 3); }
#ifndef PREP_DUP_SECT
#define PREP_DUP_SECT 15
#endif
                ck::prep_chunk(cp, ch, lds + RING_OFF, rep_ > 0 ? (sect & PREP_DUP_SECT) : sect, rep_ > 0); }
        }
        SEAM(P + 1);
        if (INK(P + 2, 4)) { PH_TID(); CP_INIT();
            for (int vb = bx; vb < 256; vb += G) ck::scan_phase(cp, vb);
        }
        SEAM(P + 2);
        if (INK(P + 3, 5)) REPS(5) { PH_TID(); CP_INIT();
            const float lam = __uint_as_float(__builtin_amdgcn_readfirstlane(__float_as_uint(G_scal[l * 2 + 0]))), osc = __uint_as_float(__builtin_amdgcn_readfirstlane(__float_as_uint(G_scal[l * 2 + 1])));
            const float* subw = INP(I_SUBW) + l * 128;
#ifndef ATT_DUP_PART
#define ATT_DUP_PART 3
#endif
#ifndef NO_ATT
            if (rep_ == 0 || (ATT_DUP_PART & 1)) for (int i = 0; i < 3; ++i) {
                int bh, qrow0, nkeys;
                if (i < 2) { bh = bx & 7; const int qb = i * 32 + (bx >> 3); qrow0 = (bh >> 2) * SEQ + qb * 128; nkeys = LCTX + SEQ; if ((bx >> 3) >= 32) continue; }
                else { if (last || (bx & 15) != 2 || (bx >> 4) >= 16) continue; const int u = bx >> 4; bh = u >> 1; qrow0 = TLAT + (bh >> 2) * LCTX + (u & 1) * 128; nkeys = LCTX; }
                att::attn_unit(G_proj, G_mix, subw, lam, osc, G_ctl + CW_KMAX + l * 16 + (bh >> 2) * 8, bh >> 2, bh & 3, qrow0, nkeys, (char*)lds + RING_OFF);
            }
#endif
#ifndef NO_FIN
            if (rep_ == 0 || (ATT_DUP_PART & 2)) for (int ui = 0; ui < 2; ++ui) { int ch, sect;
                if (ui == 0) { if (bx >= TLAT / 64) continue; ch = bx; sect = 15; }
                else { if (last || (bx & 7) != 4) continue; const int u = bx >> 3; ch = TLAT / 64 + (u >> 2); sect = 1 << (u & 3); }
                ck::finish_chunk(cp, ch, lds + RING_OFF, sect); }
#endif
        }
        SEAM(P + 3);
        if (INK(P + 4, 6)) REPS(6) { PH_TID();
            const int M = TLAT;
            pg8::Gemm g{G_mix, G_wb_out + (size_t)l * DM * DM, M, DM, DM, 0};
            pg8::StaticOrder S; S.init(M, DM, G, bx);
            pg8::EpiRes E{INP(I_X), INP(I_CTX), l == 0 ? (const bf16_t*)nullptr : (const bf16_t*)G_xw, G_xw, modl + 2 * 1024, 6144};
            pg8::gemm_phase<pg8::EpiRes, pg8::StaticOrder, true, true>((LAS unsigned char*)lds + RING_OFF, g, S, E);
            if (!last && bx < 256) ctx_outproj_block(G_mix + (size_t)TLAT * DM, G_wb_out + (size_t)l * DM * DM, INP(I_CTX), G_xw + (size_t)TLAT * DM, modl + 2 * 6144 + 2 * 1024, bx, lds + RING_OFF);
        }
        SEAM(P + 4);
        if (INK(P + 5, 7)) REPS(7) { PH_TID(); const bool dry = rep_ > 0;
            const int ntok = last ? TLAT : TALL, TPW = ntok / G;
            float* wT = (float*)(lds + RING_OFF);
            int* selE = (int*)(lds + RT_OFF); int* selP = selE + 272; int* lcnt = selP + 272; int* basep = lcnt + 32;
            { const float* wrt = (const float*)(ws + WS_WRT) + l * 32768;
              for (int i = tid; i < 8192; i += 512) *(f32x4*)(wT + 4 * i) = *(const f32x4*)(wrt + 4 * i); }
            if (tid < 32 && !dry) lcnt[tid] = 0;
            __syncthreads();
            const int tok0 = bx * TPW;
            const float* n2w = INP(I_N2W) + l * DM;
            if (TPW * G == ntok && TPW <= 68 && (TPW & 1) == 0) {
            float* wsc = (float*)(lds + RT_OFF + 2560) + wave * 80;
            const float brl = INP(I_BR)[l * NE + (lane >> 1)];
            u32x2 rawn[2][4];
#pragma unroll
            for (int t = 0; t < 2; ++t)
#pragma unroll
                for (int j = 0; j < 4; ++j) rawn[t][j] = *(const u32x2*)(G_xw + (size_t)(tok0 + wave * 2 + t) * DM + 4 * lane + 256 * j);
            for (int tl = wave * 2; tl < TPW; tl += 2 * NWAVES) {
                const int row0 = tok0 + tl;
                f32x4 v[2][4]; float ss[2] = {0.f, 0.f};
#pragma unroll
                for (int t = 0; t < 2; ++t)
#pragma unroll
                    for (int j = 0; j < 4; ++j) { const u32x2 w = rawn[t][j];
                        v[t][j] = (f32x4){__uint_as_float(w.x << 16), __uint_as_float(w.x & 0xffff0000u), __uint_as_float(w.y << 16), __uint_as_float(w.y & 0xffff0000u)};
                        ss[t] += (v[t][j].x * v[t][j].x + v[t][j].y * v[t][j].y) + (v[t][j].z * v[t][j].z + v[t][j].w * v[t][j].w); }
                { ss[0] = wave_sum(ss[0]); ss[1] = wave_sum(ss[1]); }
                { f32x4 wn[4];
#pragma unroll
                  for (int j = 0; j < 4; ++j) wn[j] = *(const f32x4*)(n2w + 4 * lane + 256 * j);
#pragma unroll
                  for (int t = 0; t < 2; ++t) { const int row = row0 + t, bidx = row < SEQ ? 0 : (row < TLAT ? 1 : 2); const float* mp = modl + (size_t)bidx * 6144;
                    const float r = rsqrtf(ss[t] * (1.0f / DM) + EPS);
                    f32x4 ma[4], mb[4];
#pragma unroll
                    for (int j = 0; j < 4; ++j) { const int c = 4 * lane + 256 * j; ma[j] = *(const f32x4*)(mp + 4 * 1024 + c); mb[j] = *(const f32x4*)(mp + 3 * 1024 + c); }
                    __builtin_amdgcn_sched_barrier(0);
#pragma unroll
                    for (int j = 0; j < 4; ++j) { const int c = 4 * lane + 256 * j;
                        v[t][j] = (v[t][j] * r) * wn[j] * (ma[j] + 1.0f) + mb[j];
                        u32x2 o; o.x = pk2(v[t][j].x, v[t][j].y); o.y = pk2(v[t][j].z, v[t][j].w); *(u32x2*)(G_hbuf + (size_t)row * DM + c) = o; } } }
                if (tl + 2 * NWAVES < TPW) {
#pragma unroll
                    for (int t = 0; t < 2; ++t)
#pragma unroll
                        for (int j = 0; j < 4; ++j) rawn[t][j] = *(const u32x2*)(G_xw + (size_t)(row0 + 2 * NWAVES + t) * DM + 4 * lane + 256 * j); }
                float pa[32], pb[32];
                { f32x2 vv[4][4];
#pragma unroll
                  for (int j = 0; j < 4; ++j) { vv[j][0] = (f32x2){v[0][j].x, v[1][j].x}; vv[j][1] = (f32x2){v[0][j].y, v[1][j].y}; vv[j][2] = (f32x2){v[0][j].z, v[1][j].z}; vv[j][3] = (f32x2){v[0][j].w, v[1][j].w}; }
                  f32x4 wb[2][8];
#pragma unroll
                  for (int q = 0; q < 8; ++q) wb[0][q] = *(const f32x4*)(wT + (q >> 2) * 1024 + 4 * lane + 256 * (q & 3));
#pragma unroll
                  for (int bt = 0; bt < 16; ++bt) {
                      if (bt + 1 < 16) {
#pragma unroll
                          for (int q = 0; q < 8; ++q) wb[(bt + 1) & 1][q] = *(const f32x4*)(wT + (2 * (bt + 1) + (q >> 2)) * 1024 + 4 * lane + 256 * (q & 3)); }
#pragma unroll
                      for (int ee = 0; ee < 2; ++ee) { f32x2 acc = {0.f, 0.f};
#pragma unroll
                          for (int j = 0; j < 4; ++j) { const f32x4 w = wb[bt & 1][ee * 4 + j];
                              acc = __builtin_elementwise_fma(vv[j][0], (f32x2){w.x, w.x}, acc); acc = __builtin_elementwise_fma(vv[j][1], (f32x2){w.y, w.y}, acc);
                              acc = __builtin_elementwise_fma(vv[j][2], (f32x2){w.z, w.z}, acc); acc = __builtin_elementwise_fma(vv[j][3], (f32x2){w.w, w.w}, acc); }
                          pa[2 * bt + ee] = acc.x; pb[2 * bt + ee] = acc.y; } } }
                float qa[16], qb[16], ra[8], rb[8], sa_[4], sb_[4], ta[2], tb[2];
#pragma unroll
                for (int i = 0; i < 16; ++i) { auto r0 = __builtin_amdgcn_permlane32_swap(__float_as_uint(pa[i]), __float_as_uint(pa[16 + i]), false, false);
                    auto r1 = __builtin_amdgcn_permlane32_swap(__float_as_uint(pb[i]), __float_as_uint(pb[16 + i]), false, false);
                    qa[i] = __uint_as_float(r0[0]) + __uint_as_float(r0[1]); qb[i] = __uint_as_float(r1[0]) + __uint_as_float(r1[1]); }
                { const bool up = (lane & 16) != 0;
#pragma unroll
                  for (int i = 0; i < 8; ++i) { const float s0 = up ? qa[i] : qa[8 + i], k0 = up ? qa[8 + i] : qa[i], s1 = up ? qb[i] : qb[8 + i], k1 = up ? qb[8 + i] : qb[i];
                      ra[i] = k0 + __shfl_xor(s0, 16); rb[i] = k1 + __shfl_xor(s1, 16); } }
                { const bool up = (lane & 8) != 0;
#pragma unroll
                  for (int i = 0; i < 4; ++i) { const float s0 = up ? ra[i] : ra[4 + i], k0 = up ? ra[4 + i] : ra[i], s1 = up ? rb[i] : rb[4 + i], k1 = up ? rb[4 + i] : rb[i];
                      sa_[i] = k0 + dpp_perm<0x128>(s0); sb_[i] = k1 + dpp_perm<0x128>(s1); } }
                { const bool up = (lane & 4) != 0;
#pragma unroll
                  for (int i = 0; i < 2; ++i) { const float s0 = up ? sa_[i] : sa_[2 + i], k0 = up ? sa_[2 + i] : sa_[i], s1 = up ? sb_[i] : sb_[2 + i], k1 = up ? sb_[2 + i] : sb_[i];
                      ta[i] = k0 + dpp_perm<0x1B>(dpp_perm<0x141>(s0)); tb[i] = k1 + dpp_perm<0x1B>(dpp_perm<0x141>(s1)); } }
                float la, lb;
                { const bool up = (lane & 2) != 0; const float s0 = up ? ta[0] : ta[1], k0 = up ? ta[1] : ta[0], s1 = up ? tb[0] : tb[1], k1 = up ? tb[1] : tb[0];
                  la = k0 + dpp_perm<0x4E>(s0); lb = k1 + dpp_perm<0x4E>(s1); }
                la += dpp_perm<0xB1>(la); lb += dpp_perm<0xB1>(lb);
                if ((lane & 1) == 0) { wsc[lane >> 1] = la + brl; wsc[32 + (lane >> 1)] = lb + brl; }
                LDS_WAIT();
                const int t = lane >> 5, e = lane & 31; const float* lg = wsc + t * 32; const float mine = lg[e]; int rank = 0;
#pragma unroll
                for (int q = 0; q < 8; ++q) { const f32x4 o4 = *(const f32x4*)(lg + 4 * q); const float ov[4] = {o4.x, o4.y, o4.z, o4.w};
#pragma unroll
                    for (int i = 0; i < 4; ++i) { const int j = 4 * q + i; rank += (ov[i] > mine || (ov[i] == mine && j < e)) ? 1 : 0; } }
                if (rank < 4) wsc[64 + t * 4 + rank] = mine;
                LDS_WAIT();
                if (rank < 4) { const f32x4 sv = *(const f32x4*)(wsc + 64 + t * 4);
                    const float e0 = __expf(sv.x - sv.x), e1 = __expf(sv.y - sv.x), e2 = __expf(sv.z - sv.x), e3 = __expf(sv.w - sv.x);
                    const float gk = __expf(mine - sv.x) / ((e0 + e1) + (e2 + e3));
                    const int lp = dry ? 0 : atomicAdd(&lcnt[e], 1);
                    if (!dry) { selE[(tl + t) * 4 + rank] = e; selP[(tl + t) * 4 + rank] = lp; } G_gatev[(size_t)(row0 + t) * 4 + rank] = gk; }
                LDS_WAIT();
            }
            }
            __syncthreads();
            if (tid < 32 && !dry) basep[tid] = (int)atomicAdd(&G_ctl[CW_CNT + l * 32 + tid], (unsigned)lcnt[tid]);
            __syncthreads();
            if (!dry) for (int i = tid; i < TPW * 4; i += 512) { const int e = selE[i]; const int pos = basep[e] + selP[i]; if (pos < LISTCAP) G_list[(size_t)e * LISTCAP + pos] = tok0 * 4 + i; }
        }
        SEAM(P + 5);
        if (INK(P + 6, 9)) REPS(9) { PH_TID();
            int* tile_e = (int*)(lds + TAB_OFF); int* pstart = tile_e + 304; int* cntl = pstart + 40;
            const int nrt = moe_tables(G_ctl + CW_CNT + l * 32, tile_e, pstart, cntl);
            pg8::Gemm g{G_hbuf, G_wb_gu + (size_t)l * NE * 2048 * DM, nrt * 256, 2048, DM, (size_t)2048 * DM * 2};
            pg8::MoeOrderT<true> S{(const LAS int*)((LAS unsigned char*)lds + TAB_OFF), (const LAS int*)((LAS unsigned char*)lds + TAB_OFF) + 304, (const LAS int*)((LAS unsigned char*)lds + TAB_OFF) + 344, G_list, nrt, 8, 3, G, vcu};
            pg8::EpiAct E{G_actb, INP(I_BGU) + (size_t)l * NE * 2048};
            pg8::gemm_phase<pg8::EpiAct, pg8::MoeOrderT<true>, true, true>((LAS unsigned char*)lds + RING_OFF, g, S, E);
        }
        SEAM(P + 6);
        if (INK(P + 7, 10)) REPS(10) { PH_TID();
            int* tile_e = (int*)(lds + TAB_OFF); int* pstart = tile_e + 304; int* cntl = pstart + 40;
            const int nrt = (IN(P + 6) && ((PH_MASK >> 9) & 1)) ? __builtin_amdgcn_readfirstlane(pstart[NE] >> 8) : moe_tables(G_ctl + CW_CNT + l * 32, tile_e, pstart, cntl);
            pg8::Gemm g{G_actb, G_wb_dn + (size_t)l * NE * DM * DE, nrt * 256, DM, DE, (size_t)DM * DE * 2};
            pg8::MoeOrderT<false> S{(const LAS int*)((LAS unsigned char*)lds + TAB_OFF), (const LAS int*)((LAS unsigned char*)lds + TAB_OFF) + 304, (const LAS int*)((LAS unsigned char*)lds + TAB_OFF) + 344, G_list, nrt, 4, 2, G, vcu};
            pg8::EpiDown E{G_yk, INP(I_BDN) + (size_t)l * NE * DM, &S, G_gatev};
            pg8::gemm_phase<pg8::EpiDown, pg8::MoeOrderT<false>, true, true>((LAS unsigned char*)lds + RING_OFF, g, S, E);
        }
        SEAM(P + 7);
        if (INK(P + 8, 11)) REPS(11) { PH_TID(); const bool dry = rep_ > 0;
            const int ntok = last ? TLAT : TALL;
            f32x4 nwv[4];
            { const float* nwp = last ? INP(I_FNW) : INP(I_N1W) + (l + 1) * DM;
#pragma unroll
              for (int q = 0; q < 4; ++q) nwv[q] = *(const f32x4*)(nwp + 8 * lane + 512 * (q >> 1) + 4 * (q & 1)); }
            for (int rowa = gw; rowa < ntok; rowa += 2 * NGW) {
                f32x4 v[2][4]; int rw[2]; bool ok[2];
#pragma unroll
                for (int t = 0; t < 2; ++t) { const int rr = rowa + t * NGW; ok[t] = rr < ntok; rw[t] = ok[t] ? rr : rowa; }
                u32x4 yv[2][2][4]; u32x4 xr[2][2];
#pragma unroll
                for (int t = 0; t < 2; ++t)
#pragma unroll
                    for (int jj = 0; jj < 2; ++jj) { const int c = 8 * lane + 512 * jj;
#pragma unroll
                        for (int k = 0; k < 4; ++k) yv[t][jj][k] = *(const u32x4*)(G_yk + ((size_t)rw[t] * 4 + k) * DM + c);
                        xr[t][jj] = *(const u32x4*)(G_xw + (size_t)rw[t] * DM + c); }
#pragma unroll
                for (int t = 0; t < 2; ++t) { const int row = rw[t], bidx = row < SEQ ? 0 : (row < TLAT ? 1 : 2); const float* mp = modl + (size_t)bidx * 6144;
                    const float* mn = G_modb + (size_t)((last ? l : l + 1) * 3 + bidx) * 6144;
                    f32x4 g2[4];
#pragma unroll
                    for (int q = 0; q < 4; ++q) g2[q] = *(const f32x4*)(mp + 5 * 1024 + 8 * lane + 512 * (q >> 1) + 4 * (q & 1));
                    __builtin_amdgcn_sched_barrier(0);
                    const float gsc = (dry && !last) ? 0.f : 1.f;
#pragma unroll
                    for (int jj = 0; jj < 2; ++jj) { const int c = 8 * lane + 512 * jj; float ff[8] = {0.f, 0.f, 0.f, 0.f, 0.f, 0.f, 0.f, 0.f};
#pragma unroll
                        for (int k = 0; k < 4; ++k) { float f8[8]; unpack8(yv[t][jj][k], f8);
#pragma unroll
                            for (int e = 0; e < 8; ++e) ff[e] += f8[e]; }
                        const f32x4 g2a = g2[jj * 2] * gsc, g2b = g2[jj * 2 + 1] * gsc;
                        float x8[8]; unpack8(xr[t][jj], x8);
                        v[t][jj * 2] = (f32x4){x8[0], x8[1], x8[2], x8[3]} + g2a * (f32x4){ff[0], ff[1], ff[2], ff[3]}; v[t][jj * 2 + 1] = (f32x4){x8[4], x8[5], x8[6], x8[7]} + g2b * (f32x4){ff[4], ff[5], ff[6], ff[7]};
                        if (!last && !dry && ok[t]) { const float o8[8] = {v[t][jj * 2].x, v[t][jj * 2].y, v[t][jj * 2].z, v[t][jj * 2].w, v[t][jj * 2 + 1].x, v[t][jj * 2 + 1].y, v[t][jj * 2 + 1].z, v[t][jj * 2 + 1].w};
                            *(u32x4*)(G_xw + (size_t)row * DM + c) = pack8(o8); } }
                    f32x4 ma[4], mb[4];
#pragma unroll
                    for (int q = 0; q < 4; ++q) { const int c = 8 * lane + 512 * (q >> 1) + 4 * (q & 1); ma[q] = *(const f32x4*)(mn + 1024 + c); mb[q] = *(const f32x4*)(mn + c); }
                    __builtin_amdgcn_sched_barrier(0);
                    float ss = 0.f;
#pragma unroll
                    for (int j = 0; j < 4; ++j) ss += (v[t][j].x * v[t][j].x + v[t][j].y * v[t][j].y) + (v[t][j].z * v[t][j].z + v[t][j].w * v[t][j].w);
                    const float r = rsqrtf(wave_sum(ss) * (1.0f / DM) + EPS);
                    if (ok[t]) {
                        if (!last) {
#pragma unroll
                            for (int jj = 0; jj < 2; ++jj) { const int c = 8 * lane + 512 * jj; float o8[8];
#pragma unroll
                                for (int hh = 0; hh < 2; ++hh) { const int q = jj * 2 + hh;
                                    const f32x4 y = (v[t][q] * r) * nwv[q] * (ma[q] + 1.0f) + mb[q]; o8[4 * hh] = y.x; o8[4 * hh + 1] = y.y; o8[4 * hh + 2] = y.z; o8[4 * hh + 3] = y.w; }
                                *(u32x4*)(G_hbuf + (size_t)row * DM + c) = pack8(o8); }
                        } else {
#pragma unroll
                            for (int jj = 0; jj < 2; ++jj) { const int c = 8 * lane + 512 * jj;
#pragma unroll
                                for (int hh = 0; hh < 2; ++hh) *(f32x4*)(args.out + (size_t)row * DM + c + 4 * hh) = (v[t][jj * 2 + hh] * r) * nwv[jj * 2 + hh]; }
                        }
                    }
                }
            }
        }
        SEAM(P + 8);
    }
#undef IN
#undef SEAM
}

extern "C" void kernel_launch(void* const* d_in, const int* in_sizes, int n_in, void* d_out, int out_size, void* d_ws, size_t ws_size, hipStream_t stream) {
    static int grid = 0;
    if (grid == 0) {
        if (n_in != 28 || out_size != TLAT * DM || ws_size < WS_END) { fprintf(stderr, "kernel_launch: unexpected shapes: n_in %d out %d ws %zu (need %zu)\n", n_in, out_size, ws_size, (size_t)WS_END); grid = -1; return; }
        int dev = 0, cus = 0, per_cu = 0;
        if (hipGetDevice(&dev) != hipSuccess || hipDeviceGetAttribute(&cus, hipDeviceAttributeMultiprocessorCount, dev) != hipSuccess) { grid = -1; return; }
        if (hipFuncSetAttribute((const void*)fwd, hipFuncAttributeMaxDynamicSharedMemorySize, LDS_BYTES) != hipSuccess) { fprintf(stderr, "kernel_launch: hipFuncSetAttribute failed\n"); grid = -1; return; }
        if (hipOccupancyMaxActiveBlocksPerMultiprocessor(&per_cu, (const void*)fwd, NWAVES * 64, LDS_BYTES) != hipSuccess || per_cu < 1) fprintf(stderr, "kernel_launch: occupancy query reports %d\n", per_cu);
        (void)hipGetLastError();
        grid = cus;
        if (grid != 256) fprintf(stderr, "kernel_launch: %d CUs (built for 256)\n", grid);
    }
    if (grid < 0) return;
    if (hipMemsetAsync((char*)d_ws + WS_CTL, 0, CTL_ZERO_BYTES, stream) != hipSuccess) return;
    Args a{};
    for (int i = 0; i < 28; ++i) a.in[i] = (const float*)d_in[i];
    a.out = (float*)d_out; a.ws = (unsigned char*)d_ws;
#if MK_N_LAUNCHES == 1
    a.ph_lo = 0; a.ph_hi = NPH;
    hipLaunchKernelGGL(fwd, dim3(grid), dim3(NWAVES * 64), LDS_BYTES, stream, a);
#else
    for (int p = 0; p < NPH; ++p) { a.ph_lo = p; a.ph_hi = p + 1; hipLaunchKernelGGL(fwd, dim3(grid), dim3(NWAVES * 64), LDS_BYTES, stream, a); }
#endif
    const hipError_t le = hipPeekAtLastError();
    if (le != hipSuccess) fprintf(stderr, "kernel_launch: launch failed: %s\n", hipGetErrorName(le));
}
```

```cpp
#include <hip/hip_runtime.h>
#include <cstdio>
#include <cstdint>

#ifndef MK_N_LAUNCHES
#define MK_N_LAUNCHES 1
#endif

#define GAS __attribute__((address_space(1)))
#define LAS __attribute__((address_space(3)))
typedef unsigned short bf16_t;
typedef short bf16x8 __attribute__((ext_vector_type(8)));
typedef short s16x4 __attribute__((ext_vector_type(4)));
typedef float f32x2 __attribute__((ext_vector_type(2)));
typedef float f32x4 __attribute__((ext_vector_type(4)));
typedef float f32x16 __attribute__((ext_vector_type(16)));
typedef unsigned u32x2 __attribute__((ext_vector_type(2)));
typedef unsigned u32x4 __attribute__((ext_vector_type(4)));

constexpr int DM = 1024, NB = 2, SEQ = 8192, LCTX = 256, NLAYER = 2;
constexpr int TLAT = NB * SEQ, TCTX = NB * LCTX, TALL = TLAT + TCTX;
constexpr int INW = 3112, INWP = 3328;
constexpr int C_Q = 0, C_K = 512, C_V = 1024, C_Z = 1536, C_XBC = 1792, C_DT = 2304, C_GQ = 2312, C_GK = 2440, C_GV = 2568, C_GG = 2824, C_CODE = 3080;
constexpr int NE = 32, DE = 1024;
constexpr int LISTCAP = TALL, MAXRT = 296, XB_ROWS = MAXRT * 256;
constexpr float EPS = 1e-6f;

constexpr size_t MiB = 1u << 20;
constexpr size_t WS_CTL = 0, CTL_ZERO_BYTES = 128 * 1024;
constexpr int CW_BAR = 4096, CW_CNT = 16384, CW_KMAX = 16384 + 64;
constexpr size_t WS_MOD = 1 * MiB, WS_ROPE = 1 * MiB + 256 * 1024, WS_SCAL = WS_ROPE + 16 * 1024, WS_CDS = WS_SCAL + 4096, WS_CDG = WS_SCAL + 32768, WS_WRT = WS_SCAL + 320 * 1024;
constexpr size_t WS_WIN = 2 * MiB, WS_WOUT = 15 * MiB, WS_WGU = 32 * MiB, WS_WDN = 288 * MiB;
constexpr size_t WS_H = 416 * MiB, WS_PROJ = 449 * MiB, WS_XBC = 557 * MiB, WS_DT = 574 * MiB, WS_AV = 575 * MiB, WS_GKV = 576 * MiB;
constexpr size_t WS_YDIR = 593 * MiB, WS_ODIR = 626 * MiB, WS_MIX = 659 * MiB, WS_XW = 692 * MiB, WS_LIST = 758 * MiB, WS_GATE = 761 * MiB, WS_RMAP = 762 * MiB;
constexpr size_t WS_HINS = 763 * MiB, WS_HING = 781 * MiB;
constexpr size_t WS_XB = 763 * MiB, WS_ACT = 911 * MiB, WS_YK = 1059 * MiB, WS_END = 1191 * MiB;

constexpr int RING_OFF = 0, RING_BYTES = 131072;
constexpr int MISC_OFF = RING_BYTES;
constexpr int TAB_OFF = RING_BYTES + 256;
constexpr int RT_OFF = RING_BYTES + 4096;
constexpr int LDS_BYTES = RING_BYTES + 12288;
constexpr int PTAB_OFF = LDS_BYTES - 256;
constexpr int NWAVES = 8;

__device__ __forceinline__ float bf2f(unsigned short b) { return __uint_as_float(((unsigned)b) << 16); }
typedef __bf16 bf16x2_t __attribute__((ext_vector_type(2)));
__device__ __forceinline__ unsigned pk2(float lo, float hi) { const f32x2 v = {lo, hi}; const bf16x2_t b = __builtin_convertvector(v, bf16x2_t); return __builtin_bit_cast(unsigned, b); }
__device__ __forceinline__ unsigned f2bf(float f) { return pk2(f, f) & 0xffffu; }
__device__ __forceinline__ float siluf(float x) { return x * __builtin_amdgcn_rcpf(1.0f + __expf(-x)); }
__device__ __forceinline__ float softplusf(float x) { return x > 20.f ? x : __logf(1.0f + __expf(x)); }
__device__ __forceinline__ float logsigmoidf(float x) { return fminf(x, 0.f) - __logf(1.0f + __expf(-fabsf(x))); }
template <int CTRL> __device__ __forceinline__ float dpp_perm(float x) {
    return __builtin_bit_cast(float, __builtin_amdgcn_mov_dpp(__builtin_bit_cast(int, x), CTRL, 0xf, 0xf, true)); }
template <int CTRL, int ROWMASK, bool BC> __device__ __forceinline__ float dpp_or0(float x) {
    return __builtin_bit_cast(float, __builtin_amdgcn_update_dpp(0, __builtin_bit_cast(int, x), CTRL, ROWMASK, 0xf, BC)); }
__device__ __forceinline__ float row16_allsum(float v) {
    v += dpp_perm<0xB1>(v); v += dpp_perm<0x4E>(v); v += dpp_perm<0x141>(v); v += dpp_perm<0x140>(v); return v; }
__device__ __forceinline__ float sum32(float v) {
    v = row16_allsum(v); const int iv = __builtin_bit_cast(int, v);
    const float s0 = __builtin_bit_cast(float, __builtin_amdgcn_readlane(iv, 0)), s1 = __builtin_bit_cast(float, __builtin_amdgcn_readlane(iv, 16));
    const float s2 = __builtin_bit_cast(float, __builtin_amdgcn_readlane(iv, 32)), s3 = __builtin_bit_cast(float, __builtin_amdgcn_readlane(iv, 48));
    return (threadIdx.x & 32) ? s2 + s3 : s0 + s1; }
__device__ __forceinline__ float wave_sum(float v) {
    v = row16_allsum(v); const int iv = __builtin_bit_cast(int, v);
    return (__builtin_bit_cast(float, __builtin_amdgcn_readlane(iv, 0)) + __builtin_bit_cast(float, __builtin_amdgcn_readlane(iv, 16))) +
           (__builtin_bit_cast(float, __builtin_amdgcn_readlane(iv, 32)) + __builtin_bit_cast(float, __builtin_amdgcn_readlane(iv, 48))); }
__device__ __forceinline__ float wave_scan(float x, int lane, bool rev) {
    float v = x;
    v += dpp_or0<0x111, 0xf, true>(v); v += dpp_or0<0x112, 0xf, true>(v); v += dpp_or0<0x114, 0xf, true>(v); v += dpp_or0<0x118, 0xf, true>(v);
    v += dpp_or0<0x142, 0xa, false>(v);
    v += dpp_or0<0x143, 0xc, false>(v);
    if (!rev) return v;
    const float tot = __builtin_bit_cast(float, __builtin_amdgcn_readlane(__builtin_bit_cast(int, v), 63));
    return (tot - v) + x;
}
__device__ __forceinline__ void unpack8(const u32x4 w, float (&f)[8]) {
    f[0] = __uint_as_float(w.x << 16); f[1] = __uint_as_float(w.x & 0xffff0000u); f[2] = __uint_as_float(w.y << 16); f[3] = __uint_as_float(w.y & 0xffff0000u);
    f[4] = __uint_as_float(w.z << 16); f[5] = __uint_as_float(w.z & 0xffff0000u); f[6] = __uint_as_float(w.w << 16); f[7] = __uint_as_float(w.w & 0xffff0000u);
}
__device__ __forceinline__ u32x4 pack8(const float (&f)[8]) { u32x4 w; w.x = pk2(f[0], f[1]); w.y = pk2(f[2], f[3]); w.z = pk2(f[4], f[5]); w.w = pk2(f[6], f[7]); return w; }
#define LDS_WAIT() asm volatile("s_waitcnt lgkmcnt(0)" ::: "memory")
#define LDS_BARRIER() asm volatile("s_waitcnt lgkmcnt(0)\n\ts_barrier" ::: "memory")
__device__ __forceinline__ int fresh_tid() { int t = threadIdx.x; asm volatile("" : "+v"(t)); return t; }

namespace pg8 {
#define PG8_LAS __attribute__((address_space(3)))
constexpr int BM = 256, BK = 64, HALF = 128, HTB = HALF * BK * 2, STAGE_BYTES = 8 * HTB, NXCD = 8, WGM = 8;
__host__ __device__ __forceinline__ int lds_byte(int r, int c) { const int st = (r >> 4) * 2 + (c >> 5), rr = r & 15, cc = c & 31, ob = rr * 64 + cc * 2; return st * 1024 + (ob ^ (((ob >> 9) & 1) << 5)); }
__host__ __device__ __forceinline__ void stage_rc(int b, int& R, int& C) { const int st = b / 1024, sb = b % 1024, swz = sb ^ (((sb >> 9) & 1) << 5); R = (st >> 1) * 16 + swz / 64; C = (st & 1) * 32 + (swz % 64) / 2; }
__host__ __device__ __forceinline__ int perm32(int rho) { const int n = rho >> 4, i = rho & 15; return 8 * (i >> 2) + 4 * n + (i & 3); }

struct Unit { int pm, pn, e; };
struct Gemm { const bf16_t* A; const bf16_t* Bt; int M, N, K; size_t estride; };

struct StaticOrder {
    static constexpr bool GATHER = false;
    int nM, nN, nwg, G, c;
    __host__ __device__ void init(int M, int N, int G_, int c_) { nM = M / BM; nN = N / BM; nwg = nM * nN; G = G_; c = c_; }
    __host__ __device__ bool next(int i, Unit& u) const {
        const long L = (long)i * G + c; if (L >= nwg) return false;
        int wgid = (int)L; { const int q = nwg / NXCD, r = nwg % NXCD, xcd = wgid % NXCD, off = wgid / NXCD; wgid = (xcd < r ? xcd * (q + 1) : r * (q + 1) + (xcd - r) * q) + off; }
        const int nig = WGM * nN, gid = wgid / nig, fm = gid * WGM, gsz = (nM - fm) < WGM ? (nM - fm) : WGM;
        u.pm = fm + ((wgid % nig) % gsz); u.pn = (wgid % nig) / gsz; u.e = 0; return true;
    }
    __device__ __forceinline__ const int* row_src(const Unit&, int) const { return nullptr; }
    __device__ __forceinline__ void a_ready(const Unit&) const {}
    __device__ __forceinline__ void done(const Unit&) const {}
};
template <bool GATHER_> struct MoeOrderT {
    static constexpr bool GATHER = GATHER_;
    const PG8_LAS int* tile_e; const PG8_LAS int* pstart; const PG8_LAS int* cntl; const int* list; int nrt, nN, lgN, G, cv;
    __device__ __forceinline__ bool next(int i, Unit& u) const {
        const int L = i * G + cv; if (L >= nrt * nN) return false;
        const int rt = L >> lgN; u.pm = rt; u.pn = L & (nN - 1); u.e = __builtin_amdgcn_readfirstlane(tile_e[rt]); return true;
    }
    __device__ __forceinline__ const int* row_src(const Unit& u, int r) const {
        const int ps = pstart[u.e], c = cntl[u.e]; int pos = u.pm * BM + r - ps; pos = pos < c ? pos : c - 1;
        return list + (size_t)u.e * LISTCAP + pos;
    }
    __device__ __forceinline__ int row_tok4(const Unit& u, int r) const {
        const int ps = pstart[u.e], c = cntl[u.e]; const int pos = u.pm * BM + r - ps;
        return pos < c ? list[(size_t)u.e * LISTCAP + pos] : -1;
    }
    __device__ __forceinline__ void a_ready(const Unit&) const {}
    __device__ __forceinline__ void done(const Unit&) const {}
};

__device__ __forceinline__ unsigned cvt_pk_bf16(float lo, float hi) { unsigned r; asm volatile("v_cvt_pk_bf16_f32 %0, %1, %2" : "=v"(r) : "v"(lo), "v"(hi)); return r; }

struct NoPre {};
struct EpiBf16 {
    static constexpr bool PERM = true, AFTER_DRAIN = false;
    typedef NoPre Pre; __device__ __forceinline__ void prefetch(Pre&, const Unit&, int, int, int, int) const {}
    bf16_t* O; int ldc;
    const float* ropet; int rope_pm;
    __device__ __forceinline__ void operator()(const f32x4 (&acc)[2][2][4][2], const Unit& u, int wr, int wc, int fr, int fq, const Pre&) const {
        const int row0 = u.pm * BM + wr * 64 + fr, col0 = u.pn * BM + wc * 32 + 8 * fq;
        if (ropet != nullptr && u.pn < 4 && u.pm < rope_pm) {
            const int t_ = fresh_tid(), fr_ = t_ & 15, fq_ = (t_ >> 4) & 3; const bool hiL = fq_ >= 2; const int half = wc & 1;
#pragma unroll
            for (int ai = 0; ai < 2; ++ai)
#pragma unroll
                for (int m = 0; m < 4; ++m) { const int row = u.pm * BM + wr * 64 + fr_ + ai * HALF + m * 16, sq = row & (SEQ - 1), pos = half ? (sq & 63) : (sq >> 6);
                    const f32x4* tp = (const f32x4*)(ropet + (size_t)(pos * 16 + 8 * (fq_ & 1)) * 2);
                    f32x4 cs[4];
#pragma unroll
                    for (int q = 0; q < 4; ++q) cs[q] = tp[q];
                    float A[8], B[8];
#pragma unroll
                    for (int i = 0; i < 8; ++i) { const float c = cs[i >> 1][(i & 1) * 2], sn = cs[i >> 1][(i & 1) * 2 + 1]; A[i] = hiL ? sn : c; B[i] = hiL ? c : -sn; }
                    bf16_t* rowp = O + (size_t)row * ldc + u.pn * BM + wc * 32 + 8 * fq_;
#pragma unroll
                    for (int bj = 0; bj < 2; ++bj) { float o8[8];
#pragma unroll
                        for (int i = 0; i < 8; ++i) { const float v = acc[ai][bj][m][i >> 2][i & 3];
                            auto r = __builtin_amdgcn_permlane32_swap(__float_as_uint(v), __float_as_uint(v), false, false);
                            o8[i] = __uint_as_float(r[0]) * A[i] + __uint_as_float(r[1]) * B[i]; }
                        u32x4 w; w.x = cvt_pk_bf16(o8[0], o8[1]); w.y = cvt_pk_bf16(o8[2], o8[3]); w.z = cvt_pk_bf16(o8[4], o8[5]); w.w = cvt_pk_bf16(o8[6], o8[7]);
                        *(u32x4*)(rowp + bj * HALF) = w; } }
            return; }
#pragma unroll
        for (int ai = 0; ai < 2; ++ai)
#pragma unroll
            for (int m = 0; m < 4; ++m) { bf16_t* rowp = O + (size_t)(row0 + ai * HALF + m * 16) * ldc + col0;
#pragma unroll
                for (int bj = 0; bj < 2; ++bj) { const f32x4 v0 = acc[ai][bj][m][0], v1 = acc[ai][bj][m][1];
                    u32x4 w; w.x = cvt_pk_bf16(v0[0], v0[1]); w.y = cvt_pk_bf16(v0[2], v0[3]); w.z = cvt_pk_bf16(v1[0], v1[1]); w.w = cvt_pk_bf16(v1[2], v1[3]);
                    *(u32x4*)(rowp + bj * HALF) = w; } }
    }
};
struct EpiRes {
    static constexpr bool PERM = false, AFTER_DRAIN = false;
    typedef NoPre Pre; __device__ __forceinline__ void prefetch(Pre&, const Unit&, int, int, int, int) const {}
    const float* baseL; const float* baseC; const bf16_t* baseB; bf16_t* out; const float* gate; int gstride;
    __device__ __forceinline__ void operator()(const f32x4 (&acc)[2][2][4][2], const Unit& u, int wr, int wc, int fr, int fq, const Pre&) const {
        const int rowt = u.pm * BM; const int bidx = rowt < SEQ ? 0 : (rowt < TLAT ? 1 : 2);
        const float* base = rowt < TLAT ? baseL + (size_t)rowt * DM : baseC + (size_t)(rowt - TLAT) * DM;
        const int t_ = fresh_tid(), fr_ = t_ & 15, fq_ = (t_ >> 4) & 3;
        (void)fr; (void)fq;
        const int rl = wr * 64 + fr_, col0 = u.pn * BM + wc * 32 + 4 * fq_;
        const float* gp = gate + (size_t)bidx * gstride + col0;
        f32x4 gv[2][2];
#pragma unroll
        for (int bj = 0; bj < 2; ++bj)
#pragma unroll
            for (int n = 0; n < 2; ++n) gv[bj][n] = *(const f32x4*)(gp + bj * HALF + n * 16);
        if (baseB) {
#pragma unroll
            for (int ai = 0; ai < 2; ++ai)
#pragma unroll
                for (int mp = 0; mp < 2; ++mp) { u32x2 bw[2][2][2];
#pragma unroll
                    for (int mm = 0; mm < 2; ++mm)
#pragma unroll
                        for (int bj = 0; bj < 2; ++bj)
#pragma unroll
                            for (int n = 0; n < 2; ++n) bw[mm][bj][n] = *(const u32x2*)(baseB + (size_t)rowt * DM + (size_t)(rl + ai * HALF + (2 * mp + mm) * 16) * DM + col0 + bj * HALF + n * 16);
                    __builtin_amdgcn_sched_barrier(0);
#pragma unroll
                    for (int mm = 0; mm < 2; ++mm) { const int m = 2 * mp + mm; bf16_t* op = out + (size_t)rowt * DM + (size_t)(rl + ai * HALF + m * 16) * DM + col0;
#pragma unroll
                        for (int bj = 0; bj < 2; ++bj)
#pragma unroll
                            for (int n = 0; n < 2; ++n) { const u32x2 w = bw[mm][bj][n];
                                const f32x4 bs = (f32x4){__uint_as_float(w.x << 16), __uint_as_float(w.x & 0xffff0000u), __uint_as_float(w.y << 16), __uint_as_float(w.y & 0xffff0000u)};
                                const f32x4 v = bs + gv[bj][n] * acc[ai][bj][m][n];
                                u32x2 o; o.x = cvt_pk_bf16(v[0], v[1]); o.y = cvt_pk_bf16(v[2], v[3]); *(u32x2*)(op + bj * HALF + n * 16) = o; } } }
        } else {
#pragma unroll
            for (int ai = 0; ai < 2; ++ai)
#pragma unroll
                for (int m = 0; m < 4; ++m) { f32x4 bf[2][2];
#pragma unroll
                    for (int bj = 0; bj < 2; ++bj)
#pragma unroll
                        for (int n = 0; n < 2; ++n) bf[bj][n] = *(const f32x4*)(base + (size_t)(rl + ai * HALF + m * 16) * DM + col0 + bj * HALF + n * 16);
                    __builtin_amdgcn_sched_barrier(0);
                    bf16_t* op = out + (size_t)rowt * DM + (size_t)(rl + ai * HALF + m * 16) * DM + col0;
#pragma unroll
                    for (int bj = 0; bj < 2; ++bj)
#pragma unroll
                        for (int n = 0; n < 2; ++n) { const f32x4 v = bf[bj][n] + gv[bj][n] * acc[ai][bj][m][n];
                            u32x2 o; o.x = cvt_pk_bf16(v[0], v[1]); o.y = cvt_pk_bf16(v[2], v[3]); *(u32x2*)(op + bj * HALF + n * 16) = o; } }
        }
    }
};
struct EpiAct {
    static constexpr bool PERM = true, AFTER_DRAIN = false;
    bf16_t* O; const float* bias;
    struct Pre { f32x4 b[4]; };
    __device__ __forceinline__ void prefetch(Pre& p, const Unit& u, int wr, int wc, int fr, int fq) const {
        const float* bp = bias + (size_t)u.e * 2048 + u.pn * HALF + wc * 32 + 8 * fq;
        p.b[0] = *(const f32x4*)(bp); p.b[1] = *(const f32x4*)(bp + 4); p.b[2] = *(const f32x4*)(bp + 1024); p.b[3] = *(const f32x4*)(bp + 1028); }
    __device__ __forceinline__ void operator()(const f32x4 (&acc)[2][2][4][2], const Unit& u, int wr, int wc, int fr, int fq, const Pre& p) const {
        const int row0 = u.pm * BM + wr * 64 + fr, col0 = u.pn * HALF + wc * 32 + 8 * fq;
        const f32x4 bg0 = p.b[0], bg1 = p.b[1], bl0 = p.b[2] + 1.0f, bl1 = p.b[3] + 1.0f;
#pragma unroll
        for (int ai = 0; ai < 2; ++ai)
#pragma unroll
            for (int m = 0; m < 4; ++m) { bf16_t* rowp = O + (size_t)(row0 + ai * HALF + m * 16) * DE + col0;
                float a[8];
#pragma unroll
                for (int n = 0; n < 2; ++n) { const f32x4 g = acc[ai][0][m][n] + (n ? bg1 : bg0), li = acc[ai][1][m][n] + (n ? bl1 : bl0);
#pragma unroll
                    for (int j = 0; j < 4; ++j) { const float gl = fminf(g[j], 7.0f), ln1 = __builtin_amdgcn_fmed3f(li[j], -6.0f, 8.0f); a[n * 4 + j] = gl * __builtin_amdgcn_rcpf(1.0f + __builtin_amdgcn_exp2f(-1.702f * 1.4426950408889634f * gl)) * ln1; } }
                u32x4 w; w.x = cvt_pk_bf16(a[0], a[1]); w.y = cvt_pk_bf16(a[2], a[3]); w.z = cvt_pk_bf16(a[4], a[5]); w.w = cvt_pk_bf16(a[6], a[7]);
                *(u32x4*)rowp = w; }
    }
};
struct EpiDown {
    static constexpr bool PERM = true, AFTER_DRAIN = false;
    bf16_t* Y; const float* bias; const MoeOrderT<false>* S; const float* gatev;
    struct Pre { int t4[8]; };
    __device__ __forceinline__ void prefetch(Pre& p, const Unit& u, int wr, int wc, int fr, int fq) const {
#pragma unroll
        for (int i = 0; i < 8; ++i) p.t4[i] = S->row_tok4(u, wr * 64 + fr + (i >> 2) * HALF + (i & 3) * 16); }
    __device__ __forceinline__ void operator()(const f32x4 (&acc)[2][2][4][2], const Unit& u, int wr, int wc, int fr, int fq, const Pre& p) const {
        const int row0 = u.pm * BM + wr * 64 + fr, col0 = u.pn * BM + wc * 32 + 8 * fq;
        const float* bp = bias + (size_t)u.e * DM + col0;
        f32x4 bv[2][2];
#pragma unroll
        for (int bj = 0; bj < 2; ++bj) { bv[bj][0] = *(const f32x4*)(bp + bj * HALF); bv[bj][1] = *(const f32x4*)(bp + bj * HALF + 4); }
        int t4[8]; float gt[8];
#pragma unroll
        for (int i = 0; i < 8; ++i) t4[i] = p.t4[i];
#pragma unroll
        for (int i = 0; i < 8; ++i) gt[i] = gatev[t4[i] >= 0 ? t4[i] : 0];
#pragma unroll
        for (int ai = 0; ai < 2; ++ai)
#pragma unroll
            for (int m = 0; m < 4; ++m) { const int tok4 = t4[ai * 4 + m];
                if (tok4 >= 0) { const float g1 = gt[ai * 4 + m]; bf16_t* rowp = Y + (size_t)tok4 * DM + col0;
#pragma unroll
                    for (int bj = 0; bj < 2; ++bj) { const f32x4 v0 = (acc[ai][bj][m][0] + bv[bj][0]) * g1, v1 = (acc[ai][bj][m][1] + bv[bj][1]) * g1;
                        u32x4 w; w.x = cvt_pk_bf16(v0[0], v0[1]); w.y = cvt_pk_bf16(v0[2], v0[3]); w.z = cvt_pk_bf16(v1[0], v1[1]); w.w = cvt_pk_bf16(v1[2], v1[3]);
                        *(u32x4*)(rowp + bj * HALF) = w; } } }
    }
};

template <class Epi, class Sched, bool ALIGN_EPI = false, bool SP2 = false>
__device__ __forceinline__ void gemm_phase(PG8_LAS unsigned char* lds, const Gemm g, const Sched& S, const Epi& E) {
    const int tid = fresh_tid(), wid = __builtin_amdgcn_readfirstlane(tid >> 6), lane = tid & 63, wr = wid >> 2, wc = wid & 3, fr = lane & 15, fq = lane >> 4;
    const int K = g.K, nt = K / BK;
    unsigned voffA[2], voffB[2];
#pragma unroll
    for (int i = 0; i < 2; ++i) { int R, C; stage_rc(tid * 16 + i * 8192, R, C); const int Rb = Epi::PERM ? ((R & ~31) + perm32(R & 31)) : R;
        voffA[i] = (unsigned)(R * K + C) * 2u; voffB[i] = (unsigned)(Rb * K + C) * 2u; }
    unsigned Rr[2], Cb2[2];
#pragma unroll
    for (int i = 0; i < 2; ++i) { int R, C; stage_rc(tid * 16 + i * 8192, R, C); Rr[i] = (unsigned)R; Cb2[i] = (unsigned)C * 2u; }
    unsigned tC4[2][2], tN4[2][2];
    const size_t kstep = (size_t)(BK * 2);
    const size_t hstep = (size_t)HALF * K * 2;
    const size_t tstep = 2 * hstep;
    const unsigned ldsw = (unsigned)wid * 1024u;
    const int aoff = lds_byte(wr * 64 + fr, fq * 8), boff = lds_byte(wc * 32 + fr, fq * 8);
#define PG8_SA(b, h) (((b) * 2 + (h)) * HTB)
#define PG8_SB(b, h) ((4 + (b) * 2 + (h)) * HTB)
#define PG8_STAGE(bufoff, gbase, voff) do { _Pragma("unroll") for (int _i = 0; _i < 2; ++_i) \
        __builtin_amdgcn_global_load_lds((const unsigned*)((const char*)(gbase) + (voff)[_i]), (PG8_LAS unsigned*)(lds + (bufoff) + ldsw + _i * 8192), 16, 0, 0); } while (0)
#define PG8_STAGE_A(bufoff, kbyte, h, isnext) do { if constexpr (Sched::GATHER) { unsigned vo_[2]; _Pragma("unroll") for (int _i = 0; _i < 2; ++_i) { asm volatile("" : "+v"(tN4[h][_i])); \
            const unsigned t4_ = (isnext) ? tN4[h][_i] : tC4[h][_i]; vo_[_i] = (t4_ >> 2) * (unsigned)(K * 2) + Cb2[_i]; } PG8_STAGE(bufoff, (const char*)g.A + (kbyte), vo_); } \
        else { PG8_STAGE(bufoff, ((isnext) ? nA : cA) + (kbyte) + (h) * hstep, voffA); } } while (0)
#define PG8_LOOKUP(dst, unit) do { _Pragma("unroll") for (int _h = 0; _h < 2; ++_h) _Pragma("unroll") for (int _i = 0; _i < 2; ++_i) { const int* p_ = S.row_src(unit, _h * HALF + (int)Rr[_i]); \
        asm volatile("global_load_dword %0, %1, off" : "=v"(dst[_h][_i]) : "v"(p_) : "memory"); } } while (0)
#define PG8_LDA(dst, b, h) do { _Pragma("unroll") for (int m = 0; m < 4; ++m) _Pragma("unroll") for (int k = 0; k < 2; ++k) dst[m][k] = *(const PG8_LAS bf16x8*)(lds + PG8_SA(b, h) + aoff + m * 2048 + k * 1024); } while (0)
#define PG8_LDB(dst, b, h) do { _Pragma("unroll") for (int n = 0; n < 2; ++n) _Pragma("unroll") for (int k = 0; k < 2; ++k) dst[n][k] = *(const PG8_LAS bf16x8*)(lds + PG8_SB(b, h) + boff + n * 2048 + k * 1024); } while (0)
#define PG8_MMA(ai, bj, At, Bt) do { __builtin_amdgcn_s_setprio(1); _Pragma("unroll") for (int m = 0; m < 4; ++m) _Pragma("unroll") for (int n = 0; n < 2; ++n) _Pragma("unroll") for (int k = 0; k < 2; ++k) \
        acc[ai][bj][m][n] = __builtin_amdgcn_mfma_f32_16x16x32_bf16(Bt[n][k], At[m][k], acc[ai][bj][m][n], 0, 0, 0); __builtin_amdgcn_s_setprio(0); } while (0)
#define PG8_WAIT_V(n) asm volatile("s_waitcnt vmcnt(" #n ")" ::: "memory")
#define PG8_WAIT_L(n) asm volatile("s_waitcnt lgkmcnt(" #n ")" ::: "memory")
#define PG8_BAR __builtin_amdgcn_s_barrier()
#define PG8_SCHED __builtin_amdgcn_sched_barrier(0)
    Unit cur, nxt; int ui = 0;
    if (!S.next(0, cur)) return;
    f32x4 acc[2][2][4][2];
#pragma unroll
    for (int a = 0; a < 2; ++a)
#pragma unroll
        for (int b = 0; b < 2; ++b)
#pragma unroll
            for (int m = 0; m < 4; ++m)
#pragma unroll
                for (int n = 0; n < 2; ++n) acc[a][b][m][n] = (f32x4){0.f, 0.f, 0.f, 0.f};
    bf16x8 At[4][2], B0[2][2], B1[2][2];
    const char* cA = (const char*)g.A + (size_t)cur.pm * tstep; const char* cB = (const char*)g.Bt + (size_t)cur.e * g.estride + (size_t)cur.pn * tstep;
    S.a_ready(cur);
    static_assert(SP2, "only the two-super-phase K-loop is kept in this file");
    const char* nA = cA;
    if constexpr (Sched::GATHER) { PG8_LOOKUP(tC4, cur); asm volatile("s_waitcnt vmcnt(0)" ::: "memory");
#pragma unroll
        for (int _h = 0; _h < 2; ++_h)
#pragma unroll
            for (int _i = 0; _i < 2; ++_i) { asm volatile("" : "+v"(tC4[_h][_i])); tN4[_h][_i] = tC4[_h][_i]; } }
    {
        PG8_STAGE(PG8_SB(0, 0), cB, voffB); PG8_STAGE(PG8_SB(0, 1), cB + hstep, voffB); PG8_STAGE_A(PG8_SA(0, 0), 0, 0, false); PG8_STAGE_A(PG8_SA(0, 1), 0, 1, false);
        if (wr == 1) PG8_BAR;
        PG8_WAIT_V(2); PG8_BAR;
        PG8_STAGE(PG8_SB(1, 0), cB + kstep, voffB); PG8_STAGE_A(PG8_SA(1, 0), kstep, 0, false); PG8_STAGE(PG8_SB(1, 1), cB + hstep + kstep, voffB);
        PG8_WAIT_V(6); PG8_BAR;
    }
    for (;;) {
        const bool has_next = S.next(ui + 1, nxt);
        nA = has_next ? (const char*)g.A + (size_t)nxt.pm * tstep : cA; const char* nB = has_next ? (const char*)g.Bt + (size_t)nxt.e * g.estride + (size_t)nxt.pn * tstep : cB;
        if constexpr (Sched::GATHER) { if (has_next) PG8_LOOKUP(tN4, nxt); }
        typename Epi::Pre pre; E.prefetch(pre, cur, wr, wc, fr, fq);
        for (int t = 0; t < nt; t += 2) {
            const bool last = (t == nt - 2);
            const size_t k1 = (size_t)(t + 1) * kstep, k2 = last ? 0 : (size_t)(t + 2) * kstep, k3 = k2 + kstep;
            const char* b2 = (last ? nB : cB) + k2; const char* b3 = b2 + kstep;
            if (last && has_next) S.a_ready(nxt);
            PG8_LDB(B0, 0, 0); PG8_LDB(B1, 0, 1); PG8_SCHED; PG8_LDA(At, 0, 0); PG8_STAGE_A(PG8_SA(1, 1), k1, 1, false);
            PG8_WAIT_V(8); PG8_WAIT_L(0); PG8_BAR; PG8_MMA(0, 0, At, B0); PG8_MMA(0, 1, At, B1); PG8_BAR; PG8_SCHED;
            PG8_LDA(At, 0, 1); PG8_STAGE(PG8_SB(0, 0), b2, voffB); PG8_STAGE(PG8_SB(0, 1), b2 + hstep, voffB); PG8_STAGE_A(PG8_SA(0, 0), k2, 0, last);
            PG8_WAIT_V(8); PG8_WAIT_L(0); PG8_BAR; PG8_MMA(1, 0, At, B0); PG8_MMA(1, 1, At, B1); PG8_BAR; PG8_SCHED;
            PG8_LDB(B0, 1, 0); PG8_LDB(B1, 1, 1); PG8_SCHED; PG8_LDA(At, 1, 0); PG8_STAGE_A(PG8_SA(0, 1), k2, 1, last);
            PG8_WAIT_V(8); PG8_WAIT_L(0); PG8_BAR; PG8_MMA(0, 0, At, B0); PG8_MMA(0, 1, At, B1); PG8_BAR; PG8_SCHED;
            PG8_LDA(At, 1, 1); PG8_STAGE(PG8_SB(1, 0), b3, voffB); PG8_STAGE(PG8_SB(1, 1), b3 + hstep, voffB); PG8_STAGE_A(PG8_SA(1, 0), k3, 0, last);
            PG8_WAIT_V(8); PG8_WAIT_L(0); PG8_BAR; PG8_MMA(1, 0, At, B0); PG8_MMA(1, 1, At, B1); PG8_BAR; PG8_SCHED;
        }
        if constexpr (ALIGN_EPI) { if (wr == 0) PG8_BAR; }
        if constexpr (!Epi::AFTER_DRAIN) { E(acc, cur, wr, wc, fr, fq, pre); S.done(cur); }
        if (!has_next) break;
#pragma unroll
        for (int a = 0; a < 2; ++a)
#pragma unroll
            for (int b = 0; b < 2; ++b)
#pragma unroll
                for (int m = 0; m < 4; ++m)
#pragma unroll
                    for (int n = 0; n < 2; ++n) acc[a][b][m][n] = (f32x4){0.f, 0.f, 0.f, 0.f};
        cur = nxt; cA = nA; cB = nB; ++ui;
        if constexpr (Sched::GATHER) {
#pragma unroll
            for (int _h = 0; _h < 2; ++_h)
#pragma unroll
                for (int _i = 0; _i < 2; ++_i) tC4[_h][_i] = tN4[_h][_i]; }
        if constexpr (ALIGN_EPI) { if (wr == 1) PG8_BAR; }
    }
    PG8_WAIT_V(0);
    if constexpr (!ALIGN_EPI) { if (wr == 0) PG8_BAR; }
    PG8_BAR;
#undef PG8_SA
#undef PG8_SB
#undef PG8_STAGE
#undef PG8_STAGE_A
#undef PG8_LOOKUP
#undef PG8_LDA
#undef PG8_LDB
#undef PG8_MMA
#undef PG8_WAIT_V
#undef PG8_WAIT_L
#undef PG8_BAR
#undef PG8_SCHED
}
}

namespace att {
constexpr float SCALE = 0.125f;
constexpr int SHM_V = 64 * 128 * 2, SHM_K = 64 * 128 * 2;
#define KSWZ(row, colB) ((row) * 256 + ((colB) ^ (((row) & 7) << 4)))
#define SBAR() __builtin_amdgcn_sched_barrier(0)
__device__ __forceinline__ int crow(int r, int hi) { return (r & 3) + 8 * (r >> 2) + 4 * hi; }
__device__ __forceinline__ unsigned cvtpk(float lo, float hi) { unsigned r; asm volatile("v_cvt_pk_bf16_f32 %0, %1, %2" : "=v"(r) : "v"(lo), "v"(hi)); return r; }
__device__ __forceinline__ bf16x8 ld8(const bf16_t* p) { return *reinterpret_cast<const bf16x8*>(p); }

__device__ __forceinline__ void partialSM(f32x16& p0) {
#pragma unroll
    for (int r = 0; r < 16; ++r) p0[r] = __builtin_amdgcn_exp2f(p0[r]);
}
__device__ __forceinline__ void finishSM(f32x16& p0, f32x16& p1, float& l_reg, bf16x8& pa0, bf16x8& pa1, bf16x8& pa2, bf16x8& pa3) {
#pragma unroll
    for (int r = 0; r < 16; ++r) p1[r] = __builtin_amdgcn_exp2f(p1[r]);
    float ps = 0;
#pragma unroll
    for (int r = 0; r < 16; ++r) ps += p0[r];
#pragma unroll
    for (int r = 0; r < 16; ++r) ps += p1[r];
    l_reg += ps;
#define PK4(P, BASE, OUT) do { u32x4 w = {cvtpk(P[BASE + 0], P[BASE + 1]), cvtpk(P[BASE + 2], P[BASE + 3]), cvtpk(P[BASE + 4], P[BASE + 5]), cvtpk(P[BASE + 6], P[BASE + 7])}; \
    OUT = *reinterpret_cast<bf16x8*>(&w); } while (0)
    PK4(p0, 0, pa0); PK4(p0, 8, pa1); PK4(p1, 0, pa2); PK4(p1, 8, pa3);
#undef PK4
}
__device__ __forceinline__ void qkt(f32x16& p0, f32x16& p1, const char* Ks, const bf16x8* qr, int r32, int hi, int mp, float nm) {
#pragma unroll
    for (int r = 0; r < 16; ++r) { p0[r] = nm; p1[r] = nm; }
    bf16x8 b0n, b1n;
    { const int cb = ((mp * 4 + 0) * 16 + hi * 8) * 2; b0n = *reinterpret_cast<const bf16x8*>(Ks + KSWZ(r32, cb)); b1n = *reinterpret_cast<const bf16x8*>(Ks + KSWZ(32 + r32, cb)); }
#pragma unroll
    for (int d0 = 0; d0 < 4; ++d0) { const bf16x8 b0 = b0n, b1 = b1n;
        if (d0 < 3) { const int cb = ((mp * 4 + d0 + 1) * 16 + hi * 8) * 2; b0n = *reinterpret_cast<const bf16x8*>(Ks + KSWZ(r32, cb)); b1n = *reinterpret_cast<const bf16x8*>(Ks + KSWZ(32 + r32, cb)); }
        __builtin_amdgcn_sched_barrier(0);
        p0 = __builtin_amdgcn_mfma_f32_32x32x16_bf16(b0, qr[d0], p0, 0, 0, 0);
        p1 = __builtin_amdgcn_mfma_f32_32x32x16_bf16(b1, qr[d0], p1, 0, 0, 0); }
}
__device__ __forceinline__ int v_st(int k, int c) { const int kk = k; return ((kk >> 3) * 4 + (c >> 5)) * 512 + ((kk & 7) * 32 + (c & 31)) * 2; }
__device__ __forceinline__ int v_rd_base(int lane) { return ((lane & 3) << 3) | (((lane >> 2) & 3) << 6) | (((lane >> 4) & 1) << 5) | (((lane >> 5) & 1) << 8); }
constexpr int v_rd_off(int d0, int ks, int half) { return d0 * 512 + ks * 4096 + half * 2048; }
template <int OFF> __device__ __forceinline__ s16x4 tr_read(int vb) {
    s16x4 r; asm volatile("ds_read_b64_tr_b16 %0, %1 offset:%2" : "=&v"(r) : "v"(vb), "i"(OFF) : "memory"); return r;
}
template <int D0, bool EXPS> __device__ __forceinline__ void pv_one(f32x16& od, int vb, bf16x8 pa0, bf16x8 pa1, bf16x8 pa2, bf16x8 pa3, f32x16& pn) {
    const s16x4 l0 = tr_read<v_rd_off(D0, 0, 0)>(vb), h0 = tr_read<v_rd_off(D0, 0, 1)>(vb), l1 = tr_read<v_rd_off(D0, 1, 0)>(vb), h1 = tr_read<v_rd_off(D0, 1, 1)>(vb);
    const s16x4 l2 = tr_read<v_rd_off(D0, 2, 0)>(vb), h2 = tr_read<v_rd_off(D0, 2, 1)>(vb), l3 = tr_read<v_rd_off(D0, 3, 0)>(vb), h3 = tr_read<v_rd_off(D0, 3, 1)>(vb);
    asm volatile("s_waitcnt lgkmcnt(0)" ::: "memory"); SBAR();
#define PK(L, H) (bf16x8){L[0], L[1], L[2], L[3], H[0], H[1], H[2], H[3]}
    od = __builtin_amdgcn_mfma_f32_32x32x16_bf16(pa0, PK(l0, h0), od, 0, 0, 0);
    od = __builtin_amdgcn_mfma_f32_32x32x16_bf16(pa1, PK(l1, h1), od, 0, 0, 0);
    od = __builtin_amdgcn_mfma_f32_32x32x16_bf16(pa2, PK(l2, h2), od, 0, 0, 0);
    od = __builtin_amdgcn_mfma_f32_32x32x16_bf16(pa3, PK(l3, h3), od, 0, 0, 0);
#undef PK
    if constexpr (EXPS) {
#pragma unroll
        for (int r = 4 * D0; r < 4 * D0 + 4; ++r) pn[r] = __builtin_amdgcn_exp2f(pn[r]); }
}
template <bool EXPS> __device__ __forceinline__ void pv_d0(f32x16* o, int vb, bf16x8 pa0, bf16x8 pa1, bf16x8 pa2, bf16x8 pa3, f32x16& pn) {
    pv_one<0, EXPS>(o[0], vb, pa0, pa1, pa2, pa3, pn); pv_one<1, EXPS>(o[1], vb, pa0, pa1, pa2, pa3, pn); pv_one<2, EXPS>(o[2], vb, pa0, pa1, pa2, pa3, pn); pv_one<3, EXPS>(o[3], vb, pa0, pa1, pa2, pa3, pn);
}

__device__ __forceinline__ void attn_unit(const bf16_t* __restrict__ proj, bf16_t* __restrict__ mix, const float* __restrict__ subw, float lam, float osc,
                                          const unsigned* __restrict__ kmax2, int b, int h, int qrow0, int nkeys, char* lds) {
    const int tid = fresh_tid(), wid = tid >> 6, lane = tid & 63, r32 = lane & 31, hi = lane >> 5, mp = wid >> 2, wq = wid & 3;
    constexpr int SLOT = SHM_V + SHM_K;
    float* ws = (float*)(lds + 3 * SLOT) + wid * 64; float* li_l = ws;
    float l_reg = 0; f32x16 o[4] = {}; bf16x8 qr[4];
    const int wu = __builtin_amdgcn_readfirstlane(wid);
    unsigned offV[2], offK[2];
#pragma unroll
    for (int q = 0; q < 2; ++q) { const int pc = 2 * wu + q;
        { const int key = 8 * (pc >> 1) + ((lane >> 2) & 7), col = 32 * (2 * (pc & 1) + (lane >> 5)) + (lane & 3) * 8; offV[q] = (unsigned)(key * INWP + col + C_V); }
        { const int row = 4 * pc + (lane >> 4), col = ((lane & 15) ^ (row & 7)) * 8; offK[q] = (unsigned)(row * INWP + col + C_K); } }
    const int vb0 = (int)(uintptr_t)lds + v_rd_base(lane);
    LAS unsigned char* lds3 = (LAS unsigned char*)(unsigned)(uintptr_t)lds;
    const int ctx_row0 = TLAT + b * LCTX, lat_row0 = b * SEQ - LCTX;
#define DMA_TILE(k0, so) do { const bf16_t* tb_ = proj + (size_t)((k0) < LCTX ? ctx_row0 + (k0) : lat_row0 + (k0)) * INWP + h * 128; \
    _Pragma("unroll") for (int q_ = 0; q_ < 2; ++q_) { \
        __builtin_amdgcn_global_load_lds((const unsigned*)(tb_ + offV[q_]), (LAS unsigned*)(lds3 + (so) + (2 * wu + q_) * 1024), 16, 0, 0); \
        __builtin_amdgcn_global_load_lds((const unsigned*)(tb_ + offK[q_]), (LAS unsigned*)(lds3 + (so) + SHM_V + (2 * wu + q_) * 1024), 16, 0, 0); } } while (0)
    f32x16 pA0, pA1, pB0, pB1; bf16x8 pa0, pa1, pa2, pa3; const int NT = nkeys / 64;
    int sl_prev = 0, sl_cur = 0, sl_next = SLOT;
#define ROT() do { sl_prev = sl_cur; sl_cur = sl_next; sl_next = (sl_next == 2 * SLOT) ? 0 : sl_next + SLOT; } while (0)
    DMA_TILE(0, 0); DMA_TILE(64, SLOT);
    const bf16_t* Qw = proj + (size_t)(qrow0 + wq * 32 + r32) * INWP + C_Q + h * 128 + mp * 64 + hi * 8;
    float qss = 0.f;
    bf16x8 qraw[4];
#pragma unroll
    for (int d0 = 0; d0 < 4; ++d0) qraw[d0] = ld8(Qw + d0 * 16);
    const float km2 = __uint_as_float(kmax2[h * 2 + mp]);
    __builtin_amdgcn_sched_barrier(0);
#pragma unroll
    for (int d0 = 0; d0 < 4; ++d0) { float f[8]; const bf16x8 raw = qraw[d0]; unpack8(*reinterpret_cast<const u32x4*>(&raw), f);
        constexpr float C = SCALE * 1.4426950408889634f;
        u32x4 w; w.x = cvtpk(f[0] * C, f[1] * C); w.y = cvtpk(f[2] * C, f[3] * C); w.z = cvtpk(f[4] * C, f[5] * C); w.w = cvtpk(f[6] * C, f[7] * C);
        float g[8]; unpack8(w, g);
#pragma unroll
        for (int e = 0; e < 8; ++e) qss += g[e] * g[e];
        qr[d0] = *reinterpret_cast<const bf16x8*>(&w); }
    qss += __shfl_xor(qss, 32);
    const float nm = -1.002f * sqrtf(qss) * sqrtf(km2);
    asm volatile("s_waitcnt vmcnt(0)" ::: "memory"); __syncthreads();
    qkt(pA0, pA1, lds + SHM_V, qr, r32, hi, mp, nm); partialSM(pA0);
    ROT();
#define ITER(PC0, PC1, PP0, PP1, j) do { if ((j) + 1 < NT) DMA_TILE(((j) + 1) * 64, sl_next); \
        SBAR(); qkt(PC0, PC1, lds + sl_cur + SHM_V, qr, r32, hi, mp, nm); \
        finishSM(PP0, PP1, l_reg, pa0, pa1, pa2, pa3); SBAR(); \
        pv_d0<true>(o, vb0 + sl_prev, pa0, pa1, pa2, pa3, PC0); \
        asm volatile("s_waitcnt vmcnt(0)" ::: "memory");     \
        __syncthreads(); ROT(); } while (0)
    for (int j = 1; j + 1 < NT; j += 2) { ITER(pB0, pB1, pA0, pA1, j); ITER(pA0, pA1, pB0, pB1, j + 1); }
    ITER(pB0, pB1, pA0, pA1, NT - 1);
    finishSM(pB0, pB1, l_reg, pa0, pa1, pa2, pa3); SBAR();
    pv_d0<false>(o, vb0 + sl_prev, pa0, pa1, pa2, pa3, pA0);
#undef ITER
#undef ROT
#undef DMA_TILE
    asm volatile("s_waitcnt vmcnt(0)" ::: "memory");
    l_reg += __shfl_xor(l_reg, 32);
    if (hi == 0) li_l[r32] = (mp ? lam : 1.0f) / l_reg;
    asm volatile("s_waitcnt lgkmcnt(0)" ::: "memory");
#pragma unroll
    for (int r = 0; r < 16; ++r) { const float f = li_l[crow(r, hi)];
#pragma unroll
        for (int d0 = 0; d0 < 4; ++d0) o[d0][r] *= f; }
    __syncthreads();
    float* ex = (float*)lds;
    bf16_t* ot = (bf16_t*)(lds + 65536);
    if (mp == 1) {
#pragma unroll
        for (int r = 0; r < 16; ++r)
#pragma unroll
            for (int d0 = 0; d0 < 4; ++d0) ex[(wq * 32 + crow(r, hi)) * 128 + d0 * 32 + r32] = o[d0][r];
    }
    __syncthreads();
    if (mp == 0) {
        const int t2 = fresh_tid(), r32 = t2 & 31, hi = (t2 >> 5) & 1, wq = (t2 >> 6) & 3;
        float wcol[4];
#pragma unroll
        for (int d0 = 0; d0 < 4; ++d0) wcol[d0] = subw[d0 * 32 + r32] * osc;
#pragma unroll
        for (int r = 0; r < 16; ++r) {
            float ss = 0.f;
#pragma unroll
            for (int d0 = 0; d0 < 4; ++d0) { o[d0][r] -= ex[(wq * 32 + crow(r, hi)) * 128 + d0 * 32 + r32]; ss += o[d0][r] * o[d0][r]; }
            ss = sum32(ss);
            const float rn = rsqrtf(ss * (1.0f / 128.0f) + EPS);
            bf16_t* op = ot + (wq * 32 + crow(r, hi)) * 136 + r32;
#pragma unroll
            for (int d0 = 0; d0 < 4; ++d0) op[d0 * 32] = (bf16_t)f2bf(o[d0][r] * rn * wcol[d0]);
        }
    }
    __syncthreads();
    { const int t3 = fresh_tid();
#pragma unroll
      for (int it = 0; it < 4; ++it) { const int idx = t3 + 512 * it, row = idx >> 4, pc = idx & 15;
          *(u32x4*)(mix + (size_t)(qrow0 + row) * DM + h * 128 + pc * 8) = *(const u32x4*)(ot + row * 136 + pc * 8); } }
    __syncthreads();
}
}


namespace ck {
template <int K>
__device__ __forceinline__ f32x16 mma32(const bf16_t* A, int lda, const bf16_t* B, int ldb, f32x16 acc, int r32, int hi) {
#pragma unroll
    for (int k0 = 0; k0 < K; k0 += 16) {
        const bf16x8 a = *(const bf16x8*)(A + r32 * lda + k0 + 8 * hi), b = *(const bf16x8*)(B + r32 * ldb + k0 + 8 * hi);
        acc = __builtin_amdgcn_mfma_f32_32x32x16_bf16(a, b, acc, 0, 0, 0); }
    return acc;
}
__device__ __forceinline__ int crow(int r, int hi) { return (r & 3) + 8 * (r >> 2) + 4 * hi; }
struct P { bf16_t* proj; bf16_t* xbcs; float* dtv; float* cumv; float* gkv; bf16_t* ssd_st; bf16_t* gla_st; float* cds; float* cdg; bf16_t* mix; const f32x2* ropet;
           const float *convw, *convb, *dtb, *alog, *gkup, *gkb, *ssdd, *ssdnw, *glanw; unsigned* kmax2; bf16_t* hins; bf16_t* hing; };

__device__ __forceinline__ void prep_chunk(const P& p, int ch, unsigned char* lds, int sect, bool dry = false) {
    const int tid = fresh_tid(), lane = tid & 63, wave = __builtin_amdgcn_readfirstlane(tid >> 6), r32 = lane & 31, hi = lane >> 5;
    const int row0 = ch * 64; const bool lat = row0 < TLAT;
    float* dtl = (float*)lds; float* al = dtl + 512; float* cuml = al + 512; float* wgt = cuml + 512; float* tot = wgt + 512;
    bf16_t* XwT = (bf16_t*)(lds + 16384);
    bf16_t* BT = (bf16_t*)(lds + 90112);
    if (lat && !dry && (sect & 1)) {
#pragma unroll 1
        for (int hb = 0; hb < 2; ++hb) {
            u32x4 a1[4], a2[4]; f32x4 tb[4][4];
#pragma unroll
            for (int q = 0; q < 4; ++q) { const int idx = tid + 512 * (hb * 4 + q);
                const int jg = idx & 1, half = (idx >> 1) & 1, mp = (idx >> 2) & 1, hh = (idx >> 3) & 3, qk = (idx >> 5) & 1, tok = idx >> 6;
                const int row = row0 + tok, s = row & (SEQ - 1), pos = half ? (s & 63) : (s >> 6);
                const bf16_t* p1 = p.proj + (size_t)row * INWP + qk * 512 + hh * 128 + mp * 64 + half * 32 + jg * 8;
                a1[q] = *(const u32x4*)p1; a2[q] = *(const u32x4*)(p1 + 16);
                const f32x4* tp = (const f32x4*)(p.ropet + pos * 16 + jg * 8);
#pragma unroll
                for (int e = 0; e < 4; ++e) tb[q][e] = tp[e]; }
#pragma unroll
            for (int q = 0; q < 4; ++q) { const int idx = tid + 512 * (hb * 4 + q);
                const int jg = idx & 1, half = (idx >> 1) & 1, mp = (idx >> 2) & 1, hh = (idx >> 3) & 3, qk = (idx >> 5) & 1, tok = idx >> 6;
                bf16_t* p1 = p.proj + (size_t)(row0 + tok) * INWP + qk * 512 + hh * 128 + mp * 64 + half * 32 + jg * 8;
                float x1[8], x2[8], o1[8], o2[8]; unpack8(a1[q], x1); unpack8(a2[q], x2);
#pragma unroll
                for (int e = 0; e < 4; ++e) { const f32x4 cs = tb[q][e];
                    o1[2 * e] = x1[2 * e] * cs.x - x2[2 * e] * cs.y; o2[2 * e] = x2[2 * e] * cs.x + x1[2 * e] * cs.y;
                    o1[2 * e + 1] = x1[2 * e + 1] * cs.z - x2[2 * e + 1] * cs.w; o2[2 * e + 1] = x2[2 * e + 1] * cs.z + x1[2 * e + 1] * cs.w; }
                *(u32x4*)p1 = pack8(o1); *(u32x4*)(p1 + 16) = pack8(o2); }
        }
    }
    const int spos = lat ? ((row0 + lane) & (SEQ - 1)) : ((row0 + lane - TLAT) & (LCTX - 1)), slen = lat ? SEQ : LCTX;
    if (sect & 2) {
    u32x4 c0[4], cm[4], cp[4];
    const bf16_t* cbase = p.proj + (size_t)(row0 + lane) * INWP + C_XBC;
    const int dm = spos > 0 ? -INWP : 0, dp = spos < slen - 1 ? INWP : 0;
#pragma unroll
    for (int q = 0; q < 4; ++q) { const bf16_t* pp = cbase + (wave + 8 * q) * 8; c0[q] = *(const u32x4*)pp; cm[q] = *(const u32x4*)(pp + dm); cp[q] = *(const u32x4*)(pp + dp); }
    float* cwl = (float*)(lds + 108544);
    { const int i4 = tid * 4; *(f32x4*)(cwl + i4) = (i4 < 512) ? *(const f32x4*)(p.convb + i4) : *(const f32x4*)(p.convw + (i4 - 512)); }
    { const int tok = tid >> 3, i = tid & 7, row = row0 + tok;
      const float x = bf2f(p.proj[(size_t)row * INWP + C_DT + i]) + p.dtb[i];
      const float dt = softplusf(x), A = -expf(p.alog[i]);
      dtl[tid] = dt; al[tid] = dt * A; p.dtv[(size_t)row * 8 + i] = dt; }
    unsigned* kml = (unsigned*)(tot + 8);
    if (tid < 8) kml[tid] = 0u;
    LDS_BARRIER();
    { const int tok = tid >> 3, hm = tid & 7; const bf16_t* kp = p.proj + (size_t)(row0 + tok) * INWP + C_K + hm * 64; float ss = 0.f;
#pragma unroll
      for (int q = 0; q < 8; ++q) { float f[8]; unpack8(*(const u32x4*)(kp + q * 8), f);
#pragma unroll
          for (int e = 0; e < 8; ++e) ss += f[e] * f[e]; }
      atomicMax(&kml[hm], __float_as_uint(ss)); }
    { const int i = wave, dir = i >> 2; const float c = wave_scan(al[lane * 8 + i], lane, dir != 0);
      cuml[lane * 8 + i] = c; if (lane == (dir ? 0 : 63)) { tot[i] = c; p.cds[ch * 8 + i] = __expf(c); } }
    LDS_BARRIER();
    if (tid < 8) atomicMax(p.kmax2 + (lat ? (row0 >> 13) : ((row0 - TLAT) >> 8)) * 8 + tid, kml[tid]);
    { const int tok = tid >> 3, i = tid & 7, row = row0 + tok; const float cmv = cuml[tid];
      wgt[tid] = __expf(tot[i] - cmv) * dtl[tid]; p.cumv[(size_t)row * 8 + i] = cmv; }
    LDS_BARRIER();
#pragma unroll
    for (int hb = 0; hb < 2; ++hb) {
        u32x4 n0[4], nm[4], np[4];
        if (hb == 0) {
#pragma unroll
            for (int q = 0; q < 4; ++q) { const bf16_t* pp = cbase + (wave + 8 * (4 + q)) * 8; n0[q] = *(const u32x4*)pp; nm[q] = *(const u32x4*)(pp + dm); np[q] = *(const u32x4*)(pp + dp); } }
#pragma unroll
        for (int q = 0; q < 4; ++q) { const int cg = wave + 8 * (hb * 4 + q), row = row0 + lane;
            float xm[8], x0[8], xp[8], o[8];
            unpack8(c0[q], x0); unpack8(cm[q], xm); unpack8(cp[q], xp);
            const float zm = spos > 0 ? 1.f : 0.f, zp = spos < slen - 1 ? 1.f : 0.f;
#pragma unroll
            for (int e = 0; e < 8; ++e) { const int c = cg * 8 + e; o[e] = siluf(cwl[c] + cwl[512 + c] * (xm[e] * zm) + cwl[1024 + c] * x0[e] + cwl[1536 + c] * (xp[e] * zp)); }
            const u32x4 pk = pack8(o);
            *(u32x4*)(p.xbcs + (size_t)row * 512 + cg * 8) = pk;
            if (cg < 32) { float ob[8]; unpack8(pk, ob); const float wf = wgt[lane * 8 + (cg >> 3)], wb = wgt[lane * 8 + 4 + (cg >> 3)];
#pragma unroll
                for (int e = 0; e < 8; ++e) { XwT[(cg * 8 + e) * 72 + lane] = (bf16_t)f2bf(ob[e] * wf); XwT[(256 + cg * 8 + e) * 72 + lane] = (bf16_t)f2bf(ob[e] * wb); } }
            else if (cg < 48) { const unsigned wv[4] = {pk.x, pk.y, pk.z, pk.w};
#pragma unroll
                for (int e = 0; e < 8; ++e) BT[((cg - 32) * 8 + e) * 72 + lane] = (bf16_t)((wv[e >> 1] >> ((e & 1) * 16)) & 0xffffu); } }
        if (hb == 0) {
#pragma unroll
            for (int q = 0; q < 4; ++q) { c0[q] = n0[q]; cm[q] = nm[q]; cp[q] = np[q]; } }
    }
    LDS_BARRIER();
#pragma unroll 1
    for (int q = 0; q < 4; ++q) {
        const int t = wave * 4 + q, dir = t >> 4, hh = (t >> 2) & 3, pt = (t >> 1) & 1, nt = t & 1;
        f32x16 acc = {};
        acc = mma32<64>(XwT + (dir * 256 + hh * 64 + pt * 32) * 72, 72, BT + ((hh >> 1) * 64 + nt * 32) * 72, 72, acc, r32, hi);
        bf16_t* dst = p.ssd_st + ((size_t)(ch * 2 + dir) * 4 + hh) * 4096 + nt * 32 + r32;
#pragma unroll
        for (int r = 0; r < 16; ++r) dst[(pt * 32 + crow(r, hi)) * 64] = (bf16_t)f2bf(acc[r]);
    }
    LDS_BARRIER();
    }
    if (sect & 12) {
    float* gkd = (float*)lds; float* bendl = (float*)(lds + 33792); bf16_t* KeT = (bf16_t*)(lds + 34816); bf16_t* VT = (bf16_t*)(lds + 71680);
    u32x4 vpk[4], kpk[2], cd[2][2];
    const bf16_t* rowp = p.proj + (size_t)(row0 + lane) * INWP;
#pragma unroll
    for (int it = 0; it < 4; ++it) vpk[it] = *(const u32x4*)(rowp + C_GV + (wave + 8 * it) * 8);
#pragma unroll
    for (int it = 0; it < 2; ++it) kpk[it] = *(const u32x4*)(rowp + C_GK + (wave + 8 * it) * 8);
    { const bf16_t* cpp = p.proj + (size_t)(row0 + (tid >> 3)) * INWP + C_CODE;
#pragma unroll
      for (int d = 0; d < 2; ++d) { cd[d][0] = *(const u32x4*)(cpp + d * 16); cd[d][1] = *(const u32x4*)(cpp + d * 16 + 8); } }
#pragma unroll
    for (int it = 0; it < 4; ++it) { const int vg = wave + 8 * it; const unsigned wv[4] = {vpk[it].x, vpk[it].y, vpk[it].z, vpk[it].w};
#pragma unroll
        for (int e = 0; e < 8; ++e) VT[(vg * 8 + e) * 72 + lane] = (bf16_t)((wv[e >> 1] >> ((e & 1) * 16)) & 0xffffu); }
    float* upl = (float*)(lds + 108544); float* gbl = upl + 4096;
    { *(f32x4*)(upl + tid * 4) = *(const f32x4*)(p.gkup + tid * 4); *(f32x4*)(upl + 2048 + tid * 4) = *(const f32x4*)(p.gkup + 2048 + tid * 4);
      if (tid < 64) *(f32x4*)(gbl + tid * 4) = *(const f32x4*)(p.gkb + tid * 4); }
    LDS_BARRIER();
#pragma unroll
    for (int dir = 0; dir < 2; ++dir) {
        if (!(sect & (4 << dir))) continue;
        { const int tok = tid >> 3, s8 = tid & 7, c0 = s8 * 16;
          float code[16]; { float t8[8]; unpack8(cd[dir][0], t8);
#pragma unroll
              for (int e = 0; e < 8; ++e) code[e] = t8[e];
              unpack8(cd[dir][1], t8);
#pragma unroll
              for (int e = 0; e < 8; ++e) code[8 + e] = t8[e]; }
          const float* up = upl + dir * 16 * 128 + c0; const float* gb = gbl + dir * 128 + c0;
#pragma unroll 1
          for (int q = 0; q < 4; ++q) { f32x4 a = *(const f32x4*)(gb + 4 * q); f32x4 w[16];
#pragma unroll
              for (int r = 0; r < 16; ++r) w[r] = *(const f32x4*)(up + r * 128 + 4 * q);
              __builtin_amdgcn_sched_barrier(0);
#pragma unroll
              for (int r = 0; r < 16; ++r) a += w[r] * code[r];
              f32x4 o; o.x = logsigmoidf(a.x) * 0.0625f; o.y = logsigmoidf(a.y) * 0.0625f; o.z = logsigmoidf(a.z) * 0.0625f; o.w = logsigmoidf(a.w) * 0.0625f;
              *(f32x4*)(gkd + tok * 132 + c0 + 4 * q) = o; } }
        LDS_BARRIER();
#pragma unroll 4
        for (int q = 0; q < 16; ++q) { const int c = wave * 16 + q; const float acc = wave_scan(gkd[lane * 132 + c], lane, dir != 0);
            gkd[lane * 132 + c] = acc; if (lane == (dir ? 0 : 63)) { bendl[c] = acc; p.cdg[ch * 256 + dir * 128 + c] = __expf(acc); } }
        LDS_BARRIER();
        for (int it = 0; it < 4; ++it) { const int idx = tid + 512 * it, tok = idx >> 5, q4 = idx & 31;
            *(f32x4*)(p.gkv + (size_t)(row0 + tok) * 256 + dir * 128 + q4 * 4) = *(const f32x4*)(gkd + tok * 132 + q4 * 4); }
#pragma unroll
        for (int it = 0; it < 2; ++it) { const int kg = wave + 8 * it;
            float kv[8]; unpack8(kpk[it], kv);
            const f32x4 b0 = *(const f32x4*)(gkd + lane * 132 + kg * 8), b1 = *(const f32x4*)(gkd + lane * 132 + kg * 8 + 4);
            const f32x4 e0 = *(const f32x4*)(bendl + kg * 8), e1 = *(const f32x4*)(bendl + kg * 8 + 4);
            const float bb[8] = {b0.x, b0.y, b0.z, b0.w, b1.x, b1.y, b1.z, b1.w}, be[8] = {e0.x, e0.y, e0.z, e0.w, e1.x, e1.y, e1.z, e1.w};
#pragma unroll
            for (int e = 0; e < 8; ++e) KeT[(dir * 128 + kg * 8 + e) * 72 + lane] = (bf16_t)f2bf(kv[e] * __expf(be[e] - bb[e])); }
        LDS_BARRIER();
    }
#pragma unroll 1
    for (int q = 0; q < 2; ++q) {
        const int t = wave * 2 + q, dir = t >> 3, hh = (t >> 1) & 3, vt = t & 1;
        if (!(sect & (4 << dir))) continue;
        f32x16 acc = {};
        acc = mma32<64>(VT + (hh * 64 + vt * 32) * 72, 72, KeT + (dir * 128 + hh * 32) * 72, 72, acc, r32, hi);
        bf16_t* dst = p.gla_st + ((size_t)(ch * 2 + dir) * 4 + hh) * 2048 + r32;
#pragma unroll
        for (int r = 0; r < 16; ++r) dst[(vt * 32 + crow(r, hi)) * 32] = (bf16_t)f2bf(acc[r]);
    }
    LDS_BARRIER();
    }
}

__device__ __forceinline__ void scan_phase(const P& p, int bx) {
    const int tid = fresh_tid();
    if (tid >= 384) return;
    const int e0 = bx * 384 + tid; const bool ssd = e0 < 65536; const int e = ssd ? e0 : e0 - 65536;
    const int b = ssd ? e >> 15 : e >> 14, dir = ssd ? (e >> 14) & 1 : (e >> 13) & 1, hh = ssd ? (e >> 12) & 3 : (e >> 11) & 3, el = ssd ? e & 4095 : e & 2047;
    const bf16_t* st = ssd ? p.ssd_st : p.gla_st; bf16_t* ho = ssd ? p.hins : p.hing; const int esz = ssd ? 4096 : 2048;
    const float* dcp = ssd ? p.cds + dir * 4 + hh : p.cdg + dir * 128 + hh * 32 + (el & 31); const int dst = ssd ? 8 : 256;
    float hst = 0.f;
#pragma unroll 1
    for (int kb = 0; kb < 132; kb += 22) {
        float sv[22], dv[22]; int ci[22];
#pragma unroll
        for (int u = 0; u < 22; ++u) { const int k = kb + u; ci[u] = k < 4 ? 256 + 4 * b + (dir ? 3 - k : k) : 128 * b + (dir ? 127 - (k - 4) : (k - 4));
            sv[u] = bf2f(st[((size_t)(ci[u] * 2 + dir) * 4 + hh) * esz + el]); dv[u] = dcp[ci[u] * dst]; }
#pragma unroll
        for (int u = 0; u < 22; ++u) { ho[((size_t)(ci[u] * 2 + dir) * 4 + hh) * esz + el] = (bf16_t)f2bf(hst); hst = hst * dv[u] + sv[u]; }
    }
}

__device__ __forceinline__ void finish_chunk(const P& p, int ch, unsigned char* lds, int sect) {
    const int tid = fresh_tid(), lane = tid & 63, wave = __builtin_amdgcn_readfirstlane(tid >> 6), r32 = lane & 31, hi = lane >> 5;
    const int row0 = ch * 64;
    float* cml = (float*)lds; float* dtl = cml + 512; float* psum = dtl + 512;
    const float cm0_ = p.cumv[(size_t)row0 * 8 + tid], dt0_ = p.dtv[(size_t)row0 * 8 + tid]; bool first_ = true;
    bf16_t* Cn = (bf16_t*)(lds + 8192); bf16_t* Bn = (bf16_t*)(lds + 17408); bf16_t* XT = (bf16_t*)(lds + 26624); bf16_t* Mb = (bf16_t*)(lds + 45056); bf16_t* hin = (bf16_t*)(lds + 63488); bf16_t* Zs = (bf16_t*)(lds + 100352);
    const int hl = wave >> 2, rt = (wave >> 1) & 1, ct = wave & 1;
#pragma unroll 1
    for (int g = 0; g < 2; ++g) {
        if (!(sect & (1 << g))) continue;
        { u32x4 sA[2], sZ[2], sX[2], sH[4];
#pragma unroll
          for (int it = 0; it < 2; ++it) { const int idx = tid + 512 * it, arr = idx >> 9, r = idx & 511, tok = r >> 3, pc = r & 7;
              sA[it] = *(const u32x4*)(p.xbcs + (size_t)(row0 + tok) * 512 + (arr ? 384 : 256) + g * 64 + pc * 8); }
#pragma unroll
          for (int it = 0; it < 2; ++it) { const int idx = tid + 512 * it, tok = idx >> 4, pc = idx & 15;
              sZ[it] = *(const u32x4*)(p.proj + (size_t)(row0 + tok) * INWP + C_Z + g * 128 + pc * 8); }
#pragma unroll
          for (int it = 0; it < 2; ++it) { const int idx = tid + 512 * it, tok = idx & 63, cg = idx >> 6;
              sX[it] = *(const u32x4*)(p.xbcs + (size_t)(row0 + tok) * 512 + g * 128 + cg * 8); }
#pragma unroll
          for (int it = 0; it < 4; ++it) { const int idx = tid + 512 * it, dq = idx >> 9, r = idx & 511, pp = r >> 3, q8 = r & 7;
              sH[it] = *(const u32x4*)(p.hins + ((size_t)(ch * 2 + (dq >> 1)) * 4 + 2 * g + (dq & 1)) * 4096 + pp * 64 + q8 * 8); }
          __builtin_amdgcn_sched_barrier(0);
          if (first_) { cml[tid] = cm0_; dtl[tid] = dt0_; first_ = false; }
#pragma unroll
          for (int it = 0; it < 2; ++it) { const int idx = tid + 512 * it, arr = idx >> 9, r = idx & 511, tok = r >> 3, pc = r & 7;
              *(u32x4*)((arr ? Cn : Bn) + tok * 72 + pc * 8) = sA[it]; }
#pragma unroll
          for (int it = 0; it < 2; ++it) { const int idx = tid + 512 * it, tok = idx >> 4, pc = idx & 15;
              *(u32x4*)(Zs + tok * 136 + pc * 8) = sZ[it]; }
#pragma unroll
          for (int it = 0; it < 2; ++it) { const int idx = tid + 512 * it, tok = idx & 63, cg = idx >> 6;
              const u32x4 pk = sX[it]; const unsigned wv[4] = {pk.x, pk.y, pk.z, pk.w};
#pragma unroll
              for (int e = 0; e < 8; ++e) XT[(cg * 8 + e) * 72 + tok] = (bf16_t)((wv[e >> 1] >> ((e & 1) * 16)) & 0xffffu); }
#pragma unroll
          for (int it = 0; it < 4; ++it) { const int idx = tid + 512 * it, dq = idx >> 9, r = idx & 511, pp = r >> 3, q8 = r & 7;
              *(u32x4*)(hin + (dq * 64 + pp) * 72 + q8 * 8) = sH[it]; } }
        LDS_BARRIER();
        const int hh = 2 * g + hl;
        { f32x16 acc = {}; acc = mma32<64>(Cn + rt * 32 * 72, 72, Bn + ct * 32 * 72, 72, acc, r32, hi);
          const int j = ct * 32 + r32; const float cfj = cml[j * 8 + hh], cbj = cml[j * 8 + 4 + hh], dfj = dtl[j * 8 + hh], dbj = dtl[j * 8 + 4 + hh];
#pragma unroll
          for (int r = 0; r < 16; ++r) { const int i = rt * 32 + crow(r, hi); const float cfi = cml[i * 8 + hh], cbi = cml[i * 8 + 4 + hh];
              const float lf = (j <= i) ? __expf(cfi - cfj) * dfj : 0.f, lb = (j >= i) ? __expf(cbi - cbj) * dbj : 0.f;
              Mb[(hl * 64 + i) * 72 + j] = (bf16_t)f2bf(acc[r] * (lf + lb)); } }
        LDS_BARRIER();
        { const int c = hh * 64 + ct * 32 + r32; const float dsk = p.ssdd[hh], wn = p.ssdnw[c];
          f32x16 y;
          { f32x16 t = {}; t = mma32<64>(Cn + rt * 32 * 72, 72, hin + ((0 * 2 + hl) * 64 + ct * 32) * 72, 72, t, r32, hi);
#pragma unroll
            for (int r = 0; r < 16; ++r) y[r] = __expf(cml[(rt * 32 + crow(r, hi)) * 8 + hh]) * t[r]; }
          { f32x16 t = {}; t = mma32<64>(Cn + rt * 32 * 72, 72, hin + ((1 * 2 + hl) * 64 + ct * 32) * 72, 72, t, r32, hi);
#pragma unroll
            for (int r = 0; r < 16; ++r) y[r] += __expf(cml[(rt * 32 + crow(r, hi)) * 8 + 4 + hh]) * t[r]; }
          y = mma32<64>(Mb + (hl * 64 + rt * 32) * 72, 72, XT + (hl * 64 + ct * 32) * 72, 72, y, r32, hi);
          const bf16_t* xcol = XT + (hl * 64 + ct * 32 + r32) * 72;
          bf16_t* zcol = Zs + hl * 64 + ct * 32 + r32;
#pragma unroll
          for (int r = 0; r < 16; ++r) { const int i = rt * 32 + crow(r, hi);
              y[r] = (y[r] + dsk * bf2f(xcol[i])) * siluf(bf2f(zcol[i * 136]));
              const float s = sum32(y[r] * y[r]); if (r32 == 0) psum[i * 8 + hl * 2 + ct] = s; }
          LDS_BARRIER();
#pragma unroll
          for (int r = 0; r < 16; ++r) { const int i = rt * 32 + crow(r, hi);
              const float rn = rsqrtf(((psum[i * 8] + psum[i * 8 + 1]) + (psum[i * 8 + 2] + psum[i * 8 + 3])) * (1.0f / 128.0f) + EPS);
              zcol[i * 136] = (bf16_t)f2bf(y[r] * rn * wn); } }
        LDS_BARRIER();
        for (int it = 0; it < 2; ++it) { const int idx = tid + 512 * it, tok = idx >> 4, pc = idx & 15;
            *(u32x4*)(p.mix + (size_t)(row0 + tok) * DM + 512 + g * 128 + pc * 8) = *(const u32x4*)(Zs + tok * 136 + pc * 8); }
        LDS_BARRIER();
    }
    float* bfl = (float*)lds; bf16_t* att = (bf16_t*)lds; float* psg = (float*)(lds + 34816);
    bf16_t* Qf = (bf16_t*)(lds + 36864); bf16_t* Kf = (bf16_t*)(lds + 57344); bf16_t* VTg = (bf16_t*)(lds + 77824); bf16_t* hing = (bf16_t*)(lds + 96256);
#pragma unroll 1
    for (int hp = 0; hp < 2; ++hp) {
        if (!(sect & (4 << hp))) continue;
        u32x4 qk4[4];
        { f32x4 sB[4]; u32x4 sV[2], sH[2];
#pragma unroll
          for (int it = 0; it < 4; ++it) { const int idx = tid + 512 * it, tok = idx >> 5, r = idx & 31, dir = r >> 4, q4 = r & 15;
              sB[it] = *(const f32x4*)(p.gkv + (size_t)(row0 + tok) * 256 + dir * 128 + hp * 64 + q4 * 4); }
#pragma unroll
          for (int it = 0; it < 2; ++it) { const int idx = tid + 512 * it, tok = idx & 63, vg = idx >> 6;
              sV[it] = *(const u32x4*)(p.proj + (size_t)(row0 + tok) * INWP + C_GV + hp * 128 + vg * 8); }
#pragma unroll
          for (int it = 0; it < 2; ++it) { const int idx = tid + 512 * it, dq = idx >> 8, r = idx & 255, vv = r >> 2, q8 = r & 3;
              sH[it] = *(const u32x4*)(p.hing + ((size_t)(ch * 2 + (dq >> 1)) * 4 + 2 * hp + (dq & 1)) * 2048 + vv * 32 + q8 * 8); }
          { const int tok = tid >> 3, s_ = tid & 7, h2 = (s_ >> 1) & 1, half = s_ & 1; const size_t row = (size_t)(row0 + tok); const int hcol = (2 * hp + h2) * 32 + half * 16;
            qk4[0] = *(const u32x4*)(p.proj + row * INWP + C_GQ + hcol); qk4[1] = *(const u32x4*)(p.proj + row * INWP + C_GQ + hcol + 8);
            qk4[2] = *(const u32x4*)(p.proj + row * INWP + C_GK + hcol); qk4[3] = *(const u32x4*)(p.proj + row * INWP + C_GK + hcol + 8); }
          __builtin_amdgcn_sched_barrier(0);
#pragma unroll
          for (int it = 0; it < 4; ++it) { const int idx = tid + 512 * it, tok = idx >> 5, r = idx & 31, dir = r >> 4, q4 = r & 15;
              *(f32x4*)(bfl + tok * 132 + dir * 64 + q4 * 4) = sB[it]; }
#pragma unroll
          for (int it = 0; it < 2; ++it) { const int idx = tid + 512 * it, tok = idx & 63, vg = idx >> 6;
              const u32x4 pk = sV[it]; const unsigned wv[4] = {pk.x, pk.y, pk.z, pk.w};
#pragma unroll
              for (int e = 0; e < 8; ++e) VTg[(vg * 8 + e) * 72 + tok] = (bf16_t)((wv[e >> 1] >> ((e & 1) * 16)) & 0xffffu); }
#pragma unroll
          for (int it = 0; it < 2; ++it) { const int idx = tid + 512 * it, dq = idx >> 8, r = idx & 255, vv = r >> 2, q8 = r & 3;
              *(u32x4*)(hing + (dq * 64 + vv) * 40 + q8 * 8) = sH[it]; } }
        LDS_BARRIER();
        { const int tok = tid >> 3, s = tid & 7, dir = s >> 2, h2 = (s >> 1) & 1, half = s & 1;
          float qv[16], kv[16];
          { float t8[8]; unpack8(qk4[0], t8);
#pragma unroll
            for (int e = 0; e < 8; ++e) qv[e] = t8[e];
            unpack8(qk4[1], t8);
#pragma unroll
            for (int e = 0; e < 8; ++e) qv[8 + e] = t8[e];
            unpack8(qk4[2], t8);
#pragma unroll
            for (int e = 0; e < 8; ++e) kv[e] = t8[e];
            unpack8(qk4[3], t8);
#pragma unroll
            for (int e = 0; e < 8; ++e) kv[8 + e] = t8[e]; }
          const float* bp = bfl + tok * 132 + dir * 64 + h2 * 32 + half * 16;
          float oq[16], ok[16];
#pragma unroll
          for (int q = 0; q < 4; ++q) { const f32x4 bv = *(const f32x4*)(bp + 4 * q); const float bb[4] = {bv.x, bv.y, bv.z, bv.w};
#pragma unroll
              for (int e = 0; e < 4; ++e) { const float ex = __expf(bb[e]), exi = __expf(-bb[e]); oq[q * 4 + e] = qv[q * 4 + e] * ex * 0.17677669529663687f; ok[q * 4 + e] = kv[q * 4 + e] * exi; } }
          bf16_t* qd = Qf + ((dir * 2 + h2) * 64 + tok) * 40 + half * 16; bf16_t* kd = Kf + ((dir * 2 + h2) * 64 + tok) * 40 + half * 16;
          u32x4 w; w.x = pk2(oq[0], oq[1]); w.y = pk2(oq[2], oq[3]); w.z = pk2(oq[4], oq[5]); w.w = pk2(oq[6], oq[7]); *(u32x4*)qd = w;
          w.x = pk2(oq[8], oq[9]); w.y = pk2(oq[10], oq[11]); w.z = pk2(oq[12], oq[13]); w.w = pk2(oq[14], oq[15]); *(u32x4*)(qd + 8) = w;
          w.x = pk2(ok[0], ok[1]); w.y = pk2(ok[2], ok[3]); w.z = pk2(ok[4], ok[5]); w.w = pk2(ok[6], ok[7]); *(u32x4*)kd = w;
          w.x = pk2(ok[8], ok[9]); w.y = pk2(ok[10], ok[11]); w.z = pk2(ok[12], ok[13]); w.w = pk2(ok[14], ok[15]); *(u32x4*)(kd + 8) = w; }
        LDS_BARRIER();
        { f32x16 af = {}, ab = {};
          af = mma32<32>(Qf + ((0 * 2 + hl) * 64 + rt * 32) * 40, 40, Kf + ((0 * 2 + hl) * 64 + ct * 32) * 40, 40, af, r32, hi);
          ab = mma32<32>(Qf + ((1 * 2 + hl) * 64 + rt * 32) * 40, 40, Kf + ((1 * 2 + hl) * 64 + ct * 32) * 40, 40, ab, r32, hi);
          const int j = ct * 32 + r32;
#pragma unroll
          for (int r = 0; r < 16; ++r) { const int i = rt * 32 + crow(r, hi);
              att[(hl * 64 + i) * 72 + j] = (bf16_t)f2bf(((j <= i) ? af[r] : 0.f) + ((j >= i) ? ab[r] : 0.f)); } }
        LDS_BARRIER();
        { f32x16 acc = {};
          bf16_t ggr[16];
          { const int c_ = (2 * hp + hl) * 64 + ct * 32 + r32;
#pragma unroll
            for (int r = 0; r < 16; ++r) ggr[r] = p.proj[(size_t)(row0 + rt * 32 + crow(r, hi)) * INWP + C_GG + c_]; }
          acc = mma32<64>(att + (hl * 64 + rt * 32) * 72, 72, VTg + (hl * 64 + ct * 32) * 72, 72, acc, r32, hi);
          acc = mma32<32>(Qf + ((0 * 2 + hl) * 64 + rt * 32) * 40, 40, hing + ((0 * 2 + hl) * 64 + ct * 32) * 40, 40, acc, r32, hi);
          acc = mma32<32>(Qf + ((1 * 2 + hl) * 64 + rt * 32) * 40, 40, hing + ((1 * 2 + hl) * 64 + ct * 32) * 40, 40, acc, r32, hi);
          const int hh = 2 * hp + hl, v = ct * 32 + r32, c = hh * 64 + v; const float wn = p.glanw[v];
#pragma unroll
          for (int r = 0; r < 16; ++r) { const int i = rt * 32 + crow(r, hi); const float s = sum32(acc[r] * acc[r]); if (r32 == 0) psg[i * 4 + hl * 2 + ct] = s; }
          LDS_BARRIER();
#pragma unroll
          for (int r = 0; r < 16; ++r) { const int i = rt * 32 + crow(r, hi); const size_t row = (size_t)(row0 + i);
              const float rn = rsqrtf((psg[i * 4 + hl * 2] + psg[i * 4 + hl * 2 + 1]) * (1.0f / 64.0f) + EPS);
              const float gg = bf2f(ggr[r]);
              p.mix[row * DM + 768 + c] = (bf16_t)f2bf(acc[r] * rn * wn * siluf(gg)); } }
        LDS_BARRIER();
    }
}
}

#define XB_TMO      128
#define XB_XCNT(j)  (256  + 64 * (j))
#define XB_XSUB(j)  (1280 + 64 * (j))
#define XB_XGEN(j)  (2304 + 64 * (j))
#define XB_TOP      3328
#define XB_TOPGEN   3392
#define XCD_BAR_WORDS 3456
#define XB_SPIN_CAP (1u << 20)
__device__ __forceinline__ unsigned xb_ld(unsigned* p)              { return __hip_atomic_load(p, __ATOMIC_RELAXED, __HIP_MEMORY_SCOPE_AGENT); }
__device__ __forceinline__ unsigned xb_add(unsigned* p, unsigned v) { return __hip_atomic_fetch_add(p, v, __ATOMIC_RELAXED, __HIP_MEMORY_SCOPE_AGENT); }
__device__ __forceinline__ unsigned xb_xcc_id() { return (unsigned)__builtin_amdgcn_s_getreg((3 << 11) | 20) & 0xFu; }
#define XB_SPIN(cond, bar) do { unsigned _sp = 0; while (cond) { __builtin_amdgcn_s_sleep(1); \
    if ((++_sp & 255u) == 0u) { if (xb_ld(&(bar)[XB_TMO])) break; if (_sp > XB_SPIN_CAP) { atomicAdd(&(bar)[XB_TMO], 1u); break; } } } } while (0)
struct XcdBarrier { unsigned* bar; unsigned x; volatile LAS unsigned* st; };
__device__ __forceinline__ XcdBarrier xcd_barrier_post(unsigned* bar, volatile LAS unsigned* st) {
    XcdBarrier b; b.bar = bar; b.x = xb_xcc_id(); b.st = st;
    if (threadIdx.x == 0) (void)xb_add(&bar[XB_XCNT(b.x)], 1u);
    return b;
}
__device__ __forceinline__ void xcd_barrier_complete(unsigned* bar, unsigned x, unsigned& nloc, unsigned& nx) {
    const unsigned G = gridDim.x * gridDim.y * gridDim.z;
    unsigned sum, cnt, mine, sp = 0u;
    for (;;) {
        sum = 0u; cnt = 0u; mine = 0u;
#pragma unroll
        for (unsigned j = 0; j < 16; ++j) { const unsigned c = xb_ld(&bar[XB_XCNT(j)]); sum += c; cnt += (c > 0u) ? 1u : 0u; mine = (j == x) ? c : mine; }
        if (sum == G) break;
        __builtin_amdgcn_s_sleep(1);
        if ((++sp & 255u) == 0u) { if (xb_ld(&bar[XB_TMO])) break; if (sp > XB_SPIN_CAP) { atomicAdd(&bar[XB_TMO], 1u); break; } }
    }
    nloc = mine > 0u ? mine : 1u; nx = cnt > 0u ? cnt : 1u;
}
__device__ __forceinline__ void xcd_barrier(const XcdBarrier& b) {
    asm volatile("s_waitcnt vmcnt(0)" ::: "memory");
    __syncthreads();
    if (threadIdx.x == 0) {
        GAS unsigned* barg_ = (GAS unsigned*)b.bar; asm volatile("" : "+s"(barg_)); unsigned* bar = (unsigned*)barg_;
        __builtin_amdgcn_s_waitcnt(0);
        unsigned nloc = b.st[0], nx = b.st[1];
        if (nloc == 0u) { xcd_barrier_complete(bar, b.x, nloc, nx); b.st[0] = nloc; b.st[1] = nx; }
        const unsigned old = xb_add(&bar[XB_XSUB(b.x)], 1u);
        const unsigned gen = old / nloc;
        if (old + 1u == (gen + 1u) * nloc) {
            __builtin_amdgcn_fence(__ATOMIC_RELEASE, "agent");
            asm volatile("s_waitcnt vmcnt(0)" ::: "memory");
            const unsigned og = xb_add(&bar[XB_TOP], 1u);
            const unsigned tg = og / nx;
            if (og + 1u == (tg + 1u) * nx) xb_add(&bar[XB_TOPGEN], 1u);
            else XB_SPIN(xb_ld(&bar[XB_TOPGEN]) == tg, bar);
            __builtin_amdgcn_fence(__ATOMIC_ACQUIRE, "agent");
            xb_add(&bar[XB_XGEN(b.x)], 1u);
            asm volatile("s_waitcnt vmcnt(0)" ::: "memory");
        } else {
            XB_SPIN(xb_ld(&bar[XB_XGEN(b.x)]) == gen, bar);
            __builtin_amdgcn_fence(__ATOMIC_ACQUIRE, "agent");
            asm volatile("s_waitcnt vmcnt(0)" ::: "memory");
        }
    }
    __syncthreads();
}

struct Args { const float* in[28]; float* out; unsigned char* ws; int ph_lo, ph_hi; };
enum { I_X = 0, I_C, I_CTX, I_CCTX, I_WADA, I_BADA, I_N1W, I_WIN, I_DALAM, I_SUBW, I_CONVW, I_CONVB, I_ALOG, I_DTB, I_SSDD, I_SSDNW, I_GKUP, I_GKB, I_GLANW, I_WOUT, I_N2W,
       I_WR, I_BR, I_WGU, I_BGU, I_WDN, I_BDN, I_FNW };

__device__ __forceinline__ void transpose_item(const float* __restrict__ W, int K, int Nsrc, bf16_t* __restrict__ WT, int n0, int dst_row0, int k0, unsigned* scr, int lane) {
    const bool ok = (n0 + lane) < Nsrc; const float* src = W + (size_t)k0 * Nsrc + n0 + lane;
#pragma unroll
    for (int hb = 0; hb < 2; ++hb) { float v[32];
#pragma unroll
        for (int i = 0; i < 32; ++i) v[i] = ok ? __builtin_nontemporal_load(src + (size_t)(hb * 32 + i) * Nsrc) : 0.f;
#pragma unroll
        for (int i = 0; i < 16; ++i) scr[lane * 33 + hb * 16 + i] = pk2(v[2 * i], v[2 * i + 1]); }
    LDS_WAIT();
    const int c = lane & 7;
#pragma unroll
    for (int j = 0; j < 8; ++j) { const int nn = (lane >> 3) + 8 * j; const unsigned* t = scr + nn * 33 + 4 * c;
        u32x4 o; o.x = t[0]; o.y = t[1]; o.z = t[2]; o.w = t[3];
        __builtin_nontemporal_store(o, (u32x4*)(WT + (size_t)(dst_row0 + nn) * K + k0 + 8 * c)); }
    LDS_WAIT();
}

__device__ __forceinline__ void norm_mod_store(const f32x4 (&v)[4], const float* __restrict__ nw, const float* __restrict__ sh, const float* __restrict__ sc, bf16_t* __restrict__ orow, int lane) {
    float ss = 0.f;
#pragma unroll
    for (int j = 0; j < 4; ++j) ss += (v[j].x * v[j].x + v[j].y * v[j].y) + (v[j].z * v[j].z + v[j].w * v[j].w);
    const float r = rsqrtf(wave_sum(ss) * (1.0f / DM) + EPS);
#pragma unroll
    for (int j = 0; j < 4; ++j) { const int c = 4 * lane + 256 * j;
        const f32x4 w = *(const f32x4*)(nw + c), a = *(const f32x4*)(sc + c), b = *(const f32x4*)(sh + c);
        const f32x4 y = (v[j] * r) * w * (a + 1.0f) + b;
        u32x2 o; o.x = pk2(y.x, y.y); o.y = pk2(y.z, y.w); *(u32x2*)(orow + c) = o; }
}

__device__ __forceinline__ int moe_tables(const unsigned* cnt, int* tile_e, int* pstart, int* cntl) {
    const int t = fresh_tid();
    if (t < NE) { int c = (int)cnt[t]; if (c > LISTCAP) c = LISTCAP; cntl[t] = c; }
    __syncthreads();
    if (t <= NE) { int acc = 0; for (int e = 0; e < t; ++e) acc += ((cntl[e] + 255) >> 8) << 8; pstart[t] = acc;
        if (t < NE) { const int nt = (cntl[t] + 255) >> 8; for (int q = 0; q < nt; ++q) tile_e[(acc >> 8) + q] = t; } }
    __syncthreads();
    return __builtin_amdgcn_readfirstlane(pstart[NE] >> 8);
}

__device__ __forceinline__ const float* inp_ptr(const unsigned char* ldsl, int i) {
    const unsigned long long v = ((const unsigned long long*)(ldsl + PTAB_OFF))[i];
    const unsigned lo = __builtin_amdgcn_readfirstlane((unsigned)v), hi = __builtin_amdgcn_readfirstlane((unsigned)(v >> 32));
    return (const float*)(const GAS float*)(((unsigned long long)hi << 32) | lo);
}

__device__ __forceinline__ void titem_load(f32x4 (&v)[16], const float* mbase, unsigned off, int pitchB, int lane) {
    const __amdgpu_buffer_rsrc_t rs = __builtin_amdgcn_make_buffer_rsrc((void*)mbase, 0, 0x7fffffff, 0x00020000);
    const int vo = (lane >> 4) * 2 * pitchB + (lane & 15) * 16;
#pragma unroll
    for (int i = 0; i < 16; ++i) v[i] = __builtin_bit_cast(f32x4, __builtin_amdgcn_raw_buffer_load_b128(rs, vo, (int)off + ((i >> 1) * 8 + (i & 1)) * pitchB, 2));
}
__device__ __forceinline__ void titem_store(const f32x4 (&v)[16], bf16_t* __restrict__ dst, unsigned* scr, int lane) {
    { unsigned* wp = scr + (lane & 15) * 4 * 33 + (lane >> 4);
#pragma unroll
      for (int i = 0; i < 8; ++i)
#pragma unroll
          for (int nn = 0; nn < 4; ++nn) wp[nn * 33 + 4 * i] = pk2(v[2 * i][nn], v[2 * i + 1][nn]); }
    LDS_WAIT();
    const int c = lane & 7;
#pragma unroll
    for (int j = 0; j < 8; ++j) { const int nn = (lane >> 3) + 8 * j; const unsigned* t = scr + nn * 33 + 4 * c;
        u32x4 o; o.x = t[0]; o.y = t[1]; o.z = t[2]; o.w = t[3];
        __builtin_nontemporal_store(o, (u32x4*)(dst + (size_t)nn * DM + 8 * c)); }
    LDS_WAIT();
}
__device__ __forceinline__ void moe_item(int it, int l, const float* wgu, const float* wdn, bf16_t* bgu, bf16_t* bdn, const float*& mbase, unsigned& off, int& pitchB, bf16_t*& dst) {
    constexpr int I_GU = 16 * 32, I_DN = 16 * 16, N_GU = 32 * I_GU;
    if (it < N_GU) { const int e = it / I_GU, r = it % I_GU, kb = r / 32, n0 = (r % 32) * 64;
        const int drow = n0 < 1024 ? (n0 >> 7) * 256 + (n0 & 127) : ((n0 - 1024) >> 7) * 256 + 128 + ((n0 - 1024) & 127);
        mbase = wgu + (size_t)l * NE * DM * 2048; off = (unsigned)((e * DM + kb * 64) * 2048 + n0) * 4u; pitchB = 2048 * 4;
        dst = bgu + (size_t)(l * NE + e) * 2048 * DM + (size_t)drow * DM + kb * 64; }
    else { const int q = it - N_GU, e = q / I_DN, r = q % I_DN, kb = r / 16, n0 = (r % 16) * 64;
        mbase = wdn + (size_t)l * NE * DE * DM; off = (unsigned)((e * DE + kb * 64) * DM + n0) * 4u; pitchB = DM * 4;
        dst = bdn + (size_t)(l * NE + e) * DM * DE + (size_t)n0 * DE + kb * 64; }
}

__device__ __forceinline__ void ctx_outproj_block(const bf16_t* __restrict__ mixc, const bf16_t* __restrict__ wout, const float* __restrict__ base, bf16_t* __restrict__ out,
                                                  const float* __restrict__ gate, int blk, unsigned char* lds) {
    const int tid = fresh_tid(), lane = tid & 63, wave = __builtin_amdgcn_readfirstlane(tid >> 6), r32 = lane & 31, hi = lane >> 5;
    const int rb = blk >> 4, cb = blk & 15;
    const bf16_t* Ap = mixc + (size_t)(rb * 32 + r32) * DM + wave * 128 + 8 * hi;
    const bf16_t* Bp = wout + (size_t)(cb * 64 + r32) * DM + wave * 128 + 8 * hi;
    bf16x8 af[8], b0f[8], b1f[8];
#pragma unroll
    for (int ks = 0; ks < 8; ++ks) { af[ks] = *(const bf16x8*)(Ap + ks * 16); b0f[ks] = *(const bf16x8*)(Bp + ks * 16); b1f[ks] = *(const bf16x8*)(Bp + (size_t)32 * DM + ks * 16); }
    f32x16 a0 = {}, a1 = {};
#pragma unroll
    for (int ks = 0; ks < 8; ++ks) { a0 = __builtin_amdgcn_mfma_f32_32x32x16_bf16(af[ks], b0f[ks], a0, 0, 0, 0); a1 = __builtin_amdgcn_mfma_f32_32x32x16_bf16(af[ks], b1f[ks], a1, 0, 0, 0); }
    float* red = (float*)lds;
#pragma unroll
    for (int r = 0; r < 16; ++r) { red[((wave * 2 + 0) * 16 + r) * 64 + lane] = a0[r]; red[((wave * 2 + 1) * 16 + r) * 64 + lane] = a1[r]; }
    __syncthreads();
#pragma unroll
    for (int q = 0; q < 4; ++q) { const int idx = tid + 512 * q, t = idx >> 10, r = (idx >> 6) & 15, ln = idx & 63; float sum = 0.f;
#pragma unroll
        for (int w = 0; w < 8; ++w) sum += red[((w * 2 + t) * 16 + r) * 64 + ln];
        const int row = rb * 32 + (r & 3) + 8 * (r >> 2) + 4 * (ln >> 5), col = cb * 64 + t * 32 + (ln & 31);
        out[(size_t)row * DM + col] = (bf16_t)f2bf(base[(size_t)row * DM + col] + gate[col] * sum); }
    __syncthreads();
}

#ifndef GSPLIT
#define GSPLIT 144
#endif
constexpr int PH_PRO = 0, PH_NORM0 = 1, PH_L0 = 2, NPH_LAYER = 9, NPH = PH_L0 + NLAYER * NPH_LAYER;

__global__ void __launch_bounds__(NWAVES * 64, 2) fwd(Args args) {
    extern __shared__ __attribute__((aligned(16))) unsigned char lds[];
    const int G = gridDim.x, bx = blockIdx.x;
    const int vcu = (G % 8 == 0) ? (bx % 8) * (G / 8) + bx / 8 : bx;
    const int NGW = G * NWAVES;
#define PH_TID() const int tid = fresh_tid(), lane = tid & 63, wave = __builtin_amdgcn_readfirstlane(tid >> 6), gw = vcu * NWAVES + wave; (void)lane; (void)wave; (void)gw; \
    GAS unsigned char* wsg_ = (GAS unsigned char*)ws0; asm volatile("" : "+s"(wsg_)); unsigned char* ws = (unsigned char*)wsg_; \
    LAS const unsigned char* ldl_ = (LAS const unsigned char*)lds; asm volatile("" : "+v"(ldl_)); const unsigned char* ldsl = (const unsigned char*)ldl_
    unsigned char* const ws0 = args.ws;
#define G_ctl   ((unsigned*)(ws + WS_CTL))
#define G_modb  ((float*)(ws + WS_MOD))
#define G_ropet ((f32x2*)(ws + WS_ROPE))
#define G_scal  ((float*)(ws + WS_SCAL))
#define G_wb_in ((bf16_t*)(ws + WS_WIN))
#define G_wb_out ((bf16_t*)(ws + WS_WOUT))
#define G_wb_gu ((bf16_t*)(ws + WS_WGU))
#define G_wb_dn ((bf16_t*)(ws + WS_WDN))
#define G_hbuf  ((bf16_t*)(ws + WS_H))
#define G_proj  ((bf16_t*)(ws + WS_PROJ))
#define G_xbcs  ((bf16_t*)(ws + WS_XBC))
#define G_dtv   ((float*)(ws + WS_DT))
#define G_av    ((float*)(ws + WS_AV))
#define G_gkv   ((float*)(ws + WS_GKV))
#define G_ydir  ((bf16_t*)(ws + WS_YDIR))
#define G_odir  ((bf16_t*)(ws + WS_ODIR))
#define G_mix   ((bf16_t*)(ws + WS_MIX))
#define G_xw    ((bf16_t*)(ws + WS_XW))
#define G_list  ((int*)(ws + WS_LIST))
#define G_gatev ((float*)(ws + WS_GATE))
#define G_actb  ((bf16_t*)(ws + WS_ACT))
#define G_yk    ((bf16_t*)(ws + WS_YK))

    volatile LAS unsigned* MISC = (volatile LAS unsigned*)((LAS unsigned char*)lds + MISC_OFF);
    for (int u = threadIdx.x; u < 64; u += NWAVES * 64) MISC[u] = 0u;
    if (threadIdx.x < 28) ((const float**)(lds + PTAB_OFF))[threadIdx.x] = args.in[threadIdx.x];
#define INP(i) inp_ptr(ldsl, (i))
    __syncthreads();
    const int lo = args.ph_lo, hi = args.ph_hi;
    XcdBarrier bar; bar.bar = (unsigned*)(ws0 + WS_CTL) + CW_BAR; bar.x = 0; bar.st = nullptr;
    if (hi - lo > 1) bar = xcd_barrier_post((unsigned*)(ws0 + WS_CTL) + CW_BAR, MISC + 8);
#ifndef PH_MASK
#define PH_MASK 0xFFF
#endif
#define KIND(k) ((k) < PH_L0 ? (k) : 2 + ((k) - PH_L0) % NPH_LAYER)
#define IN(k) (lo <= (k) && (k) < hi)
#define INK(k, kind) (((PH_MASK >> (kind)) & 1) && IN(k))
#ifndef DUP_MASK
#define DUP_MASK 0
#endif
#define REPS(kind) for (int rep_ = 0; rep_ < 1 + ((DUP_MASK >> (kind)) & 1); ++rep_)
#ifndef BAR_REPS
#define BAR_REPS 1
#endif
#define SEAM(k) do { if (IN(k) && IN((k) + 1)) for (int br_ = 0; br_ < BAR_REPS; ++br_) xcd_barrier(bar); } while (0)

    if (INK(PH_PRO, 0)) REPS(0) { PH_TID();
        unsigned* scr = (unsigned*)(lds + RING_OFF + wave * 16384);
        constexpr int I_IN = 16 * 52, I_OUT = 16 * 16;
        constexpr int N_IN = 2 * I_IN, N_OUT = 2 * I_OUT, NITEMS = N_IN + N_OUT;
        for (int it = gw; it < NITEMS; it += NGW) {
            int r = it;
            if (r < N_IN) { const int l = r / I_IN; r %= I_IN; const int kb = r / 52, nb = r % 52;
                transpose_item(INP(I_WIN) + (size_t)l * DM * INW, DM, INW, G_wb_in + (size_t)l * INWP * DM, nb * 64, nb * 64, kb * 64, scr, lane); continue; }
            r -= N_IN;
            { const int l = r / I_OUT; r %= I_OUT; const int kb = r / 16, nb = r % 16;
                transpose_item(INP(I_WOUT) + (size_t)l * DM * DM, DM, DM, G_wb_out + (size_t)l * DM * DM, nb * 64, nb * 64, kb * 64, scr, lane); }
        }
        __syncthreads();
        for (int it = bx; it < 48; it += G) {
            const int l = it / 24, j0 = (it % 24) * 256;
            float* sc = (float*)(lds + RING_OFF);
            float* red = sc + 3072;
            for (int i = tid; i < 3072; i += 512) { const int v = i >> 10, k = i & 1023; const float cv = v < 2 ? INP(I_C)[v * DM + k] : INP(I_CCTX)[k]; sc[i] = siluf(cv); }
            __syncthreads();
            const int ks = tid >> 6;
            f32x4 a0 = {0.f, 0.f, 0.f, 0.f}, a1 = a0, a2 = a0;
            const float* wp = INP(I_WADA) + (size_t)l * DM * 6144 + j0 + 4 * lane;
            for (int k = ks * 128; k < ks * 128 + 128; ++k) { const f32x4 w = *(const f32x4*)(wp + (size_t)k * 6144); a0 += w * sc[k]; a1 += w * sc[1024 + k]; a2 += w * sc[2048 + k]; }
            *(f32x4*)(red + (ks * 3 + 0) * 256 + 4 * lane) = a0; *(f32x4*)(red + (ks * 3 + 1) * 256 + 4 * lane) = a1; *(f32x4*)(red + (ks * 3 + 2) * 256 + 4 * lane) = a2;
            __syncthreads();
            for (int i = tid; i < 768; i += 512) { const int v = i >> 8, jj = i & 255; float s = INP(I_BADA)[l * 6144 + j0 + jj];
                for (int q = 0; q < 8; ++q) s += red[(q * 3 + v) * 256 + jj];
                G_modb[(size_t)(l * 3 + v) * 6144 + j0 + jj] = s; }
            __syncthreads();
        }
        if (bx == (50 % G) || bx == (51 % G)) { const int l = bx == (50 % G) ? 0 : 1; float* wrt = (float*)(ws + WS_WRT) + l * 32768; const float* wr = INP(I_WR) + (size_t)l * 32768;
            for (int i = tid; i < 32768; i += 512) wrt[(i & 31) * 1024 + (i >> 5)] = wr[i]; }
        if (bx == (48 % G)) {
            for (int i = tid; i < 2048; i += 512) { const int pos = i >> 4, j = i & 15; const float inv = exp2f(-0.25f * (float)j * 3.3219280948873623f);
                const float ang = (float)pos * inv; G_ropet[i] = (f32x2){cosf(ang), sinf(ang)}; }
        }
        if (bx == (49 % G) && tid < NLAYER) {
            const float* lp = INP(I_DALAM) + tid * 256; float s01 = 0.f, s23 = 0.f;
            for (int i = 0; i < 64; ++i) { s01 += lp[i] * lp[64 + i]; s23 += lp[128 + i] * lp[192 + i]; }
            const float li = 0.8f - 0.6f * expf(-0.3f * (float)tid);
            G_scal[tid * 2 + 0] = expf(s01) - expf(s23) + li; G_scal[tid * 2 + 1] = 1.0f - li;
        }
    }
    SEAM(PH_PRO);
    if (INK(PH_NORM0, 1)) { PH_TID();
        for (int row = gw; row < TALL; row += NGW) {
            const int bidx = row < SEQ ? 0 : (row < TLAT ? 1 : 2);
            const float* xr = row < TLAT ? INP(I_X) + (size_t)row * DM : INP(I_CTX) + (size_t)(row - TLAT) * DM;
            f32x4 v[4];
#pragma unroll
            for (int j = 0; j < 4; ++j) v[j] = *(const f32x4*)(xr + 4 * lane + 256 * j);
            const float* mp = G_modb + (size_t)bidx * 6144;
            norm_mod_store(v, INP(I_N1W), mp, mp + 1024, G_hbuf + (size_t)row * DM, lane);
        }
    }
    SEAM(PH_NORM0);

    for (int l = 0; l < NLAYER; ++l) {
        const int P = PH_L0 + l * NPH_LAYER;
        const bool last = (l == NLAYER - 1);
#define modl (G_modb + (size_t)l * 3 * 6144)
        if (INK(P + 0, 2)) REPS(2) { PH_TID();
            int bxp = bx; asm volatile("" : "+s"(bxp));
            const bool split = G > GSPLIT; const int Gg = split ? GSPLIT : G;
            if (bxp < Gg) {
            pg8::Gemm g{G_hbuf, G_wb_in + (size_t)l * INWP * DM, TALL, INWP, DM, 0};
            pg8::StaticOrder S; S.init(TALL, INWP, Gg, bxp);
            pg8::EpiBf16 E{G_proj, INWP, (const float*)G_ropet, TLAT / 256};
            pg8::gemm_phase<pg8::EpiBf16, pg8::StaticOrder, true, true>((LAS unsigned char*)lds + RING_OFF, g, S, E);
            }
            if (bxp >= Gg || !split) {
                const int lane = fresh_tid() & 63;
                unsigned* scr = (unsigned*)(lds + RING_OFF + wave * 16384);
                constexpr int NIT = 32 * (16 * 32 + 16 * 16);
                const int ncw = (split ? G - GSPLIT : G) * NWAVES; int it = (split ? bxp - GSPLIT : bxp) * NWAVES + wave;
                const float* wgu = INP(I_WGU); const float* wdn = INP(I_WDN);
                if (it < NIT) {
                    f32x4 va[16], vb[16]; const float* mb; unsigned off; int pb; bf16_t* da; bf16_t* db;
                    moe_item(it, l, wgu, wdn, G_wb_gu, G_wb_dn, mb, off, pb, da); titem_load(va, mb, off, pb, lane);
                    for (;;) {
                        int nx = it + ncw;
                        moe_item(nx < NIT ? nx : NIT - 1, l, wgu, wdn, G_wb_gu, G_wb_dn, mb, off, pb, db); titem_load(vb, mb, off, pb, lane);
                        titem_store(va, da, scr, lane);
                        if (nx >= NIT) break;
                        it = nx; nx = it + ncw;
                        moe_item(nx < NIT ? nx : NIT - 1, l, wgu, wdn, G_wb_gu, G_wb_dn, mb, off, pb, da); titem_load(va, mb, off, pb, lane);
                        titem_store(vb, db, scr, lane);
                        if (nx >= NIT) break;
                        it = nx;
                    }
                }
            }
        }
        SEAM(P + 0);
#define CP_INIT()         ck::P cp; \
        cp.proj = G_proj; cp.xbcs = G_xbcs; cp.dtv = G_dtv; cp.cumv = G_av; cp.gkv = G_gkv; cp.ssd_st = G_ydir; cp.gla_st = G_odir; cp.cds = (float*)(ws + WS_CDS); cp.cdg = (float*)(ws + WS_CDG); cp.mix = G_mix; cp.ropet = G_ropet; \
        cp.convw = INP(I_CONVW) + l * 3 * 512; cp.convb = INP(I_CONVB) + l * 512; cp.dtb = INP(I_DTB) + l * 8; cp.alog = INP(I_ALOG) + l * 8; \
        cp.gkup = INP(I_GKUP) + (size_t)l * 2 * 16 * 128; cp.gkb = INP(I_GKB) + l * 2 * 128; cp.ssdd = INP(I_SSDD) + l * 4; cp.ssdnw = INP(I_SSDNW) + l * 256; cp.glanw = INP(I_GLANW) + l * 64; cp.kmax2 = G_ctl + CW_KMAX + l * 16; cp.hins = (bf16_t*)(ws + WS_HINS); cp.hing = (bf16_t*)(ws + WS_HING);
        if (INK(P + 1, 3)) REPS(3) { PH_TID(); CP_INIT();
            for (int ui = 0; ui < 2; ++ui) { int ch, sect;
                if (ui == 0) { if (bx >= TLAT / 64) continue; ch = bx; sect = 14; }
                else { if ((bx & 7) != 4 || (bx >> 3) >= 24) continue; const int u = bx >> 3; ch = TLAT / 64 + u / 3; sect = 2 << (u % 3); }
#ifndef PREP_DUP_SECT
#define PREP_DUP_SECT 15
#endif
                ck::prep_chunk(cp, ch, lds + RING_OFF, rep_ > 0 ? (sect & PREP_DUP_SECT) : sect, rep_ > 0); }
        }
        SEAM(P + 1);
        if (INK(P + 2, 4)) { PH_TID(); CP_INIT();
            for (int vb = bx; vb < 256; vb += G) ck::scan_phase(cp, vb);
        }
        SEAM(P + 2);
        if (INK(P + 3, 5)) REPS(5) { PH_TID(); CP_INIT();
            const float lam = __uint_as_float(__builtin_amdgcn_readfirstlane(__float_as_uint(G_scal[l * 2 + 0]))), osc = __uint_as_float(__builtin_amdgcn_readfirstlane(__float_as_uint(G_scal[l * 2 + 1])));
            const float* subw = INP(I_SUBW) + l * 128;
#ifndef ATT_DUP_PART
#define ATT_DUP_PART 3
#endif
#ifndef NO_ATT
            if (rep_ == 0 || (ATT_DUP_PART & 1)) for (int i = 0; i < 3; ++i) {
                int bh, qrow0, nkeys;
                if (i < 2) { bh = bx & 7; const int qb = i * 32 + (bx >> 3); qrow0 = (bh >> 2) * SEQ + qb * 128; nkeys = LCTX + SEQ; if ((bx >> 3) >= 32) continue; }
                else { if (last || (bx & 15) != 2 || (bx >> 4) >= 16) continue; const int u = bx >> 4; bh = u >> 1; qrow0 = TLAT + (bh >> 2) * LCTX + (u & 1) * 128; nkeys = LCTX; }
                att::attn_unit(G_proj, G_mix, subw, lam, osc, G_ctl + CW_KMAX + l * 16 + (bh >> 2) * 8, bh >> 2, bh & 3, qrow0, nkeys, (char*)lds + RING_OFF);
            }
#endif
#ifndef NO_FIN
            if (rep_ == 0 || (ATT_DUP_PART & 2)) for (int ui = 0; ui < 2; ++ui) { int ch, sect;
                if (ui == 0) { if (bx >= TLAT / 64) continue; ch = bx; sect = 15; }
                else { if (last || (bx & 7) != 4) continue; const int u = bx >> 3; ch = TLAT / 64 + (u >> 2); sect = 1 << (u & 3); }
                ck::finish_chunk(cp, ch, lds + RING_OFF, sect); }
#endif
        }
        SEAM(P + 3);
        if (INK(P + 4, 6)) REPS(6) { PH_TID();
            const int M = TLAT;
            pg8::Gemm g{G_mix, G_wb_out + (size_t)l * DM * DM, M, DM, DM, 0};
            pg8::StaticOrder S; S.init(M, DM, G, bx);
            pg8::EpiRes E{INP(I_X), INP(I_CTX), l == 0 ? (const bf16_t*)nullptr : (const bf16_t*)G_xw, G_xw, modl + 2 * 1024, 6144};
            pg8::gemm_phase<pg8::EpiRes, pg8::StaticOrder, true, true>((LAS unsigned char*)lds + RING_OFF, g, S, E);
            if (!last && bx < 256) ctx_outproj_block(G_mix + (size_t)TLAT * DM, G_wb_out + (size_t)l * DM * DM, INP(I_CTX), G_xw + (size_t)TLAT * DM, modl + 2 * 6144 + 2 * 1024, bx, lds + RING_OFF);
        }
        SEAM(P + 4);
        if (INK(P + 5, 7)) REPS(7) { PH_TID(); const bool dry = rep_ > 0;
            const int ntok = last ? TLAT : TALL, TPW = ntok / G;
            float* wT = (float*)(lds + RING_OFF);
            int* selE = (int*)(lds + RT_OFF); int* selP = selE + 272; int* lcnt = selP + 272; int* basep = lcnt + 32;
            { const float* wrt = (const float*)(ws + WS_WRT) + l * 32768;
              for (int i = tid; i < 8192; i += 512) *(f32x4*)(wT + 4 * i) = *(const f32x4*)(wrt + 4 * i); }
            if (tid < 32 && !dry) lcnt[tid] = 0;
            __syncthreads();
            const int tok0 = bx * TPW;
            const float* n2w = INP(I_N2W) + l * DM;
            if (TPW * G == ntok && TPW <= 68 && (TPW & 1) == 0) {
            float* wsc = (float*)(lds + RT_OFF + 2560) + wave * 80;
            const float brl = INP(I_BR)[l * NE + (lane >> 1)];
            u32x2 rawn[2][4];
#pragma unroll
            for (int t = 0; t < 2; ++t)
#pragma unroll
                for (int j = 0; j < 4; ++j) rawn[t][j] = *(const u32x2*)(G_xw + (size_t)(tok0 + wave * 2 + t) * DM + 4 * lane + 256 * j);
            for (int tl = wave * 2; tl < TPW; tl += 2 * NWAVES) {
                const int row0 = tok0 + tl;
                f32x4 v[2][4]; float ss[2] = {0.f, 0.f};
#pragma unroll
                for (int t = 0; t < 2; ++t)
#pragma unroll
                    for (int j = 0; j < 4; ++j) { const u32x2 w = rawn[t][j];
                        v[t][j] = (f32x4){__uint_as_float(w.x << 16), __uint_as_float(w.x & 0xffff0000u), __uint_as_float(w.y << 16), __uint_as_float(w.y & 0xffff0000u)};
                        ss[t] += (v[t][j].x * v[t][j].x + v[t][j].y * v[t][j].y) + (v[t][j].z * v[t][j].z + v[t][j].w * v[t][j].w); }
                { ss[0] = wave_sum(ss[0]); ss[1] = wave_sum(ss[1]); }
                { f32x4 wn[4];
#pragma unroll
                  for (int j = 0; j < 4; ++j) wn[j] = *(const f32x4*)(n2w + 4 * lane + 256 * j);
#pragma unroll
                  for (int t = 0; t < 2; ++t) { const int row = row0 + t, bidx = row < SEQ ? 0 : (row < TLAT ? 1 : 2); const float* mp = modl + (size_t)bidx * 6144;
                    const float r = rsqrtf(ss[t] * (1.0f / DM) + EPS);
                    f32x4 ma[4], mb[4];
#pragma unroll
                    for (int j = 0; j < 4; ++j) { const int c = 4 * lane + 256 * j; ma[j] = *(const f32x4*)(mp + 4 * 1024 + c); mb[j] = *(const f32x4*)(mp + 3 * 1024 + c); }
                    __builtin_amdgcn_sched_barrier(0);
#pragma unroll
                    for (int j = 0; j < 4; ++j) { const int c = 4 * lane + 256 * j;
                        v[t][j] = (v[t][j] * r) * wn[j] * (ma[j] + 1.0f) + mb[j];
                        u32x2 o; o.x = pk2(v[t][j].x, v[t][j].y); o.y = pk2(v[t][j].z, v[t][j].w); *(u32x2*)(G_hbuf + (size_t)row * DM + c) = o; } } }
                if (tl + 2 * NWAVES < TPW) {
#pragma unroll
                    for (int t = 0; t < 2; ++t)
#pragma unroll
                        for (int j = 0; j < 4; ++j) rawn[t][j] = *(const u32x2*)(G_xw + (size_t)(row0 + 2 * NWAVES + t) * DM + 4 * lane + 256 * j); }
                float pa[32], pb[32];
                { f32x2 vv[4][4];
#pragma unroll
                  for (int j = 0; j < 4; ++j) { vv[j][0] = (f32x2){v[0][j].x, v[1][j].x}; vv[j][1] = (f32x2){v[0][j].y, v[1][j].y}; vv[j][2] = (f32x2){v[0][j].z, v[1][j].z}; vv[j][3] = (f32x2){v[0][j].w, v[1][j].w}; }
                  f32x4 wb[2][8];
#pragma unroll
                  for (int q = 0; q < 8; ++q) wb[0][q] = *(const f32x4*)(wT + (q >> 2) * 1024 + 4 * lane + 256 * (q & 3));
#pragma unroll
                  for (int bt = 0; bt < 16; ++bt) {
                      if (bt + 1 < 16) {
#pragma unroll
                          for (int q = 0; q < 8; ++q) wb[(bt + 1) & 1][q] = *(const f32x4*)(wT + (2 * (bt + 1) + (q >> 2)) * 1024 + 4 * lane + 256 * (q & 3)); }
#pragma unroll
                      for (int ee = 0; ee < 2; ++ee) { f32x2 acc = {0.f, 0.f};
#pragma unroll
                          for (int j = 0; j < 4; ++j) { const f32x4 w = wb[bt & 1][ee * 4 + j];
                              acc = __builtin_elementwise_fma(vv[j][0], (f32x2){w.x, w.x}, acc); acc = __builtin_elementwise_fma(vv[j][1], (f32x2){w.y, w.y}, acc);
                              acc = __builtin_elementwise_fma(vv[j][2], (f32x2){w.z, w.z}, acc); acc = __builtin_elementwise_fma(vv[j][3], (f32x2){w.w, w.w}, acc); }
                          pa[2 * bt + ee] = acc.x; pb[2 * bt + ee] = acc.y; } } }
                float qa[16], qb[16], ra[8], rb[8], sa_[4], sb_[4], ta[2], tb[2];
#pragma unroll
                for (int i = 0; i < 16; ++i) { auto r0 = __builtin_amdgcn_permlane32_swap(__float_as_uint(pa[i]), __float_as_uint(pa[16 + i]), false, false);
                    auto r1 = __builtin_amdgcn_permlane32_swap(__float_as_uint(pb[i]), __float_as_uint(pb[16 + i]), false, false);
                    qa[i] = __uint_as_float(r0[0]) + __uint_as_float(r0[1]); qb[i] = __uint_as_float(r1[0]) + __uint_as_float(r1[1]); }
                { const bool up = (lane & 16) != 0;
#pragma unroll
                  for (int i = 0; i < 8; ++i) { const float s0 = up ? qa[i] : qa[8 + i], k0 = up ? qa[8 + i] : qa[i], s1 = up ? qb[i] : qb[8 + i], k1 = up ? qb[8 + i] : qb[i];
                      ra[i] = k0 + __shfl_xor(s0, 16); rb[i] = k1 + __shfl_xor(s1, 16); } }
                { const bool up = (lane & 8) != 0;
#pragma unroll
                  for (int i = 0; i < 4; ++i) { const float s0 = up ? ra[i] : ra[4 + i], k0 = up ? ra[4 + i] : ra[i], s1 = up ? rb[i] : rb[4 + i], k1 = up ? rb[4 + i] : rb[i];
                      sa_[i] = k0 + dpp_perm<0x128>(s0); sb_[i] = k1 + dpp_perm<0x128>(s1); } }
                { const bool up = (lane & 4) != 0;
#pragma unroll
                  for (int i = 0; i < 2; ++i) { const float s0 = up ? sa_[i] : sa_[2 + i], k0 = up ? sa_[2 + i] : sa_[i], s1 = up ? sb_[i] : sb_[2 + i], k1 = up ? sb_[2 + i] : sb_[i];
                      ta[i] = k0 + dpp_perm<0x1B>(dpp_perm<0x141>(s0)); tb[i] = k1 + dpp_perm<0x1B>(dpp_perm<0x141>(s1)); } }
                float la, lb;
                { const bool up = (lane & 2) != 0; const float s0 = up ? ta[0] : ta[1], k0 = up ? ta[1] : ta[0], s1 = up ? tb[0] : tb[1], k1 = up ? tb[1] : tb[0];
                  la = k0 + dpp_perm<0x4E>(s0); lb = k1 + dpp_perm<0x4E>(s1); }
                la += dpp_perm<0xB1>(la); lb += dpp_perm<0xB1>(lb);
                if ((lane & 1) == 0) { wsc[lane >> 1] = la + brl; wsc[32 + (lane >> 1)] = lb + brl; }
                LDS_WAIT();
                const int t = lane >> 5, e = lane & 31; const float* lg = wsc + t * 32; const float mine = lg[e]; int rank = 0;
#pragma unroll
                for (int q = 0; q < 8; ++q) { const f32x4 o4 = *(const f32x4*)(lg + 4 * q); const float ov[4] = {o4.x, o4.y, o4.z, o4.w};
#pragma unroll
                    for (int i = 0; i < 4; ++i) { const int j = 4 * q + i; rank += (ov[i] > mine || (ov[i] == mine && j < e)) ? 1 : 0; } }
                if (rank < 4) wsc[64 + t * 4 + rank] = mine;
                LDS_WAIT();
                if (rank < 4) { const f32x4 sv = *(const f32x4*)(wsc + 64 + t * 4);
                    const float e0 = __expf(sv.x - sv.x), e1 = __expf(sv.y - sv.x), e2 = __expf(sv.z - sv.x), e3 = __expf(sv.w - sv.x);
                    const float gk = __expf(mine - sv.x) / ((e0 + e1) + (e2 + e3));
                    const int lp = dry ? 0 : atomicAdd(&lcnt[e], 1);
                    if (!dry) { selE[(tl + t) * 4 + rank] = e; selP[(tl + t) * 4 + rank] = lp; } G_gatev[(size_t)(row0 + t) * 4 + rank] = gk; }
                LDS_WAIT();
            }
            }
            __syncthreads();
            if (tid < 32 && !dry) basep[tid] = (int)atomicAdd(&G_ctl[CW_CNT + l * 32 + tid], (unsigned)lcnt[tid]);
            __syncthreads();
            if (!dry) for (int i = tid; i < TPW * 4; i += 512) { const int e = selE[i]; const int pos = basep[e] + selP[i]; if (pos < LISTCAP) G_list[(size_t)e * LISTCAP + pos] = tok0 * 4 + i; }
        }
        SEAM(P + 5);
        if (INK(P + 6, 9)) REPS(9) { PH_TID();
            int* tile_e = (int*)(lds + TAB_OFF); int* pstart = tile_e + 304; int* cntl = pstart + 40;
            const int nrt = moe_tables(G_ctl + CW_CNT + l * 32, tile_e, pstart, cntl);
            pg8::Gemm g{G_hbuf, G_wb_gu + (size_t)l * NE * 2048 * DM, nrt * 256, 2048, DM, (size_t)2048 * DM * 2};
            pg8::MoeOrderT<true> S{(const LAS int*)((LAS unsigned char*)lds + TAB_OFF), (const LAS int*)((LAS unsigned char*)lds + TAB_OFF) + 304, (const LAS int*)((LAS unsigned char*)lds + TAB_OFF) + 344, G_list, nrt, 8, 3, G, vcu};
            pg8::EpiAct E{G_actb, INP(I_BGU) + (size_t)l * NE * 2048};
            pg8::gemm_phase<pg8::EpiAct, pg8::MoeOrderT<true>, true, true>((LAS unsigned char*)lds + RING_OFF, g, S, E);
        }
        SEAM(P + 6);
        if (INK(P + 7, 10)) REPS(10) { PH_TID();
            int* tile_e = (int*)(lds + TAB_OFF); int* pstart = tile_e + 304; int* cntl = pstart + 40;
            const int nrt = (IN(P + 6) && ((PH_MASK >> 9) & 1)) ? __builtin_amdgcn_readfirstlane(pstart[NE] >> 8) : moe_tables(G_ctl + CW_CNT + l * 32, tile_e, pstart, cntl);
            pg8::Gemm g{G_actb, G_wb_dn + (size_t)l * NE * DM * DE, nrt * 256, DM, DE, (size_t)DM * DE * 2};
            pg8::MoeOrderT<false> S{(const LAS int*)((LAS unsigned char*)lds + TAB_OFF), (const LAS int*)((LAS unsigned char*)lds + TAB_OFF) + 304, (const LAS int*)((LAS unsigned char*)lds + TAB_OFF) + 344, G_list, nrt, 4, 2, G, vcu};
            pg8::EpiDown E{G_yk, INP(I_BDN) + (size_t)l * NE * DM, &S, G_gatev};
            pg8::gemm_phase<pg8::EpiDown, pg8::MoeOrderT<false>, true, true>((LAS unsigned char*)lds + RING_OFF, g, S, E);
        }
        SEAM(P + 7);
        if (INK(P + 8, 11)) REPS(11) { PH_TID(); const bool dry = rep_ > 0;
            const int ntok = last ? TLAT : TALL;
            f32x4 nwv[4];
            { const float* nwp = last ? INP(I_FNW) : INP(I_N1W) + (l + 1) * DM;
#pragma unroll
              for (int q = 0; q < 4; ++q) nwv[q] = *(const f32x4*)(nwp + 8 * lane + 512 * (q >> 1) + 4 * (q & 1)); }
            for (int rowa = gw; rowa < ntok; rowa += 2 * NGW) {
                f32x4 v[2][4]; int rw[2]; bool ok[2];
#pragma unroll
                for (int t = 0; t < 2; ++t) { const int rr = rowa + t * NGW; ok[t] = rr < ntok; rw[t] = ok[t] ? rr : rowa; }
                u32x4 yv[2][2][4]; u32x4 xr[2][2];
#pragma unroll
                for (int t = 0; t < 2; ++t)
#pragma unroll
                    for (int jj = 0; jj < 2; ++jj) { const int c = 8 * lane + 512 * jj;
#pragma unroll
                        for (int k = 0; k < 4; ++k) yv[t][jj][k] = *(const u32x4*)(G_yk + ((size_t)rw[t] * 4 + k) * DM + c);
                        xr[t][jj] = *(const u32x4*)(G_xw + (size_t)rw[t] * DM + c); }
#pragma unroll
                for (int t = 0; t < 2; ++t) { const int row = rw[t], bidx = row < SEQ ? 0 : (row < TLAT ? 1 : 2); const float* mp = modl + (size_t)bidx * 6144;
                    const float* mn = G_modb + (size_t)((last ? l : l + 1) * 3 + bidx) * 6144;
                    f32x4 g2[4];
#pragma unroll
                    for (int q = 0; q < 4; ++q) g2[q] = *(const f32x4*)(mp + 5 * 1024 + 8 * lane + 512 * (q >> 1) + 4 * (q & 1));
                    __builtin_amdgcn_sched_barrier(0);
                    const float gsc = (dry && !last) ? 0.f : 1.f;
#pragma unroll
                    for (int jj = 0; jj < 2; ++jj) { const int c = 8 * lane + 512 * jj; float ff[8] = {0.f, 0.f, 0.f, 0.f, 0.f, 0.f, 0.f, 0.f};
#pragma unroll
                        for (int k = 0; k < 4; ++k) { float f8[8]; unpack8(yv[t][jj][k], f8);
#pragma unroll
                            for (int e = 0; e < 8; ++e) ff[e] += f8[e]; }
                        const f32x4 g2a = g2[jj * 2] * gsc, g2b = g2[jj * 2 + 1] * gsc;
                        float x8[8]; unpack8(xr[t][jj], x8);
                        v[t][jj * 2] = (f32x4){x8[0], x8[1], x8[2], x8[3]} + g2a * (f32x4){ff[0], ff[1], ff[2], ff[3]}; v[t][jj * 2 + 1] = (f32x4){x8[4], x8[5], x8[6], x8[7]} + g2b * (f32x4){ff[4], ff[5], ff[6], ff[7]};
                        if (!last && !dry && ok[t]) { const float o8[8] = {v[t][jj * 2].x, v[t][jj * 2].y, v[t][jj * 2].z, v[t][jj * 2].w, v[t][jj * 2 + 1].x, v[t][jj * 2 + 1].y, v[t][jj * 2 + 1].z, v[t][jj * 2 + 1].w};
                            *(u32x4*)(G_xw + (size_t)row * DM + c) = pack8(o8); } }
                    f32x4 ma[4], mb[4];
#pragma unroll
                    for (int q = 0; q < 4; ++q) { const int c = 8 * lane + 512 * (q >> 1) + 4 * (q & 1); ma[q] = *(const f32x4*)(mn + 1024 + c); mb[q] = *(const f32x4*)(mn + c); }
                    __builtin_amdgcn_sched_barrier(0);
                    float ss = 0.f;
#pragma unroll
                    for (int j = 0; j < 4; ++j) ss += (v[t][j].x * v[t][j].x + v[t][j].y * v[t][j].y) + (v[t][j].z * v[t][j].z + v[t][j].w * v[t][j].w);
                    const float r = rsqrtf(wave_sum(ss) * (1.0f / DM) + EPS);
                    if (ok[t]) {
                        if (!last) {
#pragma unroll
                            for (int jj = 0; jj < 2; ++jj) { const int c = 8 * lane + 512 * jj; float o8[8];
#pragma unroll
                                for (int hh = 0; hh < 2; ++hh) { const int q = jj * 2 + hh;
                                    const f32x4 y = (v[t][q] * r) * nwv[q] * (ma[q] + 1.0f) + mb[q]; o8[4 * hh] = y.x; o8[4 * hh + 1] = y.y; o8[4 * hh + 2] = y.z; o8[4 * hh + 3] = y.w; }
                                *(u32x4*)(G_hbuf + (size_t)row * DM + c) = pack8(o8); }
                        } else {
#pragma unroll
                            for (int jj = 0; jj < 2; ++jj) { const int c = 8 * lane + 512 * jj;
#pragma unroll
                                for (int hh = 0; hh < 2; ++hh) *(f32x4*)(args.out + (size_t)row * DM + c + 4 * hh) = (v[t][jj * 2 + hh] * r) * nwv[jj * 2 + hh]; }
                        }
                    }
                }
            }
        }
        SEAM(P + 8);
    }
#undef IN
#undef SEAM
}

extern "C" void kernel_launch(void* const* d_in, const int* in_sizes, int n_in, void* d_out, int out_size, void* d_ws, size_t ws_size, hipStream_t stream) {
    static int grid = 0;
    if (grid == 0) {
        if (n_in != 28 || out_size != TLAT * DM || ws_size < WS_END) { fprintf(stderr, "kernel_launch: unexpected shapes: n_in %d out %d ws %zu (need %zu)\n", n_in, out_size, ws_size, (size_t)WS_END); grid = -1; return; }
        int dev = 0, cus = 0, per_cu = 0;
        if (hipGetDevice(&dev) != hipSuccess || hipDeviceGetAttribute(&cus, hipDeviceAttributeMultiprocessorCount, dev) != hipSuccess) { grid = -1; return; }
        if (hipFuncSetAttribute((const void*)fwd, hipFuncAttributeMaxDynamicSharedMemorySize, LDS_BYTES) != hipSuccess) { fprintf(stderr, "kernel_launch: hipFuncSetAttribute failed\n"); grid = -1; return; }
        if (hipOccupancyMaxActiveBlocksPerMultiprocessor(&per_cu, (const void*)fwd, NWAVES * 64, LDS_BYTES) != hipSuccess || per_cu < 1) fprintf(stderr, "kernel_launch: occupancy query reports %d\n", per_cu);
        (void)hipGetLastError();
        grid = cus;
        if (grid != 256) fprintf(stderr, "kernel_launch: %d CUs (built for 256)\n", grid);
    }
    if (grid < 0) return;
    if (hipMemsetAsync((char*)d_ws + WS_CTL, 0, CTL_ZERO_BYTES, stream) != hipSuccess) return;
    Args a{};
    for (int i = 0; i < 28; ++i) a.in[i] = (const float*)d_in[i];
    a.out = (float*)d_out; a.ws = (unsigned char*)d_ws;
#if MK_N_LAUNCHES == 1
    a.ph_lo = 0; a.ph_hi = NPH;
    hipLaunchKernelGGL(fwd, dim3(grid), dim3(NWAVES * 64), LDS_BYTES, stream, a);
#else
    for (int p = 0; p < NPH; ++p) { a.ph_lo = p; a.ph_hi = p + 1; hipLaunchKernelGGL(fwd, dim3(grid), dim3(NWAVES * 64), LDS_BYTES, stream, a); }
#endif
    const hipError_t le = hipPeekAtLastError();
    if (le != hipSuccess) fprintf(stderr, "kernel_launch: launch failed: %s\n", hipGetErrorName(le));
}
```

```cpp
#include <hip/hip_runtime.h>
#include <cstdio>
#include <cstdint>

#ifndef MK_N_LAUNCHES
#define MK_N_LAUNCHES 1
#endif

#define GAS __attribute__((address_space(1)))
#define LAS __attribute__((address_space(3)))
typedef unsigned short bf16_t;
typedef short bf16x8 __attribute__((ext_vector_type(8)));
typedef short s16x4 __attribute__((ext_vector_type(4)));
typedef float f32x2 __attribute__((ext_vector_type(2)));
typedef float f32x4 __attribute__((ext_vector_type(4)));
typedef float f32x16 __attribute__((ext_vector_type(16)));
typedef unsigned u32x2 __attribute__((ext_vector_type(2)));
typedef unsigned u32x4 __attribute__((ext_vector_type(4)));

constexpr int DM = 1024, NB = 2, SEQ = 8192, LCTX = 256, NLAYER = 2;
constexpr int TLAT = NB * SEQ, TCTX = NB * LCTX, TALL = TLAT + TCTX;
constexpr int INW = 3112, INWP = 3328;
constexpr int C_Q = 0, C_K = 512, C_V = 1024, C_Z = 1536, C_XBC = 1792, C_DT = 2304, C_GQ = 2312, C_GK = 2440, C_GV = 2568, C_GG = 2824, C_CODE = 3080;
constexpr int NE = 32, DE = 1024;
constexpr int LISTCAP = TALL, MAXRT = 296, XB_ROWS = MAXRT * 256;
constexpr float EPS = 1e-6f;

constexpr size_t MiB = 1u << 20;
constexpr size_t WS_CTL = 0, CTL_ZERO_BYTES = 128 * 1024;
constexpr int CW_BAR = 4096, CW_CNT = 16384, CW_KMAX = 16384 + 64;
constexpr size_t WS_MOD = 1 * MiB, WS_ROPE = 1 * MiB + 256 * 1024, WS_SCAL = WS_ROPE + 16 * 1024, WS_CDS = WS_SCAL + 4096, WS_CDG = WS_SCAL + 32768, WS_WRT = WS_SCAL + 320 * 1024;
constexpr size_t WS_WIN = 2 * MiB, WS_WOUT = 15 * MiB, WS_WGU = 32 * MiB, WS_WDN = 288 * MiB;
constexpr size_t WS_H = 416 * MiB, WS_PROJ = 449 * MiB, WS_XBC = 557 * MiB, WS_DT = 574 * MiB, WS_AV = 575 * MiB, WS_GKV = 576 * MiB;
constexpr size_t WS_YDIR = 593 * MiB, WS_ODIR = 626 * MiB, WS_MIX = 659 * MiB, WS_XW = 692 * MiB, WS_LIST = 758 * MiB, WS_GATE = 761 * MiB, WS_RMAP = 762 * MiB;
constexpr size_t WS_HINS = 763 * MiB, WS_HING = 781 * MiB;
constexpr size_t WS_XB = 763 * MiB, WS_ACT = 911 * MiB, WS_YK = 1059 * MiB, WS_END = 1191 * MiB;

constexpr int RING_OFF = 0, RING_BYTES = 131072;
constexpr int MISC_OFF = RING_BYTES;
constexpr int TAB_OFF = RING_BYTES + 256;
constexpr int RT_OFF = RING_BYTES + 4096;
constexpr int LDS_BYTES = RING_BYTES + 12288;
constexpr int PTAB_OFF = LDS_BYTES - 256;
constexpr int NWAVES = 8;

__device__ __forceinline__ float bf2f(unsigned short b) { return __uint_as_float(((unsigned)b) << 16); }
typedef __bf16 bf16x2_t __attribute__((ext_vector_type(2)));
__device__ __forceinline__ unsigned pk2(float lo, float hi) { const f32x2 v = {lo, hi}; const bf16x2_t b = __builtin_convertvector(v, bf16x2_t); return __builtin_bit_cast(unsigned, b); }
__device__ __forceinline__ unsigned f2bf(float f) { return pk2(f, f) & 0xffffu; }
__device__ __forceinline__ float siluf(float x) { return x * __builtin_amdgcn_rcpf(1.0f + __expf(-x)); }
__device__ __forceinline__ float softplusf(float x) { return x > 20.f ? x : __logf(1.0f + __expf(x)); }
__device__ __forceinline__ float logsigmoidf(float x) { return fminf(x, 0.f) - __logf(1.0f + __expf(-fabsf(x))); }
template <int CTRL> __device__ __forceinline__ float dpp_perm(float x) {
    return __builtin_bit_cast(float, __builtin_amdgcn_mov_dpp(__builtin_bit_cast(int, x), CTRL, 0xf, 0xf, true)); }
template <int CTRL, int ROWMASK, bool BC> __device__ __forceinline__ float dpp_or0(float x) {
    return __builtin_bit_cast(float, __builtin_amdgcn_update_dpp(0, __builtin_bit_cast(int, x), CTRL, ROWMASK, 0xf, BC)); }
__device__ __forceinline__ float row16_allsum(float v) {
    v += dpp_perm<0xB1>(v); v += dpp_perm<0x4E>(v); v += dpp_perm<0x141>(v); v += dpp_perm<0x140>(v); return v; }
__device__ __forceinline__ float sum32(float v) {
    v = row16_allsum(v); const int iv = __builtin_bit_cast(int, v);
    const float s0 = __builtin_bit_cast(float, __builtin_amdgcn_readlane(iv, 0)), s1 = __builtin_bit_cast(float, __builtin_amdgcn_readlane(iv, 16));
    const float s2 = __builtin_bit_cast(float, __builtin_amdgcn_readlane(iv, 32)), s3 = __builtin_bit_cast(float, __builtin_amdgcn_readlane(iv, 48));
    return (threadIdx.x & 32) ? s2 + s3 : s0 + s1; }
__device__ __forceinline__ float wave_sum(float v) {
    v = row16_allsum(v); const int iv = __builtin_bit_cast(int, v);
    return (__builtin_bit_cast(float, __builtin_amdgcn_readlane(iv, 0)) + __builtin_bit_cast(float, __builtin_amdgcn_readlane(iv, 16))) +
           (__builtin_bit_cast(float, __builtin_amdgcn_readlane(iv, 32)) + __builtin_bit_cast(float, __builtin_amdgcn_readlane(iv, 48))); }
__device__ __forceinline__ float wave_scan(float x, int lane, bool rev) {
    float v = x;
    v += dpp_or0<0x111, 0xf, true>(v); v += dpp_or0<0x112, 0xf, true>(v); v += dpp_or0<0x114, 0xf, true>(v); v += dpp_or0<0x118, 0xf, true>(v);
    v += dpp_or0<0x142, 0xa, false>(v);
    v += dpp_or0<0x143, 0xc, false>(v);
    if (!rev) return v;
    const float tot = __builtin_bit_cast(float, __builtin_amdgcn_readlane(__builtin_bit_cast(int, v), 63));
    return (tot - v) + x;
}
__device__ __forceinline__ void unpack8(const u32x4 w, float (&f)[8]) {
    f[0] = __uint_as_float(w.x << 16); f[1] = __uint_as_float(w.x & 0xffff0000u); f[2] = __uint_as_float(w.y << 16); f[3] = __uint_as_float(w.y & 0xffff0000u);
    f[4] = __uint_as_float(w.z << 16); f[5] = __uint_as_float(w.z & 0xffff0000u); f[6] = __uint_as_float(w.w << 16); f[7] = __uint_as_float(w.w & 0xffff0000u);
}
__device__ __forceinline__ u32x4 pack8(const float (&f)[8]) { u32x4 w; w.x = pk2(f[0], f[1]); w.y = pk2(f[2], f[3]); w.z = pk2(f[4], f[5]); w.w = pk2(f[6], f[7]); return w; }
#define LDS_WAIT() asm volatile("s_waitcnt lgkmcnt(0)" ::: "memory")
#define LDS_BARRIER() asm volatile("s_waitcnt lgkmcnt(0)\n\ts_barrier" ::: "memory")
__device__ __forceinline__ int fresh_tid() { int t = threadIdx.x; asm volatile("" : "+v"(t)); return t; }

namespace pg8 {
#define PG8_LAS __attribute__((address_space(3)))
constexpr int BM = 256, BK = 64, HALF = 128, HTB = HALF * BK * 2, STAGE_BYTES = 8 * HTB, NXCD = 8, WGM = 8;
__host__ __device__ __forceinline__ int lds_byte(int r, int c) { const int st = (r >> 4) * 2 + (c >> 5), rr = r & 15, cc = c & 31, ob = rr * 64 + cc * 2; return st * 1024 + (ob ^ (((ob >> 9) & 1) << 5)); }
__host__ __device__ __forceinline__ void stage_rc(int b, int& R, int& C) { const int st = b / 1024, sb = b % 1024, swz = sb ^ (((sb >> 9) & 1) << 5); R = (st >> 1) * 16 + swz / 64; C = (st & 1) * 32 + (swz % 64) / 2; }
__host__ __device__ __forceinline__ int perm32(int rho) { const int n = rho >> 4, i = rho & 15; return 8 * (i >> 2) + 4 * n + (i & 3); }

struct Unit { int pm, pn, e; };
struct Gemm { const bf16_t* A; const bf16_t* Bt; int M, N, K; size_t estride; };

struct StaticOrder {
    static constexpr bool GATHER = false;
    int nM, nN, nwg, G, c;
    __host__ __device__ void init(int M, int N, int G_, int c_) { nM = M / BM; nN = N / BM; nwg = nM * nN; G = G_; c = c_; }
    __host__ __device__ bool next(int i, Unit& u) const {
        const long L = (long)i * G + c; if (L >= nwg) return false;
        int wgid = (int)L; { const int q = nwg / NXCD, r = nwg % NXCD, xcd = wgid % NXCD, off = wgid / NXCD; wgid = (xcd < r ? xcd * (q + 1) : r * (q + 1) + (xcd - r) * q) + off; }
        const int nig = WGM * nN, gid = wgid / nig, fm = gid * WGM, gsz = (nM - fm) < WGM ? (nM - fm) : WGM;
        u.pm = fm + ((wgid % nig) % gsz); u.pn = (wgid % nig) / gsz; u.e = 0; return true;
    }
    __device__ __forceinline__ const int* row_src(const Unit&, int) const { return nullptr; }
    __device__ __forceinline__ void a_ready(const Unit&) const {}
    __device__ __forceinline__ void done(const Unit&) const {}
};
template <bool GATHER_> struct MoeOrderT {
    static constexpr bool GATHER = GATHER_;
    const PG8_LAS int* tile_e; const PG8_LAS int* pstart; const PG8_LAS int* cntl; const int* list; int nrt, nN, lgN, G, cv;
    __device__ __forceinline__ bool next(int i, Unit& u) const {
        const int L = i * G + cv; if (L >= nrt * nN) return false;
        const int rt = L >> lgN; u.pm = rt; u.pn = L & (nN - 1); u.e = __builtin_amdgcn_readfirstlane(tile_e[rt]); return true;
    }
    __device__ __forceinline__ const int* row_src(const Unit& u, int r) const {
        const int ps = pstart[u.e], c = cntl[u.e]; int pos = u.pm * BM + r - ps; pos = pos < c ? pos : c - 1;
        return list + (size_t)u.e * LISTCAP + pos;
    }
    __device__ __forceinline__ int row_tok4(const Unit& u, int r) const {
        const int ps = pstart[u.e], c = cntl[u.e]; const int pos = u.pm * BM + r - ps;
        return pos < c ? list[(size_t)u.e * LISTCAP + pos] : -1;
    }
    __device__ __forceinline__ void a_ready(const Unit&) const {}
    __device__ __forceinline__ void done(const Unit&) const {}
};

__device__ __forceinline__ unsigned cvt_pk_bf16(float lo, float hi) { unsigned r; asm volatile("v_cvt_pk_bf16_f32 %0, %1, %2" : "=v"(r) : "v"(lo), "v"(hi)); return r; }

struct NoPre {};
struct EpiBf16 {
    static constexpr bool PERM = true, AFTER_DRAIN = false;
    typedef NoPre Pre; __device__ __forceinline__ void prefetch(Pre&, const Unit&, int, int, int, int) const {}
    bf16_t* O; int ldc;
    const float* ropet; int rope_pm;
    __device__ __forceinline__ void operator()(const f32x4 (&acc)[2][2][4][2], const Unit& u, int wr, int wc, int fr, int fq, const Pre&) const {
        const int row0 = u.pm * BM + wr * 64 + fr, col0 = u.pn * BM + wc * 32 + 8 * fq;
        if (ropet != nullptr && u.pn < 4 && u.pm < rope_pm) {
            const int t_ = fresh_tid(), fr_ = t_ & 15, fq_ = (t_ >> 4) & 3; const bool hiL = fq_ >= 2; const int half = wc & 1;
#pragma unroll
            for (int ai = 0; ai < 2; ++ai)
#pragma unroll
                for (int m = 0; m < 4; ++m) { const int row = u.pm * BM + wr * 64 + fr_ + ai * HALF + m * 16, sq = row & (SEQ - 1), pos = half ? (sq & 63) : (sq >> 6);
                    const f32x4* tp = (const f32x4*)(ropet + (size_t)(pos * 16 + 8 * (fq_ & 1)) * 2);
                    f32x4 cs[4];
#pragma unroll
                    for (int q = 0; q < 4; ++q) cs[q] = tp[q];
                    float A[8], B[8];
#pragma unroll
                    for (int i = 0; i < 8; ++i) { const float c = cs[i >> 1][(i & 1) * 2], sn = cs[i >> 1][(i & 1) * 2 + 1]; A[i] = hiL ? sn : c; B[i] = hiL ? c : -sn; }
                    bf16_t* rowp = O + (size_t)row * ldc + u.pn * BM + wc * 32 + 8 * fq_;
#pragma unroll
                    for (int bj = 0; bj < 2; ++bj) { float o8[8];
#pragma unroll
                        for (int i = 0; i < 8; ++i) { const float v = acc[ai][bj][m][i >> 2][i & 3];
                            auto r = __builtin_amdgcn_permlane32_swap(__float_as_uint(v), __float_as_uint(v), false, false);
                            o8[i] = __uint_as_float(r[0]) * A[i] + __uint_as_float(r[1]) * B[i]; }
                        u32x4 w; w.x = cvt_pk_bf16(o8[0], o8[1]); w.y = cvt_pk_bf16(o8[2], o8[3]); w.z = cvt_pk_bf16(o8[4], o8[5]); w.w = cvt_pk_bf16(o8[6], o8[7]);
                        *(u32x4*)(rowp + bj * HALF) = w; } }
            return; }
#pragma unroll
        for (int ai = 0; ai < 2; ++ai)
#pragma unroll
            for (int m = 0; m < 4; ++m) { bf16_t* rowp = O + (size_t)(row0 + ai * HALF + m * 16) * ldc + col0;
#pragma unroll
                for (int bj = 0; bj < 2; ++bj) { const f32x4 v0 = acc[ai][bj][m][0], v1 = acc[ai][bj][m][1];
                    u32x4 w; w.x = cvt_pk_bf16(v0[0], v0[1]); w.y = cvt_pk_bf16(v0[2], v0[3]); w.z = cvt_pk_bf16(v1[0], v1[1]); w.w = cvt_pk_bf16(v1[2], v1[3]);
                    *(u32x4*)(rowp + bj * HALF) = w; } }
    }
};
struct EpiRes {
    static constexpr bool PERM = false, AFTER_DRAIN = false;
    typedef NoPre Pre; __device__ __forceinline__ void prefetch(Pre&, const Unit&, int, int, int, int) const {}
    const float* baseL; const float* baseC; const bf16_t* baseB; bf16_t* out; const float* gate; int gstride;
    __device__ __forceinline__ void operator()(const f32x4 (&acc)[2][2][4][2], const Unit& u, int wr, int wc, int fr, int fq, const Pre&) const {
        const int rowt = u.pm * BM; const int bidx = rowt < SEQ ? 0 : (rowt < TLAT ? 1 : 2);
        const float* base = rowt < TLAT ? baseL + (size_t)rowt * DM : baseC + (size_t)(rowt - TLAT) * DM;
        const int t_ = fresh_tid(), fr_ = t_ & 15, fq_ = (t_ >> 4) & 3;
        (void)fr; (void)fq;
        const int rl = wr * 64 + fr_, col0 = u.pn * BM + wc * 32 + 4 * fq_;
        const float* gp = gate + (size_t)bidx * gstride + col0;
        f32x4 gv[2][2];
#pragma unroll
        for (int bj = 0; bj < 2; ++bj)
#pragma unroll
            for (int n = 0; n < 2; ++n) gv[bj][n] = *(const f32x4*)(gp + bj * HALF + n * 16);
        if (baseB) {
#pragma unroll
            for (int ai = 0; ai < 2; ++ai)
#pragma unroll
                for (int mp = 0; mp < 2; ++mp) { u32x2 bw[2][2][2];
#pragma unroll
                    for (int mm = 0; mm < 2; ++mm)
#pragma unroll
                        for (int bj = 0; bj < 2; ++bj)
#pragma unroll
                            for (int n = 0; n < 2; ++n) bw[mm][bj][n] = *(const u32x2*)(baseB + (size_t)rowt * DM + (size_t)(rl + ai * HALF + (2 * mp + mm) * 16) * DM + col0 + bj * HALF + n * 16);
                    __builtin_amdgcn_sched_barrier(0);
#pragma unroll
                    for (int mm = 0; mm < 2; ++mm) { const int m = 2 * mp + mm; bf16_t* op = out + (size_t)rowt * DM + (size_t)(rl + ai * HALF + m * 16) * DM + col0;
#pragma unroll
                        for (int bj = 0; bj < 2; ++bj)
#pragma unroll
                            for (int n = 0; n < 2; ++n) { const u32x2 w = bw[mm][bj][n];
                                const f32x4 bs = (f32x4){__uint_as_float(w.x << 16), __uint_as_float(w.x & 0xffff0000u), __uint_as_float(w.y << 16), __uint_as_float(w.y & 0xffff0000u)};
                                const f32x4 v = bs + gv[bj][n] * acc[ai][bj][m][n];
                                u32x2 o; o.x = cvt_pk_bf16(v[0], v[1]); o.y = cvt_pk_bf16(v[2], v[3]); *(u32x2*)(op + bj * HALF + n * 16) = o; } } }
        } else {
#pragma unroll
            for (int ai = 0; ai < 2; ++ai)
#pragma unroll
                for (int m = 0; m < 4; ++m) { f32x4 bf[2][2];
#pragma unroll
                    for (int bj = 0; bj < 2; ++bj)
#pragma unroll
                        for (int n = 0; n < 2; ++n) bf[bj][n] = *(const f32x4*)(base + (size_t)(rl + ai * HALF + m * 16) * DM + col0 + bj * HALF + n * 16);
                    __builtin_amdgcn_sched_barrier(0);
                    bf16_t* op = out + (size_t)rowt * DM + (size_t)(rl + ai * HALF + m * 16) * DM + col0;
#pragma unroll
                    for (int bj = 0; bj < 2; ++bj)
#pragma unroll
                        for (int n = 0; n < 2; ++n) { const f32x4 v = bf[bj][n] + gv[bj][n] * acc[ai][bj][m][n];
                            u32x2 o; o.x = cvt_pk_bf16(v[0], v[1]); o.y = cvt_pk_bf16(v[2], v[3]); *(u32x2*)(op + bj * HALF + n * 16) = o; } }
        }
    }
};
struct EpiAct {
    static constexpr bool PERM = true, AFTER_DRAIN = false;
    bf16_t* O; const float* bias;
    struct Pre { f32x4 b[4]; };
    __device__ __forceinline__ void prefetch(Pre& p, const Unit& u, int wr, int wc, int fr, int fq) const {
        const float* bp = bias + (size_t)u.e * 2048 + u.pn * HALF + wc * 32 + 8 * fq;
        p.b[0] = *(const f32x4*)(bp); p.b[1] = *(const f32x4*)(bp + 4); p.b[2] = *(const f32x4*)(bp + 1024); p.b[3] = *(const f32x4*)(bp + 1028); }
    __device__ __forceinline__ void operator()(const f32x4 (&acc)[2][2][4][2], const Unit& u, int wr, int wc, int fr, int fq, const Pre& p) const {
        const int row0 = u.pm * BM + wr * 64 + fr, col0 = u.pn * HALF + wc * 32 + 8 * fq;
        const f32x4 bg0 = p.b[0], bg1 = p.b[1], bl0 = p.b[2] + 1.0f, bl1 = p.b[3] + 1.0f;
#pragma unroll
        for (int ai = 0; ai < 2; ++ai)
#pragma unroll
            for (int m = 0; m < 4; ++m) { bf16_t* rowp = O + (size_t)(row0 + ai * HALF + m * 16) * DE + col0;
                float a[8];
#pragma unroll
                for (int n = 0; n < 2; ++n) { const f32x4 g = acc[ai][0][m][n] + (n ? bg1 : bg0), li = acc[ai][1][m][n] + (n ? bl1 : bl0);
#pragma unroll
                    for (int j = 0; j < 4; ++j) { const float gl = fminf(g[j], 7.0f), ln1 = __builtin_amdgcn_fmed3f(li[j], -6.0f, 8.0f); a[n * 4 + j] = gl * __builtin_amdgcn_rcpf(1.0f + __builtin_amdgcn_exp2f(-1.702f * 1.4426950408889634f * gl)) * ln1; } }
                u32x4 w; w.x = cvt_pk_bf16(a[0], a[1]); w.y = cvt_pk_bf16(a[2], a[3]); w.z = cvt_pk_bf16(a[4], a[5]); w.w = cvt_pk_bf16(a[6], a[7]);
                *(u32x4*)rowp = w; }
    }
};
struct EpiDown {
    static constexpr bool PERM = true, AFTER_DRAIN = false;
    bf16_t* Y; const float* bias; const MoeOrderT<false>* S; const float* gatev;
    struct Pre { int t4[8]; };
    __device__ __forceinline__ void prefetch(Pre& p, const Unit& u, int wr, int wc, int fr, int fq) const {
#pragma unroll
        for (int i = 0; i < 8; ++i) p.t4[i] = S->row_tok4(u, wr * 64 + fr + (i >> 2) * HALF + (i & 3) * 16); }
    __device__ __forceinline__ void operator()(const f32x4 (&acc)[2][2][4][2], const Unit& u, int wr, int wc, int fr, int fq, const Pre& p) const {
        const int row0 = u.pm * BM + wr * 64 + fr, col0 = u.pn * BM + wc * 32 + 8 * fq;
        const float* bp = bias + (size_t)u.e * DM + col0;
        f32x4 bv[2][2];
#pragma unroll
        for (int bj = 0; bj < 2; ++bj) { bv[bj][0] = *(const f32x4*)(bp + bj * HALF); bv[bj][1] = *(const f32x4*)(bp + bj * HALF + 4); }
        int t4[8]; float gt[8];
#pragma unroll
        for (int i = 0; i < 8; ++i) t4[i] = p.t4[i];
#pragma unroll
        for (int i = 0; i < 8; ++i) gt[i] = gatev[t4[i] >= 0 ? t4[i] : 0];
#pragma unroll
        for (int ai = 0; ai < 2; ++ai)
#pragma unroll
            for (int m = 0; m < 4; ++m) { const int tok4 = t4[ai * 4 + m];
                if (tok4 >= 0) { const float g1 = gt[ai * 4 + m]; bf16_t* rowp = Y + (size_t)tok4 * DM + col0;
#pragma unroll
                    for (int bj = 0; bj < 2; ++bj) { const f32x4 v0 = (acc[ai][bj][m][0] + bv[bj][0]) * g1, v1 = (acc[ai][bj][m][1] + bv[bj][1]) * g1;
                        u32x4 w; w.x = cvt_pk_bf16(v0[0], v0[1]); w.y = cvt_pk_bf16(v0[2], v0[3]); w.z = cvt_pk_bf16(v1[0], v1[1]); w.w = cvt_pk_bf16(v1[2], v1[3]);
                        *(u32x4*)(rowp + bj * HALF) = w; } } }
    }
};

template <class Epi, class Sched, bool ALIGN_EPI = false, bool SP2 = false>
__device__ __forceinline__ void gemm_phase(PG8_LAS unsigned char* lds, const Gemm g, const Sched& S, const Epi& E) {
    const int tid = fresh_tid(), wid = __builtin_amdgcn_readfirstlane(tid >> 6), lane = tid & 63, wr = wid >> 2, wc = wid & 3, fr = lane & 15, fq = lane >> 4;
    const int K = g.K, nt = K / BK;
    unsigned voffA[2], voffB[2];
#pragma unroll
    for (int i = 0; i < 2; ++i) { int R, C; stage_rc(tid * 16 + i * 8192, R, C); const int Rb = Epi::PERM ? ((R & ~31) + perm32(R & 31)) : R;
        voffA[i] = (unsigned)(R * K + C) * 2u; voffB[i] = (unsigned)(Rb * K + C) * 2u; }
    unsigned Rr[2], Cb2[2];
#pragma unroll
    for (int i = 0; i < 2; ++i) { int R, C; stage_rc(tid * 16 + i * 8192, R, C); Rr[i] = (unsigned)R; Cb2[i] = (unsigned)C * 2u; }
    unsigned tC4[2][2], tN4[2][2];
    const size_t kstep = (size_t)(BK * 2);
    const size_t hstep = (size_t)HALF * K * 2;
    const size_t tstep = 2 * hstep;
    const unsigned ldsw = (unsigned)wid * 1024u;
    const int aoff = lds_byte(wr * 64 + fr, fq * 8), boff = lds_byte(wc * 32 + fr, fq * 8);
#define PG8_SA(b, h) (((b) * 2 + (h)) * HTB)
#define PG8_SB(b, h) ((4 + (b) * 2 + (h)) * HTB)
#define PG8_STAGE(bufoff, gbase, voff) do { _Pragma("unroll") for (int _i = 0; _i < 2; ++_i) \
        __builtin_amdgcn_global_load_lds((const unsigned*)((const char*)(gbase) + (voff)[_i]), (PG8_LAS unsigned*)(lds + (bufoff) + ldsw + _i * 8192), 16, 0, 0); } while (0)
#define PG8_STAGE_A(bufoff, kbyte, h, isnext) do { if constexpr (Sched::GATHER) { unsigned vo_[2]; _Pragma("unroll") for (int _i = 0; _i < 2; ++_i) { asm volatile("" : "+v"(tN4[h][_i])); \
            const unsigned t4_ = (isnext) ? tN4[h][_i] : tC4[h][_i]; vo_[_i] = (t4_ >> 2) * (unsigned)(K * 2) + Cb2[_i]; } PG8_STAGE(bufoff, (const char*)g.A + (kbyte), vo_); } \
        else { PG8_STAGE(bufoff, ((isnext) ? nA : cA) + (kbyte) + (h) * hstep, voffA); } } while (0)
#define PG8_LOOKUP(dst, unit) do { _Pragma("unroll") for (int _h = 0; _h < 2; ++_h) _Pragma("unroll") for (int _i = 0; _i < 2; ++_i) { const int* p_ = S.row_src(unit, _h * HALF + (int)Rr[_i]); \
        asm volatile("global_load_dword %0, %1, off" : "=v"(dst[_h][_i]) : "v"(p_) : "memory"); } } while (0)
#define PG8_LDA(dst, b, h) do { _Pragma("unroll") for (int m = 0; m < 4; ++m) _Pragma("unroll") for (int k = 0; k < 2; ++k) dst[m][k] = *(const PG8_LAS bf16x8*)(lds + PG8_SA(b, h) + aoff + m * 2048 + k * 1024); } while (0)
#define PG8_LDB(dst, b, h) do { _Pragma("unroll") for (int n = 0; n < 2; ++n) _Pragma("unroll") for (int k = 0; k < 2; ++k) dst[n][k] = *(const PG8_LAS bf16x8*)(lds + PG8_SB(b, h) + boff + n * 2048 + k * 1024); } while (0)
#define PG8_MMA(ai, bj, At, Bt) do { __builtin_amdgcn_s_setprio(1); _Pragma("unroll") for (int m = 0; m < 4; ++m) _Pragma("unroll") for (int n = 0; n < 2; ++n) _Pragma("unroll") for (int k = 0; k < 2; ++k) \
        acc[ai][bj][m][n] = __builtin_amdgcn_mfma_f32_16x16x32_bf16(Bt[n][k], At[m][k], acc[ai][bj][m][n], 0, 0, 0); __builtin_amdgcn_s_setprio(0); } while (0)
#define PG8_WAIT_V(n) asm volatile("s_waitcnt vmcnt(" #n ")" ::: "memory")
#define PG8_WAIT_L(n) asm volatile("s_waitcnt lgkmcnt(" #n ")" ::: "memory")
#define PG8_BAR __builtin_amdgcn_s_barrier()
#define PG8_SCHED __builtin_amdgcn_sched_barrier(0)
    Unit cur, nxt; int ui = 0;
    if (!S.next(0, cur)) return;
    f32x4 acc[2][2][4][2];
#pragma unroll
    for (int a = 0; a < 2; ++a)
#pragma unroll
        for (int b = 0; b < 2; ++b)
#pragma unroll
            for (int m = 0; m < 4; ++m)
#pragma unroll
                for (int n = 0; n < 2; ++n) acc[a][b][m][n] = (f32x4){0.f, 0.f, 0.f, 0.f};
    bf16x8 At[4][2], B0[2][2], B1[2][2];
    const char* cA = (const char*)g.A + (size_t)cur.pm * tstep; const char* cB = (const char*)g.Bt + (size_t)cur.e * g.estride + (size_t)cur.pn * tstep;
    S.a_ready(cur);
    static_assert(SP2, "only the two-super-phase K-loop is kept in this file");
    const char* nA = cA;
    if constexpr (Sched::GATHER) { PG8_LOOKUP(tC4, cur); asm volatile("s_waitcnt vmcnt(0)" ::: "memory");
#pragma unroll
        for (int _h = 0; _h < 2; ++_h)
#pragma unroll
            for (int _i = 0; _i < 2; ++_i) { asm volatile("" : "+v"(tC4[_h][_i])); tN4[_h][_i] = tC4[_h][_i]; } }
    {
        PG8_STAGE(PG8_SB(0, 0), cB, voffB); PG8_STAGE(PG8_SB(0, 1), cB + hstep, voffB); PG8_STAGE_A(PG8_SA(0, 0), 0, 0, false); PG8_STAGE_A(PG8_SA(0, 1), 0, 1, false);
        if (wr == 1) PG8_BAR;
        PG8_WAIT_V(2); PG8_BAR;
        PG8_STAGE(PG8_SB(1, 0), cB + kstep, voffB); PG8_STAGE_A(PG8_SA(1, 0), kstep, 0, false); PG8_STAGE(PG8_SB(1, 1), cB + hstep + kstep, voffB);
        PG8_WAIT_V(6); PG8_BAR;
    }
    for (;;) {
        const bool has_next = S.next(ui + 1, nxt);
        nA = has_next ? (const char*)g.A + (size_t)nxt.pm * tstep : cA; const char* nB = has_next ? (const char*)g.Bt + (size_t)nxt.e * g.estride + (size_t)nxt.pn * tstep : cB;
        if constexpr (Sched::GATHER) { if (has_next) PG8_LOOKUP(tN4, nxt); }
        typename Epi::Pre pre; E.prefetch(pre, cur, wr, wc, fr, fq);
        for (int t = 0; t < nt; t += 2) {
            const bool last = (t == nt - 2);
            const size_t k1 = (size_t)(t + 1) * kstep, k2 = last ? 0 : (size_t)(t + 2) * kstep, k3 = k2 + kstep;
            const char* b2 = (last ? nB : cB) + k2; const char* b3 = b2 + kstep;
            if (last && has_next) S.a_ready(nxt);
            PG8_LDB(B0, 0, 0); PG8_LDB(B1, 0, 1); PG8_SCHED; PG8_LDA(At, 0, 0); PG8_STAGE_A(PG8_SA(1, 1), k1, 1, false);
            PG8_WAIT_V(8); PG8_WAIT_L(0); PG8_BAR; PG8_MMA(0, 0, At, B0); PG8_MMA(0, 1, At, B1); PG8_BAR; PG8_SCHED;
            PG8_LDA(At, 0, 1); PG8_STAGE(PG8_SB(0, 0), b2, voffB); PG8_STAGE(PG8_SB(0, 1), b2 + hstep, voffB); PG8_STAGE_A(PG8_SA(0, 0), k2, 0, last);
            PG8_WAIT_V(8); PG8_WAIT_L(0); PG8_BAR; PG8_MMA(1, 0, At, B0); PG8_MMA(1, 1, At, B1); PG8_BAR; PG8_SCHED;
            PG8_LDB(B0, 1, 0); PG8_LDB(B1, 1, 1); PG8_SCHED; PG8_LDA(At, 1, 0); PG8_STAGE_A(PG8_SA(0, 1), k2, 1, last);
            PG8_WAIT_V(8); PG8_WAIT_L(0); PG8_BAR; PG8_MMA(0, 0, At, B0); PG8_MMA(0, 1, At, B1); PG8_BAR; PG8_SCHED;
            PG8_LDA(At, 1, 1); PG8_STAGE(PG8_SB(1, 0), b3, voffB); PG8_STAGE(PG8_SB(1, 1), b3 + hstep, voffB); PG8_STAGE_A(PG8_SA(1, 0), k3, 0, last);
            PG8_WAIT_V(8); PG8_WAIT_L(0); PG8_BAR; PG8_MMA(1, 0, At, B0); PG8_MMA(1, 1, At, B1); PG8_BAR; PG8_SCHED;
        }
        if constexpr (ALIGN_EPI) { if (wr == 0) PG8_BAR; }
        if constexpr (!Epi::AFTER_DRAIN) { E(acc, cur, wr, wc, fr, fq, pre); S.done(cur); }
        if (!has_next) break;
#pragma unroll
        for (int a = 0; a < 2; ++a)
#pragma unroll
            for (int b = 0; b < 2; ++b)
#pragma unroll
                for (int m = 0; m < 4; ++m)
#pragma unroll
                    for (int n = 0; n < 2; ++n) acc[a][b][m][n] = (f32x4){0.f, 0.f, 0.f, 0.f};
        cur = nxt; cA = nA; cB = nB; ++ui;
        if constexpr (Sched::GATHER) {
#pragma unroll
            for (int _h = 0; _h < 2; ++_h)
#pragma unroll
                for (int _i = 0; _i < 2; ++_i) tC4[_h][_i] = tN4[_h][_i]; }
        if constexpr (ALIGN_EPI) { if (wr == 1) PG8_BAR; }
    }
    PG8_WAIT_V(0);
    if constexpr (!ALIGN_EPI) { if (wr == 0) PG8_BAR; }
    PG8_BAR;
#undef PG8_SA
#undef PG8_SB
#undef PG8_STAGE
#undef PG8_STAGE_A
#undef PG8_LOOKUP
#undef PG8_LDA
#undef PG8_LDB
#undef PG8_MMA
#undef PG8_WAIT_V
#undef PG8_WAIT_L
#undef PG8_BAR
#undef PG8_SCHED
}
}

namespace att {
constexpr float SCALE = 0.125f;
constexpr int SHM_V = 64 * 128 * 2, SHM_K = 64 * 128 * 2;
#define KSWZ(row, colB) ((row) * 256 + ((colB) ^ (((row) & 7) << 4)))
#define SBAR() __builtin_amdgcn_sched_barrier(0)
__device__ __forceinline__ int crow(int r, int hi) { return (r & 3) + 8 * (r >> 2) + 4 * hi; }
__device__ __forceinline__ unsigned cvtpk(float lo, float hi) { unsigned r; asm volatile("v_cvt_pk_bf16_f32 %0, %1, %2" : "=v"(r) : "v"(lo), "v"(hi)); return r; }
__device__ __forceinline__ bf16x8 ld8(const bf16_t* p) { return *reinterpret_cast<const bf16x8*>(p); }

__device__ __forceinline__ void partialSM(f32x16& p0) {
#pragma unroll
    for (int r = 0; r < 16; ++r) p0[r] = __builtin_amdgcn_exp2f(p0[r]);
}
__device__ __forceinline__ void finishSM(f32x16& p0, f32x16& p1, float& l_reg, bf16x8& pa0, bf16x8& pa1, bf16x8& pa2, bf16x8& pa3) {
#pragma unroll
    for (int r = 0; r < 16; ++r) p1[r] = __builtin_amdgcn_exp2f(p1[r]);
    float ps = 0;
#pragma unroll
    for (int r = 0; r < 16; ++r) ps += p0[r];
#pragma unroll
    for (int r = 0; r < 16; ++r) ps += p1[r];
    l_reg += ps;
#define PK4(P, BASE, OUT) do { u32x4 w = {cvtpk(P[BASE + 0], P[BASE + 1]), cvtpk(P[BASE + 2], P[BASE + 3]), cvtpk(P[BASE + 4], P[BASE + 5]), cvtpk(P[BASE + 6], P[BASE + 7])}; \
    OUT = *reinterpret_cast<bf16x8*>(&w); } while (0)
    PK4(p0, 0, pa0); PK4(p0, 8, pa1); PK4(p1, 0, pa2); PK4(p1, 8, pa3);
#undef PK4
}
__device__ __forceinline__ void qkt(f32x16& p0, f32x16& p1, const char* Ks, const bf16x8* qr, int r32, int hi, int mp, float nm) {
#pragma unroll
    for (int r = 0; r < 16; ++r) { p0[r] = nm; p1[r] = nm; }
    bf16x8 b0n, b1n;
    { const int cb = ((mp * 4 + 0) * 16 + hi * 8) * 2; b0n = *reinterpret_cast<const bf16x8*>(Ks + KSWZ(r32, cb)); b1n = *reinterpret_cast<const bf16x8*>(Ks + KSWZ(32 + r32, cb)); }
#pragma unroll
    for (int d0 = 0; d0 < 4; ++d0) { const bf16x8 b0 = b0n, b1 = b1n;
        if (d0 < 3) { const int cb = ((mp * 4 + d0 + 1) * 16 + hi * 8) * 2; b0n = *reinterpret_cast<const bf16x8*>(Ks + KSWZ(r32, cb)); b1n = *reinterpret_cast<const bf16x8*>(Ks + KSWZ(32 + r32, cb)); }
        __builtin_amdgcn_sched_barrier(0);
        p0 = __builtin_amdgcn_mfma_f32_32x32x16_bf16(b0, qr[d0], p0, 0, 0, 0);
        p1 = __builtin_amdgcn_mfma_f32_32x32x16_bf16(b1, qr[d0], p1, 0, 0, 0); }
}
__device__ __forceinline__ int v_st(int k, int c) { const int kk = k; return ((kk >> 3) * 4 + (c >> 5)) * 512 + ((kk & 7) * 32 + (c & 31)) * 2; }
__device__ __forceinline__ int v_rd_base(int lane) { return ((lane & 3) << 3) | (((lane >> 2) & 3) << 6) | (((lane >> 4) & 1) << 5) | (((lane >> 5) & 1) << 8); }
constexpr int v_rd_off(int d0, int ks, int half) { return d0 * 512 + ks * 4096 + half * 2048; }
template <int OFF> __device__ __forceinline__ s16x4 tr_read(int vb) {
    s16x4 r; asm volatile("ds_read_b64_tr_b16 %0, %1 offset:%2" : "=&v"(r) : "v"(vb), "i"(OFF) : "memory"); return r;
}
template <int D0, bool EXPS> __device__ __forceinline__ void pv_one(f32x16& od, int vb, bf16x8 pa0, bf16x8 pa1, bf16x8 pa2, bf16x8 pa3, f32x16& pn) {
    const s16x4 l0 = tr_read<v_rd_off(D0, 0, 0)>(vb), h0 = tr_read<v_rd_off(D0, 0, 1)>(vb), l1 = tr_read<v_rd_off(D0, 1, 0)>(vb), h1 = tr_read<v_rd_off(D0, 1, 1)>(vb);
    const s16x4 l2 = tr_read<v_rd_off(D0, 2, 0)>(vb), h2 = tr_read<v_rd_off(D0, 2, 1)>(vb), l3 = tr_read<v_rd_off(D0, 3, 0)>(vb), h3 = tr_read<v_rd_off(D0, 3, 1)>(vb);
    asm volatile("s_waitcnt lgkmcnt(0)" ::: "memory"); SBAR();
#define PK(L, H) (bf16x8){L[0], L[1], L[2], L[3], H[0], H[1], H[2], H[3]}
    od = __builtin_amdgcn_mfma_f32_32x32x16_bf16(pa0, PK(l0, h0), od, 0, 0, 0);
    od = __builtin_amdgcn_mfma_f32_32x32x16_bf16(pa1, PK(l1, h1), od, 0, 0, 0);
    od = __builtin_amdgcn_mfma_f32_32x32x16_bf16(pa2, PK(l2, h2), od, 0, 0, 0);
    od = __builtin_amdgcn_mfma_f32_32x32x16_bf16(pa3, PK(l3, h3), od, 0, 0, 0);
#undef PK
    if constexpr (EXPS) {
#pragma unroll
        for (int r = 4 * D0; r < 4 * D0 + 4; ++r) pn[r] = __builtin_amdgcn_exp2f(pn[r]); }
}
template <bool EXPS> __device__ __forceinline__ void pv_d0(f32x16* o, int vb, bf16x8 pa0, bf16x8 pa1, bf16x8 pa2, bf16x8 pa3, f32x16& pn) {
    pv_one<0, EXPS>(o[0], vb, pa0, pa1, pa2, pa3, pn); pv_one<1, EXPS>(o[1], vb, pa0, pa1, pa2, pa3, pn); pv_one<2, EXPS>(o[2], vb, pa0, pa1, pa2, pa3, pn); pv_one<3, EXPS>(o[3], vb, pa0, pa1, pa2, pa3, pn);
}

__device__ __forceinline__ void attn_unit(const bf16_t* __restrict__ proj, bf16_t* __restrict__ mix, const float* __restrict__ subw, float lam, float osc,
                                          const unsigned* __restrict__ kmax2, int b, int h, int qrow0, int nkeys, char* lds) {
    const int tid = fresh_tid(), wid = tid >> 6, lane = tid & 63, r32 = lane & 31, hi = lane >> 5, mp = wid >> 2, wq = wid & 3;
    constexpr int SLOT = SHM_V + SHM_K;
    float* ws = (float*)(lds + 3 * SLOT) + wid * 64; float* li_l = ws;
    float l_reg = 0; f32x16 o[4] = {}; bf16x8 qr[4];
    const int wu = __builtin_amdgcn_readfirstlane(wid);
    unsigned offV[2], offK[2];
#pragma unroll
    for (int q = 0; q < 2; ++q) { const int pc = 2 * wu + q;
        { const int key = 8 * (pc >> 1) + ((lane >> 2) & 7), col = 32 * (2 * (pc & 1) + (lane >> 5)) + (lane & 3) * 8; offV[q] = (unsigned)(key * INWP + col + C_V); }
        { const int row = 4 * pc + (lane >> 4), col = ((lane & 15) ^ (row & 7)) * 8; offK[q] = (unsigned)(row * INWP + col + C_K); } }
    const int vb0 = (int)(uintptr_t)lds + v_rd_base(lane);
    LAS unsigned char* lds3 = (LAS unsigned char*)(unsigned)(uintptr_t)lds;
    const int ctx_row0 = TLAT + b * LCTX, lat_row0 = b * SEQ - LCTX;
#define DMA_TILE(k0, so) do { const bf16_t* tb_ = proj + (size_t)((k0) < LCTX ? ctx_row0 + (k0) : lat_row0 + (k0)) * INWP + h * 128; \
    _Pragma("unroll") for (int q_ = 0; q_ < 2; ++q_) { \
        __builtin_amdgcn_global_load_lds((const unsigned*)(tb_ + offV[q_]), (LAS unsigned*)(lds3 + (so) + (2 * wu + q_) * 1024), 16, 0, 0); \
        __builtin_amdgcn_global_load_lds((const unsigned*)(tb_ + offK[q_]), (LAS unsigned*)(lds3 + (so) + SHM_V + (2 * wu + q_) * 1024), 16, 0, 0); } } while (0)
    f32x16 pA0, pA1, pB0, pB1; bf16x8 pa0, pa1, pa2, pa3; const int NT = nkeys / 64;
    int sl_prev = 0, sl_cur = 0, sl_next = SLOT;
#define ROT() do { sl_prev = sl_cur; sl_cur = sl_next; sl_next = (sl_next == 2 * SLOT) ? 0 : sl_next + SLOT; } while (0)
    DMA_TILE(0, 0); DMA_TILE(64, SLOT);
    const bf16_t* Qw = proj + (size_t)(qrow0 + wq * 32 + r32) * INWP + C_Q + h * 128 + mp * 64 + hi * 8;
    float qss = 0.f;
    bf16x8 qraw[4];
#pragma unroll
    for (int d0 = 0; d0 < 4; ++d0) qraw[d0] = ld8(Qw + d0 * 16);
    const float km2 = __uint_as_float(kmax2[h * 2 + mp]);
    __builtin_amdgcn_sched_barrier(0);
#pragma unroll
    for (int d0 = 0; d0 < 4; ++d0) { float f[8]; const bf16x8 raw = qraw[d0]; unpack8(*reinterpret_cast<const u32x4*>(&raw), f);
        constexpr float C = SCALE * 1.4426950408889634f;
        u32x4 w; w.x = cvtpk(f[0] * C, f[1] * C); w.y = cvtpk(f[2] * C, f[3] * C); w.z = cvtpk(f[4] * C, f[5] * C); w.w = cvtpk(f[6] * C, f[7] * C);
        float g[8]; unpack8(w, g);
#pragma unroll
        for (int e = 0; e < 8; ++e) qss += g[e] * g[e];
        qr[d0] = *reinterpret_cast<const bf16x8*>(&w); }
    qss += __shfl_xor(qss, 32);
    const float nm = -1.002f * sqrtf(qss) * sqrtf(km2);
    asm volatile("s_waitcnt vmcnt(0)" ::: "memory"); __syncthreads();
    qkt(pA0, pA1, lds + SHM_V, qr, r32, hi, mp, nm); partialSM(pA0);
    ROT();
#define ITER(PC0, PC1, PP0, PP1, j) do { if ((j) + 1 < NT) DMA_TILE(((j) + 1) * 64, sl_next); \
        SBAR(); qkt(PC0, PC1, lds + sl_cur + SHM_V, qr, r32, hi, mp, nm); \
        finishSM(PP0, PP1, l_reg, pa0, pa1, pa2, pa3); SBAR(); \
        pv_d0<true>(o, vb0 + sl_prev, pa0, pa1, pa2, pa3, PC0); \
        asm volatile("s_waitcnt vmcnt(0)" ::: "memory");     \
        __syncthreads(); ROT(); } while (0)
    for (int j = 1; j + 1 < NT; j += 2) { ITER(pB0, pB1, pA0, pA1, j); ITER(pA0, pA1, pB0, pB1, j + 1); }
    ITER(pB0, pB1, pA0, pA1, NT - 1);
    finishSM(pB0, pB1, l_reg, pa0, pa1, pa2, pa3); SBAR();
    pv_d0<false>(o, vb0 + sl_prev, pa0, pa1, pa2, pa3, pA0);
#undef ITER
#undef ROT
#undef DMA_TILE
    asm volatile("s_waitcnt vmcnt(0)" ::: "memory");
    l_reg += __shfl_xor(l_reg, 32);
    if (hi == 0) li_l[r32] = (mp ? lam : 1.0f) / l_reg;
    asm volatile("s_waitcnt lgkmcnt(0)" ::: "memory");
#pragma unroll
    for (int r = 0; r < 16; ++r) { const float f = li_l[crow(r, hi)];
#pragma unroll
        for (int d0 = 0; d0 < 4; ++d0) o[d0][r] *= f; }
    __syncthreads();
    float* ex = (float*)lds;
    bf16_t* ot = (bf16_t*)(lds + 65536);
    if (mp == 1) {
#pragma unroll
        for (int r = 0; r < 16; ++r)
#pragma unroll
            for (int d0 = 0; d0 < 4; ++d0) ex[(wq * 32 + crow(r, hi)) * 128 + d0 * 32 + r32] = o[d0][r];
    }
    __syncthreads();
    if (mp == 0) {
        const int t2 = fresh_tid(), r32 = t2 & 31, hi = (t2 >> 5) & 1, wq = (t2 >> 6) & 3;
        float wcol[4];
#pragma unroll
        for (int d0 = 0; d0 < 4; ++d0) wcol[d0] = subw[d0 * 32 + r32] * osc;
#pragma unroll
        for (int r = 0; r < 16; ++r) {
            float ss = 0.f;
#pragma unroll
            for (int d0 = 0; d0 < 4; ++d0) { o[d0][r] -= ex[(wq * 32 + crow(r, hi)) * 128 + d0 * 32 + r32]; ss += o[d0][r] * o[d0][r]; }
            ss = sum32(ss);
            const float rn = rsqrtf(ss * (1.0f / 128.0f) + EPS);
            bf16_t* op = ot + (wq * 32 + crow(r, hi)) * 136 + r32;
#pragma unroll
            for (int d0 = 0; d0 < 4; ++d0) op[d0 * 32] = (bf16_t)f2bf(o[d0][r] * rn * wcol[d0]);
        }
    }
    __syncthreads();
    { const int t3 = fresh_tid();
#pragma unroll
      for (int it = 0; it < 4; ++it) { const int idx = t3 + 512 * it, row = idx >> 4, pc = idx & 15;
          *(u32x4*)(mix + (size_t)(qrow0 + row) * DM + h * 128 + pc * 8) = *(const u32x4*)(ot + row * 136 + pc * 8); } }
    __syncthreads();
}
}


namespace ck {
template <int K>
__device__ __forceinline__ f32x16 mma32(const bf16_t* A, int lda, const bf16_t* B, int ldb, f32x16 acc, int r32, int hi) {
#pragma unroll
    for (int k0 = 0; k0 < K; k0 += 16) {
        const bf16x8 a = *(const bf16x8*)(A + r32 * lda + k0 + 8 * hi), b = *(const bf16x8*)(B + r32 * ldb + k0 + 8 * hi);
        acc = __builtin_amdgcn_mfma_f32_32x32x16_bf16(a, b, acc, 0, 0, 0); }
    return acc;
}
__device__ __forceinline__ int crow(int r, int hi) { return (r & 3) + 8 * (r >> 2) + 4 * hi; }
struct P { bf16_t* proj; bf16_t* xbcs; float* dtv; float* cumv; float* gkv; bf16_t* ssd_st; bf16_t* gla_st; float* cds; float* cdg; bf16_t* mix; const f32x2* ropet;
           const float *convw, *convb, *dtb, *alog, *gkup, *gkb, *ssdd, *ssdnw, *glanw; unsigned* kmax2; bf16_t* hins; bf16_t* hing; };

__device__ __forceinline__ void prep_chunk(const P& p, int ch, unsigned char* lds, int sect, bool dry = false) {
    const int tid = fresh_tid(), lane = tid & 63, wave = __builtin_amdgcn_readfirstlane(tid >> 6), r32 = lane & 31, hi = lane >> 5;
    const int row0 = ch * 64; const bool lat = row0 < TLAT;
    float* dtl = (float*)lds; float* al = dtl + 512; float* cuml = al + 512; float* wgt = cuml + 512; float* tot = wgt + 512;
    bf16_t* XwT = (bf16_t*)(lds + 16384);
    bf16_t* BT = (bf16_t*)(lds + 90112);
    if (lat && !dry && (sect & 1)) {
#pragma unroll 1
        for (int hb = 0; hb < 2; ++hb) {
            u32x4 a1[4], a2[4]; f32x4 tb[4][4];
#pragma unroll
            for (int q = 0; q < 4; ++q) { const int idx = tid + 512 * (hb * 4 + q);
                const int jg = idx & 1, half = (idx >> 1) & 1, mp = (idx >> 2) & 1, hh = (idx >> 3) & 3, qk = (idx >> 5) & 1, tok = idx >> 6;
                const int row = row0 + tok, s = row & (SEQ - 1), pos = half ? (s & 63) : (s >> 6);
                const bf16_t* p1 = p.proj + (size_t)row * INWP + qk * 512 + hh * 128 + mp * 64 + half * 32 + jg * 8;
                a1[q] = *(const u32x4*)p1; a2[q] = *(const u32x4*)(p1 + 16);
                const f32x4* tp = (const f32x4*)(p.ropet + pos * 16 + jg * 8);
#pragma unroll
                for (int e = 0; e < 4; ++e) tb[q][e] = tp[e]; }
#pragma unroll
            for (int q = 0; q < 4; ++q) { const int idx = tid + 512 * (hb * 4 + q);
                const int jg = idx & 1, half = (idx >> 1) & 1, mp = (idx >> 2) & 1, hh = (idx >> 3) & 3, qk = (idx >> 5) & 1, tok = idx >> 6;
                bf16_t* p1 = p.proj + (size_t)(row0 + tok) * INWP + qk * 512 + hh * 128 + mp * 64 + half * 32 + jg * 8;
                float x1[8], x2[8], o1[8], o2[8]; unpack8(a1[q], x1); unpack8(a2[q], x2);
#pragma unroll
                for (int e = 0; e < 4; ++e) { const f32x4 cs = tb[q][e];
                    o1[2 * e] = x1[2 * e] * cs.x - x2[2 * e] * cs.y; o2[2 * e] = x2[2 * e] * cs.x + x1[2 * e] * cs.y;
                    o1[2 * e + 1] = x1[2 * e + 1] * cs.z - x2[2 * e + 1] * cs.w; o2[2 * e + 1] = x2[2 * e + 1] * cs.z + x1[2 * e + 1] * cs.w; }
                *(u32x4*)p1 = pack8(o1); *(u32x4*)(p1 + 16) = pack8(o2); }
        }
    }
    const int spos = lat ? ((row0 + lane) & (SEQ - 1)) : ((row0 + lane - TLAT) & (LCTX - 1)), slen = lat ? SEQ : LCTX;
    if (sect & 2) {
    u32x4 c0[4], cm[4], cp[4];
    const bf16_t* cbase = p.proj + (size_t)(row0 + lane) * INWP + C_XBC;
    const int dm = spos > 0 ? -INWP : 0, dp = spos < slen - 1 ? INWP : 0;
#pragma unroll
    for (int q = 0; q < 4; ++q) { const bf16_t* pp = cbase + (wave + 8 * q) * 8; c0[q] = *(const u32x4*)pp; cm[q] = *(const u32x4*)(pp + dm); cp[q] = *(const u32x4*)(pp + dp); }
    float* cwl = (float*)(lds + 108544);
    { const int i4 = tid * 4; *(f32x4*)(cwl + i4) = (i4 < 512) ? *(const f32x4*)(p.convb + i4) : *(const f32x4*)(p.convw + (i4 - 512)); }
    { const int tok = tid >> 3, i = tid & 7, row = row0 + tok;
      const float x = bf2f(p.proj[(size_t)row * INWP + C_DT + i]) + p.dtb[i];
      const float dt = softplusf(x), A = -expf(p.alog[i]);
      dtl[tid] = dt; al[tid] = dt * A; p.dtv[(size_t)row * 8 + i] = dt; }
    unsigned* kml = (unsigned*)(tot + 8);
    if (tid < 8) kml[tid] = 0u;
    LDS_BARRIER();
    { const int tok = tid >> 3, hm = tid & 7; const bf16_t* kp = p.proj + (size_t)(row0 + tok) * INWP + C_K + hm * 64; float ss = 0.f;
#pragma unroll
      for (int q = 0; q < 8; ++q) { float f[8]; unpack8(*(const u32x4*)(kp + q * 8), f);
#pragma unroll
          for (int e = 0; e < 8; ++e) ss += f[e] * f[e]; }
      atomicMax(&kml[hm], __float_as_uint(ss)); }
    { const int i = wave, dir = i >> 2; const float c = wave_scan(al[lane * 8 + i], lane, dir != 0);
      cuml[lane * 8 + i] = c; if (lane == (dir ? 0 : 63)) { tot[i] = c; p.cds[ch * 8 + i] = __expf(c); } }
    LDS_BARRIER();
    if (tid < 8) atomicMax(p.kmax2 + (lat ? (row0 >> 13) : ((row0 - TLAT) >> 8)) * 8 + tid, kml[tid]);
    { const int tok = tid >> 3, i = tid & 7, row = row0 + tok; const float cmv = cuml[tid];
      wgt[tid] = __expf(tot[i] - cmv) * dtl[tid]; p.cumv[(size_t)row * 8 + i] = cmv; }
    LDS_BARRIER();
#pragma unroll
    for (int hb = 0; hb < 2; ++hb) {
        u32x4 n0[4], nm[4], np[4];
        if (hb == 0) {
#pragma unroll
            for (int q = 0; q < 4; ++q) { const bf16_t* pp = cbase + (wave + 8 * (4 + q)) * 8; n0[q] = *(const u32x4*)pp; nm[q] = *(const u32x4*)(pp + dm); np[q] = *(const u32x4*)(pp + dp); } }
#pragma unroll
        for (int q = 0; q < 4; ++q) { const int cg = wave + 8 * (hb * 4 + q), row = row0 + lane;
            float xm[8], x0[8], xp[8], o[8];
            unpack8(c0[q], x0); unpack8(cm[q], xm); unpack8(cp[q], xp);
            const float zm = spos > 0 ? 1.f : 0.f, zp = spos < slen - 1 ? 1.f : 0.f;
#pragma unroll
            for (int e = 0; e < 8; ++e) { const int c = cg * 8 + e; o[e] = siluf(cwl[c] + cwl[512 + c] * (xm[e] * zm) + cwl[1024 + c] * x0[e] + cwl[1536 + c] * (xp[e] * zp)); }
            const u32x4 pk = pack8(o);
            *(u32x4*)(p.xbcs + (size_t)row * 512 + cg * 8) = pk;
            if (cg < 32) { float ob[8]; unpack8(pk, ob); const float wf = wgt[lane * 8 + (cg >> 3)], wb = wgt[lane * 8 + 4 + (cg >> 3)];
#pragma unroll
                for (int e = 0; e < 8; ++e) { XwT[(cg * 8 + e) * 72 + lane] = (bf16_t)f2bf(ob[e] * wf); XwT[(256 + cg * 8 + e) * 72 + lane] = (bf16_t)f2bf(ob[e] * wb); } }
            else if (cg < 48) { const unsigned wv[4] = {pk.x, pk.y, pk.z, pk.w};
#pragma unroll
                for (int e = 0; e < 8; ++e) BT[((cg - 32) * 8 + e) * 72 + lane] = (bf16_t)((wv[e >> 1] >> ((e & 1) * 16)) & 0xffffu); } }
        if (hb == 0) {
#pragma unroll
            for (int q = 0; q < 4; ++q) { c0[q] = n0[q]; cm[q] = nm[q]; cp[q] = np[q]; } }
    }
    LDS_BARRIER();
#pragma unroll 1
    for (int q = 0; q < 4; ++q) {
        const int t = wave * 4 + q, dir = t >> 4, hh = (t >> 2) & 3, pt = (t >> 1) & 1, nt = t & 1;
        f32x16 acc = {};
        acc = mma32<64>(XwT + (dir * 256 + hh * 64 + pt * 32) * 72, 72, BT + ((hh >> 1) * 64 + nt * 32) * 72, 72, acc, r32, hi);
        bf16_t* dst = p.ssd_st + ((size_t)(ch * 2 + dir) * 4 + hh) * 4096 + nt * 32 + r32;
#pragma unroll
        for (int r = 0; r < 16; ++r) dst[(pt * 32 + crow(r, hi)) * 64] = (bf16_t)f2bf(acc[r]);
    }
    LDS_BARRIER();
    }
    if (sect & 12) {
    float* gkd = (float*)lds; float* bendl = (float*)(lds + 33792); bf16_t* KeT = (bf16_t*)(lds + 34816); bf16_t* VT = (bf16_t*)(lds + 71680);
    u32x4 vpk[4], kpk[2], cd[2][2];
    const bf16_t* rowp = p.proj + (size_t)(row0 + lane) * INWP;
#pragma unroll
    for (int it = 0; it < 4; ++it) vpk[it] = *(const u32x4*)(rowp + C_GV + (wave + 8 * it) * 8);
#pragma unroll
    for (int it = 0; it < 2; ++it) kpk[it] = *(const u32x4*)(rowp + C_GK + (wave + 8 * it) * 8);
    { const bf16_t* cpp = p.proj + (size_t)(row0 + (tid >> 3)) * INWP + C_CODE;
#pragma unroll
      for (int d = 0; d < 2; ++d) { cd[d][0] = *(const u32x4*)(cpp + d * 16); cd[d][1] = *(const u32x4*)(cpp + d * 16 + 8); } }
#pragma unroll
    for (int it = 0; it < 4; ++it) { const int vg = wave + 8 * it; const unsigned wv[4] = {vpk[it].x, vpk[it].y, vpk[it].z, vpk[it].w};
#pragma unroll
        for (int e = 0; e < 8; ++e) VT[(vg * 8 + e) * 72 + lane] = (bf16_t)((wv[e >> 1] >> ((e & 1) * 16)) & 0xffffu); }
    float* upl = (float*)(lds + 108544); float* gbl = upl + 4096;
    { *(f32x4*)(upl + tid * 4) = *(const f32x4*)(p.gkup + tid * 4); *(f32x4*)(upl + 2048 + tid * 4) = *(const f32x4*)(p.gkup + 2048 + tid * 4);
      if (tid < 64) *(f32x4*)(gbl + tid * 4) = *(const f32x4*)(p.gkb + tid * 4); }
    LDS_BARRIER();
#pragma unroll
    for (int dir = 0; dir < 2; ++dir) {
        if (!(sect & (4 << dir))) continue;
        { const int tok = tid >> 3, s8 = tid & 7, c0 = s8 * 16;
          float code[16]; { float t8[8]; unpack8(cd[dir][0], t8);
#pragma unroll
              for (int e = 0; e < 8; ++e) code[e] = t8[e];
              unpack8(cd[dir][1], t8);
#pragma unroll
              for (int e = 0; e < 8; ++e) code[8 + e] = t8[e]; }
          const float* up = upl + dir * 16 * 128 + c0; const float* gb = gbl + dir * 128 + c0;
#pragma unroll 1
          for (int q = 0; q < 4; ++q) { f32x4 a = *(const f32x4*)(gb + 4 * q); f32x4 w[16];
#pragma unroll
              for (int r = 0; r < 16; ++r) w[r] = *(const f32x4*)(up + r * 128 + 4 * q);
              __builtin_amdgcn_sched_barrier(0);
#pragma unroll
              for (int r = 0; r < 16; ++r) a += w[r] * code[r];
              f32x4 o; o.x = logsigmoidf(a.x) * 0.0625f; o.y = logsigmoidf(a.y) * 0.0625f; o.z = logsigmoidf(a.z) * 0.0625f; o.w = logsigmoidf(a.w) * 0.0625f;
              *(f32x4*)(gkd + tok * 132 + c0 + 4 * q) = o; } }
        LDS_BARRIER();
#pragma unroll 4
        for (int q = 0; q < 16; ++q) { const int c = wave * 16 + q; const float acc = wave_scan(gkd[lane * 132 + c], lane, dir != 0);
            gkd[lane * 132 + c] = acc; if (lane == (dir ? 0 : 63)) { bendl[c] = acc; p.cdg[ch * 256 + dir * 128 + c] = __expf(acc); } }
        LDS_BARRIER();
        for (int it = 0; it < 4; ++it) { const int idx = tid + 512 * it, tok = idx >> 5, q4 = idx & 31;
            *(f32x4*)(p.gkv + (size_t)(row0 + tok) * 256 + dir * 128 + q4 * 4) = *(const f32x4*)(gkd + tok * 132 + q4 * 4); }
#pragma unroll
        for (int it = 0; it < 2; ++it) { const int kg = wave + 8 * it;
            float kv[8]; unpack8(kpk[it], kv);
            const f32x4 b0 = *(const f32x4*)(gkd + lane * 132 + kg * 8), b1 = *(const f32x4*)(gkd + lane * 132 + kg * 8 + 4);
            const f32x4 e0 = *(const f32x4*)(bendl + kg * 8), e1 = *(const f32x4*)(bendl + kg * 8 + 4);
            const float bb[8] = {b0.x, b0.y, b0.z, b0.w, b1.x, b1.y, b1.z, b1.w}, be[8] = {e0.x, e0.y, e0.z, e0.w, e1.x, e1.y, e1.z, e1.w};
#pragma unroll
            for (int e = 0; e < 8; ++e) KeT[(dir * 128 + kg * 8 + e) * 72 + lane] = (bf16_t)f2bf(kv[e] * __expf(be[e] - bb[e])); }
        LDS_BARRIER();
    }
#pragma unroll 1
    for (int q = 0; q < 2; ++q) {
        const int t = wave * 2 + q, dir = t >> 3, hh = (t >> 1) & 3, vt = t & 1;
        if (!(sect & (4 << dir))) continue;
        f32x16 acc = {};
        acc = mma32<64>(VT + (hh * 64 + vt * 32) * 72, 72, KeT + (dir * 128 + hh * 32) * 72, 72, acc, r32, hi);
        bf16_t* dst = p.gla_st + ((size_t)(ch * 2 + dir) * 4 + hh) * 2048 + r32;
#pragma unroll
        for (int r = 0; r < 16; ++r) dst[(vt * 32 + crow(r, hi)) * 32] = (bf16_t)f2bf(acc[r]);
    }
    LDS_BARRIER();
    }
}

__device__ __forceinline__ void scan_phase(const P& p, int bx) {
    const int tid = fresh_tid();
    if (tid >= 384) return;
    const int e0 = bx * 384 + tid; const bool ssd = e0 < 65536; const int e = ssd ? e0 : e0 - 65536;
    const int b = ssd ? e >> 15 : e >> 14, dir = ssd ? (e >> 14) & 1 : (e >> 13) & 1, hh = ssd ? (e >> 12) & 3 : (e >> 11) & 3, el = ssd ? e & 4095 : e & 2047;
    const bf16_t* st = ssd ? p.ssd_st : p.gla_st; bf16_t* ho = ssd ? p.hins : p.hing; const int esz = ssd ? 4096 : 2048;
    const float* dcp = ssd ? p.cds + dir * 4 + hh : p.cdg + dir * 128 + hh * 32 + (el & 31); const int dst = ssd ? 8 : 256;
    float hst = 0.f;
#pragma unroll 1
    for (int kb = 0; kb < 132; kb += 22) {
        float sv[22], dv[22]; int ci[22];
#pragma unroll
        for (int u = 0; u < 22; ++u) { const int k = kb + u; ci[u] = k < 4 ? 256 + 4 * b + (dir ? 3 - k : k) : 128 * b + (dir ? 127 - (k - 4) : (k - 4));
            sv[u] = bf2f(st[((size_t)(ci[u] * 2 + dir) * 4 + hh) * esz + el]); dv[u] = dcp[ci[u] * dst]; }
#pragma unroll
        for (int u = 0; u < 22; ++u) { ho[((size_t)(ci[u] * 2 + dir) * 4 + hh) * esz + el] = (bf16_t)f2bf(hst); hst = hst * dv[u] + sv[u]; }
    }
}

__device__ __forceinline__ void finish_chunk(const P& p, int ch, unsigned char* lds, int sect) {
    const int tid = fresh_tid(), lane = tid & 63, wave = __builtin_amdgcn_readfirstlane(tid >> 6), r32 = lane & 31, hi = lane >> 5;
    const int row0 = ch * 64;
    float* cml = (float*)lds; float* dtl = cml + 512; float* psum = dtl + 512;
    const float cm0_ = p.cumv[(size_t)row0 * 8 + tid], dt0_ = p.dtv[(size_t)row0 * 8 + tid]; bool first_ = true;
    bf16_t* Cn = (bf16_t*)(lds + 8192); bf16_t* Bn = (bf16_t*)(lds + 17408); bf16_t* XT = (bf16_t*)(lds + 26624); bf16_t* Mb = (bf16_t*)(lds + 45056); bf16_t* hin = (bf16_t*)(lds + 63488); bf16_t* Zs = (bf16_t*)(lds + 100352);
    const int hl = wave >> 2, rt = (wave >> 1) & 1, ct = wave & 1;
#pragma unroll 1
    for (int g = 0; g < 2; ++g) {
        if (!(sect & (1 << g))) continue;
        { u32x4 sA[2], sZ[2], sX[2], sH[4];
#pragma unroll
          for (int it = 0; it < 2; ++it) { const int idx = tid + 512 * it, arr = idx >> 9, r = idx & 511, tok = r >> 3, pc = r & 7;
              sA[it] = *(const u32x4*)(p.xbcs + (size_t)(row0 + tok) * 512 + (arr ? 384 : 256) + g * 64 + pc * 8); }
#pragma unroll
          for (int it = 0; it < 2; ++it) { const int idx = tid + 512 * it, tok = idx >> 4, pc = idx & 15;
              sZ[it] = *(const u32x4*)(p.proj + (size_t)(row0 + tok) * INWP + C_Z + g * 128 + pc * 8); }
#pragma unroll
          for (int it = 0; it < 2; ++it) { const int idx = tid + 512 * it, tok = idx & 63, cg = idx >> 6;
              sX[it] = *(const u32x4*)(p.xbcs + (size_t)(row0 + tok) * 512 + g * 128 + cg * 8); }
#pragma unroll
          for (int it = 0; it < 4; ++it) { const int idx = tid + 512 * it, dq = idx >> 9, r = idx & 511, pp = r >> 3, q8 = r & 7;
              sH[it] = *(const u32x4*)(p.hins + ((size_t)(ch * 2 + (dq >> 1)) * 4 + 2 * g + (dq & 1)) * 4096 + pp * 64 + q8 * 8); }
          __builtin_amdgcn_sched_barrier(0);
          if (first_) { cml[tid] = cm0_; dtl[tid] = dt0_; first_ = false; }
#pragma unroll
          for (int it = 0; it < 2; ++it) { const int idx = tid + 512 * it, arr = idx >> 9, r = idx & 511, tok = r >> 3, pc = r & 7;
              *(u32x4*)((arr ? Cn : Bn) + tok * 72 + pc * 8) = sA[it]; }
#pragma unroll
          for (int it = 0; it < 2; ++it) { const int idx = tid + 512 * it, tok = idx >> 4, pc = idx & 15;
              *(u32x4*)(Zs + tok * 136 + pc * 8) = sZ[it]; }
#pragma unroll
          for (int it = 0; it < 2; ++it) { const int idx = tid + 512 * it, tok = idx & 63, cg = idx >> 6;
              const u32x4 pk = sX[it]; const unsigned wv[4] = {pk.x, pk.y, pk.z, pk.w};
#pragma unroll
              for (int e = 0; e < 8; ++e) XT[(cg * 8 + e) * 72 + tok] = (bf16_t)((wv[e >> 1] >> ((e & 1) * 16)) & 0xffffu); }
#pragma unroll
          for (int it = 0; it < 4; ++it) { const int idx = tid + 512 * it, dq = idx >> 9, r = idx & 511, pp = r >> 3, q8 = r & 7;
              *(u32x4*)(hin + (dq * 64 + pp) * 72 + q8 * 8) = sH[it]; } }
        LDS_BARRIER();
        const int hh = 2 * g + hl;
        { f32x16 acc = {}; acc = mma32<64>(Cn + rt * 32 * 72, 72, Bn + ct * 32 * 72, 72, acc, r32, hi);
          const int j = ct * 32 + r32; const float cfj = cml[j * 8 + hh], cbj = cml[j * 8 + 4 + hh], dfj = dtl[j * 8 + hh], dbj = dtl[j * 8 + 4 + hh];
#pragma unroll
          for (int r = 0; r < 16; ++r) { const int i = rt * 32 + crow(r, hi); const float cfi = cml[i * 8 + hh], cbi = cml[i * 8 + 4 + hh];
              const float lf = (j <= i) ? __expf(cfi - cfj) * dfj : 0.f, lb = (j >= i) ? __expf(cbi - cbj) * dbj : 0.f;
              Mb[(hl * 64 + i) * 72 + j] = (bf16_t)f2bf(acc[r] * (lf + lb)); } }
        LDS_BARRIER();
        { const int c = hh * 64 + ct * 32 + r32; const float dsk = p.ssdd[hh], wn = p.ssdnw[c];
          f32x16 y;
          { f32x16 t = {}; t = mma32<64>(Cn + rt * 32 * 72, 72, hin + ((0 * 2 + hl) * 64 + ct * 32) * 72, 72, t, r32, hi);
#pragma unroll
            for (int r = 0; r < 16; ++r) y[r] = __expf(cml[(rt * 32 + crow(r, hi)) * 8 + hh]) * t[r]; }
          { f32x16 t = {}; t = mma32<64>(Cn + rt * 32 * 72, 72, hin + ((1 * 2 + hl) * 64 + ct * 32) * 72, 72, t, r32, hi);
#pragma unroll
            for (int r = 0; r < 16; ++r) y[r] += __expf(cml[(rt * 32 + crow(r, hi)) * 8 + 4 + hh]) * t[r]; }
          y = mma32<64>(Mb + (hl * 64 + rt * 32) * 72, 72, XT + (hl * 64 + ct * 32) * 72, 72, y, r32, hi);
          const bf16_t* xcol = XT + (hl * 64 + ct * 32 + r32) * 72;
          bf16_t* zcol = Zs + hl * 64 + ct * 32 + r32;
#pragma unroll
          for (int r = 0; r < 16; ++r) { const int i = rt * 32 + crow(r, hi);
              y[r] = (y[r] + dsk * bf2f(xcol[i])) * siluf(bf2f(zcol[i * 136]));
              const float s = sum32(y[r] * y[r]); if (r32 == 0) psum[i * 8 + hl * 2 + ct] = s; }
          LDS_BARRIER();
#pragma unroll
          for (int r = 0; r < 16; ++r) { const int i = rt * 32 + crow(r, hi);
              const float rn = rsqrtf(((psum[i * 8] + psum[i * 8 + 1]) + (psum[i * 8 + 2] + psum[i * 8 + 3])) * (1.0f / 128.0f) + EPS);
              zcol[i * 136] = (bf16_t)f2bf(y[r] * rn * wn); } }
        LDS_BARRIER();
        for (int it = 0; it < 2; ++it) { const int idx = tid + 512 * it, tok = idx >> 4, pc = idx & 15;
            *(u32x4*)(p.mix + (size_t)(row0 + tok) * DM + 512 + g * 128 + pc * 8) = *(const u32x4*)(Zs + tok * 136 + pc * 8); }
        LDS_BARRIER();
    }
    float* bfl = (float*)lds; bf16_t* att = (bf16_t*)lds; float* psg = (float*)(lds + 34816);
    bf16_t* Qf = (bf16_t*)(lds + 36864); bf16_t* Kf = (bf16_t*)(lds + 57344); bf16_t* VTg = (bf16_t*)(lds + 77824); bf16_t* hing = (bf16_t*)(lds + 96256);
#pragma unroll 1
    for (int hp = 0; hp < 2; ++hp) {
        if (!(sect & (4 << hp))) continue;
        u32x4 qk4[4];
        { f32x4 sB[4]; u32x4 sV[2], sH[2];
#pragma unroll
          for (int it = 0; it < 4; ++it) { const int idx = tid + 512 * it, tok = idx >> 5, r = idx & 31, dir = r >> 4, q4 = r & 15;
              sB[it] = *(const f32x4*)(p.gkv + (size_t)(row0 + tok) * 256 + dir * 128 + hp * 64 + q4 * 4); }
#pragma unroll
          for (int it = 0; it < 2; ++it) { const int idx = tid + 512 * it, tok = idx & 63, vg = idx >> 6;
              sV[it] = *(const u32x4*)(p.proj + (size_t)(row0 + tok) * INWP + C_GV + hp * 128 + vg * 8); }
#pragma unroll
          for (int it = 0; it < 2; ++it) { const int idx = tid + 512 * it, dq = idx >> 8, r = idx & 255, vv = r >> 2, q8 = r & 3;
              sH[it] = *(const u32x4*)(p.hing + ((size_t)(ch * 2 + (dq >> 1)) * 4 + 2 * hp + (dq & 1)) * 2048 + vv * 32 + q8 * 8); }
          { const int tok = tid >> 3, s_ = tid & 7, h2 = (s_ >> 1) & 1, half = s_ & 1; const size_t row = (size_t)(row0 + tok); const int hcol = (2 * hp + h2) * 32 + half * 16;
            qk4[0] = *(const u32x4*)(p.proj + row * INWP + C_GQ + hcol); qk4[1] = *(const u32x4*)(p.proj + row * INWP + C_GQ + hcol + 8);
            qk4[2] = *(const u32x4*)(p.proj + row * INWP + C_GK + hcol); qk4[3] = *(const u32x4*)(p.proj + row * INWP + C_GK + hcol + 8); }
          __builtin_amdgcn_sched_barrier(0);
#pragma unroll
          for (int it = 0; it < 4; ++it) { const int idx = tid + 512 * it, tok = idx >> 5, r = idx & 31, dir = r >> 4, q4 = r & 15;
              *(f32x4*)(bfl + tok * 132 + dir * 64 + q4 * 4) = sB[it]; }
#pragma unroll
          for (int it = 0; it < 2; ++it) { const int idx = tid + 512 * it, tok = idx & 63, vg = idx >> 6;
              const u32x4 pk = sV[it]; const unsigned wv[4] = {pk.x, pk.y, pk.z, pk.w};
#pragma unroll
              for (int e = 0; e < 8; ++e) VTg[(vg * 8 + e) * 72 + tok] = (bf16_t)((wv[e >> 1] >> ((e & 1) * 16)) & 0xffffu); }
#pragma unroll
          for (int it = 0; it < 2; ++it) { const int idx = tid + 512 * it, dq = idx >> 8, r = idx & 255, vv = r >> 2, q8 = r & 3;
              *(u32x4*)(hing + (dq * 64 + vv) * 40 + q8 * 8) = sH[it]; } }
        LDS_BARRIER();
        { const int tok = tid >> 3, s = tid & 7, dir = s >> 2, h2 = (s >> 1) & 1, half = s & 1;
          float qv[16], kv[16];
          { float t8[8]; unpack8(qk4[0], t8);
#pragma unroll
            for (int e = 0; e < 8; ++e) qv[e] = t8[e];
            unpack8(qk4[1], t8);
#pragma unroll
            for (int e = 0; e < 8; ++e) qv[8 + e] = t8[e];
            unpack8(qk4[2], t8);
#pragma unroll
            for (int e = 0; e < 8; ++e) kv[e] = t8[e];
            unpack8(qk4[3], t8);
#pragma unroll
            for (int e = 0; e < 8; ++e) kv[8 + e] = t8[e]; }
          const float* bp = bfl + tok * 132 + dir * 64 + h2 * 32 + half * 16;
          float oq[16], ok[16];
#pragma unroll
          for (int q = 0; q < 4; ++q) { const f32x4 bv = *(const f32x4*)(bp + 4 * q); const float bb[4] = {bv.x, bv.y, bv.z, bv.w};
#pragma unroll
              for (int e = 0; e < 4; ++e) { const float ex = __expf(bb[e]), exi = __expf(-bb[e]); oq[q * 4 + e] = qv[q * 4 + e] * ex * 0.17677669529663687f; ok[q * 4 + e] = kv[q * 4 + e] * exi; } }
          bf16_t* qd = Qf + ((dir * 2 + h2) * 64 + tok) * 40 + half * 16; bf16_t* kd = Kf + ((dir * 2 + h2) * 64 + tok) * 40 + half * 16;
          u32x4 w; w.x = pk2(oq[0], oq[1]); w.y = pk2(oq[2], oq[3]); w.z = pk2(oq[4], oq[5]); w.w = pk2(oq[6], oq[7]); *(u32x4*)qd = w;
          w.x = pk2(oq[8], oq[9]); w.y = pk2(oq[10], oq[11]); w.z = pk2(oq[12], oq[13]); w.w = pk2(oq[14], oq[15]); *(u32x4*)(qd + 8) = w;
          w.x = pk2(ok[0], ok[1]); w.y = pk2(ok[2], ok[3]); w.z = pk2(ok[4], ok[5]); w.w = pk2(ok[6], ok[7]); *(u32x4*)kd = w;
          w.x = pk2(ok[8], ok[9]); w.y = pk2(ok[10], ok[11]); w.z = pk2(ok[12], ok[13]); w.w = pk2(ok[14], ok[15]); *(u32x4*)(kd + 8) = w; }
        LDS_BARRIER();
        { f32x16 af = {}, ab = {};
          af = mma32<32>(Qf + ((0 * 2 + hl) * 64 + rt * 32) * 40, 40, Kf + ((0 * 2 + hl) * 64 + ct * 32) * 40, 40, af, r32, hi);
          ab = mma32<32>(Qf + ((1 * 2 + hl) * 64 + rt * 32) * 40, 40, Kf + ((1 * 2 + hl) * 64 + ct * 32) * 40, 40, ab, r32, hi);
          const int j = ct * 32 + r32;
#pragma unroll
          for (int r = 0; r < 16; ++r) { const int i = rt * 32 + crow(r, hi);
              att[(hl * 64 + i) * 72 + j] = (bf16_t)f2bf(((j <= i) ? af[r] : 0.f) + ((j >= i) ? ab[r] : 0.f)); } }
        LDS_BARRIER();
        { f32x16 acc = {};
          bf16_t ggr[16];
          { const int c_ = (2 * hp + hl) * 64 + ct * 32 + r32;
#pragma unroll
            for (int r = 0; r < 16; ++r) ggr[r] = p.proj[(size_t)(row0 + rt * 32 + crow(r, hi)) * INWP + C_GG + c_]; }
          acc = mma32<64>(att + (hl * 64 + rt * 32) * 72, 72, VTg + (hl * 64 + ct * 32) * 72, 72, acc, r32, hi);
          acc = mma32<32>(Qf + ((0 * 2 + hl) * 64 + rt * 32) * 40, 40, hing + ((0 * 2 + hl) * 64 + ct * 32) * 40, 40, acc, r32, hi);
          acc = mma32<32>(Qf + ((1 * 2 + hl) * 64 + rt * 32) * 40, 40, hing + ((1 * 2 + hl) * 64 + ct * 32) * 40, 40, acc, r32, hi);
          const int hh = 2 * hp + hl, v = ct * 32 + r32, c = hh * 64 + v; const float wn = p.glanw[v];
#pragma unroll
          for (int r = 0; r < 16; ++r) { const int i = rt * 32 + crow(r, hi); const float s = sum32(acc[r] * acc[r]); if (r32 == 0) psg[i * 4 + hl * 2 + ct] = s; }
          LDS_BARRIER();
#pragma unroll
          for (int r = 0; r < 16; ++r) { const int i = rt * 32 + crow(r, hi); const size_t row = (size_t)(row0 + i);
              const float rn = rsqrtf((psg[i * 4 + hl * 2] + psg[i * 4 + hl * 2 + 1]) * (1.0f / 64.0f) + EPS);
              const float gg = bf2f(ggr[r]);
              p.mix[row * DM + 768 + c] = (bf16_t)f2bf(acc[r] * rn * wn * siluf(gg)); } }
        LDS_BARRIER();
    }
}
}

#define XB_TMO      128
#define XB_XCNT(j)  (256  + 64 * (j))
#define XB_XSUB(j)  (1280 + 64 * (j))
#define XB_XGEN(j)  (2304 + 64 * (j))
#define XB_TOP      3328
#define XB_TOPGEN   3392
#define XCD_BAR_WORDS 3456
#define XB_SPIN_CAP (1u << 20)
__device__ __forceinline__ unsigned xb_ld(unsigned* p)              { return __hip_atomic_load(p, __ATOMIC_RELAXED, __HIP_MEMORY_SCOPE_AGENT); }
__device__ __forceinline__ unsigned xb_add(unsigned* p, unsigned v) { return __hip_atomic_fetch_add(p, v, __ATOMIC_RELAXED, __HIP_MEMORY_SCOPE_AGENT); }
__device__ __forceinline__ unsigned xb_xcc_id() { return (unsigned)__builtin_amdgcn_s_getreg((3 << 11) | 20) & 0xFu; }
#define XB_SPIN(cond, bar) do { unsigned _sp = 0; while (cond) { __builtin_amdgcn_s_sleep(1); \
    if ((++_sp & 255u) == 0u) { if (xb_ld(&(bar)[XB_TMO])) break; if (_sp > XB_SPIN_CAP) { atomicAdd(&(bar)[XB_TMO], 1u); break; } } } } while (0)
struct XcdBarrier { unsigned* bar; unsigned x; volatile LAS unsigned* st; };
__device__ __forceinline__ XcdBarrier xcd_barrier_post(unsigned* bar, volatile LAS unsigned* st) {
    XcdBarrier b; b.bar = bar; b.x = xb_xcc_id(); b.st = st;
    if (threadIdx.x == 0) (void)xb_add(&bar[XB_XCNT(b.x)], 1u);
    return b;
}
__device__ __forceinline__ void xcd_barrier_complete(unsigned* bar, unsigned x, unsigned& nloc, unsigned& nx) {
    const unsigned G = gridDim.x * gridDim.y * gridDim.z;
    unsigned sum, cnt, mine, sp = 0u;
    for (;;) {
        sum = 0u; cnt = 0u; mine = 0u;
#pragma unroll
        for (unsigned j = 0; j < 16; ++j) { const unsigned c = xb_ld(&bar[XB_XCNT(j)]); sum += c; cnt += (c > 0u) ? 1u : 0u; mine = (j == x) ? c : mine; }
        if (sum == G) break;
        __builtin_amdgcn_s_sleep(1);
        if ((++sp & 255u) == 0u) { if (xb_ld(&bar[XB_TMO])) break; if (sp > XB_SPIN_CAP) { atomicAdd(&bar[XB_TMO], 1u); break; } }
    }
    nloc = mine > 0u ? mine : 1u; nx = cnt > 0u ? cnt : 1u;
}
__device__ __forceinline__ void xcd_barrier(const XcdBarrier& b) {
    asm volatile("s_waitcnt vmcnt(0)" ::: "memory");
    __syncthreads();
    if (threadIdx.x == 0) {
        GAS unsigned* barg_ = (GAS unsigned*)b.bar; asm volatile("" : "+s"(barg_)); unsigned* bar = (unsigned*)barg_;
        __builtin_amdgcn_s_waitcnt(0);
        unsigned nloc = b.st[0], nx = b.st[1];
        if (nloc == 0u) { xcd_barrier_complete(bar, b.x, nloc, nx); b.st[0] = nloc; b.st[1] = nx; }
        const unsigned old = xb_add(&bar[XB_XSUB(b.x)], 1u);
        const unsigned gen = old / nloc;
        if (old + 1u == (gen + 1u) * nloc) {
            __builtin_amdgcn_fence(__ATOMIC_RELEASE, "agent");
            asm volatile("s_waitcnt vmcnt(0)" ::: "memory");
            const unsigned og = xb_add(&bar[XB_TOP], 1u);
            const unsigned tg = og / nx;
            if (og + 1u == (tg + 1u) * nx) xb_add(&bar[XB_TOPGEN], 1u);
            else XB_SPIN(xb_ld(&bar[XB_TOPGEN]) == tg, bar);
            __builtin_amdgcn_fence(__ATOMIC_ACQUIRE, "agent");
            xb_add(&bar[XB_XGEN(b.x)], 1u);
            asm volatile("s_waitcnt vmcnt(0)" ::: "memory");
        } else {
            XB_SPIN(xb_ld(&bar[XB_XGEN(b.x)]) == gen, bar);
            __builtin_amdgcn_fence(__ATOMIC_ACQUIRE, "agent");
            asm volatile("s_waitcnt vmcnt(0)" ::: "memory");
        }
    }
    __syncthreads();
}

struct Args { const float* in[28]; float* out; unsigned char* ws; int ph_lo, ph_hi; };
enum { I_X = 0, I_C, I_CTX, I_CCTX, I_WADA, I_BADA, I_N1W, I_WIN, I_DALAM, I_SUBW, I_CONVW, I_CONVB, I_ALOG, I_DTB, I_SSDD, I_SSDNW, I_GKUP, I_GKB, I_GLANW, I_WOUT, I_N2W,
       I_WR, I_BR, I_WGU, I_BGU, I_WDN, I_BDN, I_FNW };

__device__ __forceinline__ void transpose_item(const float* __restrict__ W, int K, int Nsrc, bf16_t* __restrict__ WT, int n0, int dst_row0, int k0, unsigned* scr, int lane) {
    const bool ok = (n0 + lane) < Nsrc; const float* src = W + (size_t)k0 * Nsrc + n0 + lane;
#pragma unroll
    for (int hb = 0; hb < 2; ++hb) { float v[32];
#pragma unroll
        for (int i = 0; i < 32; ++i) v[i] = ok ? __builtin_nontemporal_load(src + (size_t)(hb * 32 + i) * Nsrc) : 0.f;
#pragma unroll
        for (int i = 0; i < 16; ++i) scr[lane * 33 + hb * 16 + i] = pk2(v[2 * i], v[2 * i + 1]); }
    LDS_WAIT();
    const int c = lane & 7;
#pragma unroll
    for (int j = 0; j < 8; ++j) { const int nn = (lane >> 3) + 8 * j; const unsigned* t = scr + nn * 33 + 4 * c;
        u32x4 o; o.x = t[0]; o.y = t[1]; o.z = t[2]; o.w = t[3];
        __builtin_nontemporal_store(o, (u32x4*)(WT + (size_t)(dst_row0 + nn) * K + k0 + 8 * c)); }
    LDS_WAIT();
}

__device__ __forceinline__ void norm_mod_store(const f32x4 (&v)[4], const float* __restrict__ nw, const float* __restrict__ sh, const float* __restrict__ sc, bf16_t* __restrict__ orow, int lane) {
    float ss = 0.f;
#pragma unroll
    for (int j = 0; j < 4; ++j) ss += (v[j].x * v[j].x + v[j].y * v[j].y) + (v[j].z * v[j].z + v[j].w * v[j].w);
    const float r = rsqrtf(wave_sum(ss) * (1.0f / DM) + EPS);
#pragma unroll
    for (int j = 0; j < 4; ++j) { const int c = 4 * lane + 256 * j;
        const f32x4 w = *(const f32x4*)(nw + c), a = *(const f32x4*)(sc + c), b = *(const f32x4*)(sh + c);
        const f32x4 y = (v[j] * r) * w * (a + 1.0f) + b;
        u32x2 o; o.x = pk2(y.x, y.y); o.y = pk2(y.z, y.w); *(u32x2*)(orow + c) = o; }
}

__device__ __forceinline__ int moe_tables(const unsigned* cnt, int* tile_e, int* pstart, int* cntl) {
    const int t = fresh_tid();
    if (t < NE) { int c = (int)cnt[t]; if (c > LISTCAP) c = LISTCAP; cntl[t] = c; }
    __syncthreads();
    if (t <= NE) { int acc = 0; for (int e = 0; e < t; ++e) acc += ((cntl[e] + 255) >> 8) << 8; pstart[t] = acc;
        if (t < NE) { const int nt = (cntl[t] + 255) >> 8; for (int q = 0; q < nt; ++q) tile_e[(acc >> 8) + q] = t; } }
    __syncthreads();
    return __builtin_amdgcn_readfirstlane(pstart[NE] >> 8);
}

__device__ __forceinline__ const float* inp_ptr(const unsigned char* ldsl, int i) {
    const unsigned long long v = ((const unsigned long long*)(ldsl + PTAB_OFF))[i];
    const unsigned lo = __builtin_amdgcn_readfirstlane((unsigned)v), hi = __builtin_amdgcn_readfirstlane((unsigned)(v >> 32));
    return (const float*)(const GAS float*)(((unsigned long long)hi << 32) | lo);
}

__device__ __forceinline__ void titem_load(f32x4 (&v)[16], const float* mbase, unsigned off, int pitchB, int lane) {
    const __amdgpu_buffer_rsrc_t rs = __builtin_amdgcn_make_buffer_rsrc((void*)mbase, 0, 0x7fffffff, 0x00020000);
    const int vo = (lane >> 4) * 2 * pitchB + (lane & 15) * 16;
#pragma unroll
    for (int i = 0; i < 16; ++i) v[i] = __builtin_bit_cast(f32x4, __builtin_amdgcn_raw_buffer_load_b128(rs, vo, (int)off + ((i >> 1) * 8 + (i & 1)) * pitchB, 2));
}
__device__ __forceinline__ void titem_store(const f32x4 (&v)[16], bf16_t* __restrict__ dst, unsigned* scr, int lane) {
    { unsigned* wp = scr + (lane & 15) * 4 * 33 + (lane >> 4);
#pragma unroll
      for (int i = 0; i < 8; ++i)
#pragma unroll
          for (int nn = 0; nn < 4; ++nn) wp[nn * 33 + 4 * i] = pk2(v[2 * i][nn], v[2 * i + 1][nn]); }
    LDS_WAIT();
    const int c = lane & 7;
#pragma unroll
    for (int j = 0; j < 8; ++j) { const int nn = (lane >> 3) + 8 * j; const unsigned* t = scr + nn * 33 + 4 * c;
        u32x4 o; o.x = t[0]; o.y = t[1]; o.z = t[2]; o.w = t[3];
        __builtin_nontemporal_store(o, (u32x4*)(dst + (size_t)nn * DM + 8 * c)); }
    LDS_WAIT();
}
__device__ __forceinline__ void moe_item(int it, int l, const float* wgu, const float* wdn, bf16_t* bgu, bf16_t* bdn, const float*& mbase, unsigned& off, int& pitchB, bf16_t*& dst) {
    constexpr int I_GU = 16 * 32, I_DN = 16 * 16, N_GU = 32 * I_GU;
    if (it < N_GU) { const int e = it / I_GU, r = it % I_GU, kb = r / 32, n0 = (r % 32) * 64;
        const int drow = n0 < 1024 ? (n0 >> 7) * 256 + (n0 & 127) : ((n0 - 1024) >> 7) * 256 + 128 + ((n0 - 1024) & 127);
        mbase = wgu + (size_t)l * NE * DM * 2048; off = (unsigned)((e * DM + kb * 64) * 2048 + n0) * 4u; pitchB = 2048 * 4;
        dst = bgu + (size_t)(l * NE + e) * 2048 * DM + (size_t)drow * DM + kb * 64; }
    else { const int q = it - N_GU, e = q / I_DN, r = q % I_DN, kb = r / 16, n0 = (r % 16) * 64;
        mbase = wdn + (size_t)l * NE * DE * DM; off = (unsigned)((e * DE + kb * 64) * DM + n0) * 4u; pitchB = DM * 4;
        dst = bdn + (size_t)(l * NE + e) * DM * DE + (size_t)n0 * DE + kb * 64; }
}

__device__ __forceinline__ void ctx_outproj_block(const bf16_t* __restrict__ mixc, const bf16_t* __restrict__ wout, const float* __restrict__ base, bf16_t* __restrict__ out,
                                                  const float* __restrict__ gate, int blk, unsigned char* lds) {
    const int tid = fresh_tid(), lane = tid & 63, wave = __builtin_amdgcn_readfirstlane(tid >> 6), r32 = lane & 31, hi = lane >> 5;
    const int rb = blk >> 4, cb = blk & 15;
    const bf16_t* Ap = mixc + (size_t)(rb * 32 + r32) * DM + wave * 128 + 8 * hi;
    const bf16_t* Bp = wout + (size_t)(cb * 64 + r32) * DM + wave * 128 + 8 * hi;
    bf16x8 af[8], b0f[8], b1f[8];
#pragma unroll
    for (int ks = 0; ks < 8; ++ks) { af[ks] = *(const bf16x8*)(Ap + ks * 16); b0f[ks] = *(const bf16x8*)(Bp + ks * 16); b1f[ks] = *(const bf16x8*)(Bp + (size_t)32 * DM + ks * 16); }
    f32x16 a0 = {}, a1 = {};
#pragma unroll
    for (int ks = 0; ks < 8; ++ks) { a0 = __builtin_amdgcn_mfma_f32_32x32x16_bf16(af[ks], b0f[ks], a0, 0, 0, 0); a1 = __builtin_amdgcn_mfma_f32_32x32x16_bf16(af[ks], b1f[ks], a1, 0, 0, 0); }
    float* red = (float*)lds;
#pragma unroll
    for (int r = 0; r < 16; ++r) { red[((wave * 2 + 0) * 16 + r) * 64 + lane] = a0[r]; red[((wave * 2 + 1) * 16 + r) * 64 + lane] = a1[r]; }
    __syncthreads();
#pragma unroll
    for (int q = 0; q < 4; ++q) { const int idx = tid + 512 * q, t = idx >> 10, r = (idx >> 6) & 15, ln = idx & 63; float sum = 0.f;
#pragma unroll
        for (int w = 0; w < 8; ++w) sum += red[((w * 2 + t) * 16 + r) * 64 + ln];
        const int row = rb * 32 + (r & 3) + 8 * (r >> 2) + 4 * (ln >> 5), col = cb * 64 + t * 32 + (ln & 31);
        out[(size_t)row * DM + col] = (bf16_t)f2bf(base[(size_t)row * DM + col] + gate[col] * sum); }
    __syncthreads();
}

#ifndef GSPLIT
#define GSPLIT 144
#endif
constexpr int PH_PRO = 0, PH_NORM0 = 1, PH_L0 = 2, NPH_LAYER = 9, NPH = PH_L0 + NLAYER * NPH_LAYER;

__global__ void __launch_bounds__(NWAVES * 64, 2) fwd(Args args) {
    extern __shared__ __attribute__((aligned(16))) unsigned char lds[];
    const int G = gridDim.x, bx = blockIdx.x;
    const int vcu = (G % 8 == 0) ? (bx % 8) * (G / 8) + bx / 8 : bx;
    const int NGW = G * NWAVES;
#define PH_TID() const int tid = fresh_tid(), lane = tid & 63, wave = __builtin_amdgcn_readfirstlane(tid >> 6), gw = vcu * NWAVES + wave; (void)lane; (void)wave; (void)gw; \
    GAS unsigned char* wsg_ = (GAS unsigned char*)ws0; asm volatile("" : "+s"(wsg_)); unsigned char* ws = (unsigned char*)wsg_; \
    LAS const unsigned char* ldl_ = (LAS const unsigned char*)lds; asm volatile("" : "+v"(ldl_)); const unsigned char* ldsl = (const unsigned char*)ldl_
    unsigned char* const ws0 = args.ws;
#define G_ctl   ((unsigned*)(ws + WS_CTL))
#define G_modb  ((float*)(ws + WS_MOD))
#define G_ropet ((f32x2*)(ws + WS_ROPE))
#define G_scal  ((float*)(ws + WS_SCAL))
#define G_wb_in ((bf16_t*)(ws + WS_WIN))
#define G_wb_out ((bf16_t*)(ws + WS_WOUT))
#define G_wb_gu ((bf16_t*)(ws + WS_WGU))
#define G_wb_dn ((bf16_t*)(ws + WS_WDN))
#define G_hbuf  ((bf16_t*)(ws + WS_H))
#define G_proj  ((bf16_t*)(ws + WS_PROJ))
#define G_xbcs  ((bf16_t*)(ws + WS_XBC))
#define G_dtv   ((float*)(ws + WS_DT))
#define G_av    ((float*)(ws + WS_AV))
#define G_gkv   ((float*)(ws + WS_GKV))
#define G_ydir  ((bf16_t*)(ws + WS_YDIR))
#define G_odir  ((bf16_t*)(ws + WS_ODIR))
#define G_mix   ((bf16_t*)(ws + WS_MIX))
#define G_xw    ((bf16_t*)(ws + WS_XW))
#define G_list  ((int*)(ws + WS_LIST))
#define G_gatev ((float*)(ws + WS_GATE))
#define G_actb  ((bf16_t*)(ws + WS_ACT))
#define G_yk    ((bf16_t*)(ws + WS_YK))

    volatile LAS unsigned* MISC = (volatile LAS unsigned*)((LAS unsigned char*)lds + MISC_OFF);
    for (int u = threadIdx.x; u < 64; u += NWAVES * 64) MISC[u] = 0u;
    if (threadIdx.x < 28) ((const float**)(lds + PTAB_OFF))[threadIdx.x] = args.in[threadIdx.x];
#define INP(i) inp_ptr(ldsl, (i))
    __syncthreads();
    const int lo = args.ph_lo, hi = args.ph_hi;
    XcdBarrier bar; bar.bar = (unsigned*)(ws0 + WS_CTL) + CW_BAR; bar.x = 0; bar.st = nullptr;
    if (hi - lo > 1) bar = xcd_barrier_post((unsigned*)(ws0 + WS_CTL) + CW_BAR, MISC + 8);
#ifndef PH_MASK
#define PH_MASK 0xFFF
#endif
#define KIND(k) ((k) < PH_L0 ? (k) : 2 + ((k) - PH_L0) % NPH_LAYER)
#define IN(k) (lo <= (k) && (k) < hi)
#define INK(k, kind) (((PH_MASK >> (kind)) & 1) && IN(k))
#ifndef DUP_MASK
#define DUP_MASK 0
#endif
#define REPS(kind) for (int rep_ = 0; rep_ < 1 + ((DUP_MASK >> (kind)) & 1); ++rep_)
#ifndef BAR_REPS
#define BAR_REPS 1
#endif
#define SEAM(k) do { if (IN(k) && IN((k) + 1)) for (int br_ = 0; br_ < BAR_REPS; ++br_) xcd_barrier(bar); } while (0)

    if (INK(PH_PRO, 0)) REPS(0) { PH_TID();
        unsigned* scr = (unsigned*)(lds + RING_OFF + wave * 16384);
        constexpr int I_IN = 16 * 52, I_OUT = 16 * 16;
        constexpr int N_IN = 2 * I_IN, N_OUT = 2 * I_OUT, NITEMS = N_IN + N_OUT;
        for (int it = gw; it < NITEMS; it += NGW) {
            int r = it;
            if (r < N_IN) { const int l = r / I_IN; r %= I_IN; const int kb = r / 52, nb = r % 52;
                transpose_item(INP(I_WIN) + (size_t)l * DM * INW, DM, INW, G_wb_in + (size_t)l * INWP * DM, nb * 64, nb * 64, kb * 64, scr, lane); continue; }
            r -= N_IN;
            { const int l = r / I_OUT; r %= I_OUT; const int kb = r / 16, nb = r % 16;
                transpose_item(INP(I_WOUT) + (size_t)l * DM * DM, DM, DM, G_wb_out + (size_t)l * DM * DM, nb * 64, nb * 64, kb * 64, scr, lane); }
        }
        __syncthreads();
        for (int it = bx; it < 48; it += G) {
            const int l = it / 24, j0 = (it % 24) * 256;
            float* sc = (float*)(lds + RING_OFF);
            float* red = sc + 3072;
            for (int i = tid; i < 3072; i += 512) { const int v = i >> 10, k = i & 1023; const float cv = v < 2 ? INP(I_C)[v * DM + k] : INP(I_CCTX)[k]; sc[i] = siluf(cv); }
            __syncthreads();
            const int ks = tid >> 6;
            f32x4 a0 = {0.f, 0.f, 0.f, 0.f}, a1 = a0, a2 = a0;
            const float* wp = INP(I_WADA) + (size_t)l * DM * 6144 + j0 + 4 * lane;
            for (int k = ks * 128; k < ks * 128 + 128; ++k) { const f32x4 w = *(const f32x4*)(wp + (size_t)k * 6144); a0 += w * sc[k]; a1 += w * sc[1024 + k]; a2 += w * sc[2048 + k]; }
            *(f32x4*)(red + (ks * 3 + 0) * 256 + 4 * lane) = a0; *(f32x4*)(red + (ks * 3 + 1) * 256 + 4 * lane) = a1; *(f32x4*)(red + (ks * 3 + 2) * 256 + 4 * lane) = a2;
            __syncthreads();
            for (int i = tid; i < 768; i += 512) { const int v = i >> 8, jj = i & 255; float s = INP(I_BADA)[l * 6144 + j0 + jj];
                for (int q = 0; q < 8; ++q) s += red[(q * 3 + v) * 256 + jj];
                G_modb[(size_t)(l * 3 + v) * 6144 + j0 + jj] = s; }
            __syncthreads();
        }
        if (bx == (50 % G) || bx == (51 % G)) { const int l = bx == (50 % G) ? 0 : 1; float* wrt = (float*)(ws + WS_WRT) + l * 32768; const float* wr = INP(I_WR) + (size_t)l * 32768;
            for (int i = tid; i < 32768; i += 512) wrt[(i & 31) * 1024 + (i >> 5)] = wr[i]; }
        if (bx == (48 % G)) {
            for (int i = tid; i < 2048; i += 512) { const int pos = i >> 4, j = i & 15; const float inv = exp2f(-0.25f * (float)j * 3.3219280948873623f);
                const float ang = (float)pos * inv; G_ropet[i] = (f32x2){cosf(ang), sinf(ang)}; }
        }
        if (bx == (49 % G) && tid < NLAYER) {
            const float* lp = INP(I_DALAM) + tid * 256; float s01 = 0.f, s23 = 0.f;
            for (int i = 0; i < 64; ++i) { s01 += lp[i] * lp[64 + i]; s23 += lp[128 + i] * lp[192 + i]; }
            const float li = 0.8f - 0.6f * expf(-0.3f * (float)tid);
            G_scal[tid * 2 + 0] = expf(s01) - expf(s23) + li; G_scal[tid * 2 + 1] = 1.0f - li;
        }
    }
    SEAM(PH_PRO);
    if (INK(PH_NORM0, 1)) { PH_TID();
        for (int row = gw; row < TALL; row += NGW) {
            const int bidx = row < SEQ ? 0 : (row < TLAT ? 1 : 2);
            const float* xr = row < TLAT ? INP(I_X) + (size_t)row * DM : INP(I_CTX) + (size_t)(row - TLAT) * DM;
            f32x4 v[4];
#pragma unroll
            for (int j = 0; j < 4; ++j) v[j] = *(const f32x4*)(xr + 4 * lane + 256 * j);
            const float* mp = G_modb + (size_t)bidx * 6144;
            norm_mod_store(v, INP(I_N1W), mp, mp + 1024, G_hbuf + (size_t)row * DM, lane);
        }
    }
    SEAM(PH_NORM0);

    for (int l = 0; l < NLAYER; ++l) {
        const int P = PH_L0 + l * NPH_LAYER;
        const bool last = (l == NLAYER - 1);
#define modl (G_modb + (size_t)l * 3 * 6144)
        if (INK(P + 0, 2)) REPS(2) { PH_TID();
            int bxp = bx; asm volatile("" : "+s"(bxp));
            const bool split = G > GSPLIT; const int Gg = split ? GSPLIT : G;
            if (bxp < Gg) {
            pg8::Gemm g{G_hbuf, G_wb_in + (size_t)l * INWP * DM, TALL, INWP, DM, 0};
            pg8::StaticOrder S; S.init(TALL, INWP, Gg, bxp);
            pg8::EpiBf16 E{G_proj, INWP, (const float*)G_ropet, TLAT / 256};
            pg8::gemm_phase<pg8::EpiBf16, pg8::StaticOrder, true, true>((LAS unsigned char*)lds + RING_OFF, g, S, E);
            }
            if (bxp >= Gg || !split) {
                const int lane = fresh_tid() & 63;
                unsigned* scr = (unsigned*)(lds + RING_OFF + wave * 16384);
                constexpr int NIT = 32 * (16 * 32 + 16 * 16);
                const int ncw = (split ? G - GSPLIT : G) * NWAVES; int it = (split ? bxp - GSPLIT : bxp) * NWAVES + wave;
                const float* wgu = INP(I_WGU); const float* wdn = INP(I_WDN);
                if (it < NIT) {
                    f32x4 va[16], vb[16]; const float* mb; unsigned off; int pb; bf16_t* da; bf16_t* db;
                    moe_item(it, l, wgu, wdn, G_wb_gu, G_wb_dn, mb, off, pb, da); titem_load(va, mb, off, pb, lane);
                    for (;;) {
                        int nx = it + ncw;
                        moe_item(nx < NIT ? nx : NIT - 1, l, wgu, wdn, G_wb_gu, G_wb_dn, mb, off, pb, db); titem_load(vb, mb, off, pb, lane);
                        titem_store(va, da, scr, lane);
                        if (nx >= NIT) break;
                        it = nx; nx = it + ncw;
                        moe_item(nx < NIT ? nx : NIT - 1, l, wgu, wdn, G_wb_gu, G_wb_dn, mb, off, pb, da); titem_load(va, mb, off, pb, lane);
                        titem_store(vb, db, scr, lane);
                        if (nx >= NIT) break;
                        it = nx;
                    }
                }
            }
        }
        SEAM(P + 0);
#define CP_INIT()         ck::P cp; \
        cp.proj = G_proj; cp.xbcs = G_xbcs; cp.dtv = G_dtv; cp.cumv = G_av; cp.gkv = G_gkv; cp.ssd_st = G_ydir; cp.gla_st = G_odir; cp.cds = (float*)(ws + WS_CDS); cp.cdg = (float*)(ws + WS_CDG); cp.mix = G_mix; cp.ropet = G_ropet; \
        cp.convw = INP(I_CONVW) + l * 3 * 512; cp.convb = INP(I_CONVB) + l * 512; cp.dtb = INP(I_DTB) + l * 8; cp.alog = INP(I_ALOG) + l * 8; \
        cp.gkup = INP(I_GKUP) + (size_t)l * 2 * 16 * 128; cp.gkb = INP(I_GKB) + l * 2 * 128; cp.ssdd = INP(I_SSDD) + l * 4; cp.ssdnw = INP(I_SSDNW) + l * 256; cp.glanw = INP(I_GLANW) + l * 64; cp.kmax2 = G_ctl + CW_KMAX + l * 16; cp.hins = (bf16_t*)(ws + WS_HINS); cp.hing = (bf16_t*)(ws + WS_HING);
        if (INK(P + 1, 3)) REPS(3) { PH_TID(); CP_INIT();
            for (int ui = 0; ui < 2; ++ui) { int ch, sect;
                if (ui == 0) { if (bx >= TLAT / 64) continue; ch = bx; sect = 14; }
                else { if ((bx & 7) != 4 || (bx >> 3) >= 24) continue; const int u = bx >> 3; ch = TLAT / 64 + u / 3; sect = 2 << (u % 3); }
#ifndef PREP_DUP_SECT
#define PREP_DUP_SECT 15
#endif
                ck::prep_chunk(cp, ch, lds + RING_OFF, rep_ > 0 ? (sect & PREP_DUP_SECT) : sect, rep_ > 0); }
        }
        SEAM(P + 1);
        if (INK(P + 2, 4)) { PH_TID(); CP_INIT();
            for (int vb = bx; vb < 256; vb += G) ck::scan_phase(cp, vb);
        }
        SEAM(P + 2);
        if (INK(P + 3, 5)) REPS(5) { PH_TID(); CP_INIT();
            const float lam = __uint_as_float(__builtin_amdgcn_readfirstlane(__float_as_uint(G_scal[l * 2 + 0]))), osc = __uint_as_float(__builtin_amdgcn_readfirstlane(__float_as_uint(G_scal[l * 2 + 1])));
            const float* subw = INP(I_SUBW) + l * 128;
#ifndef ATT_DUP_PART
#define ATT_DUP_PART 3
#endif
#ifndef NO_ATT
            if (rep_ == 0 || (ATT_DUP_PART & 1)) for (int i = 0; i < 3; ++i) {
                int bh, qrow0, nkeys;
                if (i < 2) { bh = bx & 7; const int qb = i * 32 + (bx >> 3); qrow0 = (bh >> 2) * SEQ + qb * 128; nkeys = LCTX + SEQ; if ((bx >> 3) >= 32) continue; }
                else { if (last || (bx & 15) != 2 || (bx >> 4) >= 16) continue; const int u = bx >> 4; bh = u >> 1; qrow0 = TLAT + (bh >> 2) * LCTX + (u & 1) * 128; nkeys = LCTX; }
                att::attn_unit(G_proj, G_mix, subw, lam, osc, G_ctl + CW_KMAX + l * 16 + (bh >> 2) * 8, bh >> 2, bh & 3, qrow0, nkeys, (char*)lds + RING_OFF);
            }
#endif
#ifndef NO_FIN
            if (rep_ == 0 || (ATT_DUP_PART & 2)) for (int ui = 0; ui < 2; ++ui) { int ch, sect;
                if (ui == 0) { if (bx >= TLAT / 64) continue; ch = bx; sect = 15; }
                else { if (last || (bx & 7) != 4) continue; const int u = bx >> 3; ch = TLAT / 64 + (u >> 2); sect = 1 << (u & 3); }
                ck::finish_chunk(cp, ch, lds + RING_OFF, sect); }
#endif
        }
        SEAM(P + 3);
        if (INK(P + 4, 6)) REPS(6) { PH_TID();
            const int M = TLAT;
            pg8::Gemm g{G_mix, G_wb_out + (size_t)l * DM * DM, M, DM, DM, 0};
            pg8::StaticOrder S; S.init(M, DM, G, bx);
            pg8::EpiRes E{INP(I_X), INP(I_CTX), l == 0 ? (const bf16_t*)nullptr : (const bf16_t*)G_xw, G_xw, modl + 2 * 1024, 6144};
            pg8::gemm_phase<pg8::EpiRes, pg8::StaticOrder, true, true>((LAS unsigned char*)lds + RING_OFF, g, S, E);
            if (!last && bx < 256) ctx_outproj_block(G_mix + (size_t)TLAT * DM, G_wb_out + (size_t)l * DM * DM, INP(I_CTX), G_xw + (size_t)TLAT * DM, modl + 2 * 6144 + 2 * 1024, bx, lds + RING_OFF);
        }
        SEAM(P + 4);
        if (INK(P + 5, 7)) REPS(7) { PH_TID(); const bool dry = rep_ > 0;
            const int ntok = last ? TLAT : TALL, TPW = ntok / G;
            float* wT = (float*)(lds + RING_OFF);
            int* selE = (int*)(lds + RT_OFF); int* selP = selE + 272; int* lcnt = selP + 272; int* basep = lcnt + 32;
            { const float* wrt = (const float*)(ws + WS_WRT) + l * 32768;
              f32x4 wr_[16];
#pragma unroll
              for (int q = 0; q < 16; ++q) wr_[q] = *(const f32x4*)(wrt + 4 * (tid + 512 * q));
              __builtin_amdgcn_sched_barrier(0);
#pragma unroll
              for (int q = 0; q < 16; ++q) *(f32x4*)(wT + 4 * (tid + 512 * q)) = wr_[q]; }
            if (tid < 32 && !dry) lcnt[tid] = 0;
            __syncthreads();
            const int tok0 = bx * TPW;
            const float* n2w = INP(I_N2W) + l * DM;
            if (TPW * G == ntok && TPW <= 68 && (TPW & 1) == 0) {
            float* wsc = (float*)(lds + RT_OFF + 2560) + wave * 80;
            const float brl = INP(I_BR)[l * NE + (lane >> 1)];
            u32x2 rawn[2][4];
#pragma unroll
            for (int t = 0; t < 2; ++t)
#pragma unroll
                for (int j = 0; j < 4; ++j) rawn[t][j] = *(const u32x2*)(G_xw + (size_t)(tok0 + wave * 2 + t) * DM + 4 * lane + 256 * j);
            for (int tl = wave * 2; tl < TPW; tl += 2 * NWAVES) {
                const int row0 = tok0 + tl;
                f32x4 v[2][4]; float ss[2] = {0.f, 0.f};
#pragma unroll
                for (int t = 0; t < 2; ++t)
#pragma unroll
                    for (int j = 0; j < 4; ++j) { const u32x2 w = rawn[t][j];
                        v[t][j] = (f32x4){__uint_as_float(w.x << 16), __uint_as_float(w.x & 0xffff0000u), __uint_as_float(w.y << 16), __uint_as_float(w.y & 0xffff0000u)};
                        ss[t] += (v[t][j].x * v[t][j].x + v[t][j].y * v[t][j].y) + (v[t][j].z * v[t][j].z + v[t][j].w * v[t][j].w); }
                { ss[0] = wave_sum(ss[0]); ss[1] = wave_sum(ss[1]); }
                { f32x4 wn[4];
#pragma unroll
                  for (int j = 0; j < 4; ++j) wn[j] = *(const f32x4*)(n2w + 4 * lane + 256 * j);
#pragma unroll
                  for (int t = 0; t < 2; ++t) { const int row = row0 + t, bidx = row < SEQ ? 0 : (row < TLAT ? 1 : 2); const float* mp = modl + (size_t)bidx * 6144;
                    const float r = rsqrtf(ss[t] * (1.0f / DM) + EPS);
                    f32x4 ma[4], mb[4];
#pragma unroll
                    for (int j = 0; j < 4; ++j) { const int c = 4 * lane + 256 * j; ma[j] = *(const f32x4*)(mp + 4 * 1024 + c); mb[j] = *(const f32x4*)(mp + 3 * 1024 + c); }
                    __builtin_amdgcn_sched_barrier(0);
#pragma unroll
                    for (int j = 0; j < 4; ++j) { const int c = 4 * lane + 256 * j;
                        v[t][j] = (v[t][j] * r) * wn[j] * (ma[j] + 1.0f) + mb[j];
                        u32x2 o; o.x = pk2(v[t][j].x, v[t][j].y); o.y = pk2(v[t][j].z, v[t][j].w); *(u32x2*)(G_hbuf + (size_t)row * DM + c) = o; } } }
                if (tl + 2 * NWAVES < TPW) {
#pragma unroll
                    for (int t = 0; t < 2; ++t)
#pragma unroll
                        for (int j = 0; j < 4; ++j) rawn[t][j] = *(const u32x2*)(G_xw + (size_t)(row0 + 2 * NWAVES + t) * DM + 4 * lane + 256 * j); }
                float pa[32], pb[32];
                { f32x2 vv[4][4];
#pragma unroll
                  for (int j = 0; j < 4; ++j) { vv[j][0] = (f32x2){v[0][j].x, v[1][j].x}; vv[j][1] = (f32x2){v[0][j].y, v[1][j].y}; vv[j][2] = (f32x2){v[0][j].z, v[1][j].z}; vv[j][3] = (f32x2){v[0][j].w, v[1][j].w}; }
                  f32x4 wb[2][8];
#pragma unroll
                  for (int q = 0; q < 8; ++q) wb[0][q] = *(const f32x4*)(wT + (q >> 2) * 1024 + 4 * lane + 256 * (q & 3));
#pragma unroll
                  for (int bt = 0; bt < 16; ++bt) {
                      if (bt + 1 < 16) {
#pragma unroll
                          for (int q = 0; q < 8; ++q) wb[(bt + 1) & 1][q] = *(const f32x4*)(wT + (2 * (bt + 1) + (q >> 2)) * 1024 + 4 * lane + 256 * (q & 3)); }
#pragma unroll
                      for (int ee = 0; ee < 2; ++ee) { f32x2 acc = {0.f, 0.f};
#pragma unroll
                          for (int j = 0; j < 4; ++j) { const f32x4 w = wb[bt & 1][ee * 4 + j];
                              acc = __builtin_elementwise_fma(vv[j][0], (f32x2){w.x, w.x}, acc); acc = __builtin_elementwise_fma(vv[j][1], (f32x2){w.y, w.y}, acc);
                              acc = __builtin_elementwise_fma(vv[j][2], (f32x2){w.z, w.z}, acc); acc = __builtin_elementwise_fma(vv[j][3], (f32x2){w.w, w.w}, acc); }
                          pa[2 * bt + ee] = acc.x; pb[2 * bt + ee] = acc.y; } } }
                float qa[16], qb[16], ra[8], rb[8], sa_[4], sb_[4], ta[2], tb[2];
#pragma unroll
                for (int i = 0; i < 16; ++i) { auto r0 = __builtin_amdgcn_permlane32_swap(__float_as_uint(pa[i]), __float_as_uint(pa[16 + i]), false, false);
                    auto r1 = __builtin_amdgcn_permlane32_swap(__float_as_uint(pb[i]), __float_as_uint(pb[16 + i]), false, false);
                    qa[i] = __uint_as_float(r0[0]) + __uint_as_float(r0[1]); qb[i] = __uint_as_float(r1[0]) + __uint_as_float(r1[1]); }
                { const bool up = (lane & 16) != 0;
#pragma unroll
                  for (int i = 0; i < 8; ++i) { const float s0 = up ? qa[i] : qa[8 + i], k0 = up ? qa[8 + i] : qa[i], s1 = up ? qb[i] : qb[8 + i], k1 = up ? qb[8 + i] : qb[i];
                      ra[i] = k0 + __shfl_xor(s0, 16); rb[i] = k1 + __shfl_xor(s1, 16); } }
                { const bool up = (lane & 8) != 0;
#pragma unroll
                  for (int i = 0; i < 4; ++i) { const float s0 = up ? ra[i] : ra[4 + i], k0 = up ? ra[4 + i] : ra[i], s1 = up ? rb[i] : rb[4 + i], k1 = up ? rb[4 + i] : rb[i];
                      sa_[i] = k0 + dpp_perm<0x128>(s0); sb_[i] = k1 + dpp_perm<0x128>(s1); } }
                { const bool up = (lane & 4) != 0;
#pragma unroll
                  for (int i = 0; i < 2; ++i) { const float s0 = up ? sa_[i] : sa_[2 + i], k0 = up ? sa_[2 + i] : sa_[i], s1 = up ? sb_[i] : sb_[2 + i], k1 = up ? sb_[2 + i] : sb_[i];
                      ta[i] = k0 + dpp_perm<0x1B>(dpp_perm<0x141>(s0)); tb[i] = k1 + dpp_perm<0x1B>(dpp_perm<0x141>(s1)); } }
                float la, lb;
                { const bool up = (lane & 2) != 0; const float s0 = up ? ta[0] : ta[1], k0 = up ? ta[1] : ta[0], s1 = up ? tb[0] : tb[1], k1 = up ? tb[1] : tb[0];
                  la = k0 + dpp_perm<0x4E>(s0); lb = k1 + dpp_perm<0x4E>(s1); }
                la += dpp_perm<0xB1>(la); lb += dpp_perm<0xB1>(lb);
                if ((lane & 1) == 0) { wsc[lane >> 1] = la + brl; wsc[32 + (lane >> 1)] = lb + brl; }
                LDS_WAIT();
                const int t = lane >> 5, e = lane & 31; const float* lg = wsc + t * 32; const float mine = lg[e]; int rank = 0;
#pragma unroll
                for (int q = 0; q < 8; ++q) { const f32x4 o4 = *(const f32x4*)(lg + 4 * q); const float ov[4] = {o4.x, o4.y, o4.z, o4.w};
#pragma unroll
                    for (int i = 0; i < 4; ++i) { const int j = 4 * q + i; rank += (ov[i] > mine || (ov[i] == mine && j < e)) ? 1 : 0; } }
                if (rank < 4) wsc[64 + t * 4 + rank] = mine;
                LDS_WAIT();
                if (rank < 4) { const f32x4 sv = *(const f32x4*)(wsc + 64 + t * 4);
                    const float e0 = __expf(sv.x - sv.x), e1 = __expf(sv.y - sv.x), e2 = __expf(sv.z - sv.x), e3 = __expf(sv.w - sv.x);
                    const float gk = __expf(mine - sv.x) / ((e0 + e1) + (e2 + e3));
                    const int lp = dry ? 0 : atomicAdd(&lcnt[e], 1);
                    if (!dry) { selE[(tl + t) * 4 + rank] = e; selP[(tl + t) * 4 + rank] = lp; } G_gatev[(size_t)(row0 + t) * 4 + rank] = gk; }
                LDS_WAIT();
            }
            }
            __syncthreads();
            if (tid < 32 && !dry) basep[tid] = (int)atomicAdd(&G_ctl[CW_CNT + l * 32 + tid], (unsigned)lcnt[tid]);
            __syncthreads();
            if (!dry) for (int i = tid; i < TPW * 4; i += 512) { const int e = selE[i]; const int pos = basep[e] + selP[i]; if (pos < LISTCAP) G_list[(size_t)e * LISTCAP + pos] = tok0 * 4 + i; }
        }
        SEAM(P + 5);
        if (INK(P + 6, 9)) REPS(9) { PH_TID();
            int* tile_e = (int*)(lds + TAB_OFF); int* pstart = tile_e + 304; int* cntl = pstart + 40;
            const int nrt = moe_tables(G_ctl + CW_CNT + l * 32, tile_e, pstart, cntl);
            pg8::Gemm g{G_hbuf, G_wb_gu + (size_t)l * NE * 2048 * DM, nrt * 256, 2048, DM, (size_t)2048 * DM * 2};
            pg8::MoeOrderT<true> S{(const LAS int*)((LAS unsigned char*)lds + TAB_OFF), (const LAS int*)((LAS unsigned char*)lds + TAB_OFF) + 304, (const LAS int*)((LAS unsigned char*)lds + TAB_OFF) + 344, G_list, nrt, 8, 3, G, vcu};
            pg8::EpiAct E{G_actb, INP(I_BGU) + (size_t)l * NE * 2048};
            pg8::gemm_phase<pg8::EpiAct, pg8::MoeOrderT<true>, true, true>((LAS unsigned char*)lds + RING_OFF, g, S, E);
        }
        SEAM(P + 6);
        if (INK(P + 7, 10)) REPS(10) { PH_TID();
            int* tile_e = (int*)(lds + TAB_OFF); int* pstart = tile_e + 304; int* cntl = pstart + 40;
            const int nrt = (IN(P + 6) && ((PH_MASK >> 9) & 1)) ? __builtin_amdgcn_readfirstlane(pstart[NE] >> 8) : moe_tables(G_ctl + CW_CNT + l * 32, tile_e, pstart, cntl);
            pg8::Gemm g{G_actb, G_wb_dn + (size_t)l * NE * DM * DE, nrt * 256, DM, DE, (size_t)DM * DE * 2};
            pg8::MoeOrderT<false> S{(const LAS int*)((LAS unsigned char*)lds + TAB_OFF), (const LAS int*)((LAS unsigned char*)lds + TAB_OFF) + 304, (const LAS int*)((LAS unsigned char*)lds + TAB_OFF) + 344, G_list, nrt, 4, 2, G, vcu};
            pg8::EpiDown E{G_yk, INP(I_BDN) + (size_t)l * NE * DM, &S, G_gatev};
            pg8::gemm_phase<pg8::EpiDown, pg8::MoeOrderT<false>, true, true>((LAS unsigned char*)lds + RING_OFF, g, S, E);
        }
        SEAM(P + 7);
        if (INK(P + 8, 11)) REPS(11) { PH_TID(); const bool dry = rep_ > 0;
            const int ntok = last ? TLAT : TALL;
            f32x4 nwv[4];
            { const float* nwp = last ? INP(I_FNW) : INP(I_N1W) + (l + 1) * DM;
#pragma unroll
              for (int q = 0; q < 4; ++q) nwv[q] = *(const f32x4*)(nwp + 8 * lane + 512 * (q >> 1) + 4 * (q & 1)); }
            for (int rowa = gw; rowa < ntok; rowa += 2 * NGW) {
                f32x4 v[2][4]; int rw[2]; bool ok[2];
#pragma unroll
                for (int t = 0; t < 2; ++t) { const int rr = rowa + t * NGW; ok[t] = rr < ntok; rw[t] = ok[t] ? rr : rowa; }
                u32x4 yv[2][2][4]; u32x4 xr[2][2];
#pragma unroll
                for (int t = 0; t < 2; ++t)
#pragma unroll
                    for (int jj = 0; jj < 2; ++jj) { const int c = 8 * lane + 512 * jj;
#pragma unroll
                        for (int k = 0; k < 4; ++k) yv[t][jj][k] = *(const u32x4*)(G_yk + ((size_t)rw[t] * 4 + k) * DM + c);
                        xr[t][jj] = *(const u32x4*)(G_xw + (size_t)rw[t] * DM + c); }
#pragma unroll
                for (int t = 0; t < 2; ++t) { const int row = rw[t], bidx = row < SEQ ? 0 : (row < TLAT ? 1 : 2); const float* mp = modl + (size_t)bidx * 6144;
                    const float* mn = G_modb + (size_t)((last ? l : l + 1) * 3 + bidx) * 6144;
                    f32x4 g2[4];
#pragma unroll
                    for (int q = 0; q < 4; ++q) g2[q] = *(const f32x4*)(mp + 5 * 1024 + 8 * lane + 512 * (q >> 1) + 4 * (q & 1));
                    __builtin_amdgcn_sched_barrier(0);
                    const float gsc = (dry && !last) ? 0.f : 1.f;
#pragma unroll
                    for (int jj = 0; jj < 2; ++jj) { const int c = 8 * lane + 512 * jj; float ff[8] = {0.f, 0.f, 0.f, 0.f, 0.f, 0.f, 0.f, 0.f};
#pragma unroll
                        for (int k = 0; k < 4; ++k) { float f8[8]; unpack8(yv[t][jj][k], f8);
#pragma unroll
                            for (int e = 0; e < 8; ++e) ff[e] += f8[e]; }
                        const f32x4 g2a = g2[jj * 2] * gsc, g2b = g2[jj * 2 + 1] * gsc;
                        float x8[8]; unpack8(xr[t][jj], x8);
                        v[t][jj * 2] = (f32x4){x8[0], x8[1], x8[2], x8[3]} + g2a * (f32x4){ff[0], ff[1], ff[2], ff[3]}; v[t][jj * 2 + 1] = (f32x4){x8[4], x8[5], x8[6], x8[7]} + g2b * (f32x4){ff[4], ff[5], ff[6], ff[7]};
                        if (!last && !dry && ok[t]) { const float o8[8] = {v[t][jj * 2].x, v[t][jj * 2].y, v[t][jj * 2].z, v[t][jj * 2].w, v[t][jj * 2 + 1].x, v[t][jj * 2 + 1].y, v[t][jj * 2 + 1].z, v[t][jj * 2 + 1].w};
                            *(u32x4*)(G_xw + (size_t)row * DM + c) = pack8(o8); } }
                    f32x4 ma[4], mb[4];
#pragma unroll
                    for (int q = 0; q < 4; ++q) { const int c = 8 * lane + 512 * (q >> 1) + 4 * (q & 1); ma[q] = *(const f32x4*)(mn + 1024 + c); mb[q] = *(const f32x4*)(mn + c); }
                    __builtin_amdgcn_sched_barrier(0);
                    float ss = 0.f;
#pragma unroll
                    for (int j = 0; j < 4; ++j) ss += (v[t][j].x * v[t][j].x + v[t][j].y * v[t][j].y) + (v[t][j].z * v[t][j].z + v[t][j].w * v[t][j].w);
                    const float r = rsqrtf(wave_sum(ss) * (1.0f / DM) + EPS);
                    if (ok[t]) {
                        if (!last) {
#pragma unroll
                            for (int jj = 0; jj < 2; ++jj) { const int c = 8 * lane + 512 * jj; float o8[8];
#pragma unroll
                                for (int hh = 0; hh < 2; ++hh) { const int q = jj * 2 + hh;
                                    const f32x4 y = (v[t][q] * r) * nwv[q] * (ma[q] + 1.0f) + mb[q]; o8[4 * hh] = y.x; o8[4 * hh + 1] = y.y; o8[4 * hh + 2] = y.z; o8[4 * hh + 3] = y.w; }
                                *(u32x4*)(G_hbuf + (size_t)row * DM + c) = pack8(o8); }
                        } else {
#pragma unroll
                            for (int jj = 0; jj < 2; ++jj) { const int c = 8 * lane + 512 * jj;
#pragma unroll
                                for (int hh = 0; hh < 2; ++hh) *(f32x4*)(args.out + (size_t)row * DM + c + 4 * hh) = (v[t][jj * 2 + hh] * r) * nwv[jj * 2 + hh]; }
                        }
                    }
                }
            }
        }
        SEAM(P + 8);
    }
#undef IN
#undef SEAM
}

extern "C" void kernel_launch(void* const* d_in, const int* in_sizes, int n_in, void* d_out, int out_size, void* d_ws, size_t ws_size, hipStream_t stream) {
    static int grid = 0;
    if (grid == 0) {
        if (n_in != 28 || out_size != TLAT * DM || ws_size < WS_END) { fprintf(stderr, "kernel_launch: unexpected shapes: n_in %d out %d ws %zu (need %zu)\n", n_in, out_size, ws_size, (size_t)WS_END); grid = -1; return; }
        int dev = 0, cus = 0, per_cu = 0;
        if (hipGetDevice(&dev) != hipSuccess || hipDeviceGetAttribute(&cus, hipDeviceAttributeMultiprocessorCount, dev) != hipSuccess) { grid = -1; return; }
        if (hipFuncSetAttribute((const void*)fwd, hipFuncAttributeMaxDynamicSharedMemorySize, LDS_BYTES) != hipSuccess) { fprintf(stderr, "kernel_launch: hipFuncSetAttribute failed\n"); grid = -1; return; }
        if (hipOccupancyMaxActiveBlocksPerMultiprocessor(&per_cu, (const void*)fwd, NWAVES * 64, LDS_BYTES) != hipSuccess || per_cu < 1) fprintf(stderr, "kernel_launch: occupancy query reports %d\n", per_cu);
        (void)hipGetLastError();
        grid = cus;
        if (grid != 256) fprintf(stderr, "kernel_launch: %d CUs (built for 256)\n", grid);
    }
    if (grid < 0) return;
    if (hipMemsetAsync((char*)d_ws + WS_CTL, 0, CTL_ZERO_BYTES, stream) != hipSuccess) return;
    Args a{};
    for (int i = 0; i < 28; ++i) a.in[i] = (const float*)d_in[i];
    a.out = (float*)d_out; a.ws = (unsigned char*)d_ws;
#if MK_N_LAUNCHES == 1
    a.ph_lo = 0; a.ph_hi = NPH;
    hipLaunchKernelGGL(fwd, dim3(grid), dim3(NWAVES * 64), LDS_BYTES, stream, a);
#else
    for (int p = 0; p < NPH; ++p) { a.ph_lo = p; a.ph_hi = p + 1; hipLaunchKernelGGL(fwd, dim3(grid), dim3(NWAVES * 64), LDS_BYTES, stream, a); }
#endif
    const hipError_t le = hipPeekAtLastError();
    if (le != hipSuccess) fprintf(stderr, "kernel_launch: launch failed: %s\n", hipGetErrorName(le));
}
```

```cpp
#include <hip/hip_runtime.h>
#include <cstdio>
#include <cstdint>

#ifndef MK_N_LAUNCHES
#define MK_N_LAUNCHES 1
#endif

#define GAS __attribute__((address_space(1)))
#define LAS __attribute__((address_space(3)))
typedef unsigned short bf16_t;
typedef short bf16x8 __attribute__((ext_vector_type(8)));
typedef short s16x4 __attribute__((ext_vector_type(4)));
typedef float f32x2 __attribute__((ext_vector_type(2)));
typedef float f32x4 __attribute__((ext_vector_type(4)));
typedef float f32x16 __attribute__((ext_vector_type(16)));
typedef unsigned u32x2 __attribute__((ext_vector_type(2)));
typedef unsigned u32x4 __attribute__((ext_vector_type(4)));

constexpr int DM = 1024, NB = 2, SEQ = 8192, LCTX = 256, NLAYER = 2;
constexpr int TLAT = NB * SEQ, TCTX = NB * LCTX, TALL = TLAT + TCTX;
constexpr int INW = 3112, INWP = 3328;
constexpr int C_Q = 0, C_K = 512, C_V = 1024, C_Z = 1536, C_XBC = 1792, C_DT = 2304, C_GQ = 2312, C_GK = 2440, C_GV = 2568, C_GG = 2824, C_CODE = 3080;
constexpr int NE = 32, DE = 1024;
constexpr int LISTCAP = TALL, MAXRT = 296, XB_ROWS = MAXRT * 256;
constexpr float EPS = 1e-6f;

constexpr size_t MiB = 1u << 20;
constexpr size_t WS_CTL = 0, CTL_ZERO_BYTES = 128 * 1024;
constexpr int CW_BAR = 4096, CW_CNT = 16384, CW_KMAX = 16384 + 64;
constexpr size_t WS_MOD = 1 * MiB, WS_ROPE = 1 * MiB + 256 * 1024, WS_SCAL = WS_ROPE + 16 * 1024, WS_CDS = WS_SCAL + 4096, WS_CDG = WS_SCAL + 32768, WS_WRT = WS_SCAL + 320 * 1024;
constexpr size_t WS_WIN = 2 * MiB, WS_WOUT = 15 * MiB, WS_WGU = 32 * MiB, WS_WDN = 288 * MiB;
constexpr size_t WS_H = 416 * MiB, WS_PROJ = 449 * MiB, WS_XBC = 557 * MiB, WS_DT = 574 * MiB, WS_AV = 575 * MiB, WS_GKV = 576 * MiB;
constexpr size_t WS_YDIR = 593 * MiB, WS_ODIR = 626 * MiB, WS_MIX = 659 * MiB, WS_XW = 692 * MiB, WS_LIST = 758 * MiB, WS_GATE = 761 * MiB, WS_RMAP = 762 * MiB;
constexpr size_t WS_HINS = 763 * MiB, WS_HING = 781 * MiB;
constexpr size_t WS_XB = 763 * MiB, WS_ACT = 911 * MiB, WS_YK = 1059 * MiB, WS_END = 1191 * MiB;

constexpr int RING_OFF = 0, RING_BYTES = 131072;
constexpr int MISC_OFF = RING_BYTES;
constexpr int TAB_OFF = RING_BYTES + 256;
constexpr int RT_OFF = RING_BYTES + 4096;
constexpr int LDS_BYTES = RING_BYTES + 12288;
constexpr int PTAB_OFF = LDS_BYTES - 256;
constexpr int NWAVES = 8;

__device__ __forceinline__ float bf2f(unsigned short b) { return __uint_as_float(((unsigned)b) << 16); }
typedef __bf16 bf16x2_t __attribute__((ext_vector_type(2)));
__device__ __forceinline__ unsigned pk2(float lo, float hi) { const f32x2 v = {lo, hi}; const bf16x2_t b = __builtin_convertvector(v, bf16x2_t); return __builtin_bit_cast(unsigned, b); }
__device__ __forceinline__ unsigned f2bf(float f) { return pk2(f, f) & 0xffffu; }
__device__ __forceinline__ float siluf(float x) { return x * __builtin_amdgcn_rcpf(1.0f + __expf(-x)); }
__device__ __forceinline__ float softplusf(float x) { return x > 20.f ? x : __logf(1.0f + __expf(x)); }
__device__ __forceinline__ float logsigmoidf(float x) { return fminf(x, 0.f) - __logf(1.0f + __expf(-fabsf(x))); }
template <int CTRL> __device__ __forceinline__ float dpp_perm(float x) {
    return __builtin_bit_cast(float, __builtin_amdgcn_mov_dpp(__builtin_bit_cast(int, x), CTRL, 0xf, 0xf, true)); }
template <int CTRL, int ROWMASK, bool BC> __device__ __forceinline__ float dpp_or0(float x) {
    return __builtin_bit_cast(float, __builtin_amdgcn_update_dpp(0, __builtin_bit_cast(int, x), CTRL, ROWMASK, 0xf, BC)); }
__device__ __forceinline__ float row16_allsum(float v) {
    v += dpp_perm<0xB1>(v); v += dpp_perm<0x4E>(v); v += dpp_perm<0x141>(v); v += dpp_perm<0x140>(v); return v; }
__device__ __forceinline__ float sum32(float v) {
    v = row16_allsum(v); const int iv = __builtin_bit_cast(int, v);
    const float s0 = __builtin_bit_cast(float, __builtin_amdgcn_readlane(iv, 0)), s1 = __builtin_bit_cast(float, __builtin_amdgcn_readlane(iv, 16));
    const float s2 = __builtin_bit_cast(float, __builtin_amdgcn_readlane(iv, 32)), s3 = __builtin_bit_cast(float, __builtin_amdgcn_readlane(iv, 48));
    return (threadIdx.x & 32) ? s2 + s3 : s0 + s1; }
__device__ __forceinline__ float wave_sum(float v) {
    v = row16_allsum(v); const int iv = __builtin_bit_cast(int, v);
    return (__builtin_bit_cast(float, __builtin_amdgcn_readlane(iv, 0)) + __builtin_bit_cast(float, __builtin_amdgcn_readlane(iv, 16))) +
           (__builtin_bit_cast(float, __builtin_amdgcn_readlane(iv, 32)) + __builtin_bit_cast(float, __builtin_amdgcn_readlane(iv, 48))); }
__device__ __forceinline__ float wave_scan(float x, int lane, bool rev) {
    float v = x;
    v += dpp_or0<0x111, 0xf, true>(v); v += dpp_or0<0x112, 0xf, true>(v); v += dpp_or0<0x114, 0xf, true>(v); v += dpp_or0<0x118, 0xf, true>(v);
    v += dpp_or0<0x142, 0xa, false>(v);
    v += dpp_or0<0x143, 0xc, false>(v);
    if (!rev) return v;
    const float tot = __builtin_bit_cast(float, __builtin_amdgcn_readlane(__builtin_bit_cast(int, v), 63));
    return (tot - v) + x;
}
__device__ __forceinline__ void unpack8(const u32x4 w, float (&f)[8]) {
    f[0] = __uint_as_float(w.x << 16); f[1] = __uint_as_float(w.x & 0xffff0000u); f[2] = __uint_as_float(w.y << 16); f[3] = __uint_as_float(w.y & 0xffff0000u);
    f[4] = __uint_as_float(w.z << 16); f[5] = __uint_as_float(w.z & 0xffff0000u); f[6] = __uint_as_float(w.w << 16); f[7] = __uint_as_float(w.w & 0xffff0000u);
}
__device__ __forceinline__ u32x4 pack8(const float (&f)[8]) { u32x4 w; w.x = pk2(f[0], f[1]); w.y = pk2(f[2], f[3]); w.z = pk2(f[4], f[5]); w.w = pk2(f[6], f[7]); return w; }
#define LDS_WAIT() asm volatile("s_waitcnt lgkmcnt(0)" ::: "memory")
#define LDS_BARRIER() asm volatile("s_waitcnt lgkmcnt(0)\n\ts_barrier" ::: "memory")
__device__ __forceinline__ int fresh_tid() { int t = threadIdx.x; asm volatile("" : "+v"(t)); return t; }

namespace pg8 {
#define PG8_LAS __attribute__((address_space(3)))
constexpr int BM = 256, BK = 64, HALF = 128, HTB = HALF * BK * 2, STAGE_BYTES = 8 * HTB, NXCD = 8, WGM = 8;
__host__ __device__ __forceinline__ int lds_byte(int r, int c) { const int st = (r >> 4) * 2 + (c >> 5), rr = r & 15, cc = c & 31, ob = rr * 64 + cc * 2; return st * 1024 + (ob ^ (((ob >> 9) & 1) << 5)); }
__host__ __device__ __forceinline__ void stage_rc(int b, int& R, int& C) { const int st = b / 1024, sb = b % 1024, swz = sb ^ (((sb >> 9) & 1) << 5); R = (st >> 1) * 16 + swz / 64; C = (st & 1) * 32 + (swz % 64) / 2; }
__host__ __device__ __forceinline__ int perm32(int rho) { const int n = rho >> 4, i = rho & 15; return 8 * (i >> 2) + 4 * n + (i & 3); }

struct Unit { int pm, pn, e; };
struct Gemm { const bf16_t* A; const bf16_t* Bt; int M, N, K; size_t estride; };

struct StaticOrder {
    static constexpr bool GATHER = false;
    int nM, nN, nwg, G, c;
    __host__ __device__ void init(int M, int N, int G_, int c_) { nM = M / BM; nN = N / BM; nwg = nM * nN; G = G_; c = c_; }
    __host__ __device__ bool next(int i, Unit& u) const {
        const long L = (long)i * G + c; if (L >= nwg) return false;
        int wgid = (int)L; { const int q = nwg / NXCD, r = nwg % NXCD, xcd = wgid % NXCD, off = wgid / NXCD; wgid = (xcd < r ? xcd * (q + 1) : r * (q + 1) + (xcd - r) * q) + off; }
        const int nig = WGM * nN, gid = wgid / nig, fm = gid * WGM, gsz = (nM - fm) < WGM ? (nM - fm) : WGM;
        u.pm = fm + ((wgid % nig) % gsz); u.pn = (wgid % nig) / gsz; u.e = 0; return true;
    }
    __device__ __forceinline__ const int* row_src(const Unit&, int) const { return nullptr; }
    __device__ __forceinline__ void a_ready(const Unit&) const {}
    __device__ __forceinline__ void done(const Unit&) const {}
};
template <bool GATHER_> struct MoeOrderT {
    static constexpr bool GATHER = GATHER_;
    const PG8_LAS int* tile_e; const PG8_LAS int* pstart; const PG8_LAS int* cntl; const int* list; int nrt, nN, lgN, G, cv;
    __device__ __forceinline__ bool next(int i, Unit& u) const {
        const int L = i * G + cv; if (L >= nrt * nN) return false;
        const int rt = L >> lgN; u.pm = rt; u.pn = L & (nN - 1); u.e = __builtin_amdgcn_readfirstlane(tile_e[rt]); return true;
    }
    __device__ __forceinline__ const int* row_src(const Unit& u, int r) const {
        const int ps = pstart[u.e], c = cntl[u.e]; int pos = u.pm * BM + r - ps; pos = pos < c ? pos : c - 1;
        return list + (size_t)u.e * LISTCAP + pos;
    }
    __device__ __forceinline__ int row_tok4(const Unit& u, int r) const {
        const int ps = pstart[u.e], c = cntl[u.e]; const int pos = u.pm * BM + r - ps;
        return pos < c ? list[(size_t)u.e * LISTCAP + pos] : -1;
    }
    __device__ __forceinline__ void a_ready(const Unit&) const {}
    __device__ __forceinline__ void done(const Unit&) const {}
};

__device__ __forceinline__ unsigned cvt_pk_bf16(float lo, float hi) { unsigned r; asm volatile("v_cvt_pk_bf16_f32 %0, %1, %2" : "=v"(r) : "v"(lo), "v"(hi)); return r; }

struct NoPre {};
struct EpiBf16 {
    static constexpr bool PERM = true, AFTER_DRAIN = false;
    typedef NoPre Pre; __device__ __forceinline__ void prefetch(Pre&, const Unit&, int, int, int, int) const {}
    bf16_t* O; int ldc;
    const float* ropet; int rope_pm;
    __device__ __forceinline__ void operator()(const f32x4 (&acc)[2][2][4][2], const Unit& u, int wr, int wc, int fr, int fq, const Pre&) const {
        const int row0 = u.pm * BM + wr * 64 + fr, col0 = u.pn * BM + wc * 32 + 8 * fq;
        if (ropet != nullptr && u.pn < 4 && u.pm < rope_pm) {
            const int t_ = fresh_tid(), fr_ = t_ & 15, fq_ = (t_ >> 4) & 3; const bool hiL = fq_ >= 2; const int half = wc & 1;
#pragma unroll
            for (int ai = 0; ai < 2; ++ai)
#pragma unroll
                for (int m = 0; m < 4; ++m) { const int row = u.pm * BM + wr * 64 + fr_ + ai * HALF + m * 16, sq = row & (SEQ - 1), pos = half ? (sq & 63) : (sq >> 6);
                    const f32x4* tp = (const f32x4*)(ropet + (size_t)(pos * 16 + 8 * (fq_ & 1)) * 2);
                    f32x4 cs[4];
#pragma unroll
                    for (int q = 0; q < 4; ++q) cs[q] = tp[q];
                    float A[8], B[8];
#pragma unroll
                    for (int i = 0; i < 8; ++i) { const float c = cs[i >> 1][(i & 1) * 2], sn = cs[i >> 1][(i & 1) * 2 + 1]; A[i] = hiL ? sn : c; B[i] = hiL ? c : -sn; }
                    bf16_t* rowp = O + (size_t)row * ldc + u.pn * BM + wc * 32 + 8 * fq_;
#pragma unroll
                    for (int bj = 0; bj < 2; ++bj) { float o8[8];
#pragma unroll
                        for (int i = 0; i < 8; ++i) { const float v = acc[ai][bj][m][i >> 2][i & 3];
                            auto r = __builtin_amdgcn_permlane32_swap(__float_as_uint(v), __float_as_uint(v), false, false);
                            o8[i] = __uint_as_float(r[0]) * A[i] + __uint_as_float(r[1]) * B[i]; }
                        u32x4 w; w.x = cvt_pk_bf16(o8[0], o8[1]); w.y = cvt_pk_bf16(o8[2], o8[3]); w.z = cvt_pk_bf16(o8[4], o8[5]); w.w = cvt_pk_bf16(o8[6], o8[7]);
                        *(u32x4*)(rowp + bj * HALF) = w; } }
            return; }
#pragma unroll
        for (int ai = 0; ai < 2; ++ai)
#pragma unroll
            for (int m = 0; m < 4; ++m) { bf16_t* rowp = O + (size_t)(row0 + ai * HALF + m * 16) * ldc + col0;
#pragma unroll
                for (int bj = 0; bj < 2; ++bj) { const f32x4 v0 = acc[ai][bj][m][0], v1 = acc[ai][bj][m][1];
                    u32x4 w; w.x = cvt_pk_bf16(v0[0], v0[1]); w.y = cvt_pk_bf16(v0[2], v0[3]); w.z = cvt_pk_bf16(v1[0], v1[1]); w.w = cvt_pk_bf16(v1[2], v1[3]);
                    *(u32x4*)(rowp + bj * HALF) = w; } }
    }
};
struct EpiRes {
    static constexpr bool PERM = false, AFTER_DRAIN = false;
    typedef NoPre Pre; __device__ __forceinline__ void prefetch(Pre&, const Unit&, int, int, int, int) const {}
    const float* baseL; const float* baseC; const bf16_t* baseB; bf16_t* out; const float* gate; int gstride;
    __device__ __forceinline__ void operator()(const f32x4 (&acc)[2][2][4][2], const Unit& u, int wr, int wc, int fr, int fq, const Pre&) const {
        const int rowt = u.pm * BM; const int bidx = rowt < SEQ ? 0 : (rowt < TLAT ? 1 : 2);
        const float* base = rowt < TLAT ? baseL + (size_t)rowt * DM : baseC + (size_t)(rowt - TLAT) * DM;
        const int t_ = fresh_tid(), fr_ = t_ & 15, fq_ = (t_ >> 4) & 3;
        (void)fr; (void)fq;
        const int rl = wr * 64 + fr_, col0 = u.pn * BM + wc * 32 + 4 * fq_;
        const float* gp = gate + (size_t)bidx * gstride + col0;
        f32x4 gv[2][2];
#pragma unroll
        for (int bj = 0; bj < 2; ++bj)
#pragma unroll
            for (int n = 0; n < 2; ++n) gv[bj][n] = *(const f32x4*)(gp + bj * HALF + n * 16);
        if (baseB) {
#pragma unroll
            for (int ai = 0; ai < 2; ++ai)
#pragma unroll
                for (int mp = 0; mp < 2; ++mp) { u32x2 bw[2][2][2];
#pragma unroll
                    for (int mm = 0; mm < 2; ++mm)
#pragma unroll
                        for (int bj = 0; bj < 2; ++bj)
#pragma unroll
                            for (int n = 0; n < 2; ++n) bw[mm][bj][n] = *(const u32x2*)(baseB + (size_t)rowt * DM + (size_t)(rl + ai * HALF + (2 * mp + mm) * 16) * DM + col0 + bj * HALF + n * 16);
                    __builtin_amdgcn_sched_barrier(0);
#pragma unroll
                    for (int mm = 0; mm < 2; ++mm) { const int m = 2 * mp + mm; bf16_t* op = out + (size_t)rowt * DM + (size_t)(rl + ai * HALF + m * 16) * DM + col0;
#pragma unroll
                        for (int bj = 0; bj < 2; ++bj)
#pragma unroll
                            for (int n = 0; n < 2; ++n) { const u32x2 w = bw[mm][bj][n];
                                const f32x4 bs = (f32x4){__uint_as_float(w.x << 16), __uint_as_float(w.x & 0xffff0000u), __uint_as_float(w.y << 16), __uint_as_float(w.y & 0xffff0000u)};
                                const f32x4 v = bs + gv[bj][n] * acc[ai][bj][m][n];
                                u32x2 o; o.x = cvt_pk_bf16(v[0], v[1]); o.y = cvt_pk_bf16(v[2], v[3]); *(u32x2*)(op + bj * HALF + n * 16) = o; } } }
        } else {
#pragma unroll
            for (int ai = 0; ai < 2; ++ai)
#pragma unroll
                for (int m = 0; m < 4; ++m) { f32x4 bf[2][2];
#pragma unroll
                    for (int bj = 0; bj < 2; ++bj)
#pragma unroll
                        for (int n = 0; n < 2; ++n) bf[bj][n] = *(const f32x4*)(base + (size_t)(rl + ai * HALF + m * 16) * DM + col0 + bj * HALF + n * 16);
                    __builtin_amdgcn_sched_barrier(0);
                    bf16_t* op = out + (size_t)rowt * DM + (size_t)(rl + ai * HALF + m * 16) * DM + col0;
#pragma unroll
                    for (int bj = 0; bj < 2; ++bj)
#pragma unroll
                        for (int n = 0; n < 2; ++n) { const f32x4 v = bf[bj][n] + gv[bj][n] * acc[ai][bj][m][n];
                            u32x2 o; o.x = cvt_pk_bf16(v[0], v[1]); o.y = cvt_pk_bf16(v[2], v[3]); *(u32x2*)(op + bj * HALF + n * 16) = o; } }
        }
    }
};
struct EpiAct {
    static constexpr bool PERM = true, AFTER_DRAIN = false;
    bf16_t* O; const float* bias;
    struct Pre { f32x4 b[4]; };
    __device__ __forceinline__ void prefetch(Pre& p, const Unit& u, int wr, int wc, int fr, int fq) const {
        const float* bp = bias + (size_t)u.e * 2048 + u.pn * HALF + wc * 32 + 8 * fq;
        p.b[0] = *(const f32x4*)(bp); p.b[1] = *(const f32x4*)(bp + 4); p.b[2] = *(const f32x4*)(bp + 1024); p.b[3] = *(const f32x4*)(bp + 1028); }
    __device__ __forceinline__ void operator()(const f32x4 (&acc)[2][2][4][2], const Unit& u, int wr, int wc, int fr, int fq, const Pre& p) const {
        const int row0 = u.pm * BM + wr * 64 + fr, col0 = u.pn * HALF + wc * 32 + 8 * fq;
        const f32x4 bg0 = p.b[0], bg1 = p.b[1], bl0 = p.b[2] + 1.0f, bl1 = p.b[3] + 1.0f;
#pragma unroll
        for (int ai = 0; ai < 2; ++ai)
#pragma unroll
            for (int m = 0; m < 4; ++m) { bf16_t* rowp = O + (size_t)(row0 + ai * HALF + m * 16) * DE + col0;
                float a[8];
#pragma unroll
                for (int n = 0; n < 2; ++n) { const f32x4 g = acc[ai][0][m][n] + (n ? bg1 : bg0), li = acc[ai][1][m][n] + (n ? bl1 : bl0);
#pragma unroll
                    for (int j = 0; j < 4; ++j) { const float gl = fminf(g[j], 7.0f), ln1 = __builtin_amdgcn_fmed3f(li[j], -6.0f, 8.0f); a[n * 4 + j] = gl * __builtin_amdgcn_rcpf(1.0f + __builtin_amdgcn_exp2f(-1.702f * 1.4426950408889634f * gl)) * ln1; } }
                u32x4 w; w.x = cvt_pk_bf16(a[0], a[1]); w.y = cvt_pk_bf16(a[2], a[3]); w.z = cvt_pk_bf16(a[4], a[5]); w.w = cvt_pk_bf16(a[6], a[7]);
                *(u32x4*)rowp = w; }
    }
};
struct EpiDown {
    static constexpr bool PERM = true, AFTER_DRAIN = false;
    bf16_t* Y; const float* bias; const MoeOrderT<false>* S; const float* gatev;
    struct Pre { int t4[8]; };
    __device__ __forceinline__ void prefetch(Pre& p, const Unit& u, int wr, int wc, int fr, int fq) const {
#pragma unroll
        for (int i = 0; i < 8; ++i) p.t4[i] = S->row_tok4(u, wr * 64 + fr + (i >> 2) * HALF + (i & 3) * 16); }
    __device__ __forceinline__ void operator()(const f32x4 (&acc)[2][2][4][2], const Unit& u, int wr, int wc, int fr, int fq, const Pre& p) const {
        const int row0 = u.pm * BM + wr * 64 + fr, col0 = u.pn * BM + wc * 32 + 8 * fq;
        const float* bp = bias + (size_t)u.e * DM + col0;
        f32x4 bv[2][2];
#pragma unroll
        for (int bj = 0; bj < 2; ++bj) { bv[bj][0] = *(const f32x4*)(bp + bj * HALF); bv[bj][1] = *(const f32x4*)(bp + bj * HALF + 4); }
        int t4[8]; float gt[8];
#pragma unroll
        for (int i = 0; i < 8; ++i) t4[i] = p.t4[i];
#pragma unroll
        for (int i = 0; i < 8; ++i) gt[i] = gatev[t4[i] >= 0 ? t4[i] : 0];
#pragma unroll
        for (int ai = 0; ai < 2; ++ai)
#pragma unroll
            for (int m = 0; m < 4; ++m) { const int tok4 = t4[ai * 4 + m];
                if (tok4 >= 0) { const float g1 = gt[ai * 4 + m]; bf16_t* rowp = Y + (size_t)tok4 * DM + col0;
#pragma unroll
                    for (int bj = 0; bj < 2; ++bj) { const f32x4 v0 = (acc[ai][bj][m][0] + bv[bj][0]) * g1, v1 = (acc[ai][bj][m][1] + bv[bj][1]) * g1;
                        u32x4 w; w.x = cvt_pk_bf16(v0[0], v0[1]); w.y = cvt_pk_bf16(v0[2], v0[3]); w.z = cvt_pk_bf16(v1[0], v1[1]); w.w = cvt_pk_bf16(v1[2], v1[3]);
                        *(u32x4*)(rowp + bj * HALF) = w; } } }
    }
};

template <class Epi, class Sched, bool ALIGN_EPI = false, bool SP2 = false>
__device__ __forceinline__ void gemm_phase(PG8_LAS unsigned char* lds, const Gemm g, const Sched& S, const Epi& E) {
    const int tid = fresh_tid(), wid = __builtin_amdgcn_readfirstlane(tid >> 6), lane = tid & 63, wr = wid >> 2, wc = wid & 3, fr = lane & 15, fq = lane >> 4;
    const int K = g.K, nt = K / BK;
    unsigned voffA[2], voffB[2];
#pragma unroll
    for (int i = 0; i < 2; ++i) { int R, C; stage_rc(tid * 16 + i * 8192, R, C); const int Rb = Epi::PERM ? ((R & ~31) + perm32(R & 31)) : R;
        voffA[i] = (unsigned)(R * K + C) * 2u; voffB[i] = (unsigned)(Rb * K + C) * 2u; }
    unsigned Rr[2], Cb2[2];
#pragma unroll
    for (int i = 0; i < 2; ++i) { int R, C; stage_rc(tid * 16 + i * 8192, R, C); Rr[i] = (unsigned)R; Cb2[i] = (unsigned)C * 2u; }
    unsigned tC4[2][2], tN4[2][2];
    const size_t kstep = (size_t)(BK * 2);
    const size_t hstep = (size_t)HALF * K * 2;
    const size_t tstep = 2 * hstep;
    const unsigned ldsw = (unsigned)wid * 1024u;
    const int aoff = lds_byte(wr * 64 + fr, fq * 8), boff = lds_byte(wc * 32 + fr, fq * 8);
#define PG8_SA(b, h) (((b) * 2 + (h)) * HTB)
#define PG8_SB(b, h) ((4 + (b) * 2 + (h)) * HTB)
#define PG8_STAGE(bufoff, gbase, voff) do { _Pragma("unroll") for (int _i = 0; _i < 2; ++_i) \
        __builtin_amdgcn_global_load_lds((const unsigned*)((const char*)(gbase) + (voff)[_i]), (PG8_LAS unsigned*)(lds + (bufoff) + ldsw + _i * 8192), 16, 0, 0); } while (0)
#define PG8_STAGE_A(bufoff, kbyte, h, isnext) do { if constexpr (Sched::GATHER) { unsigned vo_[2]; _Pragma("unroll") for (int _i = 0; _i < 2; ++_i) { asm volatile("" : "+v"(tN4[h][_i])); \
            const unsigned t4_ = (isnext) ? tN4[h][_i] : tC4[h][_i]; vo_[_i] = (t4_ >> 2) * (unsigned)(K * 2) + Cb2[_i]; } PG8_STAGE(bufoff, (const char*)g.A + (kbyte), vo_); } \
        else { PG8_STAGE(bufoff, ((isnext) ? nA : cA) + (kbyte) + (h) * hstep, voffA); } } while (0)
#define PG8_LOOKUP(dst, unit) do { _Pragma("unroll") for (int _h = 0; _h < 2; ++_h) _Pragma("unroll") for (int _i = 0; _i < 2; ++_i) { const int* p_ = S.row_src(unit, _h * HALF + (int)Rr[_i]); \
        asm volatile("global_load_dword %0, %1, off" : "=v"(dst[_h][_i]) : "v"(p_) : "memory"); } } while (0)
#define PG8_LDA(dst, b, h) do { _Pragma("unroll") for (int m = 0; m < 4; ++m) _Pragma("unroll") for (int k = 0; k < 2; ++k) dst[m][k] = *(const PG8_LAS bf16x8*)(lds + PG8_SA(b, h) + aoff + m * 2048 + k * 1024); } while (0)
#define PG8_LDB(dst, b, h) do { _Pragma("unroll") for (int n = 0; n < 2; ++n) _Pragma("unroll") for (int k = 0; k < 2; ++k) dst[n][k] = *(const PG8_LAS bf16x8*)(lds + PG8_SB(b, h) + boff + n * 2048 + k * 1024); } while (0)
#define PG8_MMA(ai, bj, At, Bt) do { __builtin_amdgcn_s_setprio(1); _Pragma("unroll") for (int m = 0; m < 4; ++m) _Pragma("unroll") for (int n = 0; n < 2; ++n) _Pragma("unroll") for (int k = 0; k < 2; ++k) \
        acc[ai][bj][m][n] = __builtin_amdgcn_mfma_f32_16x16x32_bf16(Bt[n][k], At[m][k], acc[ai][bj][m][n], 0, 0, 0); __builtin_amdgcn_s_setprio(0); } while (0)
#define PG8_WAIT_V(n) asm volatile("s_waitcnt vmcnt(" #n ")" ::: "memory")
#define PG8_WAIT_L(n) asm volatile("s_waitcnt lgkmcnt(" #n ")" ::: "memory")
#define PG8_BAR __builtin_amdgcn_s_barrier()
#define PG8_SCHED __builtin_amdgcn_sched_barrier(0)
    Unit cur, nxt; int ui = 0;
    if (!S.next(0, cur)) return;
    f32x4 acc[2][2][4][2];
#pragma unroll
    for (int a = 0; a < 2; ++a)
#pragma unroll
        for (int b = 0; b < 2; ++b)
#pragma unroll
            for (int m = 0; m < 4; ++m)
#pragma unroll
                for (int n = 0; n < 2; ++n) acc[a][b][m][n] = (f32x4){0.f, 0.f, 0.f, 0.f};
    bf16x8 At[4][2], B0[2][2], B1[2][2];
    const char* cA = (const char*)g.A + (size_t)cur.pm * tstep; const char* cB = (const char*)g.Bt + (size_t)cur.e * g.estride + (size_t)cur.pn * tstep;
    S.a_ready(cur);
    static_assert(SP2, "only the two-super-phase K-loop is kept in this file");
    const char* nA = cA;
    if constexpr (Sched::GATHER) { PG8_LOOKUP(tC4, cur); asm volatile("s_waitcnt vmcnt(0)" ::: "memory");
#pragma unroll
        for (int _h = 0; _h < 2; ++_h)
#pragma unroll
            for (int _i = 0; _i < 2; ++_i) { asm volatile("" : "+v"(tC4[_h][_i])); tN4[_h][_i] = tC4[_h][_i]; } }
    {
        PG8_STAGE(PG8_SB(0, 0), cB, voffB); PG8_STAGE(PG8_SB(0, 1), cB + hstep, voffB); PG8_STAGE_A(PG8_SA(0, 0), 0, 0, false); PG8_STAGE_A(PG8_SA(0, 1), 0, 1, false);
        if (wr == 1) PG8_BAR;
        PG8_WAIT_V(2); PG8_BAR;
        PG8_STAGE(PG8_SB(1, 0), cB + kstep, voffB); PG8_STAGE_A(PG8_SA(1, 0), kstep, 0, false); PG8_STAGE(PG8_SB(1, 1), cB + hstep + kstep, voffB);
        PG8_WAIT_V(6); PG8_BAR;
    }
    for (;;) {
        const bool has_next = S.next(ui + 1, nxt);
        nA = has_next ? (const char*)g.A + (size_t)nxt.pm * tstep : cA; const char* nB = has_next ? (const char*)g.Bt + (size_t)nxt.e * g.estride + (size_t)nxt.pn * tstep : cB;
        if constexpr (Sched::GATHER) { if (has_next) PG8_LOOKUP(tN4, nxt); }
        typename Epi::Pre pre; E.prefetch(pre, cur, wr, wc, fr, fq);
        for (int t = 0; t < nt; t += 2) {
            const bool last = (t == nt - 2);
            const size_t k1 = (size_t)(t + 1) * kstep, k2 = last ? 0 : (size_t)(t + 2) * kstep, k3 = k2 + kstep;
            const char* b2 = (last ? nB : cB) + k2; const char* b3 = b2 + kstep;
            if (last && has_next) S.a_ready(nxt);
            PG8_LDB(B0, 0, 0); PG8_LDB(B1, 0, 1); PG8_SCHED; PG8_LDA(At, 0, 0); PG8_STAGE_A(PG8_SA(1, 1), k1, 1, false);
            PG8_WAIT_V(8); PG8_WAIT_L(0); PG8_BAR; PG8_MMA(0, 0, At, B0); PG8_MMA(0, 1, At, B1); PG8_BAR; PG8_SCHED;
            PG8_LDA(At, 0, 1); PG8_STAGE(PG8_SB(0, 0), b2, voffB); PG8_STAGE(PG8_SB(0, 1), b2 + hstep, voffB); PG8_STAGE_A(PG8_SA(0, 0), k2, 0, last);
            PG8_WAIT_V(8); PG8_WAIT_L(0); PG8_BAR; PG8_MMA(1, 0, At, B0); PG8_MMA(1, 1, At, B1); PG8_BAR; PG8_SCHED;
            PG8_LDB(B0, 1, 0); PG8_LDB(B1, 1, 1); PG8_SCHED; PG8_LDA(At, 1, 0); PG8_STAGE_A(PG8_SA(0, 1), k2, 1, last);
            PG8_WAIT_V(8); PG8_WAIT_L(0); PG8_BAR; PG8_MMA(0, 0, At, B0); PG8_MMA(0, 1, At, B1); PG8_BAR; PG8_SCHED;
            PG8_LDA(At, 1, 1); PG8_STAGE(PG8_SB(1, 0), b3, voffB); PG8_STAGE(PG8_SB(1, 1), b3 + hstep, voffB); PG8_STAGE_A(PG8_SA(1, 0), k3, 0, last);
            PG8_WAIT_V(8); PG8_WAIT_L(0); PG8_BAR; PG8_MMA(1, 0, At, B0); PG8_MMA(1, 1, At, B1); PG8_BAR; PG8_SCHED;
        }
        if constexpr (ALIGN_EPI) { if (wr == 0) PG8_BAR; }
        if constexpr (!Epi::AFTER_DRAIN) { E(acc, cur, wr, wc, fr, fq, pre); S.done(cur); }
        if (!has_next) break;
#pragma unroll
        for (int a = 0; a < 2; ++a)
#pragma unroll
            for (int b = 0; b < 2; ++b)
#pragma unroll
                for (int m = 0; m < 4; ++m)
#pragma unroll
                    for (int n = 0; n < 2; ++n) acc[a][b][m][n] = (f32x4){0.f, 0.f, 0.f, 0.f};
        cur = nxt; cA = nA; cB = nB; ++ui;
        if constexpr (Sched::GATHER) {
#pragma unroll
            for (int _h = 0; _h < 2; ++_h)
#pragma unroll
                for (int _i = 0; _i < 2; ++_i) tC4[_h][_i] = tN4[_h][_i]; }
        if constexpr (ALIGN_EPI) { if (wr == 1) PG8_BAR; }
    }
    PG8_WAIT_V(0);
    if constexpr (!ALIGN_EPI) { if (wr == 0) PG8_BAR; }
    PG8_BAR;
#undef PG8_SA
#undef PG8_SB
#undef PG8_STAGE
#undef PG8_STAGE_A
#undef PG8_LOOKUP
#undef PG8_LDA
#undef PG8_LDB
#undef PG8_MMA
#undef PG8_WAIT_V
#undef PG8_WAIT_L
#undef PG8_BAR
#undef PG8_SCHED
}
}

namespace att {
constexpr float SCALE = 0.125f;
constexpr int SHM_V = 64 * 128 * 2, SHM_K = 64 * 128 * 2;
#define KSWZ(row, colB) ((row) * 256 + ((colB) ^ (((row) & 7) << 4)))
#define SBAR() __builtin_amdgcn_sched_barrier(0)
__device__ __forceinline__ int crow(int r, int hi) { return (r & 3) + 8 * (r >> 2) + 4 * hi; }
__device__ __forceinline__ unsigned cvtpk(float lo, float hi) { unsigned r; asm volatile("v_cvt_pk_bf16_f32 %0, %1, %2" : "=v"(r) : "v"(lo), "v"(hi)); return r; }
__device__ __forceinline__ bf16x8 ld8(const bf16_t* p) { return *reinterpret_cast<const bf16x8*>(p); }

__device__ __forceinline__ void partialSM(f32x16& p0) {
#pragma unroll
    for (int r = 0; r < 16; ++r) p0[r] = __builtin_amdgcn_exp2f(p0[r]);
}
__device__ __forceinline__ void finishSM(f32x16& p0, f32x16& p1, float& l_reg, bf16x8& pa0, bf16x8& pa1, bf16x8& pa2, bf16x8& pa3) {
#pragma unroll
    for (int r = 0; r < 16; ++r) p1[r] = __builtin_amdgcn_exp2f(p1[r]);
    float ps = 0;
#pragma unroll
    for (int r = 0; r < 16; ++r) ps += p0[r];
#pragma unroll
    for (int r = 0; r < 16; ++r) ps += p1[r];
    l_reg += ps;
#define PK4(P, BASE, OUT) do { u32x4 w = {cvtpk(P[BASE + 0], P[BASE + 1]), cvtpk(P[BASE + 2], P[BASE + 3]), cvtpk(P[BASE + 4], P[BASE + 5]), cvtpk(P[BASE + 6], P[BASE + 7])}; \
    OUT = *reinterpret_cast<bf16x8*>(&w); } while (0)
    PK4(p0, 0, pa0); PK4(p0, 8, pa1); PK4(p1, 0, pa2); PK4(p1, 8, pa3);
#undef PK4
}
__device__ __forceinline__ void qkt(f32x16& p0, f32x16& p1, const char* Ks, const bf16x8* qr, int r32, int hi, int mp, float nm) {
#pragma unroll
    for (int r = 0; r < 16; ++r) { p0[r] = nm; p1[r] = nm; }
    bf16x8 b0n, b1n;
    { const int cb = ((mp * 4 + 0) * 16 + hi * 8) * 2; b0n = *reinterpret_cast<const bf16x8*>(Ks + KSWZ(r32, cb)); b1n = *reinterpret_cast<const bf16x8*>(Ks + KSWZ(32 + r32, cb)); }
#pragma unroll
    for (int d0 = 0; d0 < 4; ++d0) { const bf16x8 b0 = b0n, b1 = b1n;
        if (d0 < 3) { const int cb = ((mp * 4 + d0 + 1) * 16 + hi * 8) * 2; b0n = *reinterpret_cast<const bf16x8*>(Ks + KSWZ(r32, cb)); b1n = *reinterpret_cast<const bf16x8*>(Ks + KSWZ(32 + r32, cb)); }
        __builtin_amdgcn_sched_barrier(0);
        p0 = __builtin_amdgcn_mfma_f32_32x32x16_bf16(b0, qr[d0], p0, 0, 0, 0);
        p1 = __builtin_amdgcn_mfma_f32_32x32x16_bf16(b1, qr[d0], p1, 0, 0, 0); }
}
__device__ __forceinline__ int v_st(int k, int c) { const int kk = k; return ((kk >> 3) * 4 + (c >> 5)) * 512 + ((kk & 7) * 32 + (c & 31)) * 2; }
__device__ __forceinline__ int v_rd_base(int lane) { return ((lane & 3) << 3) | (((lane >> 2) & 3) << 6) | (((lane >> 4) & 1) << 5) | (((lane >> 5) & 1) << 8); }
constexpr int v_rd_off(int d0, int ks, int half) { return d0 * 512 + ks * 4096 + half * 2048; }
template <int OFF> __device__ __forceinline__ s16x4 tr_read(int vb) {
    s16x4 r; asm volatile("ds_read_b64_tr_b16 %0, %1 offset:%2" : "=&v"(r) : "v"(vb), "i"(OFF) : "memory"); return r;
}
template <int D0, bool EXPS> __device__ __forceinline__ void pv_one(f32x16& od, int vb, bf16x8 pa0, bf16x8 pa1, bf16x8 pa2, bf16x8 pa3, f32x16& pn) {
    const s16x4 l0 = tr_read<v_rd_off(D0, 0, 0)>(vb), h0 = tr_read<v_rd_off(D0, 0, 1)>(vb), l1 = tr_read<v_rd_off(D0, 1, 0)>(vb), h1 = tr_read<v_rd_off(D0, 1, 1)>(vb);
    const s16x4 l2 = tr_read<v_rd_off(D0, 2, 0)>(vb), h2 = tr_read<v_rd_off(D0, 2, 1)>(vb), l3 = tr_read<v_rd_off(D0, 3, 0)>(vb), h3 = tr_read<v_rd_off(D0, 3, 1)>(vb);
    asm volatile("s_waitcnt lgkmcnt(0)" ::: "memory"); SBAR();
#define PK(L, H) (bf16x8){L[0], L[1], L[2], L[3], H[0], H[1], H[2], H[3]}
    od = __builtin_amdgcn_mfma_f32_32x32x16_bf16(pa0, PK(l0, h0), od, 0, 0, 0);
    od = __builtin_amdgcn_mfma_f32_32x32x16_bf16(pa1, PK(l1, h1), od, 0, 0, 0);
    od = __builtin_amdgcn_mfma_f32_32x32x16_bf16(pa2, PK(l2, h2), od, 0, 0, 0);
    od = __builtin_amdgcn_mfma_f32_32x32x16_bf16(pa3, PK(l3, h3), od, 0, 0, 0);
#undef PK
    if constexpr (EXPS) {
#pragma unroll
        for (int r = 4 * D0; r < 4 * D0 + 4; ++r) pn[r] = __builtin_amdgcn_exp2f(pn[r]); }
}
template <bool EXPS> __device__ __forceinline__ void pv_d0(f32x16* o, int vb, bf16x8 pa0, bf16x8 pa1, bf16x8 pa2, bf16x8 pa3, f32x16& pn) {
    pv_one<0, EXPS>(o[0], vb, pa0, pa1, pa2, pa3, pn); pv_one<1, EXPS>(o[1], vb, pa0, pa1, pa2, pa3, pn); pv_one<2, EXPS>(o[2], vb, pa0, pa1, pa2, pa3, pn); pv_one<3, EXPS>(o[3], vb, pa0, pa1, pa2, pa3, pn);
}

__device__ __forceinline__ void attn_unit(const bf16_t* __restrict__ proj, bf16_t* __restrict__ mix, const float* __restrict__ subw, float lam, float osc,
                                          const unsigned* __restrict__ kmax2, int b, int h, int qrow0, int nkeys, char* lds) {
    const int tid = fresh_tid(), wid = tid >> 6, lane = tid & 63, r32 = lane & 31, hi = lane >> 5, mp = wid >> 2, wq = wid & 3;
    constexpr int SLOT = SHM_V + SHM_K;
    float* ws = (float*)(lds + 3 * SLOT) + wid * 64; float* li_l = ws;
    float l_reg = 0; f32x16 o[4] = {}; bf16x8 qr[4];
    const int wu = __builtin_amdgcn_readfirstlane(wid);
    unsigned offV[2], offK[2];
#pragma unroll
    for (int q = 0; q < 2; ++q) { const int pc = 2 * wu + q;
        { const int key = 8 * (pc >> 1) + ((lane >> 2) & 7), col = 32 * (2 * (pc & 1) + (lane >> 5)) + (lane & 3) * 8; offV[q] = (unsigned)(key * INWP + col + C_V); }
        { const int row = 4 * pc + (lane >> 4), col = ((lane & 15) ^ (row & 7)) * 8; offK[q] = (unsigned)(row * INWP + col + C_K); } }
    const int vb0 = (int)(uintptr_t)lds + v_rd_base(lane);
    LAS unsigned char* lds3 = (LAS unsigned char*)(unsigned)(uintptr_t)lds;
    const int ctx_row0 = TLAT + b * LCTX, lat_row0 = b * SEQ - LCTX;
#define DMA_TILE(k0, so) do { const bf16_t* tb_ = proj + (size_t)((k0) < LCTX ? ctx_row0 + (k0) : lat_row0 + (k0)) * INWP + h * 128; \
    _Pragma("unroll") for (int q_ = 0; q_ < 2; ++q_) { \
        __builtin_amdgcn_global_load_lds((const unsigned*)(tb_ + offV[q_]), (LAS unsigned*)(lds3 + (so) + (2 * wu + q_) * 1024), 16, 0, 0); \
        __builtin_amdgcn_global_load_lds((const unsigned*)(tb_ + offK[q_]), (LAS unsigned*)(lds3 + (so) + SHM_V + (2 * wu + q_) * 1024), 16, 0, 0); } } while (0)
    f32x16 pA0, pA1, pB0, pB1; bf16x8 pa0, pa1, pa2, pa3; const int NT = nkeys / 64;
    int sl_prev = 0, sl_cur = 0, sl_next = SLOT;
#define ROT() do { sl_prev = sl_cur; sl_cur = sl_next; sl_next = (sl_next == 2 * SLOT) ? 0 : sl_next + SLOT; } while (0)
    DMA_TILE(0, 0); DMA_TILE(64, SLOT);
    const bf16_t* Qw = proj + (size_t)(qrow0 + wq * 32 + r32) * INWP + C_Q + h * 128 + mp * 64 + hi * 8;
    float qss = 0.f;
    bf16x8 qraw[4];
#pragma unroll
    for (int d0 = 0; d0 < 4; ++d0) qraw[d0] = ld8(Qw + d0 * 16);
    const float km2 = __uint_as_float(kmax2[h * 2 + mp]);
    __builtin_amdgcn_sched_barrier(0);
#pragma unroll
    for (int d0 = 0; d0 < 4; ++d0) { float f[8]; const bf16x8 raw = qraw[d0]; unpack8(*reinterpret_cast<const u32x4*>(&raw), f);
        constexpr float C = SCALE * 1.4426950408889634f;
        u32x4 w; w.x = cvtpk(f[0] * C, f[1] * C); w.y = cvtpk(f[2] * C, f[3] * C); w.z = cvtpk(f[4] * C, f[5] * C); w.w = cvtpk(f[6] * C, f[7] * C);
        float g[8]; unpack8(w, g);
#pragma unroll
        for (int e = 0; e < 8; ++e) qss += g[e] * g[e];
        qr[d0] = *reinterpret_cast<const bf16x8*>(&w); }
    qss += __shfl_xor(qss, 32);
    const float nm = -1.002f * sqrtf(qss) * sqrtf(km2);
    asm volatile("s_waitcnt vmcnt(0)" ::: "memory"); __syncthreads();
    qkt(pA0, pA1, lds + SHM_V, qr, r32, hi, mp, nm); partialSM(pA0);
    ROT();
#define ITER(PC0, PC1, PP0, PP1, j) do { if ((j) + 1 < NT) DMA_TILE(((j) + 1) * 64, sl_next); \
        SBAR(); qkt(PC0, PC1, lds + sl_cur + SHM_V, qr, r32, hi, mp, nm); \
        finishSM(PP0, PP1, l_reg, pa0, pa1, pa2, pa3); SBAR(); \
        pv_d0<true>(o, vb0 + sl_prev, pa0, pa1, pa2, pa3, PC0); \
        asm volatile("s_waitcnt vmcnt(0)" ::: "memory");     \
        __syncthreads(); ROT(); } while (0)
    for (int j = 1; j + 1 < NT; j += 2) { ITER(pB0, pB1, pA0, pA1, j); ITER(pA0, pA1, pB0, pB1, j + 1); }
    ITER(pB0, pB1, pA0, pA1, NT - 1);
    finishSM(pB0, pB1, l_reg, pa0, pa1, pa2, pa3); SBAR();
    pv_d0<false>(o, vb0 + sl_prev, pa0, pa1, pa2, pa3, pA0);
#undef ITER
#undef ROT
#undef DMA_TILE
    asm volatile("s_waitcnt vmcnt(0)" ::: "memory");
    l_reg += __shfl_xor(l_reg, 32);
    if (hi == 0) li_l[r32] = (mp ? lam : 1.0f) / l_reg;
    asm volatile("s_waitcnt lgkmcnt(0)" ::: "memory");
#pragma unroll
    for (int r = 0; r < 16; ++r) { const float f = li_l[crow(r, hi)];
#pragma unroll
        for (int d0 = 0; d0 < 4; ++d0) o[d0][r] *= f; }
    __syncthreads();
    float* ex = (float*)lds;
    bf16_t* ot = (bf16_t*)(lds + 65536);
    if (mp == 1) {
#pragma unroll
        for (int r = 0; r < 16; ++r)
#pragma unroll
            for (int d0 = 0; d0 < 4; ++d0) ex[(wq * 32 + crow(r, hi)) * 128 + d0 * 32 + r32] = o[d0][r];
    }
    __syncthreads();
    if (mp == 0) {
        const int t2 = fresh_tid(), r32 = t2 & 31, hi = (t2 >> 5) & 1, wq = (t2 >> 6) & 3;
        float wcol[4];
#pragma unroll
        for (int d0 = 0; d0 < 4; ++d0) wcol[d0] = subw[d0 * 32 + r32] * osc;
#pragma unroll
        for (int r = 0; r < 16; ++r) {
            float ss = 0.f;
#pragma unroll
            for (int d0 = 0; d0 < 4; ++d0) { o[d0][r] -= ex[(wq * 32 + crow(r, hi)) * 128 + d0 * 32 + r32]; ss += o[d0][r] * o[d0][r]; }
            ss = sum32(ss);
            const float rn = rsqrtf(ss * (1.0f / 128.0f) + EPS);
            bf16_t* op = ot + (wq * 32 + crow(r, hi)) * 136 + r32;
#pragma unroll
            for (int d0 = 0; d0 < 4; ++d0) op[d0 * 32] = (bf16_t)f2bf(o[d0][r] * rn * wcol[d0]);
        }
    }
    __syncthreads();
    { const int t3 = fresh_tid();
#pragma unroll
      for (int it = 0; it < 4; ++it) { const int idx = t3 + 512 * it, row = idx >> 4, pc = idx & 15;
          *(u32x4*)(mix + (size_t)(qrow0 + row) * DM + h * 128 + pc * 8) = *(const u32x4*)(ot + row * 136 + pc * 8); } }
    __syncthreads();
}
}


namespace ck {
template <int K>
__device__ __forceinline__ f32x16 mma32(const bf16_t* A, int lda, const bf16_t* B, int ldb, f32x16 acc, int r32, int hi) {
#pragma unroll
    for (int k0 = 0; k0 < K; k0 += 16) {
        const bf16x8 a = *(const bf16x8*)(A + r32 * lda + k0 + 8 * hi), b = *(const bf16x8*)(B + r32 * ldb + k0 + 8 * hi);
        acc = __builtin_amdgcn_mfma_f32_32x32x16_bf16(a, b, acc, 0, 0, 0); }
    return acc;
}
__device__ __forceinline__ int crow(int r, int hi) { return (r & 3) + 8 * (r >> 2) + 4 * hi; }
struct P { bf16_t* proj; bf16_t* xbcs; float* dtv; float* cumv; float* gkv; bf16_t* ssd_st; bf16_t* gla_st; float* cds; float* cdg; bf16_t* mix; const f32x2* ropet;
           const float *convw, *convb, *dtb, *alog, *gkup, *gkb, *ssdd, *ssdnw, *glanw; unsigned* kmax2; bf16_t* hins; bf16_t* hing; };

__device__ __forceinline__ void prep_chunk(const P& p, int ch, unsigned char* lds, int sect, bool dry = false) {
    const int tid = fresh_tid(), lane = tid & 63, wave = __builtin_amdgcn_readfirstlane(tid >> 6), r32 = lane & 31, hi = lane >> 5;
    const int row0 = ch * 64; const bool lat = row0 < TLAT;
    float* dtl = (float*)lds; float* al = dtl + 512; float* cuml = al + 512; float* wgt = cuml + 512; float* tot = wgt + 512;
    bf16_t* XwT = (bf16_t*)(lds + 16384);
    bf16_t* BT = (bf16_t*)(lds + 90112);
    if (lat && !dry && (sect & 1)) {
#pragma unroll 1
        for (int hb = 0; hb < 2; ++hb) {
            u32x4 a1[4], a2[4]; f32x4 tb[4][4];
#pragma unroll
            for (int q = 0; q < 4; ++q) { const int idx = tid + 512 * (hb * 4 + q);
                const int jg = idx & 1, half = (idx >> 1) & 1, mp = (idx >> 2) & 1, hh = (idx >> 3) & 3, qk = (idx >> 5) & 1, tok = idx >> 6;
                const int row = row0 + tok, s = row & (SEQ - 1), pos = half ? (s & 63) : (s >> 6);
                const bf16_t* p1 = p.proj + (size_t)row * INWP + qk * 512 + hh * 128 + mp * 64 + half * 32 + jg * 8;
                a1[q] = *(const u32x4*)p1; a2[q] = *(const u32x4*)(p1 + 16);
                const f32x4* tp = (const f32x4*)(p.ropet + pos * 16 + jg * 8);
#pragma unroll
                for (int e = 0; e < 4; ++e) tb[q][e] = tp[e]; }
#pragma unroll
            for (int q = 0; q < 4; ++q) { const int idx = tid + 512 * (hb * 4 + q);
                const int jg = idx & 1, half = (idx >> 1) & 1, mp = (idx >> 2) & 1, hh = (idx >> 3) & 3, qk = (idx >> 5) & 1, tok = idx >> 6;
                bf16_t* p1 = p.proj + (size_t)(row0 + tok) * INWP + qk * 512 + hh * 128 + mp * 64 + half * 32 + jg * 8;
                float x1[8], x2[8], o1[8], o2[8]; unpack8(a1[q], x1); unpack8(a2[q], x2);
#pragma unroll
                for (int e = 0; e < 4; ++e) { const f32x4 cs = tb[q][e];
                    o1[2 * e] = x1[2 * e] * cs.x - x2[2 * e] * cs.y; o2[2 * e] = x2[2 * e] * cs.x + x1[2 * e] * cs.y;
                    o1[2 * e + 1] = x1[2 * e + 1] * cs.z - x2[2 * e + 1] * cs.w; o2[2 * e + 1] = x2[2 * e + 1] * cs.z + x1[2 * e + 1] * cs.w; }
                *(u32x4*)p1 = pack8(o1); *(u32x4*)(p1 + 16) = pack8(o2); }
        }
    }
    const int spos = lat ? ((row0 + lane) & (SEQ - 1)) : ((row0 + lane - TLAT) & (LCTX - 1)), slen = lat ? SEQ : LCTX;
    if (sect & 2) {
    u32x4 c0[4], cm[4], cp[4];
    const bf16_t* cbase = p.proj + (size_t)(row0 + lane) * INWP + C_XBC;
    const int dm = spos > 0 ? -INWP : 0, dp = spos < slen - 1 ? INWP : 0;
#pragma unroll
    for (int q = 0; q < 4; ++q) { const bf16_t* pp = cbase + (wave + 8 * q) * 8; c0[q] = *(const u32x4*)pp; cm[q] = *(const u32x4*)(pp + dm); cp[q] = *(const u32x4*)(pp + dp); }
    float* cwl = (float*)(lds + 108544);
    { const int i4 = tid * 4; *(f32x4*)(cwl + i4) = (i4 < 512) ? *(const f32x4*)(p.convb + i4) : *(const f32x4*)(p.convw + (i4 - 512)); }
    { const int tok = tid >> 3, i = tid & 7, row = row0 + tok;
      const float x = bf2f(p.proj[(size_t)row * INWP + C_DT + i]) + p.dtb[i];
      const float dt = softplusf(x), A = -expf(p.alog[i]);
      dtl[tid] = dt; al[tid] = dt * A; p.dtv[(size_t)row * 8 + i] = dt; }
    unsigned* kml = (unsigned*)(tot + 8);
    if (tid < 8) kml[tid] = 0u;
    LDS_BARRIER();
    { const int tok = tid >> 3, hm = tid & 7; const bf16_t* kp = p.proj + (size_t)(row0 + tok) * INWP + C_K + hm * 64; float ss = 0.f;
#pragma unroll
      for (int q = 0; q < 8; ++q) { float f[8]; unpack8(*(const u32x4*)(kp + q * 8), f);
#pragma unroll
          for (int e = 0; e < 8; ++e) ss += f[e] * f[e]; }
      atomicMax(&kml[hm], __float_as_uint(ss)); }
    { const int i = wave, dir = i >> 2; const float c = wave_scan(al[lane * 8 + i], lane, dir != 0);
      cuml[lane * 8 + i] = c; if (lane == (dir ? 0 : 63)) { tot[i] = c; p.cds[ch * 8 + i] = __expf(c); } }
    LDS_BARRIER();
    if (tid < 8) atomicMax(p.kmax2 + (lat ? (row0 >> 13) : ((row0 - TLAT) >> 8)) * 8 + tid, kml[tid]);
    { const int tok = tid >> 3, i = tid & 7, row = row0 + tok; const float cmv = cuml[tid];
      wgt[tid] = __expf(tot[i] - cmv) * dtl[tid]; p.cumv[(size_t)row * 8 + i] = cmv; }
    LDS_BARRIER();
#pragma unroll
    for (int hb = 0; hb < 2; ++hb) {
        u32x4 n0[4], nm[4], np[4];
        if (hb == 0) {
#pragma unroll
            for (int q = 0; q < 4; ++q) { const bf16_t* pp = cbase + (wave + 8 * (4 + q)) * 8; n0[q] = *(const u32x4*)pp; nm[q] = *(const u32x4*)(pp + dm); np[q] = *(const u32x4*)(pp + dp); } }
#pragma unroll
        for (int q = 0; q < 4; ++q) { const int cg = wave + 8 * (hb * 4 + q), row = row0 + lane;
            float xm[8], x0[8], xp[8], o[8];
            unpack8(c0[q], x0); unpack8(cm[q], xm); unpack8(cp[q], xp);
            const float zm = spos > 0 ? 1.f : 0.f, zp = spos < slen - 1 ? 1.f : 0.f;
#pragma unroll
            for (int e = 0; e < 8; ++e) { const int c = cg * 8 + e; o[e] = siluf(cwl[c] + cwl[512 + c] * (xm[e] * zm) + cwl[1024 + c] * x0[e] + cwl[1536 + c] * (xp[e] * zp)); }
            const u32x4 pk = pack8(o);
            *(u32x4*)(p.xbcs + (size_t)row * 512 + cg * 8) = pk;
            if (cg < 32) { float ob[8]; unpack8(pk, ob); const float wf = wgt[lane * 8 + (cg >> 3)], wb = wgt[lane * 8 + 4 + (cg >> 3)];
#pragma unroll
                for (int e = 0; e < 8; ++e) { XwT[(cg * 8 + e) * 72 + lane] = (bf16_t)f2bf(ob[e] * wf); XwT[(256 + cg * 8 + e) * 72 + lane] = (bf16_t)f2bf(ob[e] * wb); } }
            else if (cg < 48) { const unsigned wv[4] = {pk.x, pk.y, pk.z, pk.w};
#pragma unroll
                for (int e = 0; e < 8; ++e) BT[((cg - 32) * 8 + e) * 72 + lane] = (bf16_t)((wv[e >> 1] >> ((e & 1) * 16)) & 0xffffu); } }
        if (hb == 0) {
#pragma unroll
            for (int q = 0; q < 4; ++q) { c0[q] = n0[q]; cm[q] = nm[q]; cp[q] = np[q]; } }
    }
    LDS_BARRIER();
#pragma unroll 1
    for (int q = 0; q < 4; ++q) {
        const int t = wave * 4 + q, dir = t >> 4, hh = (t >> 2) & 3, pt = (t >> 1) & 1, nt = t & 1;
        f32x16 acc = {};
        acc = mma32<64>(XwT + (dir * 256 + hh * 64 + pt * 32) * 72, 72, BT + ((hh >> 1) * 64 + nt * 32) * 72, 72, acc, r32, hi);
        bf16_t* dst = p.ssd_st + ((size_t)(ch * 2 + dir) * 4 + hh) * 4096 + nt * 32 + r32;
#pragma unroll
        for (int r = 0; r < 16; ++r) dst[(pt * 32 + crow(r, hi)) * 64] = (bf16_t)f2bf(acc[r]);
    }
    LDS_BARRIER();
    }
    if (sect & 12) {
    float* gkd = (float*)lds; float* bendl = (float*)(lds + 33792); bf16_t* KeT = (bf16_t*)(lds + 34816); bf16_t* VT = (bf16_t*)(lds + 71680);
    u32x4 vpk[4], kpk[2], cd[2][2];
    const bf16_t* rowp = p.proj + (size_t)(row0 + lane) * INWP;
#pragma unroll
    for (int it = 0; it < 4; ++it) vpk[it] = *(const u32x4*)(rowp + C_GV + (wave + 8 * it) * 8);
#pragma unroll
    for (int it = 0; it < 2; ++it) kpk[it] = *(const u32x4*)(rowp + C_GK + (wave + 8 * it) * 8);
    { const bf16_t* cpp = p.proj + (size_t)(row0 + (tid >> 3)) * INWP + C_CODE;
#pragma unroll
      for (int d = 0; d < 2; ++d) { cd[d][0] = *(const u32x4*)(cpp + d * 16); cd[d][1] = *(const u32x4*)(cpp + d * 16 + 8); } }
#pragma unroll
    for (int it = 0; it < 4; ++it) { const int vg = wave + 8 * it; const unsigned wv[4] = {vpk[it].x, vpk[it].y, vpk[it].z, vpk[it].w};
#pragma unroll
        for (int e = 0; e < 8; ++e) VT[(vg * 8 + e) * 72 + lane] = (bf16_t)((wv[e >> 1] >> ((e & 1) * 16)) & 0xffffu); }
    float* upl = (float*)(lds + 108544); float* gbl = upl + 4096;
    { *(f32x4*)(upl + tid * 4) = *(const f32x4*)(p.gkup + tid * 4); *(f32x4*)(upl + 2048 + tid * 4) = *(const f32x4*)(p.gkup + 2048 + tid * 4);
      if (tid < 64) *(f32x4*)(gbl + tid * 4) = *(const f32x4*)(p.gkb + tid * 4); }
    LDS_BARRIER();
#pragma unroll
    for (int dir = 0; dir < 2; ++dir) {
        if (!(sect & (4 << dir))) continue;
        { const int tok = tid >> 3, s8 = tid & 7, c0 = s8 * 16;
          float code[16]; { float t8[8]; unpack8(cd[dir][0], t8);
#pragma unroll
              for (int e = 0; e < 8; ++e) code[e] = t8[e];
              unpack8(cd[dir][1], t8);
#pragma unroll
              for (int e = 0; e < 8; ++e) code[8 + e] = t8[e]; }
          const float* up = upl + dir * 16 * 128 + c0; const float* gb = gbl + dir * 128 + c0;
#pragma unroll 1
          for (int q = 0; q < 4; ++q) { f32x4 a = *(const f32x4*)(gb + 4 * q); f32x4 w[16];
#pragma unroll
              for (int r = 0; r < 16; ++r) w[r] = *(const f32x4*)(up + r * 128 + 4 * q);
              __builtin_amdgcn_sched_barrier(0);
#pragma unroll
              for (int r = 0; r < 16; ++r) a += w[r] * code[r];
              f32x4 o; o.x = logsigmoidf(a.x) * 0.0625f; o.y = logsigmoidf(a.y) * 0.0625f; o.z = logsigmoidf(a.z) * 0.0625f; o.w = logsigmoidf(a.w) * 0.0625f;
              *(f32x4*)(gkd + tok * 132 + c0 + 4 * q) = o; } }
        LDS_BARRIER();
#pragma unroll 4
        for (int q = 0; q < 16; ++q) { const int c = wave * 16 + q; const float acc = wave_scan(gkd[lane * 132 + c], lane, dir != 0);
            gkd[lane * 132 + c] = acc; if (lane == (dir ? 0 : 63)) { bendl[c] = acc; p.cdg[ch * 256 + dir * 128 + c] = __expf(acc); } }
        LDS_BARRIER();
        for (int it = 0; it < 4; ++it) { const int idx = tid + 512 * it, tok = idx >> 5, q4 = idx & 31;
            *(f32x4*)(p.gkv + (size_t)(row0 + tok) * 256 + dir * 128 + q4 * 4) = *(const f32x4*)(gkd + tok * 132 + q4 * 4); }
#pragma unroll
        for (int it = 0; it < 2; ++it) { const int kg = wave + 8 * it;
            float kv[8]; unpack8(kpk[it], kv);
            const f32x4 b0 = *(const f32x4*)(gkd + lane * 132 + kg * 8), b1 = *(const f32x4*)(gkd + lane * 132 + kg * 8 + 4);
            const f32x4 e0 = *(const f32x4*)(bendl + kg * 8), e1 = *(const f32x4*)(bendl + kg * 8 + 4);
            const float bb[8] = {b0.x, b0.y, b0.z, b0.w, b1.x, b1.y, b1.z, b1.w}, be[8] = {e0.x, e0.y, e0.z, e0.w, e1.x, e1.y, e1.z, e1.w};
#pragma unroll
            for (int e = 0; e < 8; ++e) KeT[(dir * 128 + kg * 8 + e) * 72 + lane] = (bf16_t)f2bf(kv[e] * __expf(be[e] - bb[e])); }
        LDS_BARRIER();
    }
#pragma unroll 1
    for (int q = 0; q < 2; ++q) {
        const int t = wave * 2 + q, dir = t >> 3, hh = (t >> 1) & 3, vt = t & 1;
        if (!(sect & (4 << dir))) continue;
        f32x16 acc = {};
        acc = mma32<64>(VT + (hh * 64 + vt * 32) * 72, 72, KeT + (dir * 128 + hh * 32) * 72, 72, acc, r32, hi);
        bf16_t* dst = p.gla_st + ((size_t)(ch * 2 + dir) * 4 + hh) * 2048 + r32;
#pragma unroll
        for (int r = 0; r < 16; ++r) dst[(vt * 32 + crow(r, hi)) * 32] = (bf16_t)f2bf(acc[r]);
    }
    LDS_BARRIER();
    }
}

__device__ __forceinline__ void scan_phase(const P& p, int bx) {
    const int tid = fresh_tid();
    if (tid >= 384) return;
    const int e0 = bx * 384 + tid; const bool ssd = e0 < 65536; const int e = ssd ? e0 : e0 - 65536;
    const int b = ssd ? e >> 15 : e >> 14, dir = ssd ? (e >> 14) & 1 : (e >> 13) & 1, hh = ssd ? (e >> 12) & 3 : (e >> 11) & 3, el = ssd ? e & 4095 : e & 2047;
    const bf16_t* st = ssd ? p.ssd_st : p.gla_st; bf16_t* ho = ssd ? p.hins : p.hing; const int esz = ssd ? 4096 : 2048;
    const float* dcp = ssd ? p.cds + dir * 4 + hh : p.cdg + dir * 128 + hh * 32 + (el & 31); const int dst = ssd ? 8 : 256;
    float hst = 0.f;
#pragma unroll 1
    for (int kb = 0; kb < 132; kb += 22) {
        float sv[22], dv[22]; int ci[22];
#pragma unroll
        for (int u = 0; u < 22; ++u) { const int k = kb + u; ci[u] = k < 4 ? 256 + 4 * b + (dir ? 3 - k : k) : 128 * b + (dir ? 127 - (k - 4) : (k - 4));
            sv[u] = bf2f(st[((size_t)(ci[u] * 2 + dir) * 4 + hh) * esz + el]); dv[u] = dcp[ci[u] * dst]; }
#pragma unroll
        for (int u = 0; u < 22; ++u) { ho[((size_t)(ci[u] * 2 + dir) * 4 + hh) * esz + el] = (bf16_t)f2bf(hst); hst = hst * dv[u] + sv[u]; }
    }
}

__device__ __forceinline__ void finish_chunk(const P& p, int ch, unsigned char* lds, int sect) {
    const int tid = fresh_tid(), lane = tid & 63, wave = __builtin_amdgcn_readfirstlane(tid >> 6), r32 = lane & 31, hi = lane >> 5;
    const int row0 = ch * 64;
    float* cml = (float*)lds; float* dtl = cml + 512; float* psum = dtl + 512;
    const float cm0_ = p.cumv[(size_t)row0 * 8 + tid], dt0_ = p.dtv[(size_t)row0 * 8 + tid]; bool first_ = true;
    bf16_t* Cn = (bf16_t*)(lds + 8192); bf16_t* Bn = (bf16_t*)(lds + 17408); bf16_t* XT = (bf16_t*)(lds + 26624); bf16_t* Mb = (bf16_t*)(lds + 45056); bf16_t* hin = (bf16_t*)(lds + 63488); bf16_t* Zs = (bf16_t*)(lds + 100352);
    const int hl = wave >> 2, rt = (wave >> 1) & 1, ct = wave & 1;
#pragma unroll 1
    for (int g = 0; g < 2; ++g) {
        if (!(sect & (1 << g))) continue;
        { u32x4 sA[2], sZ[2], sX[2], sH[4];
#pragma unroll
          for (int it = 0; it < 2; ++it) { const int idx = tid + 512 * it, arr = idx >> 9, r = idx & 511, tok = r >> 3, pc = r & 7;
              sA[it] = *(const u32x4*)(p.xbcs + (size_t)(row0 + tok) * 512 + (arr ? 384 : 256) + g * 64 + pc * 8); }
#pragma unroll
          for (int it = 0; it < 2; ++it) { const int idx = tid + 512 * it, tok = idx >> 4, pc = idx & 15;
              sZ[it] = *(const u32x4*)(p.proj + (size_t)(row0 + tok) * INWP + C_Z + g * 128 + pc * 8); }
#pragma unroll
          for (int it = 0; it < 2; ++it) { const int idx = tid + 512 * it, tok = idx & 63, cg = idx >> 6;
              sX[it] = *(const u32x4*)(p.xbcs + (size_t)(row0 + tok) * 512 + g * 128 + cg * 8); }
#pragma unroll
          for (int it = 0; it < 4; ++it) { const int idx = tid + 512 * it, dq = idx >> 9, r = idx & 511, pp = r >> 3, q8 = r & 7;
              sH[it] = *(const u32x4*)(p.hins + ((size_t)(ch * 2 + (dq >> 1)) * 4 + 2 * g + (dq & 1)) * 4096 + pp * 64 + q8 * 8); }
          __builtin_amdgcn_sched_barrier(0);
          if (first_) { cml[tid] = cm0_; dtl[tid] = dt0_; first_ = false; }
#pragma unroll
          for (int it = 0; it < 2; ++it) { const int idx = tid + 512 * it, arr = idx >> 9, r = idx & 511, tok = r >> 3, pc = r & 7;
              *(u32x4*)((arr ? Cn : Bn) + tok * 72 + pc * 8) = sA[it]; }
#pragma unroll
          for (int it = 0; it < 2; ++it) { const int idx = tid + 512 * it, tok = idx >> 4, pc = idx & 15;
              *(u32x4*)(Zs + tok * 136 + pc * 8) = sZ[it]; }
#pragma unroll
          for (int it = 0; it < 2; ++it) { const int idx = tid + 512 * it, tok = idx & 63, cg = idx >> 6;
              const u32x4 pk = sX[it]; const unsigned wv[4] = {pk.x, pk.y, pk.z, pk.w};
#pragma unroll
              for (int e = 0; e < 8; ++e) XT[(cg * 8 + e) * 72 + tok] = (bf16_t)((wv[e >> 1] >> ((e & 1) * 16)) & 0xffffu); }
#pragma unroll
          for (int it = 0; it < 4; ++it) { const int idx = tid + 512 * it, dq = idx >> 9, r = idx & 511, pp = r >> 3, q8 = r & 7;
              *(u32x4*)(hin + (dq * 64 + pp) * 72 + q8 * 8) = sH[it]; } }
        LDS_BARRIER();
        const int hh = 2 * g + hl;
        { f32x16 acc = {}; acc = mma32<64>(Cn + rt * 32 * 72, 72, Bn + ct * 32 * 72, 72, acc, r32, hi);
          const int j = ct * 32 + r32; const float cfj = cml[j * 8 + hh], cbj = cml[j * 8 + 4 + hh], dfj = dtl[j * 8 + hh], dbj = dtl[j * 8 + 4 + hh];
#pragma unroll
          for (int r = 0; r < 16; ++r) { const int i = rt * 32 + crow(r, hi); const float cfi = cml[i * 8 + hh], cbi = cml[i * 8 + 4 + hh];
              const float lf = (j <= i) ? __expf(cfi - cfj) * dfj : 0.f, lb = (j >= i) ? __expf(cbi - cbj) * dbj : 0.f;
              Mb[(hl * 64 + i) * 72 + j] = (bf16_t)f2bf(acc[r] * (lf + lb)); } }
        LDS_BARRIER();
        { const int c = hh * 64 + ct * 32 + r32; const float dsk = p.ssdd[hh], wn = p.ssdnw[c];
          f32x16 y;
          { f32x16 t = {}; t = mma32<64>(Cn + rt * 32 * 72, 72, hin + ((0 * 2 + hl) * 64 + ct * 32) * 72, 72, t, r32, hi);
#pragma unroll
            for (int r = 0; r < 16; ++r) y[r] = __expf(cml[(rt * 32 + crow(r, hi)) * 8 + hh]) * t[r]; }
          { f32x16 t = {}; t = mma32<64>(Cn + rt * 32 * 72, 72, hin + ((1 * 2 + hl) * 64 + ct * 32) * 72, 72, t, r32, hi);
#pragma unroll
            for (int r = 0; r < 16; ++r) y[r] += __expf(cml[(rt * 32 + crow(r, hi)) * 8 + 4 + hh]) * t[r]; }
          y = mma32<64>(Mb + (hl * 64 + rt * 32) * 72, 72, XT + (hl * 64 + ct * 32) * 72, 72, y, r32, hi);
          const bf16_t* xcol = XT + (hl * 64 + ct * 32 + r32) * 72;
          bf16_t* zcol = Zs + hl * 64 + ct * 32 + r32;
#pragma unroll
          for (int r = 0; r < 16; ++r) { const int i = rt * 32 + crow(r, hi);
              y[r] = (y[r] + dsk * bf2f(xcol[i])) * siluf(bf2f(zcol[i * 136]));
              const float s = sum32(y[r] * y[r]); if (r32 == 0) psum[i * 8 + hl * 2 + ct] = s; }
          LDS_BARRIER();
#pragma unroll
          for (int r = 0; r < 16; ++r) { const int i = rt * 32 + crow(r, hi);
              const float rn = rsqrtf(((psum[i * 8] + psum[i * 8 + 1]) + (psum[i * 8 + 2] + psum[i * 8 + 3])) * (1.0f / 128.0f) + EPS);
              zcol[i * 136] = (bf16_t)f2bf(y[r] * rn * wn); } }
        LDS_BARRIER();
        for (int it = 0; it < 2; ++it) { const int idx = tid + 512 * it, tok = idx >> 4, pc = idx & 15;
            *(u32x4*)(p.mix + (size_t)(row0 + tok) * DM + 512 + g * 128 + pc * 8) = *(const u32x4*)(Zs + tok * 136 + pc * 8); }
        LDS_BARRIER();
    }
    float* bfl = (float*)lds; bf16_t* att = (bf16_t*)lds; float* psg = (float*)(lds + 34816);
    bf16_t* Qf = (bf16_t*)(lds + 36864); bf16_t* Kf = (bf16_t*)(lds + 57344); bf16_t* VTg = (bf16_t*)(lds + 77824); bf16_t* hing = (bf16_t*)(lds + 96256);
#pragma unroll 1
    for (int hp = 0; hp < 2; ++hp) {
        if (!(sect & (4 << hp))) continue;
        u32x4 qk4[4];
        { f32x4 sB[4]; u32x4 sV[2], sH[2];
#pragma unroll
          for (int it = 0; it < 4; ++it) { const int idx = tid + 512 * it, tok = idx >> 5, r = idx & 31, dir = r >> 4, q4 = r & 15;
              sB[it] = *(const f32x4*)(p.gkv + (size_t)(row0 + tok) * 256 + dir * 128 + hp * 64 + q4 * 4); }
#pragma unroll
          for (int it = 0; it < 2; ++it) { const int idx = tid + 512 * it, tok = idx & 63, vg = idx >> 6;
              sV[it] = *(const u32x4*)(p.proj + (size_t)(row0 + tok) * INWP + C_GV + hp * 128 + vg * 8); }
#pragma unroll
          for (int it = 0; it < 2; ++it) { const int idx = tid + 512 * it, dq = idx >> 8, r = idx & 255, vv = r >> 2, q8 = r & 3;
              sH[it] = *(const u32x4*)(p.hing + ((size_t)(ch * 2 + (dq >> 1)) * 4 + 2 * hp + (dq & 1)) * 2048 + vv * 32 + q8 * 8); }
          { const int tok = tid >> 3, s_ = tid & 7, h2 = (s_ >> 1) & 1, half = s_ & 1; const size_t row = (size_t)(row0 + tok); const int hcol = (2 * hp + h2) * 32 + half * 16;
            qk4[0] = *(const u32x4*)(p.proj + row * INWP + C_GQ + hcol); qk4[1] = *(const u32x4*)(p.proj + row * INWP + C_GQ + hcol + 8);
            qk4[2] = *(const u32x4*)(p.proj + row * INWP + C_GK + hcol); qk4[3] = *(const u32x4*)(p.proj + row * INWP + C_GK + hcol + 8); }
          __builtin_amdgcn_sched_barrier(0);
#pragma unroll
          for (int it = 0; it < 4; ++it) { const int idx = tid + 512 * it, tok = idx >> 5, r = idx & 31, dir = r >> 4, q4 = r & 15;
              *(f32x4*)(bfl + tok * 132 + dir * 64 + q4 * 4) = sB[it]; }
#pragma unroll
          for (int it = 0; it < 2; ++it) { const int idx = tid + 512 * it, tok = idx & 63, vg = idx >> 6;
              const u32x4 pk = sV[it]; const unsigned wv[4] = {pk.x, pk.y, pk.z, pk.w};
#pragma unroll
              for (int e = 0; e < 8; ++e) VTg[(vg * 8 + e) * 72 + tok] = (bf16_t)((wv[e >> 1] >> ((e & 1) * 16)) & 0xffffu); }
#pragma unroll
          for (int it = 0; it < 2; ++it) { const int idx = tid + 512 * it, dq = idx >> 8, r = idx & 255, vv = r >> 2, q8 = r & 3;
              *(u32x4*)(hing + (dq * 64 + vv) * 40 + q8 * 8) = sH[it]; } }
        LDS_BARRIER();
        { const int tok = tid >> 3, s = tid & 7, dir = s >> 2, h2 = (s >> 1) & 1, half = s & 1;
          float qv[16], kv[16];
          { float t8[8]; unpack8(qk4[0], t8);
#pragma unroll
            for (int e = 0; e < 8; ++e) qv[e] = t8[e];
            unpack8(qk4[1], t8);
#pragma unroll
            for (int e = 0; e < 8; ++e) qv[8 + e] = t8[e];
            unpack8(qk4[2], t8);
#pragma unroll
            for (int e = 0; e < 8; ++e) kv[e] = t8[e];
            unpack8(qk4[3], t8);
#pragma unroll
            for (int e = 0; e < 8; ++e) kv[8 + e] = t8[e]; }
          const float* bp = bfl + tok * 132 + dir * 64 + h2 * 32 + half * 16;
          float oq[16], ok[16];
#pragma unroll
          for (int q = 0; q < 4; ++q) { const f32x4 bv = *(const f32x4*)(bp + 4 * q); const float bb[4] = {bv.x, bv.y, bv.z, bv.w};
#pragma unroll
              for (int e = 0; e < 4; ++e) { const float ex = __expf(bb[e]), exi = __expf(-bb[e]); oq[q * 4 + e] = qv[q * 4 + e] * ex * 0.17677669529663687f; ok[q * 4 + e] = kv[q * 4 + e] * exi; } }
          bf16_t* qd = Qf + ((dir * 2 + h2) * 64 + tok) * 40 + half * 16; bf16_t* kd = Kf + ((dir * 2 + h2) * 64 + tok) * 40 + half * 16;
          u32x4 w; w.x = pk2(oq[0], oq[1]); w.y = pk2(oq[2], oq[3]); w.z = pk2(oq[4], oq[5]); w.w = pk2(oq[6], oq[7]); *(u32x4*)qd = w;
          w.x = pk2(oq[8], oq[9]); w.y = pk2(oq[10], oq[11]); w.z = pk2(oq[12], oq[13]); w.w = pk2(oq[14], oq[15]); *(u32x4*)(qd + 8) = w;
          w.x = pk2(ok[0], ok[1]); w.y = pk2(ok[2], ok[3]); w.z = pk2(ok[4], ok[5]); w.w = pk2(ok[6], ok[7]); *(u32x4*)kd = w;
          w.x = pk2(ok[8], ok[9]); w.y = pk2(ok[10], ok[11]); w.z = pk2(ok[12], ok[13]); w.w = pk2(ok[14], ok[15]); *(u32x4*)(kd + 8) = w; }
        LDS_BARRIER();
        { f32x16 af = {}, ab = {};
          af = mma32<32>(Qf + ((0 * 2 + hl) * 64 + rt * 32) * 40, 40, Kf + ((0 * 2 + hl) * 64 + ct * 32) * 40, 40, af, r32, hi);
          ab = mma32<32>(Qf + ((1 * 2 + hl) * 64 + rt * 32) * 40, 40, Kf + ((1 * 2 + hl) * 64 + ct * 32) * 40, 40, ab, r32, hi);
          const int j = ct * 32 + r32;
#pragma unroll
          for (int r = 0; r < 16; ++r) { const int i = rt * 32 + crow(r, hi);
              att[(hl * 64 + i) * 72 + j] = (bf16_t)f2bf(((j <= i) ? af[r] : 0.f) + ((j >= i) ? ab[r] : 0.f)); } }
        LDS_BARRIER();
        { f32x16 acc = {};
          bf16_t ggr[16];
          { const int c_ = (2 * hp + hl) * 64 + ct * 32 + r32;
#pragma unroll
            for (int r = 0; r < 16; ++r) ggr[r] = p.proj[(size_t)(row0 + rt * 32 + crow(r, hi)) * INWP + C_GG + c_]; }
          acc = mma32<64>(att + (hl * 64 + rt * 32) * 72, 72, VTg + (hl * 64 + ct * 32) * 72, 72, acc, r32, hi);
          acc = mma32<32>(Qf + ((0 * 2 + hl) * 64 + rt * 32) * 40, 40, hing + ((0 * 2 + hl) * 64 + ct * 32) * 40, 40, acc, r32, hi);
          acc = mma32<32>(Qf + ((1 * 2 + hl) * 64 + rt * 32) * 40, 40, hing + ((1 * 2 + hl) * 64 + ct * 32) * 40, 40, acc, r32, hi);
          const int hh = 2 * hp + hl, v = ct * 32 + r32, c = hh * 64 + v; const float wn = p.glanw[v];
#pragma unroll
          for (int r = 0; r < 16; ++r) { const int i = rt * 32 + crow(r, hi); const float s = sum32(acc[r] * acc[r]); if (r32 == 0) psg[i * 4 + hl * 2 + ct] = s; }
          LDS_BARRIER();
#pragma unroll
          for (int r = 0; r < 16; ++r) { const int i = rt * 32 + crow(r, hi); const size_t row = (size_t)(row0 + i);
              const float rn = rsqrtf((psg[i * 4 + hl * 2] + psg[i * 4 + hl * 2 + 1]) * (1.0f / 64.0f) + EPS);
              const float gg = bf2f(ggr[r]);
              p.mix[row * DM + 768 + c] = (bf16_t)f2bf(acc[r] * rn * wn * siluf(gg)); } }
        LDS_BARRIER();
    }
}
}

#define XB_TMO      128
#define XB_XCNT(j)  (256  + 64 * (j))
#define XB_XSUB(j)  (1280 + 64 * (j))
#define XB_XGEN(j)  (2304 + 64 * (j))
#define XB_TOP      3328
#define XB_TOPGEN   3392
#define XCD_BAR_WORDS 3456
#define XB_SPIN_CAP (1u << 20)
__device__ __forceinline__ unsigned xb_ld(unsigned* p)              { return __hip_atomic_load(p, __ATOMIC_RELAXED, __HIP_MEMORY_SCOPE_AGENT); }
__device__ __forceinline__ unsigned xb_add(unsigned* p, unsigned v) { return __hip_atomic_fetch_add(p, v, __ATOMIC_RELAXED, __HIP_MEMORY_SCOPE_AGENT); }
__device__ __forceinline__ unsigned xb_xcc_id() { return (unsigned)__builtin_amdgcn_s_getreg((3 << 11) | 20) & 0xFu; }
#define XB_SPIN(cond, bar) do { unsigned _sp = 0; while (cond) { __builtin_amdgcn_s_sleep(1); \
    if ((++_sp & 255u) == 0u) { if (xb_ld(&(bar)[XB_TMO])) break; if (_sp > XB_SPIN_CAP) { atomicAdd(&(bar)[XB_TMO], 1u); break; } } } } while (0)
struct XcdBarrier { unsigned* bar; unsigned x; volatile LAS unsigned* st; };
__device__ __forceinline__ XcdBarrier xcd_barrier_post(unsigned* bar, volatile LAS unsigned* st) {
    XcdBarrier b; b.bar = bar; b.x = xb_xcc_id(); b.st = st;
    if (threadIdx.x == 0) (void)xb_add(&bar[XB_XCNT(b.x)], 1u);
    return b;
}
__device__ __forceinline__ void xcd_barrier_complete(unsigned* bar, unsigned x, unsigned& nloc, unsigned& nx) {
    const unsigned G = gridDim.x * gridDim.y * gridDim.z;
    unsigned sum, cnt, mine, sp = 0u;
    for (;;) {
        sum = 0u; cnt = 0u; mine = 0u;
#pragma unroll
        for (unsigned j = 0; j < 16; ++j) { const unsigned c = xb_ld(&bar[XB_XCNT(j)]); sum += c; cnt += (c > 0u) ? 1u : 0u; mine = (j == x) ? c : mine; }
        if (sum == G) break;
        __builtin_amdgcn_s_sleep(1);
        if ((++sp & 255u) == 0u) { if (xb_ld(&bar[XB_TMO])) break; if (sp > XB_SPIN_CAP) { atomicAdd(&bar[XB_TMO], 1u); break; } }
    }
    nloc = mine > 0u ? mine : 1u; nx = cnt > 0u ? cnt : 1u;
}
__device__ __forceinline__ void xcd_barrier(const XcdBarrier& b) {
    asm volatile("s_waitcnt vmcnt(0)" ::: "memory");
    __syncthreads();
    if (threadIdx.x == 0) {
        GAS unsigned* barg_ = (GAS unsigned*)b.bar; asm volatile("" : "+s"(barg_)); unsigned* bar = (unsigned*)barg_;
        __builtin_amdgcn_s_waitcnt(0);
        unsigned nloc = b.st[0], nx = b.st[1];
        if (nloc == 0u) { xcd_barrier_complete(bar, b.x, nloc, nx); b.st[0] = nloc; b.st[1] = nx; }
        const unsigned old = xb_add(&bar[XB_XSUB(b.x)], 1u);
        const unsigned gen = old / nloc;
        if (old + 1u == (gen + 1u) * nloc) {
            __builtin_amdgcn_fence(__ATOMIC_RELEASE, "agent");
            asm volatile("s_waitcnt vmcnt(0)" ::: "memory");
            const unsigned og = xb_add(&bar[XB_TOP], 1u);
            const unsigned tg = og / nx;
            if (og + 1u == (tg + 1u) * nx) xb_add(&bar[XB_TOPGEN], 1u);
            else XB_SPIN(xb_ld(&bar[XB_TOPGEN]) == tg, bar);
            __builtin_amdgcn_fence(__ATOMIC_ACQUIRE, "agent");
            xb_add(&bar[XB_XGEN(b.x)], 1u);
            asm volatile("s_waitcnt vmcnt(0)" ::: "memory");
        } else {
            XB_SPIN(xb_ld(&bar[XB_XGEN(b.x)]) == gen, bar);
            __builtin_amdgcn_fence(__ATOMIC_ACQUIRE, "agent");
            asm volatile("s_waitcnt vmcnt(0)" ::: "memory");
        }
    }
    __syncthreads();
}

struct Args { const float* in[28]; float* out; unsigned char* ws; int ph_lo, ph_hi; };
enum { I_X = 0, I_C, I_CTX, I_CCTX, I_WADA, I_BADA, I_N1W, I_WIN, I_DALAM, I_SUBW, I_CONVW, I_CONVB, I_ALOG, I_DTB, I_SSDD, I_SSDNW, I_GKUP, I_GKB, I_GLANW, I_WOUT, I_N2W,
       I_WR, I_BR, I_WGU, I_BGU, I_WDN, I_BDN, I_FNW };

__device__ __forceinline__ void transpose_item(const float* __restrict__ W, int K, int Nsrc, bf16_t* __restrict__ WT, int n0, int dst_row0, int k0, unsigned* scr, int lane) {
    const bool ok = (n0 + lane) < Nsrc; const float* src = W + (size_t)k0 * Nsrc + n0 + lane;
#pragma unroll
    for (int hb = 0; hb < 2; ++hb) { float v[32];
#pragma unroll
        for (int i = 0; i < 32; ++i) v[i] = ok ? __builtin_nontemporal_load(src + (size_t)(hb * 32 + i) * Nsrc) : 0.f;
#pragma unroll
        for (int i = 0; i < 16; ++i) scr[lane * 33 + hb * 16 + i] = pk2(v[2 * i], v[2 * i + 1]); }
    LDS_WAIT();
    const int c = lane & 7;
#pragma unroll
    for (int j = 0; j < 8; ++j) { const int nn = (lane >> 3) + 8 * j; const unsigned* t = scr + nn * 33 + 4 * c;
        u32x4 o; o.x = t[0]; o.y = t[1]; o.z = t[2]; o.w = t[3];
        __builtin_nontemporal_store(o, (u32x4*)(WT + (size_t)(dst_row0 + nn) * K + k0 + 8 * c)); }
    LDS_WAIT();
}

__device__ __forceinline__ void norm_mod_store(const f32x4 (&v)[4], const float* __restrict__ nw, const float* __restrict__ sh, const float* __restrict__ sc, bf16_t* __restrict__ orow, int lane) {
    float ss = 0.f;
#pragma unroll
    for (int j = 0; j < 4; ++j) ss += (v[j].x * v[j].x + v[j].y * v[j].y) + (v[j].z * v[j].z + v[j].w * v[j].w);
    const float r = rsqrtf(wave_sum(ss) * (1.0f / DM) + EPS);
#pragma unroll
    for (int j = 0; j < 4; ++j) { const int c = 4 * lane + 256 * j;
        const f32x4 w = *(const f32x4*)(nw + c), a = *(const f32x4*)(sc + c), b = *(const f32x4*)(sh + c);
        const f32x4 y = (v[j] * r) * w * (a + 1.0f) + b;
        u32x2 o; o.x = pk2(y.x, y.y); o.y = pk2(y.z, y.w); *(u32x2*)(orow + c) = o; }
}

__device__ __forceinline__ int moe_tables(const unsigned* cnt, int* tile_e, int* pstart, int* cntl) {
    const int t = fresh_tid();
    if (t < NE) { int c = (int)cnt[t]; if (c > LISTCAP) c = LISTCAP; cntl[t] = c; }
    __syncthreads();
    if (t <= NE) { int acc = 0; for (int e = 0; e < t; ++e) acc += ((cntl[e] + 255) >> 8) << 8; pstart[t] = acc;
        if (t < NE) { const int nt = (cntl[t] + 255) >> 8; for (int q = 0; q < nt; ++q) tile_e[(acc >> 8) + q] = t; } }
    __syncthreads();
    return __builtin_amdgcn_readfirstlane(pstart[NE] >> 8);
}

__device__ __forceinline__ const float* inp_ptr(const unsigned char* ldsl, int i) {
    const unsigned long long v = ((const unsigned long long*)(ldsl + PTAB_OFF))[i];
    const unsigned lo = __builtin_amdgcn_readfirstlane((unsigned)v), hi = __builtin_amdgcn_readfirstlane((unsigned)(v >> 32));
    return (const float*)(const GAS float*)(((unsigned long long)hi << 32) | lo);
}

__device__ __forceinline__ void titem_load(f32x4 (&v)[16], const float* mbase, unsigned off, int pitchB, int lane) {
    const __amdgpu_buffer_rsrc_t rs = __builtin_amdgcn_make_buffer_rsrc((void*)mbase, 0, 0x7fffffff, 0x00020000);
    const int vo = (lane >> 4) * 2 * pitchB + (lane & 15) * 16;
#pragma unroll
    for (int i = 0; i < 16; ++i) v[i] = __builtin_bit_cast(f32x4, __builtin_amdgcn_raw_buffer_load_b128(rs, vo, (int)off + ((i >> 1) * 8 + (i & 1)) * pitchB, 2));
}
__device__ __forceinline__ void titem_store(const f32x4 (&v)[16], bf16_t* __restrict__ dst, unsigned* scr, int lane) {
    { unsigned* wp = scr + (lane & 15) * 4 * 33 + (lane >> 4);
#pragma unroll
      for (int i = 0; i < 8; ++i)
#pragma unroll
          for (int nn = 0; nn < 4; ++nn) wp[nn * 33 + 4 * i] = pk2(v[2 * i][nn], v[2 * i + 1][nn]); }
    LDS_WAIT();
    const int c = lane & 7;
#pragma unroll
    for (int j = 0; j < 8; ++j) { const int nn = (lane >> 3) + 8 * j; const unsigned* t = scr + nn * 33 + 4 * c;
        u32x4 o; o.x = t[0]; o.y = t[1]; o.z = t[2]; o.w = t[3];
        __builtin_nontemporal_store(o, (u32x4*)(dst + (size_t)nn * DM + 8 * c)); }
    LDS_WAIT();
}
__device__ __forceinline__ void moe_item(int it, int l, const float* wgu, const float* wdn, bf16_t* bgu, bf16_t* bdn, const float*& mbase, unsigned& off, int& pitchB, bf16_t*& dst) {
    constexpr int I_GU = 16 * 32, I_DN = 16 * 16, N_GU = 32 * I_GU;
    if (it < N_GU) { const int e = it / I_GU, r = it % I_GU, kb = r / 32, n0 = (r % 32) * 64;
        const int drow = n0 < 1024 ? (n0 >> 7) * 256 + (n0 & 127) : ((n0 - 1024) >> 7) * 256 + 128 + ((n0 - 1024) & 127);
        mbase = wgu + (size_t)l * NE * DM * 2048; off = (unsigned)((e * DM + kb * 64) * 2048 + n0) * 4u; pitchB = 2048 * 4;
        dst = bgu + (size_t)(l * NE + e) * 2048 * DM + (size_t)drow * DM + kb * 64; }
    else { const int q = it - N_GU, e = q / I_DN, r = q % I_DN, kb = r / 16, n0 = (r % 16) * 64;
        mbase = wdn + (size_t)l * NE * DE * DM; off = (unsigned)((e * DE + kb * 64) * DM + n0) * 4u; pitchB = DM * 4;
        dst = bdn + (size_t)(l * NE + e) * DM * DE + (size_t)n0 * DE + kb * 64; }
}

__device__ __forceinline__ void ctx_outproj_block(const bf16_t* __restrict__ mixc, const bf16_t* __restrict__ wout, const float* __restrict__ base, bf16_t* __restrict__ out,
                                                  const float* __restrict__ gate, int blk, unsigned char* lds) {
    const int tid = fresh_tid(), lane = tid & 63, wave = __builtin_amdgcn_readfirstlane(tid >> 6), r32 = lane & 31, hi = lane >> 5;
    const int rb = blk >> 4, cb = blk & 15;
    const bf16_t* Ap = mixc + (size_t)(rb * 32 + r32) * DM + wave * 128 + 8 * hi;
    const bf16_t* Bp = wout + (size_t)(cb * 64 + r32) * DM + wave * 128 + 8 * hi;
    bf16x8 af[8], b0f[8], b1f[8];
#pragma unroll
    for (int ks = 0; ks < 8; ++ks) { af[ks] = *(const bf16x8*)(Ap + ks * 16); b0f[ks] = *(const bf16x8*)(Bp + ks * 16); b1f[ks] = *(const bf16x8*)(Bp + (size_t)32 * DM + ks * 16); }
    f32x16 a0 = {}, a1 = {};
#pragma unroll
    for (int ks = 0; ks < 8; ++ks) { a0 = __builtin_amdgcn_mfma_f32_32x32x16_bf16(af[ks], b0f[ks], a0, 0, 0, 0); a1 = __builtin_amdgcn_mfma_f32_32x32x16_bf16(af[ks], b1f[ks], a1, 0, 0, 0); }
    float* red = (float*)lds;
#pragma unroll
    for (int r = 0; r < 16; ++r) { red[((wave * 2 + 0) * 16 + r) * 64 + lane] = a0[r]; red[((wave * 2 + 1) * 16 + r) * 64 + lane] = a1[r]; }
    __syncthreads();
#pragma unroll
    for (int q = 0; q < 4; ++q) { const int idx = tid + 512 * q, t = idx >> 10, r = (idx >> 6) & 15, ln = idx & 63; float sum = 0.f;
#pragma unroll
        for (int w = 0; w < 8; ++w) sum += red[((w * 2 + t) * 16 + r) * 64 + ln];
        const int row = rb * 32 + (r & 3) + 8 * (r >> 2) + 4 * (ln >> 5), col = cb * 64 + t * 32 + (ln & 31);
        out[(size_t)row * DM + col] = (bf16_t)f2bf(base[(size_t)row * DM + col] + gate[col] * sum); }
    __syncthreads();
}

#ifndef GSPLIT
#define GSPLIT 144
#endif
constexpr int PH_PRO = 0, PH_NORM0 = 1, PH_L0 = 2, NPH_LAYER = 9, NPH = PH_L0 + NLAYER * NPH_LAYER;

__global__ void __launch_bounds__(NWAVES * 64, 2) fwd(Args args) {
    extern __shared__ __attribute__((aligned(16))) unsigned char lds[];
    const int G = gridDim.x, bx = blockIdx.x;
    const int vcu = (G % 8 == 0) ? (bx % 8) * (G / 8) + bx / 8 : bx;
    const int NGW = G * NWAVES;
#define PH_TID() const int tid = fresh_tid(), lane = tid & 63, wave = __builtin_amdgcn_readfirstlane(tid >> 6), gw = vcu * NWAVES + wave; (void)lane; (void)wave; (void)gw; \
    GAS unsigned char* wsg_ = (GAS unsigned char*)ws0; asm volatile("" : "+s"(wsg_)); unsigned char* ws = (unsigned char*)wsg_; \
    LAS const unsigned char* ldl_ = (LAS const unsigned char*)lds; asm volatile("" : "+v"(ldl_)); const unsigned char* ldsl = (const unsigned char*)ldl_
    unsigned char* const ws0 = args.ws;
#define G_ctl   ((unsigned*)(ws + WS_CTL))
#define G_modb  ((float*)(ws + WS_MOD))
#define G_ropet ((f32x2*)(ws + WS_ROPE))
#define G_scal  ((float*)(ws + WS_SCAL))
#define G_wb_in ((bf16_t*)(ws + WS_WIN))
#define G_wb_out ((bf16_t*)(ws + WS_WOUT))
#define G_wb_gu ((bf16_t*)(ws + WS_WGU))
#define G_wb_dn ((bf16_t*)(ws + WS_WDN))
#define G_hbuf  ((bf16_t*)(ws + WS_H))
#define G_proj  ((bf16_t*)(ws + WS_PROJ))
#define G_xbcs  ((bf16_t*)(ws + WS_XBC))
#define G_dtv   ((float*)(ws + WS_DT))
#define G_av    ((float*)(ws + WS_AV))
#define G_gkv   ((float*)(ws + WS_GKV))
#define G_ydir  ((bf16_t*)(ws + WS_YDIR))
#define G_odir  ((bf16_t*)(ws + WS_ODIR))
#define G_mix   ((bf16_t*)(ws + WS_MIX))
#define G_xw    ((bf16_t*)(ws + WS_XW))
#define G_list  ((int*)(ws + WS_LIST))
#define G_gatev ((float*)(ws + WS_GATE))
#define G_actb  ((bf16_t*)(ws + WS_ACT))
#define G_yk    ((bf16_t*)(ws + WS_YK))

    volatile LAS unsigned* MISC = (volatile LAS unsigned*)((LAS unsigned char*)lds + MISC_OFF);
    for (int u = threadIdx.x; u < 64; u += NWAVES * 64) MISC[u] = 0u;
    if (threadIdx.x < 28) ((const float**)(lds + PTAB_OFF))[threadIdx.x] = args.in[threadIdx.x];
#define INP(i) inp_ptr(ldsl, (i))
    __syncthreads();
    const int lo = args.ph_lo, hi = args.ph_hi;
    XcdBarrier bar; bar.bar = (unsigned*)(ws0 + WS_CTL) + CW_BAR; bar.x = 0; bar.st = nullptr;
    if (hi - lo > 1) bar = xcd_barrier_post((unsigned*)(ws0 + WS_CTL) + CW_BAR, MISC + 8);
#ifndef PH_MASK
#define PH_MASK 0xFFF
#endif
#define KIND(k) ((k) < PH_L0 ? (k) : 2 + ((k) - PH_L0) % NPH_LAYER)
#define IN(k) (lo <= (k) && (k) < hi)
#define INK(k, kind) (((PH_MASK >> (kind)) & 1) && IN(k))
#ifndef DUP_MASK
#define DUP_MASK 0
#endif
#define REPS(kind) for (int rep_ = 0; rep_ < 1 + ((DUP_MASK >> (kind)) & 1); ++rep_)
#ifndef BAR_REPS
#define BAR_REPS 1
#endif
#define SEAM(k) do { if (IN(k) && IN((k) + 1)) for (int br_ = 0; br_ < BAR_REPS; ++br_) xcd_barrier(bar); } while (0)

    if (INK(PH_PRO, 0)) REPS(0) { PH_TID();
        unsigned* scr = (unsigned*)(lds + RING_OFF + wave * 16384);
        constexpr int I_IN = 16 * 52, I_OUT = 16 * 16;
        constexpr int N_IN = 2 * I_IN, N_OUT = 2 * I_OUT, NITEMS = N_IN + N_OUT;
        for (int it = gw; it < NITEMS; it += NGW) {
            int r = it;
            if (r < N_IN) { const int l = r / I_IN; r %= I_IN; const int kb = r / 52, nb = r % 52;
                transpose_item(INP(I_WIN) + (size_t)l * DM * INW, DM, INW, G_wb_in + (size_t)l * INWP * DM, nb * 64, nb * 64, kb * 64, scr, lane); continue; }
            r -= N_IN;
            { const int l = r / I_OUT; r %= I_OUT; const int kb = r / 16, nb = r % 16;
                transpose_item(INP(I_WOUT) + (size_t)l * DM * DM, DM, DM, G_wb_out + (size_t)l * DM * DM, nb * 64, nb * 64, kb * 64, scr, lane); }
        }
        __syncthreads();
        for (int it = bx; it < 48; it += G) {
            const int l = it / 24, j0 = (it % 24) * 256;
            float* sc = (float*)(lds + RING_OFF);
            float* red = sc + 3072;
            for (int i = tid; i < 3072; i += 512) { const int v = i >> 10, k = i & 1023; const float cv = v < 2 ? INP(I_C)[v * DM + k] : INP(I_CCTX)[k]; sc[i] = siluf(cv); }
            __syncthreads();
            const int ks = tid >> 6;
            f32x4 a0 = {0.f, 0.f, 0.f, 0.f}, a1 = a0, a2 = a0;
            const float* wp = INP(I_WADA) + (size_t)l * DM * 6144 + j0 + 4 * lane;
            for (int k = ks * 128; k < ks * 128 + 128; ++k) { const f32x4 w = *(const f32x4*)(wp + (size_t)k * 6144); a0 += w * sc[k]; a1 += w * sc[1024 + k]; a2 += w * sc[2048 + k]; }
            *(f32x4*)(red + (ks * 3 + 0) * 256 + 4 * lane) = a0; *(f32x4*)(red + (ks * 3 + 1) * 256 + 4 * lane) = a1; *(f32x4*)(red + (ks * 3 + 2) * 256 + 4 * lane) = a2;
            __syncthreads();
            for (int i = tid; i < 768; i += 512) { const int v = i >> 8, jj = i & 255; float s = INP(I_BADA)[l * 6144 + j0 + jj];
                for (int q = 0; q < 8; ++q) s += red[(q * 3 + v) * 256 + jj];
                G_modb[(size_t)(l * 3 + v) * 6144 + j0 + jj] = s; }
            __syncthreads();
        }
        if (tid < 256) { float* wrt = (float*)(ws + WS_WRT); const float* wr = INP(I_WR);
            for (int g = bx * 256 + tid; g < 2 * 32768; g += G * 256) { const int l = g >> 15, i = g & 32767; wrt[l * 32768 + (i & 31) * 1024 + (i >> 5)] = wr[g]; } }
        if (bx == (48 % G)) {
            for (int i = tid; i < 2048; i += 512) { const int pos = i >> 4, j = i & 15; const float inv = exp2f(-0.25f * (float)j * 3.3219280948873623f);
                const float ang = (float)pos * inv; G_ropet[i] = (f32x2){cosf(ang), sinf(ang)}; }
        }
        if (bx == (49 % G) && tid < NLAYER) {
            const float* lp = INP(I_DALAM) + tid * 256; float s01 = 0.f, s23 = 0.f;
            for (int i = 0; i < 64; ++i) { s01 += lp[i] * lp[64 + i]; s23 += lp[128 + i] * lp[192 + i]; }
            const float li = 0.8f - 0.6f * expf(-0.3f * (float)tid);
            G_scal[tid * 2 + 0] = expf(s01) - expf(s23) + li; G_scal[tid * 2 + 1] = 1.0f - li;
        }
    }
    SEAM(PH_PRO);
    if (INK(PH_NORM0, 1)) { PH_TID();
        for (int row = gw; row < TALL; row += NGW) {
            const int bidx = row < SEQ ? 0 : (row < TLAT ? 1 : 2);
            const float* xr = row < TLAT ? INP(I_X) + (size_t)row * DM : INP(I_CTX) + (size_t)(row - TLAT) * DM;
            f32x4 v[4];
#pragma unroll
            for (int j = 0; j < 4; ++j) v[j] = *(const f32x4*)(xr + 4 * lane + 256 * j);
            const float* mp = G_modb + (size_t)bidx * 6144;
            norm_mod_store(v, INP(I_N1W), mp, mp + 1024, G_hbuf + (size_t)row * DM, lane);
        }
    }
    SEAM(PH_NORM0);

    for (int l = 0; l < NLAYER; ++l) {
        const int P = PH_L0 + l * NPH_LAYER;
        const bool last = (l == NLAYER - 1);
#define modl (G_modb + (size_t)l * 3 * 6144)
        if (INK(P + 0, 2)) REPS(2) { PH_TID();
            int bxp = bx; asm volatile("" : "+s"(bxp));
            const bool split = G > GSPLIT; const int Gg = split ? GSPLIT : G;
            if (bxp < Gg) {
            pg8::Gemm g{G_hbuf, G_wb_in + (size_t)l * INWP * DM, TALL, INWP, DM, 0};
            pg8::StaticOrder S; S.init(TALL, INWP, Gg, bxp);
            pg8::EpiBf16 E{G_proj, INWP, (const float*)G_ropet, TLAT / 256};
            pg8::gemm_phase<pg8::EpiBf16, pg8::StaticOrder, true, true>((LAS unsigned char*)lds + RING_OFF, g, S, E);
            }
            if (bxp >= Gg || !split) {
                const int lane = fresh_tid() & 63;
                unsigned* scr = (unsigned*)(lds + RING_OFF + wave * 16384);
                constexpr int NIT = 32 * (16 * 32 + 16 * 16);
                const int ncw = (split ? G - GSPLIT : G) * NWAVES; int it = (split ? bxp - GSPLIT : bxp) * NWAVES + wave;
                const float* wgu = INP(I_WGU); const float* wdn = INP(I_WDN);
                if (it < NIT) {
                    f32x4 va[16], vb[16]; const float* mb; unsigned off; int pb; bf16_t* da; bf16_t* db;
                    moe_item(it, l, wgu, wdn, G_wb_gu, G_wb_dn, mb, off, pb, da); titem_load(va, mb, off, pb, lane);
                    for (;;) {
                        int nx = it + ncw;
                        moe_item(nx < NIT ? nx : NIT - 1, l, wgu, wdn, G_wb_gu, G_wb_dn, mb, off, pb, db); titem_load(vb, mb, off, pb, lane);
                        titem_store(va, da, scr, lane);
                        if (nx >= NIT) break;
                        it = nx; nx = it + ncw;
                        moe_item(nx < NIT ? nx : NIT - 1, l, wgu, wdn, G_wb_gu, G_wb_dn, mb, off, pb, da); titem_load(va, mb, off, pb, lane);
                        titem_store(vb, db, scr, lane);
                        if (nx >= NIT) break;
                        it = nx;
                    }
                }
            }
        }
        SEAM(P + 0);
#define CP_INIT()         ck::P cp; \
        cp.proj = G_proj; cp.xbcs = G_xbcs; cp.dtv = G_dtv; cp.cumv = G_av; cp.gkv = G_gkv; cp.ssd_st = G_ydir; cp.gla_st = G_odir; cp.cds = (float*)(ws + WS_CDS); cp.cdg = (float*)(ws + WS_CDG); cp.mix = G_mix; cp.ropet = G_ropet; \
        cp.convw = INP(I_CONVW) + l * 3 * 512; cp.convb = INP(I_CONVB) + l * 512; cp.dtb = INP(I_DTB) + l * 8; cp.alog = INP(I_ALOG) + l * 8; \
        cp.gkup = INP(I_GKUP) + (size_t)l * 2 * 16 * 128; cp.gkb = INP(I_GKB) + l * 2 * 128; cp.ssdd = INP(I_SSDD) + l * 4; cp.ssdnw = INP(I_SSDNW) + l * 256; cp.glanw = INP(I_GLANW) + l * 64; cp.kmax2 = G_ctl + CW_KMAX + l * 16; cp.hins = (bf16_t*)(ws + WS_HINS); cp.hing = (bf16_t*)(ws + WS_HING);
        if (INK(P + 1, 3)) REPS(3) { PH_TID(); CP_INIT();
            for (int ui = 0; ui < 2; ++ui) { int ch, sect;
                if (ui == 0) { if (bx >= TLAT / 64) continue; ch = bx; sect = 14; }
                else { if ((bx & 7) != 4 || (bx >> 3) >= 24) continue; const int u = bx >> 3; ch = TLAT / 64 + u / 3; sect = 2 << (u % 3); }
#ifndef PREP_DUP_SECT
#define PREP_DUP_SECT 15
#endif
                ck::prep_chunk(cp, ch, lds + RING_OFF, rep_ > 0 ? (sect & PREP_DUP_SECT) : sect, rep_ > 0); }
        }
        SEAM(P + 1);
        if (INK(P + 2, 4)) { PH_TID(); CP_INIT();
            for (int vb = bx; vb < 256; vb += G) ck::scan_phase(cp, vb);
        }
        SEAM(P + 2);
        if (INK(P + 3, 5)) REPS(5) { PH_TID(); CP_INIT();
            const float lam = __uint_as_float(__builtin_amdgcn_readfirstlane(__float_as_uint(G_scal[l * 2 + 0]))), osc = __uint_as_float(__builtin_amdgcn_readfirstlane(__float_as_uint(G_scal[l * 2 + 1])));
            const float* subw = INP(I_SUBW) + l * 128;
#ifndef ATT_DUP_PART
#define ATT_DUP_PART 3
#endif
#ifndef NO_ATT
            if (rep_ == 0 || (ATT_DUP_PART & 1)) for (int i = 0; i < 3; ++i) {
                int bh, qrow0, nkeys;
                if (i < 2) { bh = bx & 7; const int qb = i * 32 + (bx >> 3); qrow0 = (bh >> 2) * SEQ + qb * 128; nkeys = LCTX + SEQ; if ((bx >> 3) >= 32) continue; }
                else { if (last || (bx & 15) != 2 || (bx >> 4) >= 16) continue; const int u = bx >> 4; bh = u >> 1; qrow0 = TLAT + (bh >> 2) * LCTX + (u & 1) * 128; nkeys = LCTX; }
                att::attn_unit(G_proj, G_mix, subw, lam, osc, G_ctl + CW_KMAX + l * 16 + (bh >> 2) * 8, bh >> 2, bh & 3, qrow0, nkeys, (char*)lds + RING_OFF);
            }
#endif
#ifndef NO_FIN
            if (rep_ == 0 || (ATT_DUP_PART & 2)) for (int ui = 0; ui < 2; ++ui) { int ch, sect;
                if (ui == 0) { if (bx >= TLAT / 64) continue; ch = bx; sect = 15; }
                else { if (last || (bx & 7) != 4) continue; const int u = bx >> 3; ch = TLAT / 64 + (u >> 2); sect = 1 << (u & 3); }
                ck::finish_chunk(cp, ch, lds + RING_OFF, sect); }
#endif
        }
        SEAM(P + 3);
        if (INK(P + 4, 6)) REPS(6) { PH_TID();
            const int M = TLAT;
            pg8::Gemm g{G_mix, G_wb_out + (size_t)l * DM * DM, M, DM, DM, 0};
            pg8::StaticOrder S; S.init(M, DM, G, bx);
            pg8::EpiRes E{INP(I_X), INP(I_CTX), l == 0 ? (const bf16_t*)nullptr : (const bf16_t*)G_xw, G_xw, modl + 2 * 1024, 6144};
            pg8::gemm_phase<pg8::EpiRes, pg8::StaticOrder, true, true>((LAS unsigned char*)lds + RING_OFF, g, S, E);
            if (!last && bx < 256) ctx_outproj_block(G_mix + (size_t)TLAT * DM, G_wb_out + (size_t)l * DM * DM, INP(I_CTX), G_xw + (size_t)TLAT * DM, modl + 2 * 6144 + 2 * 1024, bx, lds + RING_OFF);
        }
        SEAM(P + 4);
        if (INK(P + 5, 7)) REPS(7) { PH_TID(); const bool dry = rep_ > 0;
            const int ntok = last ? TLAT : TALL, TPW = ntok / G;
            float* wT = (float*)(lds + RING_OFF);
            int* selE = (int*)(lds + RT_OFF); int* selP = selE + 272; int* lcnt = selP + 272; int* basep = lcnt + 32;
            { const float* wrt = (const float*)(ws + WS_WRT) + l * 32768;
              f32x4 wr_[16];
#pragma unroll
              for (int q = 0; q < 16; ++q) wr_[q] = *(const f32x4*)(wrt + 4 * (tid + 512 * q));
              __builtin_amdgcn_sched_barrier(0);
#pragma unroll
              for (int q = 0; q < 16; ++q) *(f32x4*)(wT + 4 * (tid + 512 * q)) = wr_[q]; }
            if (tid < 32 && !dry) lcnt[tid] = 0;
            __syncthreads();
            const int tok0 = bx * TPW;
            const float* n2w = INP(I_N2W) + l * DM;
            if (TPW * G == ntok && TPW <= 68 && (TPW & 1) == 0) {
            float* wsc = (float*)(lds + RT_OFF + 2560) + wave * 80;
            const float brl = INP(I_BR)[l * NE + (lane >> 1)];
            u32x2 rawn[2][4];
#pragma unroll
            for (int t = 0; t < 2; ++t)
#pragma unroll
                for (int j = 0; j < 4; ++j) rawn[t][j] = *(const u32x2*)(G_xw + (size_t)(tok0 + wave * 2 + t) * DM + 4 * lane + 256 * j);
            for (int tl = wave * 2; tl < TPW; tl += 2 * NWAVES) {
                const int row0 = tok0 + tl;
                f32x4 v[2][4]; float ss[2] = {0.f, 0.f};
#pragma unroll
                for (int t = 0; t < 2; ++t)
#pragma unroll
                    for (int j = 0; j < 4; ++j) { const u32x2 w = rawn[t][j];
                        v[t][j] = (f32x4){__uint_as_float(w.x << 16), __uint_as_float(w.x & 0xffff0000u), __uint_as_float(w.y << 16), __uint_as_float(w.y & 0xffff0000u)};
                        ss[t] += (v[t][j].x * v[t][j].x + v[t][j].y * v[t][j].y) + (v[t][j].z * v[t][j].z + v[t][j].w * v[t][j].w); }
                { ss[0] = wave_sum(ss[0]); ss[1] = wave_sum(ss[1]); }
                { f32x4 wn[4];
#pragma unroll
                  for (int j = 0; j < 4; ++j) wn[j] = *(const f32x4*)(n2w + 4 * lane + 256 * j);
#pragma unroll
                  for (int t = 0; t < 2; ++t) { const int row = row0 + t, bidx = row < SEQ ? 0 : (row < TLAT ? 1 : 2); const float* mp = modl + (size_t)bidx * 6144;
                    const float r = rsqrtf(ss[t] * (1.0f / DM) + EPS);
                    f32x4 ma[4], mb[4];
#pragma unroll
                    for (int j = 0; j < 4; ++j) { const int c = 4 * lane + 256 * j; ma[j] = *(const f32x4*)(mp + 4 * 1024 + c); mb[j] = *(const f32x4*)(mp + 3 * 1024 + c); }
                    __builtin_amdgcn_sched_barrier(0);
#pragma unroll
                    for (int j = 0; j < 4; ++j) { const int c = 4 * lane + 256 * j;
                        v[t][j] = (v[t][j] * r) * wn[j] * (ma[j] + 1.0f) + mb[j];
                        u32x2 o; o.x = pk2(v[t][j].x, v[t][j].y); o.y = pk2(v[t][j].z, v[t][j].w); *(u32x2*)(G_hbuf + (size_t)row * DM + c) = o; } } }
                if (tl + 2 * NWAVES < TPW) {
#pragma unroll
                    for (int t = 0; t < 2; ++t)
#pragma unroll
                        for (int j = 0; j < 4; ++j) rawn[t][j] = *(const u32x2*)(G_xw + (size_t)(row0 + 2 * NWAVES + t) * DM + 4 * lane + 256 * j); }
                float pa[32], pb[32];
                { f32x2 vv[4][4];
#pragma unroll
                  for (int j = 0; j < 4; ++j) { vv[j][0] = (f32x2){v[0][j].x, v[1][j].x}; vv[j][1] = (f32x2){v[0][j].y, v[1][j].y}; vv[j][2] = (f32x2){v[0][j].z, v[1][j].z}; vv[j][3] = (f32x2){v[0][j].w, v[1][j].w}; }
                  f32x4 wb[2][8];
#pragma unroll
                  for (int q = 0; q < 8; ++q) wb[0][q] = *(const f32x4*)(wT + (q >> 2) * 1024 + 4 * lane + 256 * (q & 3));
#pragma unroll
                  for (int bt = 0; bt < 16; ++bt) {
                      if (bt + 1 < 16) {
#pragma unroll
                          for (int q = 0; q < 8; ++q) wb[(bt + 1) & 1][q] = *(const f32x4*)(wT + (2 * (bt + 1) + (q >> 2)) * 1024 + 4 * lane + 256 * (q & 3)); }
#pragma unroll
                      for (int ee = 0; ee < 2; ++ee) { f32x2 acc = {0.f, 0.f};
#pragma unroll
                          for (int j = 0; j < 4; ++j) { const f32x4 w = wb[bt & 1][ee * 4 + j];
                              acc = __builtin_elementwise_fma(vv[j][0], (f32x2){w.x, w.x}, acc); acc = __builtin_elementwise_fma(vv[j][1], (f32x2){w.y, w.y}, acc);
                              acc = __builtin_elementwise_fma(vv[j][2], (f32x2){w.z, w.z}, acc); acc = __builtin_elementwise_fma(vv[j][3], (f32x2){w.w, w.w}, acc); }
                          pa[2 * bt + ee] = acc.x; pb[2 * bt + ee] = acc.y; } } }
                float qa[16], qb[16], ra[8], rb[8], sa_[4], sb_[4], ta[2], tb[2];
#pragma unroll
                for (int i = 0; i < 16; ++i) { auto r0 = __builtin_amdgcn_permlane32_swap(__float_as_uint(pa[i]), __float_as_uint(pa[16 + i]), false, false);
                    auto r1 = __builtin_amdgcn_permlane32_swap(__float_as_uint(pb[i]), __float_as_uint(pb[16 + i]), false, false);
                    qa[i] = __uint_as_float(r0[0]) + __uint_as_float(r0[1]); qb[i] = __uint_as_float(r1[0]) + __uint_as_float(r1[1]); }
                { const bool up = (lane & 16) != 0;
#pragma unroll
                  for (int i = 0; i < 8; ++i) { const float s0 = up ? qa[i] : qa[8 + i], k0 = up ? qa[8 + i] : qa[i], s1 = up ? qb[i] : qb[8 + i], k1 = up ? qb[8 + i] : qb[i];
                      ra[i] = k0 + __shfl_xor(s0, 16); rb[i] = k1 + __shfl_xor(s1, 16); } }
                { const bool up = (lane & 8) != 0;
#pragma unroll
                  for (int i = 0; i < 4; ++i) { const float s0 = up ? ra[i] : ra[4 + i], k0 = up ? ra[4 + i] : ra[i], s1 = up ? rb[i] : rb[4 + i], k1 = up ? rb[4 + i] : rb[i];
                      sa_[i] = k0 + dpp_perm<0x128>(s0); sb_[i] = k1 + dpp_perm<0x128>(s1); } }
                { const bool up = (lane & 4) != 0;
#pragma unroll
                  for (int i = 0; i < 2; ++i) { const float s0 = up ? sa_[i] : sa_[2 + i], k0 = up ? sa_[2 + i] : sa_[i], s1 = up ? sb_[i] : sb_[2 + i], k1 = up ? sb_[2 + i] : sb_[i];
                      ta[i] = k0 + dpp_perm<0x1B>(dpp_perm<0x141>(s0)); tb[i] = k1 + dpp_perm<0x1B>(dpp_perm<0x141>(s1)); } }
                float la, lb;
                { const bool up = (lane & 2) != 0; const float s0 = up ? ta[0] : ta[1], k0 = up ? ta[1] : ta[0], s1 = up ? tb[0] : tb[1], k1 = up ? tb[1] : tb[0];
                  la = k0 + dpp_perm<0x4E>(s0); lb = k1 + dpp_perm<0x4E>(s1); }
                la += dpp_perm<0xB1>(la); lb += dpp_perm<0xB1>(lb);
                if ((lane & 1) == 0) { wsc[lane >> 1] = la + brl; wsc[32 + (lane >> 1)] = lb + brl; }
                LDS_WAIT();
                const int t = lane >> 5, e = lane & 31; const float* lg = wsc + t * 32; const float mine = lg[e]; int rank = 0;
#pragma unroll
                for (int q = 0; q < 8; ++q) { const f32x4 o4 = *(const f32x4*)(lg + 4 * q); const float ov[4] = {o4.x, o4.y, o4.z, o4.w};
#pragma unroll
                    for (int i = 0; i < 4; ++i) { const int j = 4 * q + i; rank += (ov[i] > mine || (ov[i] == mine && j < e)) ? 1 : 0; } }
                if (rank < 4) wsc[64 + t * 4 + rank] = mine;
                LDS_WAIT();
                if (rank < 4) { const f32x4 sv = *(const f32x4*)(wsc + 64 + t * 4);
                    const float e0 = __expf(sv.x - sv.x), e1 = __expf(sv.y - sv.x), e2 = __expf(sv.z - sv.x), e3 = __expf(sv.w - sv.x);
                    const float gk = __expf(mine - sv.x) / ((e0 + e1) + (e2 + e3));
                    const int lp = dry ? 0 : atomicAdd(&lcnt[e], 1);
                    if (!dry) { selE[(tl + t) * 4 + rank] = e; selP[(tl + t) * 4 + rank] = lp; } G_gatev[(size_t)(row0 + t) * 4 + rank] = gk; }
                LDS_WAIT();
            }
            }
            __syncthreads();
            if (tid < 32 && !dry) basep[tid] = (int)atomicAdd(&G_ctl[CW_CNT + l * 32 + tid], (unsigned)lcnt[tid]);
            __syncthreads();
            if (!dry) for (int i = tid; i < TPW * 4; i += 512) { const int e = selE[i]; const int pos = basep[e] + selP[i]; if (pos < LISTCAP) G_list[(size_t)e * LISTCAP + pos] = tok0 * 4 + i; }
        }
        SEAM(P + 5);
        if (INK(P + 6, 9)) REPS(9) { PH_TID();
            int* tile_e = (int*)(lds + TAB_OFF); int* pstart = tile_e + 304; int* cntl = pstart + 40;
            const int nrt = moe_tables(G_ctl + CW_CNT + l * 32, tile_e, pstart, cntl);
            pg8::Gemm g{G_hbuf, G_wb_gu + (size_t)l * NE * 2048 * DM, nrt * 256, 2048, DM, (size_t)2048 * DM * 2};
            pg8::MoeOrderT<true> S{(const LAS int*)((LAS unsigned char*)lds + TAB_OFF), (const LAS int*)((LAS unsigned char*)lds + TAB_OFF) + 304, (const LAS int*)((LAS unsigned char*)lds + TAB_OFF) + 344, G_list, nrt, 8, 3, G, vcu};
            pg8::EpiAct E{G_actb, INP(I_BGU) + (size_t)l * NE * 2048};
            pg8::gemm_phase<pg8::EpiAct, pg8::MoeOrderT<true>, true, true>((LAS unsigned char*)lds + RING_OFF, g, S, E);
        }
        SEAM(P + 6);
        if (INK(P + 7, 10)) REPS(10) { PH_TID();
            int* tile_e = (int*)(lds + TAB_OFF); int* pstart = tile_e + 304; int* cntl = pstart + 40;
            const int nrt = (IN(P + 6) && ((PH_MASK >> 9) & 1)) ? __builtin_amdgcn_readfirstlane(pstart[NE] >> 8) : moe_tables(G_ctl + CW_CNT + l * 32, tile_e, pstart, cntl);
            pg8::Gemm g{G_actb, G_wb_dn + (size_t)l * NE * DM * DE, nrt * 256, DM, DE, (size_t)DM * DE * 2};
            pg8::MoeOrderT<false> S{(const LAS int*)((LAS unsigned char*)lds + TAB_OFF), (const LAS int*)((LAS unsigned char*)lds + TAB_OFF) + 304, (const LAS int*)((LAS unsigned char*)lds + TAB_OFF) + 344, G_list, nrt, 4, 2, G, vcu};
            pg8::EpiDown E{G_yk, INP(I_BDN) + (size_t)l * NE * DM, &S, G_gatev};
            pg8::gemm_phase<pg8::EpiDown, pg8::MoeOrderT<false>, true, true>((LAS unsigned char*)lds + RING_OFF, g, S, E);
        }
        SEAM(P + 7);
        if (INK(P + 8, 11)) REPS(11) { PH_TID(); const bool dry = rep_ > 0;
            const int ntok = last ? TLAT : TALL;
            f32x4 nwv[4];
            { const float* nwp = last ? INP(I_FNW) : INP(I_N1W) + (l + 1) * DM;
#pragma unroll
              for (int q = 0; q < 4; ++q) nwv[q] = *(const f32x4*)(nwp + 8 * lane + 512 * (q >> 1) + 4 * (q & 1)); }
            for (int rowa = gw; rowa < ntok; rowa += 2 * NGW) {
                f32x4 v[2][4]; int rw[2]; bool ok[2];
#pragma unroll
                for (int t = 0; t < 2; ++t) { const int rr = rowa + t * NGW; ok[t] = rr < ntok; rw[t] = ok[t] ? rr : rowa; }
                u32x4 yv[2][2][4]; u32x4 xr[2][2];
#pragma unroll
                for (int t = 0; t < 2; ++t)
#pragma unroll
                    for (int jj = 0; jj < 2; ++jj) { const int c = 8 * lane + 512 * jj;
#pragma unroll
                        for (int k = 0; k < 4; ++k) yv[t][jj][k] = *(const u32x4*)(G_yk + ((size_t)rw[t] * 4 + k) * DM + c);
                        xr[t][jj] = *(const u32x4*)(G_xw + (size_t)rw[t] * DM + c); }
#pragma unroll
                for (int t = 0; t < 2; ++t) { const int row = rw[t], bidx = row < SEQ ? 0 : (row < TLAT ? 1 : 2); const float* mp = modl + (size_t)bidx * 6144;
                    const float* mn = G_modb + (size_t)((last ? l : l + 1) * 3 + bidx) * 6144;
                    f32x4 g2[4];
#pragma unroll
                    for (int q = 0; q < 4; ++q) g2[q] = *(const f32x4*)(mp + 5 * 1024 + 8 * lane + 512 * (q >> 1) + 4 * (q & 1));
                    __builtin_amdgcn_sched_barrier(0);
                    const float gsc = (dry && !last) ? 0.f : 1.f;
#pragma unroll
                    for (int jj = 0; jj < 2; ++jj) { const int c = 8 * lane + 512 * jj; float ff[8] = {0.f, 0.f, 0.f, 0.f, 0.f, 0.f, 0.f, 0.f};
#pragma unroll
                        for (int k = 0; k < 4; ++k) { float f8[8]; unpack8(yv[t][jj][k], f8);
#pragma unroll
                            for (int e = 0; e < 8; ++e) ff[e] += f8[e]; }
                        const f32x4 g2a = g2[jj * 2] * gsc, g2b = g2[jj * 2 + 1] * gsc;
                        float x8[8]; unpack8(xr[t][jj], x8);
                        v[t][jj * 2] = (f32x4){x8[0], x8[1], x8[2], x8[3]} + g2a * (f32x4){ff[0], ff[1], ff[2], ff[3]}; v[t][jj * 2 + 1] = (f32x4){x8[4], x8[5], x8[6], x8[7]} + g2b * (f32x4){ff[4], ff[5], ff[6], ff[7]};
                        if (!last && !dry && ok[t]) { const float o8[8] = {v[t][jj * 2].x, v[t][jj * 2].y, v[t][jj * 2].z, v[t][jj * 2].w, v[t][jj * 2 + 1].x, v[t][jj * 2 + 1].y, v[t][jj * 2 + 1].z, v[t][jj * 2 + 1].w};
                            *(u32x4*)(G_xw + (size_t)row * DM + c) = pack8(o8); } }
                    f32x4 ma[4], mb[4];
#pragma unroll
                    for (int q = 0; q < 4; ++q) { const int c = 8 * lane + 512 * (q >> 1) + 4 * (q & 1); ma[q] = *(const f32x4*)(mn + 1024 + c); mb[q] = *(const f32x4*)(mn + c); }
                    __builtin_amdgcn_sched_barrier(0);
                    float ss = 0.f;
#pragma unroll
                    for (int j = 0; j < 4; ++j) ss += (v[t][j].x * v[t][j].x + v[t][j].y * v[t][j].y) + (v[t][j].z * v[t][j].z + v[t][j].w * v[t][j].w);
                    const float r = rsqrtf(wave_sum(ss) * (1.0f / DM) + EPS);
                    if (ok[t]) {
                        if (!last) {
#pragma unroll
                            for (int jj = 0; jj < 2; ++jj) { const int c = 8 * lane + 512 * jj; float o8[8];
#pragma unroll
                                for (int hh = 0; hh < 2; ++hh) { const int q = jj * 2 + hh;
                                    const f32x4 y = (v[t][q] * r) * nwv[q] * (ma[q] + 1.0f) + mb[q]; o8[4 * hh] = y.x; o8[4 * hh + 1] = y.y; o8[4 * hh + 2] = y.z; o8[4 * hh + 3] = y.w; }
                                *(u32x4*)(G_hbuf + (size_t)row * DM + c) = pack8(o8); }
                        } else {
#pragma unroll
                            for (int jj = 0; jj < 2; ++jj) { const int c = 8 * lane + 512 * jj;
#pragma unroll
                                for (int hh = 0; hh < 2; ++hh) *(f32x4*)(args.out + (size_t)row * DM + c + 4 * hh) = (v[t][jj * 2 + hh] * r) * nwv[jj * 2 + hh]; }
                        }
                    }
                }
            }
        }
        SEAM(P + 8);
    }
#undef IN
#undef SEAM
}

extern "C" void kernel_launch(void* const* d_in, const int* in_sizes, int n_in, void* d_out, int out_size, void* d_ws, size_t ws_size, hipStream_t stream) {
    static int grid = 0;
    if (grid == 0) {
        if (n_in != 28 || out_size != TLAT * DM || ws_size < WS_END) { fprintf(stderr, "kernel_launch: unexpected shapes: n_in %d out %d ws %zu (need %zu)\n", n_in, out_size, ws_size, (size_t)WS_END); grid = -1; return; }
        int dev = 0, cus = 0, per_cu = 0;
        if (hipGetDevice(&dev) != hipSuccess || hipDeviceGetAttribute(&cus, hipDeviceAttributeMultiprocessorCount, dev) != hipSuccess) { grid = -1; return; }
        if (hipFuncSetAttribute((const void*)fwd, hipFuncAttributeMaxDynamicSharedMemorySize, LDS_BYTES) != hipSuccess) { fprintf(stderr, "kernel_launch: hipFuncSetAttribute failed\n"); grid = -1; return; }
        if (hipOccupancyMaxActiveBlocksPerMultiprocessor(&per_cu, (const void*)fwd, NWAVES * 64, LDS_BYTES) != hipSuccess || per_cu < 1) fprintf(stderr, "kernel_launch: occupancy query reports %d\n", per_cu);
        (void)hipGetLastError();
        grid = cus;
        if (grid != 256) fprintf(stderr, "kernel_launch: %d CUs (built for 256)\n", grid);
    }
    if (grid < 0) return;
    if (hipMemsetAsync((char*)d_ws + WS_CTL, 0, CTL_ZERO_BYTES, stream) != hipSuccess) return;
    Args a{};
    for (int i = 0; i < 28; ++i) a.in[i] = (const float*)d_in[i];
    a.out = (float*)d_out; a.ws = (unsigned char*)d_ws;
#if MK_N_LAUNCHES == 1
    a.ph_lo = 0; a.ph_hi = NPH;
    hipLaunchKernelGGL(fwd, dim3(grid), dim3(NWAVES * 64), LDS_BYTES, stream, a);
#else
    for (int p = 0; p < NPH; ++p) { a.ph_lo = p; a.ph_hi = p + 1; hipLaunchKernelGGL(fwd, dim3(grid), dim3(NWAVES * 64), LDS_BYTES, stream, a); }
#endif
    const hipError_t le = hipPeekAtLastError();
    if (le != hipSuccess) fprintf(stderr, "kernel_launch: launch failed: %s\n", hipGetErrorName(le));
}
```

```cpp
#include <hip/hip_runtime.h>
#include <cstdio>
#include <cstdint>

#ifndef MK_N_LAUNCHES
#define MK_N_LAUNCHES 1
#endif

#define GAS __attribute__((address_space(1)))
#define LAS __attribute__((address_space(3)))
typedef unsigned short bf16_t;
typedef short bf16x8 __attribute__((ext_vector_type(8)));
typedef short s16x4 __attribute__((ext_vector_type(4)));
typedef float f32x2 __attribute__((ext_vector_type(2)));
typedef float f32x4 __attribute__((ext_vector_type(4)));
typedef float f32x16 __attribute__((ext_vector_type(16)));
typedef unsigned u32x2 __attribute__((ext_vector_type(2)));
typedef unsigned u32x4 __attribute__((ext_vector_type(4)));

constexpr int DM = 1024, NB = 2, SEQ = 8192, LCTX = 256, NLAYER = 2;
constexpr int TLAT = NB * SEQ, TCTX = NB * LCTX, TALL = TLAT + TCTX;
constexpr int INW = 3112, INWP = 3328;
constexpr int C_Q = 0, C_K = 512, C_V = 1024, C_Z = 1536, C_XBC = 1792, C_DT = 2304, C_GQ = 2312, C_GK = 2440, C_GV = 2568, C_GG = 2824, C_CODE = 3080;
constexpr int NE = 32, DE = 1024;
constexpr int LISTCAP = TALL, MAXRT = 296, XB_ROWS = MAXRT * 256;
constexpr float EPS = 1e-6f;

constexpr size_t MiB = 1u << 20;
constexpr size_t WS_CTL = 0, CTL_ZERO_BYTES = 128 * 1024;
constexpr int CW_BAR = 4096, CW_CNT = 16384, CW_KMAX = 16384 + 64;
constexpr size_t WS_MOD = 1 * MiB, WS_ROPE = 1 * MiB + 256 * 1024, WS_SCAL = WS_ROPE + 16 * 1024, WS_CDS = WS_SCAL + 4096, WS_CDG = WS_SCAL + 32768, WS_WRT = WS_SCAL + 320 * 1024;
constexpr size_t WS_WIN = 2 * MiB, WS_WOUT = 15 * MiB, WS_WGU = 32 * MiB, WS_WDN = 288 * MiB;
constexpr size_t WS_H = 416 * MiB, WS_PROJ = 449 * MiB, WS_XBC = 557 * MiB, WS_DT = 574 * MiB, WS_AV = 575 * MiB, WS_GKV = 576 * MiB;
constexpr size_t WS_YDIR = 593 * MiB, WS_ODIR = 626 * MiB, WS_MIX = 659 * MiB, WS_XW = 692 * MiB, WS_LIST = 758 * MiB, WS_GATE = 761 * MiB, WS_RMAP = 762 * MiB;
constexpr size_t WS_HINS = 763 * MiB, WS_HING = 781 * MiB;
constexpr size_t WS_XB = 763 * MiB, WS_ACT = 911 * MiB, WS_YK = 1059 * MiB, WS_END = 1191 * MiB;

constexpr int RING_OFF = 0, RING_BYTES = 131072;
constexpr int MISC_OFF = RING_BYTES;
constexpr int TAB_OFF = RING_BYTES + 256;
constexpr int RT_OFF = RING_BYTES + 4096;
constexpr int LDS_BYTES = RING_BYTES + 12288;
constexpr int PTAB_OFF = LDS_BYTES - 256;
constexpr int NWAVES = 8;

__device__ __forceinline__ float bf2f(unsigned short b) { return __uint_as_float(((unsigned)b) << 16); }
typedef __bf16 bf16x2_t __attribute__((ext_vector_type(2)));
__device__ __forceinline__ unsigned pk2(float lo, float hi) { const f32x2 v = {lo, hi}; const bf16x2_t b = __builtin_convertvector(v, bf16x2_t); return __builtin_bit_cast(unsigned, b); }
__device__ __forceinline__ unsigned f2bf(float f) { return pk2(f, f) & 0xffffu; }
__device__ __forceinline__ float siluf(float x) { return x * __builtin_amdgcn_rcpf(1.0f + __expf(-x)); }
__device__ __forceinline__ float softplusf(float x) { return x > 20.f ? x : __logf(1.0f + __expf(x)); }
__device__ __forceinline__ float logsigmoidf(float x) { return fminf(x, 0.f) - __logf(1.0f + __expf(-fabsf(x))); }
template <int CTRL> __device__ __forceinline__ float dpp_perm(float x) {
    return __builtin_bit_cast(float, __builtin_amdgcn_mov_dpp(__builtin_bit_cast(int, x), CTRL, 0xf, 0xf, true)); }
template <int CTRL, int ROWMASK, bool BC> __device__ __forceinline__ float dpp_or0(float x) {
    return __builtin_bit_cast(float, __builtin_amdgcn_update_dpp(0, __builtin_bit_cast(int, x), CTRL, ROWMASK, 0xf, BC)); }
__device__ __forceinline__ float row16_allsum(float v) {
    v += dpp_perm<0xB1>(v); v += dpp_perm<0x4E>(v); v += dpp_perm<0x141>(v); v += dpp_perm<0x140>(v); return v; }
__device__ __forceinline__ float sum32(float v) {
    v = row16_allsum(v); const int iv = __builtin_bit_cast(int, v);
    const float s0 = __builtin_bit_cast(float, __builtin_amdgcn_readlane(iv, 0)), s1 = __builtin_bit_cast(float, __builtin_amdgcn_readlane(iv, 16));
    const float s2 = __builtin_bit_cast(float, __builtin_amdgcn_readlane(iv, 32)), s3 = __builtin_bit_cast(float, __builtin_amdgcn_readlane(iv, 48));
    return (threadIdx.x & 32) ? s2 + s3 : s0 + s1; }
__device__ __forceinline__ float wave_sum(float v) {
    v = row16_allsum(v); const int iv = __builtin_bit_cast(int, v);
    return (__builtin_bit_cast(float, __builtin_amdgcn_readlane(iv, 0)) + __builtin_bit_cast(float, __builtin_amdgcn_readlane(iv, 16))) +
           (__builtin_bit_cast(float, __builtin_amdgcn_readlane(iv, 32)) + __builtin_bit_cast(float, __builtin_amdgcn_readlane(iv, 48))); }
__device__ __forceinline__ float wave_scan(float x, int lane, bool rev) {
    float v = x;
    v += dpp_or0<0x111, 0xf, true>(v); v += dpp_or0<0x112, 0xf, true>(v); v += dpp_or0<0x114, 0xf, true>(v); v += dpp_or0<0x118, 0xf, true>(v);
    v += dpp_or0<0x142, 0xa, false>(v);
    v += dpp_or0<0x143, 0xc, false>(v);
    if (!rev) return v;
    const float tot = __builtin_bit_cast(float, __builtin_amdgcn_readlane(__builtin_bit_cast(int, v), 63));
    return (tot - v) + x;
}
__device__ __forceinline__ void unpack8(const u32x4 w, float (&f)[8]) {
    f[0] = __uint_as_float(w.x << 16); f[1] = __uint_as_float(w.x & 0xffff0000u); f[2] = __uint_as_float(w.y << 16); f[3] = __uint_as_float(w.y & 0xffff0000u);
    f[4] = __uint_as_float(w.z << 16); f[5] = __uint_as_float(w.z & 0xffff0000u); f[6] = __uint_as_float(w.w << 16); f[7] = __uint_as_float(w.w & 0xffff0000u);
}
__device__ __forceinline__ u32x4 pack8(const float (&f)[8]) { u32x4 w; w.x = pk2(f[0], f[1]); w.y = pk2(f[2], f[3]); w.z = pk2(f[4], f[5]); w.w = pk2(f[6], f[7]); return w; }
#define LDS_WAIT() asm volatile("s_waitcnt lgkmcnt(0)" ::: "memory")
#define LDS_BARRIER() asm volatile("s_waitcnt lgkmcnt(0)\n\ts_barrier" ::: "memory")
__device__ __forceinline__ int fresh_tid() { int t = threadIdx.x; asm volatile("" : "+v"(t)); return t; }

namespace pg8 {
#define PG8_LAS __attribute__((address_space(3)))
constexpr int BM = 256, BK = 64, HALF = 128, HTB = HALF * BK * 2, STAGE_BYTES = 8 * HTB, NXCD = 8, WGM = 8;
__host__ __device__ __forceinline__ int lds_byte(int r, int c) { const int st = (r >> 4) * 2 + (c >> 5), rr = r & 15, cc = c & 31, ob = rr * 64 + cc * 2; return st * 1024 + (ob ^ (((ob >> 9) & 1) << 5)); }
__host__ __device__ __forceinline__ void stage_rc(int b, int& R, int& C) { const int st = b / 1024, sb = b % 1024, swz = sb ^ (((sb >> 9) & 1) << 5); R = (st >> 1) * 16 + swz / 64; C = (st & 1) * 32 + (swz % 64) / 2; }
__host__ __device__ __forceinline__ int perm32(int rho) { const int n = rho >> 4, i = rho & 15; return 8 * (i >> 2) + 4 * n + (i & 3); }

struct Unit { int pm, pn, e; };
struct Gemm { const bf16_t* A; const bf16_t* Bt; int M, N, K; size_t estride; };

struct StaticOrder {
    static constexpr bool GATHER = false;
    int nM, nN, nwg, G, c;
    __host__ __device__ void init(int M, int N, int G_, int c_) { nM = M / BM; nN = N / BM; nwg = nM * nN; G = G_; c = c_; }
    __host__ __device__ bool next(int i, Unit& u) const {
        const long L = (long)i * G + c; if (L >= nwg) return false;
        int wgid = (int)L; { const int q = nwg / NXCD, r = nwg % NXCD, xcd = wgid % NXCD, off = wgid / NXCD; wgid = (xcd < r ? xcd * (q + 1) : r * (q + 1) + (xcd - r) * q) + off; }
        const int nig = WGM * nN, gid = wgid / nig, fm = gid * WGM, gsz = (nM - fm) < WGM ? (nM - fm) : WGM;
        u.pm = fm + ((wgid % nig) % gsz); u.pn = (wgid % nig) / gsz; u.e = 0; return true;
    }
    __device__ __forceinline__ const int* row_src(const Unit&, int) const { return nullptr; }
    __device__ __forceinline__ void a_ready(const Unit&) const {}
    __device__ __forceinline__ void done(const Unit&) const {}
};
template <bool GATHER_> struct MoeOrderT {
    static constexpr bool GATHER = GATHER_;
    const PG8_LAS int* tile_e; const PG8_LAS int* pstart; const PG8_LAS int* cntl; const int* list; int nrt, nN, lgN, G, cv;
    __device__ __forceinline__ bool next(int i, Unit& u) const {
        const int L = i * G + cv; if (L >= nrt * nN) return false;
        const int rt = L >> lgN; u.pm = rt; u.pn = L & (nN - 1); u.e = __builtin_amdgcn_readfirstlane(tile_e[rt]); return true;
    }
    __device__ __forceinline__ const int* row_src(const Unit& u, int r) const {
        const int ps = pstart[u.e], c = cntl[u.e]; int pos = u.pm * BM + r - ps; pos = pos < c ? pos : c - 1;
        return list + (size_t)u.e * LISTCAP + pos;
    }
    __device__ __forceinline__ int row_tok4(const Unit& u, int r) const {
        const int ps = pstart[u.e], c = cntl[u.e]; const int pos = u.pm * BM + r - ps;
        return pos < c ? list[(size_t)u.e * LISTCAP + pos] : -1;
    }
    __device__ __forceinline__ void a_ready(const Unit&) const {}
    __device__ __forceinline__ void done(const Unit&) const {}
};

__device__ __forceinline__ unsigned cvt_pk_bf16(float lo, float hi) { unsigned r; asm volatile("v_cvt_pk_bf16_f32 %0, %1, %2" : "=v"(r) : "v"(lo), "v"(hi)); return r; }

struct NoPre {};
struct EpiBf16 {
    static constexpr bool PERM = true, AFTER_DRAIN = false;
    typedef NoPre Pre; __device__ __forceinline__ void prefetch(Pre&, const Unit&, int, int, int, int) const {}
    bf16_t* O; int ldc;
    const float* ropet; int rope_pm;
    __device__ __forceinline__ void operator()(const f32x4 (&acc)[2][2][4][2], const Unit& u, int wr, int wc, int fr, int fq, const Pre&) const {
        const int row0 = u.pm * BM + wr * 64 + fr, col0 = u.pn * BM + wc * 32 + 8 * fq;
        if (ropet != nullptr && u.pn < 4 && u.pm < rope_pm) {
            const int t_ = fresh_tid(), fr_ = t_ & 15, fq_ = (t_ >> 4) & 3; const bool hiL = fq_ >= 2; const int half = wc & 1;
#pragma unroll
            for (int ai = 0; ai < 2; ++ai)
#pragma unroll
                for (int m = 0; m < 4; ++m) { const int row = u.pm * BM + wr * 64 + fr_ + ai * HALF + m * 16, sq = row & (SEQ - 1), pos = half ? (sq & 63) : (sq >> 6);
                    const f32x4* tp = (const f32x4*)(ropet + (size_t)(pos * 16 + 8 * (fq_ & 1)) * 2);
                    f32x4 cs[4];
#pragma unroll
                    for (int q = 0; q < 4; ++q) cs[q] = tp[q];
                    float A[8], B[8];
#pragma unroll
                    for (int i = 0; i < 8; ++i) { const float c = cs[i >> 1][(i & 1) * 2], sn = cs[i >> 1][(i & 1) * 2 + 1]; A[i] = hiL ? sn : c; B[i] = hiL ? c : -sn; }
                    bf16_t* rowp = O + (size_t)row * ldc + u.pn * BM + wc * 32 + 8 * fq_;
#pragma unroll
                    for (int bj = 0; bj < 2; ++bj) { float o8[8];
#pragma unroll
                        for (int i = 0; i < 8; ++i) { const float v = acc[ai][bj][m][i >> 2][i & 3];
                            auto r = __builtin_amdgcn_permlane32_swap(__float_as_uint(v), __float_as_uint(v), false, false);
                            o8[i] = __uint_as_float(r[0]) * A[i] + __uint_as_float(r[1]) * B[i]; }
                        u32x4 w; w.x = cvt_pk_bf16(o8[0], o8[1]); w.y = cvt_pk_bf16(o8[2], o8[3]); w.z = cvt_pk_bf16(o8[4], o8[5]); w.w = cvt_pk_bf16(o8[6], o8[7]);
                        *(u32x4*)(rowp + bj * HALF) = w; } }
            return; }
#pragma unroll
        for (int ai = 0; ai < 2; ++ai)
#pragma unroll
            for (int m = 0; m < 4; ++m) { bf16_t* rowp = O + (size_t)(row0 + ai * HALF + m * 16) * ldc + col0;
#pragma unroll
                for (int bj = 0; bj < 2; ++bj) { const f32x4 v0 = acc[ai][bj][m][0], v1 = acc[ai][bj][m][1];
                    u32x4 w; w.x = cvt_pk_bf16(v0[0], v0[1]); w.y = cvt_pk_bf16(v0[2], v0[3]); w.z = cvt_pk_bf16(v1[0], v1[1]); w.w = cvt_pk_bf16(v1[2], v1[3]);
                    *(u32x4*)(rowp + bj * HALF) = w; } }
    }
};
struct EpiRes {
    static constexpr bool PERM = false, AFTER_DRAIN = false;
    typedef NoPre Pre; __device__ __forceinline__ void prefetch(Pre&, const Unit&, int, int, int, int) const {}
    const float* baseL; const float* baseC; const bf16_t* baseB; bf16_t* out; const float* gate; int gstride;
    __device__ __forceinline__ void operator()(const f32x4 (&acc)[2][2][4][2], const Unit& u, int wr, int wc, int fr, int fq, const Pre&) const {
        const int rowt = u.pm * BM; const int bidx = rowt < SEQ ? 0 : (rowt < TLAT ? 1 : 2);
        const float* base = rowt < TLAT ? baseL + (size_t)rowt * DM : baseC + (size_t)(rowt - TLAT) * DM;
        const int t_ = fresh_tid(), fr_ = t_ & 15, fq_ = (t_ >> 4) & 3;
        (void)fr; (void)fq;
        const int rl = wr * 64 + fr_, col0 = u.pn * BM + wc * 32 + 4 * fq_;
        const float* gp = gate + (size_t)bidx * gstride + col0;
        f32x4 gv[2][2];
#pragma unroll
        for (int bj = 0; bj < 2; ++bj)
#pragma unroll
            for (int n = 0; n < 2; ++n) gv[bj][n] = *(const f32x4*)(gp + bj * HALF + n * 16);
        if (baseB) {
#pragma unroll
            for (int ai = 0; ai < 2; ++ai)
#pragma unroll
                for (int mp = 0; mp < 2; ++mp) { u32x2 bw[2][2][2];
#pragma unroll
                    for (int mm = 0; mm < 2; ++mm)
#pragma unroll
                        for (int bj = 0; bj < 2; ++bj)
#pragma unroll
                            for (int n = 0; n < 2; ++n) bw[mm][bj][n] = *(const u32x2*)(baseB + (size_t)rowt * DM + (size_t)(rl + ai * HALF + (2 * mp + mm) * 16) * DM + col0 + bj * HALF + n * 16);
                    __builtin_amdgcn_sched_barrier(0);
#pragma unroll
                    for (int mm = 0; mm < 2; ++mm) { const int m = 2 * mp + mm; bf16_t* op = out + (size_t)rowt * DM + (size_t)(rl + ai * HALF + m * 16) * DM + col0;
#pragma unroll
                        for (int bj = 0; bj < 2; ++bj)
#pragma unroll
                            for (int n = 0; n < 2; ++n) { const u32x2 w = bw[mm][bj][n];
                                const f32x4 bs = (f32x4){__uint_as_float(w.x << 16), __uint_as_float(w.x & 0xffff0000u), __uint_as_float(w.y << 16), __uint_as_float(w.y & 0xffff0000u)};
                                const f32x4 v = bs + gv[bj][n] * acc[ai][bj][m][n];
                                u32x2 o; o.x = cvt_pk_bf16(v[0], v[1]); o.y = cvt_pk_bf16(v[2], v[3]); *(u32x2*)(op + bj * HALF + n * 16) = o; } } }
        } else {
#pragma unroll
            for (int ai = 0; ai < 2; ++ai)
#pragma unroll
                for (int m = 0; m < 4; ++m) { f32x4 bf[2][2];
#pragma unroll
                    for (int bj = 0; bj < 2; ++bj)
#pragma unroll
                        for (int n = 0; n < 2; ++n) bf[bj][n] = *(const f32x4*)(base + (size_t)(rl + ai * HALF + m * 16) * DM + col0 + bj * HALF + n * 16);
                    __builtin_amdgcn_sched_barrier(0);
                    bf16_t* op = out + (size_t)rowt * DM + (size_t)(rl + ai * HALF + m * 16) * DM + col0;
#pragma unroll
                    for (int bj = 0; bj < 2; ++bj)
#pragma unroll
                        for (int n = 0; n < 2; ++n) { const f32x4 v = bf[bj][n] + gv[bj][n] * acc[ai][bj][m][n];
                            u32x2 o; o.x = cvt_pk_bf16(v[0], v[1]); o.y = cvt_pk_bf16(v[2], v[3]); *(u32x2*)(op + bj * HALF + n * 16) = o; } }
        }
    }
};
struct EpiAct {
    static constexpr bool PERM = true, AFTER_DRAIN = false;
    bf16_t* O; const float* bias;
    struct Pre { f32x4 b[4]; };
    __device__ __forceinline__ void prefetch(Pre& p, const Unit& u, int wr, int wc, int fr, int fq) const {
        const float* bp = bias + (size_t)u.e * 2048 + u.pn * HALF + wc * 32 + 8 * fq;
        p.b[0] = *(const f32x4*)(bp); p.b[1] = *(const f32x4*)(bp + 4); p.b[2] = *(const f32x4*)(bp + 1024); p.b[3] = *(const f32x4*)(bp + 1028); }
    __device__ __forceinline__ void operator()(const f32x4 (&acc)[2][2][4][2], const Unit& u, int wr, int wc, int fr, int fq, const Pre& p) const {
        const int row0 = u.pm * BM + wr * 64 + fr, col0 = u.pn * HALF + wc * 32 + 8 * fq;
        const f32x4 bg0 = p.b[0], bg1 = p.b[1], bl0 = p.b[2] + 1.0f, bl1 = p.b[3] + 1.0f;
#pragma unroll
        for (int ai = 0; ai < 2; ++ai)
#pragma unroll
            for (int m = 0; m < 4; ++m) { bf16_t* rowp = O + (size_t)(row0 + ai * HALF + m * 16) * DE + col0;
                float a[8];
#pragma unroll
                for (int n = 0; n < 2; ++n) { const f32x4 g = acc[ai][0][m][n] + (n ? bg1 : bg0), li = acc[ai][1][m][n] + (n ? bl1 : bl0);
#pragma unroll
                    for (int j = 0; j < 4; ++j) { const float gl = fminf(g[j], 7.0f), ln1 = __builtin_amdgcn_fmed3f(li[j], -6.0f, 8.0f); a[n * 4 + j] = gl * __builtin_amdgcn_rcpf(1.0f + __builtin_amdgcn_exp2f(-1.702f * 1.4426950408889634f * gl)) * ln1; } }
                u32x4 w; w.x = cvt_pk_bf16(a[0], a[1]); w.y = cvt_pk_bf16(a[2], a[3]); w.z = cvt_pk_bf16(a[4], a[5]); w.w = cvt_pk_bf16(a[6], a[7]);
                *(u32x4*)rowp = w; }
    }
};
struct EpiDown {
    static constexpr bool PERM = true, AFTER_DRAIN = false;
    bf16_t* Y; const float* bias; const MoeOrderT<false>* S; const float* gatev;
    struct Pre { int t4[8]; };
    __device__ __forceinline__ void prefetch(Pre& p, const Unit& u, int wr, int wc, int fr, int fq) const {
#pragma unroll
        for (int i = 0; i < 8; ++i) p.t4[i] = S->row_tok4(u, wr * 64 + fr + (i >> 2) * HALF + (i & 3) * 16); }
    __device__ __forceinline__ void operator()(const f32x4 (&acc)[2][2][4][2], const Unit& u, int wr, int wc, int fr, int fq, const Pre& p) const {
        const int row0 = u.pm * BM + wr * 64 + fr, col0 = u.pn * BM + wc * 32 + 8 * fq;
        const float* bp = bias + (size_t)u.e * DM + col0;
        f32x4 bv[2][2];
#pragma unroll
        for (int bj = 0; bj < 2; ++bj) { bv[bj][0] = *(const f32x4*)(bp + bj * HALF); bv[bj][1] = *(const f32x4*)(bp + bj * HALF + 4); }
        int t4[8]; float gt[8];
#pragma unroll
        for (int i = 0; i < 8; ++i) t4[i] = p.t4[i];
#pragma unroll
        for (int i = 0; i < 8; ++i) gt[i] = gatev[t4[i] >= 0 ? t4[i] : 0];
#pragma unroll
        for (int ai = 0; ai < 2; ++ai)
#pragma unroll
            for (int m = 0; m < 4; ++m) { const int tok4 = t4[ai * 4 + m];
                if (tok4 >= 0) { const float g1 = gt[ai * 4 + m]; bf16_t* rowp = Y + (size_t)tok4 * DM + col0;
#pragma unroll
                    for (int bj = 0; bj < 2; ++bj) { const f32x4 v0 = (acc[ai][bj][m][0] + bv[bj][0]) * g1, v1 = (acc[ai][bj][m][1] + bv[bj][1]) * g1;
                        u32x4 w; w.x = cvt_pk_bf16(v0[0], v0[1]); w.y = cvt_pk_bf16(v0[2], v0[3]); w.z = cvt_pk_bf16(v1[0], v1[1]); w.w = cvt_pk_bf16(v1[2], v1[3]);
                        *(u32x4*)(rowp + bj * HALF) = w; } } }
    }
};

template <class Epi, class Sched, bool ALIGN_EPI = false, bool SP2 = false>
__device__ __forceinline__ void gemm_phase(PG8_LAS unsigned char* lds, const Gemm g, const Sched& S, const Epi& E) {
    const int tid = fresh_tid(), wid = __builtin_amdgcn_readfirstlane(tid >> 6), lane = tid & 63, wr = wid >> 2, wc = wid & 3, fr = lane & 15, fq = lane >> 4;
    const int K = g.K, nt = K / BK;
    unsigned voffA[2], voffB[2];
#pragma unroll
    for (int i = 0; i < 2; ++i) { int R, C; stage_rc(tid * 16 + i * 8192, R, C); const int Rb = Epi::PERM ? ((R & ~31) + perm32(R & 31)) : R;
        voffA[i] = (unsigned)(R * K + C) * 2u; voffB[i] = (unsigned)(Rb * K + C) * 2u; }
    unsigned Rr[2], Cb2[2];
#pragma unroll
    for (int i = 0; i < 2; ++i) { int R, C; stage_rc(tid * 16 + i * 8192, R, C); Rr[i] = (unsigned)R; Cb2[i] = (unsigned)C * 2u; }
    unsigned tC4[2][2], tN4[2][2];
    const size_t kstep = (size_t)(BK * 2);
    const size_t hstep = (size_t)HALF * K * 2;
    const size_t tstep = 2 * hstep;
    const unsigned ldsw = (unsigned)wid * 1024u;
    const int aoff = lds_byte(wr * 64 + fr, fq * 8), boff = lds_byte(wc * 32 + fr, fq * 8);
#define PG8_SA(b, h) (((b) * 2 + (h)) * HTB)
#define PG8_SB(b, h) ((4 + (b) * 2 + (h)) * HTB)
#define PG8_STAGE(bufoff, gbase, voff) do { _Pragma("unroll") for (int _i = 0; _i < 2; ++_i) \
        __builtin_amdgcn_global_load_lds((const unsigned*)((const char*)(gbase) + (voff)[_i]), (PG8_LAS unsigned*)(lds + (bufoff) + ldsw + _i * 8192), 16, 0, 0); } while (0)
#define PG8_STAGE_A(bufoff, kbyte, h, isnext) do { if constexpr (Sched::GATHER) { unsigned vo_[2]; _Pragma("unroll") for (int _i = 0; _i < 2; ++_i) { asm volatile("" : "+v"(tN4[h][_i])); \
            const unsigned t4_ = (isnext) ? tN4[h][_i] : tC4[h][_i]; vo_[_i] = (t4_ >> 2) * (unsigned)(K * 2) + Cb2[_i]; } PG8_STAGE(bufoff, (const char*)g.A + (kbyte), vo_); } \
        else { PG8_STAGE(bufoff, ((isnext) ? nA : cA) + (kbyte) + (h) * hstep, voffA); } } while (0)
#define PG8_LOOKUP(dst, unit) do { _Pragma("unroll") for (int _h = 0; _h < 2; ++_h) _Pragma("unroll") for (int _i = 0; _i < 2; ++_i) { const int* p_ = S.row_src(unit, _h * HALF + (int)Rr[_i]); \
        asm volatile("global_load_dword %0, %1, off" : "=v"(dst[_h][_i]) : "v"(p_) : "memory"); } } while (0)
#define PG8_LDA(dst, b, h) do { _Pragma("unroll") for (int m = 0; m < 4; ++m) _Pragma("unroll") for (int k = 0; k < 2; ++k) dst[m][k] = *(const PG8_LAS bf16x8*)(lds + PG8_SA(b, h) + aoff + m * 2048 + k * 1024); } while (0)
#define PG8_LDB(dst, b, h) do { _Pragma("unroll") for (int n = 0; n < 2; ++n) _Pragma("unroll") for (int k = 0; k < 2; ++k) dst[n][k] = *(const PG8_LAS bf16x8*)(lds + PG8_SB(b, h) + boff + n * 2048 + k * 1024); } while (0)
#define PG8_MMA(ai, bj, At, Bt) do { __builtin_amdgcn_s_setprio(1); _Pragma("unroll") for (int m = 0; m < 4; ++m) _Pragma("unroll") for (int n = 0; n < 2; ++n) _Pragma("unroll") for (int k = 0; k < 2; ++k) \
        acc[ai][bj][m][n] = __builtin_amdgcn_mfma_f32_16x16x32_bf16(Bt[n][k], At[m][k], acc[ai][bj][m][n], 0, 0, 0); __builtin_amdgcn_s_setprio(0); } while (0)
#define PG8_WAIT_V(n) asm volatile("s_waitcnt vmcnt(" #n ")" ::: "memory")
#define PG8_WAIT_L(n) asm volatile("s_waitcnt lgkmcnt(" #n ")" ::: "memory")
#define PG8_BAR __builtin_amdgcn_s_barrier()
#define PG8_SCHED __builtin_amdgcn_sched_barrier(0)
    Unit cur, nxt; int ui = 0;
    if (!S.next(0, cur)) return;
    f32x4 acc[2][2][4][2];
#pragma unroll
    for (int a = 0; a < 2; ++a)
#pragma unroll
        for (int b = 0; b < 2; ++b)
#pragma unroll
            for (int m = 0; m < 4; ++m)
#pragma unroll
                for (int n = 0; n < 2; ++n) acc[a][b][m][n] = (f32x4){0.f, 0.f, 0.f, 0.f};
    bf16x8 At[4][2], B0[2][2], B1[2][2];
    const char* cA = (const char*)g.A + (size_t)cur.pm * tstep; const char* cB = (const char*)g.Bt + (size_t)cur.e * g.estride + (size_t)cur.pn * tstep;
    S.a_ready(cur);
    static_assert(SP2, "only the two-super-phase K-loop is kept in this file");
    const char* nA = cA;
    if constexpr (Sched::GATHER) { PG8_LOOKUP(tC4, cur); asm volatile("s_waitcnt vmcnt(0)" ::: "memory");
#pragma unroll
        for (int _h = 0; _h < 2; ++_h)
#pragma unroll
            for (int _i = 0; _i < 2; ++_i) { asm volatile("" : "+v"(tC4[_h][_i])); tN4[_h][_i] = tC4[_h][_i]; } }
    {
        PG8_STAGE(PG8_SB(0, 0), cB, voffB); PG8_STAGE(PG8_SB(0, 1), cB + hstep, voffB); PG8_STAGE_A(PG8_SA(0, 0), 0, 0, false); PG8_STAGE_A(PG8_SA(0, 1), 0, 1, false);
        if (wr == 1) PG8_BAR;
        PG8_WAIT_V(2); PG8_BAR;
        PG8_STAGE(PG8_SB(1, 0), cB + kstep, voffB); PG8_STAGE_A(PG8_SA(1, 0), kstep, 0, false); PG8_STAGE(PG8_SB(1, 1), cB + hstep + kstep, voffB);
        PG8_WAIT_V(6); PG8_BAR;
    }
    for (;;) {
        const bool has_next = S.next(ui + 1, nxt);
        nA = has_next ? (const char*)g.A + (size_t)nxt.pm * tstep : cA; const char* nB = has_next ? (const char*)g.Bt + (size_t)nxt.e * g.estride + (size_t)nxt.pn * tstep : cB;
        if constexpr (Sched::GATHER) { if (has_next) PG8_LOOKUP(tN4, nxt); }
        typename Epi::Pre pre; E.prefetch(pre, cur, wr, wc, fr, fq);
        for (int t = 0; t < nt; t += 2) {
            const bool last = (t == nt - 2);
            const size_t k1 = (size_t)(t + 1) * kstep, k2 = last ? 0 : (size_t)(t + 2) * kstep, k3 = k2 + kstep;
            const char* b2 = (last ? nB : cB) + k2; const char* b3 = b2 + kstep;
            if (last && has_next) S.a_ready(nxt);
            PG8_LDB(B0, 0, 0); PG8_LDB(B1, 0, 1); PG8_SCHED; PG8_LDA(At, 0, 0); PG8_STAGE_A(PG8_SA(1, 1), k1, 1, false);
            PG8_WAIT_V(8); PG8_WAIT_L(0); PG8_BAR; PG8_MMA(0, 0, At, B0); PG8_MMA(0, 1, At, B1); PG8_BAR; PG8_SCHED;
            PG8_LDA(At, 0, 1); PG8_STAGE(PG8_SB(0, 0), b2, voffB); PG8_STAGE(PG8_SB(0, 1), b2 + hstep, voffB); PG8_STAGE_A(PG8_SA(0, 0), k2, 0, last);
            PG8_WAIT_V(8); PG8_WAIT_L(0); PG8_BAR; PG8_MMA(1, 0, At, B0); PG8_MMA(1, 1, At, B1); PG8_BAR; PG8_SCHED;
            PG8_LDB(B0, 1, 0); PG8_LDB(B1, 1, 1); PG8_SCHED; PG8_LDA(At, 1, 0); PG8_STAGE_A(PG8_SA(0, 1), k2, 1, last);
            PG8_WAIT_V(8); PG8_WAIT_L(0); PG8_BAR; PG8_MMA(0, 0, At, B0); PG8_MMA(0, 1, At, B1); PG8_BAR; PG8_SCHED;
            PG8_LDA(At, 1, 1); PG8_STAGE(PG8_SB(1, 0), b3, voffB); PG8_STAGE(PG8_SB(1, 1), b3 + hstep, voffB); PG8_STAGE_A(PG8_SA(1, 0), k3, 0, last);
            PG8_WAIT_V(8); PG8_WAIT_L(0); PG8_BAR; PG8_MMA(1, 0, At, B0); PG8_MMA(1, 1, At, B1); PG8_BAR; PG8_SCHED;
        }
        if constexpr (ALIGN_EPI) { if (wr == 0) PG8_BAR; }
        if constexpr (!Epi::AFTER_DRAIN) { E(acc, cur, wr, wc, fr, fq, pre); S.done(cur); }
        if (!has_next) break;
#pragma unroll
        for (int a = 0; a < 2; ++a)
#pragma unroll
            for (int b = 0; b < 2; ++b)
#pragma unroll
                for (int m = 0; m < 4; ++m)
#pragma unroll
                    for (int n = 0; n < 2; ++n) acc[a][b][m][n] = (f32x4){0.f, 0.f, 0.f, 0.f};
        cur = nxt; cA = nA; cB = nB; ++ui;
        if constexpr (Sched::GATHER) {
#pragma unroll
            for (int _h = 0; _h < 2; ++_h)
#pragma unroll
                for (int _i = 0; _i < 2; ++_i) tC4[_h][_i] = tN4[_h][_i]; }
        if constexpr (ALIGN_EPI) { if (wr == 1) PG8_BAR; }
    }
    PG8_WAIT_V(0);
    if constexpr (!ALIGN_EPI) { if (wr == 0) PG8_BAR; }
    PG8_BAR;
#undef PG8_SA
#undef PG8_SB
#undef PG8_STAGE
#undef PG8_STAGE_A
#undef PG8_LOOKUP
#undef PG8_LDA
#undef PG8_LDB
#undef PG8_MMA
#undef PG8_WAIT_V
#undef PG8_WAIT_L
#undef PG8_BAR
#undef PG8_SCHED
}
}

namespace att {
constexpr float SCALE = 0.125f;
constexpr int SHM_V = 64 * 128 * 2, SHM_K = 64 * 128 * 2;
#define KSWZ(row, colB) ((row) * 256 + ((colB) ^ (((row) & 7) << 4)))
#define SBAR() __builtin_amdgcn_sched_barrier(0)
__device__ __forceinline__ int crow(int r, int hi) { return (r & 3) + 8 * (r >> 2) + 4 * hi; }
__device__ __forceinline__ unsigned cvtpk(float lo, float hi) { unsigned r; asm volatile("v_cvt_pk_bf16_f32 %0, %1, %2" : "=v"(r) : "v"(lo), "v"(hi)); return r; }
__device__ __forceinline__ bf16x8 ld8(const bf16_t* p) { return *reinterpret_cast<const bf16x8*>(p); }

__device__ __forceinline__ void partialSM(f32x16& p0) {
#pragma unroll
    for (int r = 0; r < 16; ++r) p0[r] = __builtin_amdgcn_exp2f(p0[r]);
}
__device__ __forceinline__ void finishSM(f32x16& p0, f32x16& p1, float& l_reg, bf16x8& pa0, bf16x8& pa1, bf16x8& pa2, bf16x8& pa3) {
#pragma unroll
    for (int r = 0; r < 16; ++r) p1[r] = __builtin_amdgcn_exp2f(p1[r]);
    float ps = 0;
#pragma unroll
    for (int r = 0; r < 16; ++r) ps += p0[r];
#pragma unroll
    for (int r = 0; r < 16; ++r) ps += p1[r];
    l_reg += ps;
#define PK4(P, BASE, OUT) do { u32x4 w = {cvtpk(P[BASE + 0], P[BASE + 1]), cvtpk(P[BASE + 2], P[BASE + 3]), cvtpk(P[BASE + 4], P[BASE + 5]), cvtpk(P[BASE + 6], P[BASE + 7])}; \
    OUT = *reinterpret_cast<bf16x8*>(&w); } while (0)
    PK4(p0, 0, pa0); PK4(p0, 8, pa1); PK4(p1, 0, pa2); PK4(p1, 8, pa3);
#undef PK4
}
__device__ __forceinline__ void qkt(f32x16& p0, f32x16& p1, const char* Ks, const bf16x8* qr, int r32, int hi, int mp, float nm) {
#pragma unroll
    for (int r = 0; r < 16; ++r) { p0[r] = nm; p1[r] = nm; }
    bf16x8 b0n, b1n;
    { const int cb = ((mp * 4 + 0) * 16 + hi * 8) * 2; b0n = *reinterpret_cast<const bf16x8*>(Ks + KSWZ(r32, cb)); b1n = *reinterpret_cast<const bf16x8*>(Ks + KSWZ(32 + r32, cb)); }
#pragma unroll
    for (int d0 = 0; d0 < 4; ++d0) { const bf16x8 b0 = b0n, b1 = b1n;
        if (d0 < 3) { const int cb = ((mp * 4 + d0 + 1) * 16 + hi * 8) * 2; b0n = *reinterpret_cast<const bf16x8*>(Ks + KSWZ(r32, cb)); b1n = *reinterpret_cast<const bf16x8*>(Ks + KSWZ(32 + r32, cb)); }
        __builtin_amdgcn_sched_barrier(0);
        p0 = __builtin_amdgcn_mfma_f32_32x32x16_bf16(b0, qr[d0], p0, 0, 0, 0);
        p1 = __builtin_amdgcn_mfma_f32_32x32x16_bf16(b1, qr[d0], p1, 0, 0, 0); }
}
__device__ __forceinline__ int v_st(int k, int c) { const int kk = k; return ((kk >> 3) * 4 + (c >> 5)) * 512 + ((kk & 7) * 32 + (c & 31)) * 2; }
__device__ __forceinline__ int v_rd_base(int lane) { return ((lane & 3) << 3) | (((lane >> 2) & 3) << 6) | (((lane >> 4) & 1) << 5) | (((lane >> 5) & 1) << 8); }
constexpr int v_rd_off(int d0, int ks, int half) { return d0 * 512 + ks * 4096 + half * 2048; }
template <int OFF> __device__ __forceinline__ s16x4 tr_read(int vb) {
    s16x4 r; asm volatile("ds_read_b64_tr_b16 %0, %1 offset:%2" : "=&v"(r) : "v"(vb), "i"(OFF) : "memory"); return r;
}
template <int D0, bool EXPS> __device__ __forceinline__ void pv_one(f32x16& od, int vb, bf16x8 pa0, bf16x8 pa1, bf16x8 pa2, bf16x8 pa3, f32x16& pn) {
    const s16x4 l0 = tr_read<v_rd_off(D0, 0, 0)>(vb), h0 = tr_read<v_rd_off(D0, 0, 1)>(vb), l1 = tr_read<v_rd_off(D0, 1, 0)>(vb), h1 = tr_read<v_rd_off(D0, 1, 1)>(vb);
    const s16x4 l2 = tr_read<v_rd_off(D0, 2, 0)>(vb), h2 = tr_read<v_rd_off(D0, 2, 1)>(vb), l3 = tr_read<v_rd_off(D0, 3, 0)>(vb), h3 = tr_read<v_rd_off(D0, 3, 1)>(vb);
    asm volatile("s_waitcnt lgkmcnt(0)" ::: "memory"); SBAR();
#define PK(L, H) (bf16x8){L[0], L[1], L[2], L[3], H[0], H[1], H[2], H[3]}
    od = __builtin_amdgcn_mfma_f32_32x32x16_bf16(pa0, PK(l0, h0), od, 0, 0, 0);
    od = __builtin_amdgcn_mfma_f32_32x32x16_bf16(pa1, PK(l1, h1), od, 0, 0, 0);
    od = __builtin_amdgcn_mfma_f32_32x32x16_bf16(pa2, PK(l2, h2), od, 0, 0, 0);
    od = __builtin_amdgcn_mfma_f32_32x32x16_bf16(pa3, PK(l3, h3), od, 0, 0, 0);
#undef PK
    if constexpr (EXPS) {
#pragma unroll
        for (int r = 4 * D0; r < 4 * D0 + 4; ++r) pn[r] = __builtin_amdgcn_exp2f(pn[r]); }
}
template <bool EXPS> __device__ __forceinline__ void pv_d0(f32x16* o, int vb, bf16x8 pa0, bf16x8 pa1, bf16x8 pa2, bf16x8 pa3, f32x16& pn) {
    pv_one<0, EXPS>(o[0], vb, pa0, pa1, pa2, pa3, pn); pv_one<1, EXPS>(o[1], vb, pa0, pa1, pa2, pa3, pn); pv_one<2, EXPS>(o[2], vb, pa0, pa1, pa2, pa3, pn); pv_one<3, EXPS>(o[3], vb, pa0, pa1, pa2, pa3, pn);
}

__device__ __forceinline__ void attn_unit(const bf16_t* __restrict__ proj, bf16_t* __restrict__ mix, const float* __restrict__ subw, float lam, float osc,
                                          const unsigned* __restrict__ kmax2, int b, int h, int qrow0, int nkeys, char* lds) {
    const int tid = fresh_tid(), wid = tid >> 6, lane = tid & 63, r32 = lane & 31, hi = lane >> 5, mp = wid >> 2, wq = wid & 3;
    constexpr int SLOT = SHM_V + SHM_K;
    float* ws = (float*)(lds + 3 * SLOT) + wid * 64; float* li_l = ws;
    float l_reg = 0; f32x16 o[4] = {}; bf16x8 qr[4];
    const int wu = __builtin_amdgcn_readfirstlane(wid);
    unsigned offV[2], offK[2];
#pragma unroll
    for (int q = 0; q < 2; ++q) { const int pc = 2 * wu + q;
        { const int key = 8 * (pc >> 1) + ((lane >> 2) & 7), col = 32 * (2 * (pc & 1) + (lane >> 5)) + (lane & 3) * 8; offV[q] = (unsigned)(key * INWP + col + C_V); }
        { const int row = 4 * pc + (lane >> 4), col = ((lane & 15) ^ (row & 7)) * 8; offK[q] = (unsigned)(row * INWP + col + C_K); } }
    const int vb0 = (int)(uintptr_t)lds + v_rd_base(lane);
    LAS unsigned char* lds3 = (LAS unsigned char*)(unsigned)(uintptr_t)lds;
    const int ctx_row0 = TLAT + b * LCTX, lat_row0 = b * SEQ - LCTX;
#define DMA_TILE(k0, so) do { const bf16_t* tb_ = proj + (size_t)((k0) < LCTX ? ctx_row0 + (k0) : lat_row0 + (k0)) * INWP + h * 128; \
    _Pragma("unroll") for (int q_ = 0; q_ < 2; ++q_) { \
        __builtin_amdgcn_global_load_lds((const unsigned*)(tb_ + offV[q_]), (LAS unsigned*)(lds3 + (so) + (2 * wu + q_) * 1024), 16, 0, 0); \
        __builtin_amdgcn_global_load_lds((const unsigned*)(tb_ + offK[q_]), (LAS unsigned*)(lds3 + (so) + SHM_V + (2 * wu + q_) * 1024), 16, 0, 0); } } while (0)
    f32x16 pA0, pA1, pB0, pB1; bf16x8 pa0, pa1, pa2, pa3; const int NT = nkeys / 64;
    int sl_prev = 0, sl_cur = 0, sl_next = SLOT;
#define ROT() do { sl_prev = sl_cur; sl_cur = sl_next; sl_next = (sl_next == 2 * SLOT) ? 0 : sl_next + SLOT; } while (0)
    DMA_TILE(0, 0); DMA_TILE(64, SLOT);
    const bf16_t* Qw = proj + (size_t)(qrow0 + wq * 32 + r32) * INWP + C_Q + h * 128 + mp * 64 + hi * 8;
    float qss = 0.f;
    bf16x8 qraw[4];
#pragma unroll
    for (int d0 = 0; d0 < 4; ++d0) qraw[d0] = ld8(Qw + d0 * 16);
    const float km2 = __uint_as_float(kmax2[h * 2 + mp]);
    __builtin_amdgcn_sched_barrier(0);
#pragma unroll
    for (int d0 = 0; d0 < 4; ++d0) { float f[8]; const bf16x8 raw = qraw[d0]; unpack8(*reinterpret_cast<const u32x4*>(&raw), f);
        constexpr float C = SCALE * 1.4426950408889634f;
        u32x4 w; w.x = cvtpk(f[0] * C, f[1] * C); w.y = cvtpk(f[2] * C, f[3] * C); w.z = cvtpk(f[4] * C, f[5] * C); w.w = cvtpk(f[6] * C, f[7] * C);
        float g[8]; unpack8(w, g);
#pragma unroll
        for (int e = 0; e < 8; ++e) qss += g[e] * g[e];
        qr[d0] = *reinterpret_cast<const bf16x8*>(&w); }
    qss += __shfl_xor(qss, 32);
    const float nm = -1.002f * sqrtf(qss) * sqrtf(km2);
    asm volatile("s_waitcnt vmcnt(0)" ::: "memory"); __syncthreads();
    qkt(pA0, pA1, lds + SHM_V, qr, r32, hi, mp, nm); partialSM(pA0);
    ROT();
#define ITER(PC0, PC1, PP0, PP1, j) do { if ((j) + 1 < NT) DMA_TILE(((j) + 1) * 64, sl_next); \
        SBAR(); qkt(PC0, PC1, lds + sl_cur + SHM_V, qr, r32, hi, mp, nm); \
        finishSM(PP0, PP1, l_reg, pa0, pa1, pa2, pa3); SBAR(); \
        pv_d0<true>(o, vb0 + sl_prev, pa0, pa1, pa2, pa3, PC0); \
        asm volatile("s_waitcnt vmcnt(0)" ::: "memory");     \
        __syncthreads(); ROT(); } while (0)
    for (int j = 1; j + 1 < NT; j += 2) { ITER(pB0, pB1, pA0, pA1, j); ITER(pA0, pA1, pB0, pB1, j + 1); }
    ITER(pB0, pB1, pA0, pA1, NT - 1);
    finishSM(pB0, pB1, l_reg, pa0, pa1, pa2, pa3); SBAR();
    pv_d0<false>(o, vb0 + sl_prev, pa0, pa1, pa2, pa3, pA0);
#undef ITER
#undef ROT
#undef DMA_TILE
    asm volatile("s_waitcnt vmcnt(0)" ::: "memory");
    l_reg += __shfl_xor(l_reg, 32);
    if (hi == 0) li_l[r32] = (mp ? lam : 1.0f) / l_reg;
    asm volatile("s_waitcnt lgkmcnt(0)" ::: "memory");
#pragma unroll
    for (int r = 0; r < 16; ++r) { const float f = li_l[crow(r, hi)];
#pragma unroll
        for (int d0 = 0; d0 < 4; ++d0) o[d0][r] *= f; }
    __syncthreads();
    float* ex = (float*)lds;
    bf16_t* ot = (bf16_t*)(lds + 65536);
    if (mp == 1) {
#pragma unroll
        for (int r = 0; r < 16; ++r)
#pragma unroll
            for (int d0 = 0; d0 < 4; ++d0) ex[(wq * 32 + crow(r, hi)) * 128 + d0 * 32 + r32] = o[d0][r];
    }
    __syncthreads();
    if (mp == 0) {
        const int t2 = fresh_tid(), r32 = t2 & 31, hi = (t2 >> 5) & 1, wq = (t2 >> 6) & 3;
        float wcol[4];
#pragma unroll
        for (int d0 = 0; d0 < 4; ++d0) wcol[d0] = subw[d0 * 32 + r32] * osc;
#pragma unroll
        for (int r = 0; r < 16; ++r) {
            float ss = 0.f;
#pragma unroll
            for (int d0 = 0; d0 < 4; ++d0) { o[d0][r] -= ex[(wq * 32 + crow(r, hi)) * 128 + d0 * 32 + r32]; ss += o[d0][r] * o[d0][r]; }
            ss = sum32(ss);
            const float rn = rsqrtf(ss * (1.0f / 128.0f) + EPS);
            bf16_t* op = ot + (wq * 32 + crow(r, hi)) * 136 + r32;
#pragma unroll
            for (int d0 = 0; d0 < 4; ++d0) op[d0 * 32] = (bf16_t)f2bf(o[d0][r] * rn * wcol[d0]);
        }
    }
    __syncthreads();
    { const int t3 = fresh_tid();
#pragma unroll
      for (int it = 0; it < 4; ++it) { const int idx = t3 + 512 * it, row = idx >> 4, pc = idx & 15;
          *(u32x4*)(mix + (size_t)(qrow0 + row) * DM + h * 128 + pc * 8) = *(const u32x4*)(ot + row * 136 + pc * 8); } }
    __syncthreads();
}
}


namespace ck {
template <int K>
__device__ __forceinline__ f32x16 mma32(const bf16_t* A, int lda, const bf16_t* B, int ldb, f32x16 acc, int r32, int hi) {
#pragma unroll
    for (int k0 = 0; k0 < K; k0 += 16) {
        const bf16x8 a = *(const bf16x8*)(A + r32 * lda + k0 + 8 * hi), b = *(const bf16x8*)(B + r32 * ldb + k0 + 8 * hi);
        acc = __builtin_amdgcn_mfma_f32_32x32x16_bf16(a, b, acc, 0, 0, 0); }
    return acc;
}
__device__ __forceinline__ int crow(int r, int hi) { return (r & 3) + 8 * (r >> 2) + 4 * hi; }
struct P { bf16_t* proj; bf16_t* xbcs; float* dtv; float* cumv; float* gkv; bf16_t* ssd_st; bf16_t* gla_st; float* cds; float* cdg; bf16_t* mix; const f32x2* ropet;
           const float *convw, *convb, *dtb, *alog, *gkup, *gkb, *ssdd, *ssdnw, *glanw; unsigned* kmax2; bf16_t* hins; bf16_t* hing; };

__device__ __forceinline__ void prep_chunk(const P& p, int ch, unsigned char* lds, int sect, bool dry = false) {
    const int tid = fresh_tid(), lane = tid & 63, wave = __builtin_amdgcn_readfirstlane(tid >> 6), r32 = lane & 31, hi = lane >> 5;
    const int row0 = ch * 64; const bool lat = row0 < TLAT;
    float* dtl = (float*)lds; float* al = dtl + 512; float* cuml = al + 512; float* wgt = cuml + 512; float* tot = wgt + 512;
    bf16_t* XwT = (bf16_t*)(lds + 16384);
    bf16_t* BT = (bf16_t*)(lds + 90112);
    if (lat && !dry && (sect & 1)) {
#pragma unroll 1
        for (int hb = 0; hb < 2; ++hb) {
            u32x4 a1[4], a2[4]; f32x4 tb[4][4];
#pragma unroll
            for (int q = 0; q < 4; ++q) { const int idx = tid + 512 * (hb * 4 + q);
                const int jg = idx & 1, half = (idx >> 1) & 1, mp = (idx >> 2) & 1, hh = (idx >> 3) & 3, qk = (idx >> 5) & 1, tok = idx >> 6;
                const int row = row0 + tok, s = row & (SEQ - 1), pos = half ? (s & 63) : (s >> 6);
                const bf16_t* p1 = p.proj + (size_t)row * INWP + qk * 512 + hh * 128 + mp * 64 + half * 32 + jg * 8;
                a1[q] = *(const u32x4*)p1; a2[q] = *(const u32x4*)(p1 + 16);
                const f32x4* tp = (const f32x4*)(p.ropet + pos * 16 + jg * 8);
#pragma unroll
                for (int e = 0; e < 4; ++e) tb[q][e] = tp[e]; }
#pragma unroll
            for (int q = 0; q < 4; ++q) { const int idx = tid + 512 * (hb * 4 + q);
                const int jg = idx & 1, half = (idx >> 1) & 1, mp = (idx >> 2) & 1, hh = (idx >> 3) & 3, qk = (idx >> 5) & 1, tok = idx >> 6;
                bf16_t* p1 = p.proj + (size_t)(row0 + tok) * INWP + qk * 512 + hh * 128 + mp * 64 + half * 32 + jg * 8;
                float x1[8], x2[8], o1[8], o2[8]; unpack8(a1[q], x1); unpack8(a2[q], x2);
#pragma unroll
                for (int e = 0; e < 4; ++e) { const f32x4 cs = tb[q][e];
                    o1[2 * e] = x1[2 * e] * cs.x - x2[2 * e] * cs.y; o2[2 * e] = x2[2 * e] * cs.x + x1[2 * e] * cs.y;
                    o1[2 * e + 1] = x1[2 * e + 1] * cs.z - x2[2 * e + 1] * cs.w; o2[2 * e + 1] = x2[2 * e + 1] * cs.z + x1[2 * e + 1] * cs.w; }
                *(u32x4*)p1 = pack8(o1); *(u32x4*)(p1 + 16) = pack8(o2); }
        }
    }
    const int spos = lat ? ((row0 + lane) & (SEQ - 1)) : ((row0 + lane - TLAT) & (LCTX - 1)), slen = lat ? SEQ : LCTX;
    if (sect & 2) {
    u32x4 c0[4], cm[4], cp[4];
    const bf16_t* cbase = p.proj + (size_t)(row0 + lane) * INWP + C_XBC;
    const int dm = spos > 0 ? -INWP : 0, dp = spos < slen - 1 ? INWP : 0;
#pragma unroll
    for (int q = 0; q < 4; ++q) { const bf16_t* pp = cbase + (wave + 8 * q) * 8; c0[q] = *(const u32x4*)pp; cm[q] = *(const u32x4*)(pp + dm); cp[q] = *(const u32x4*)(pp + dp); }
    float* cwl = (float*)(lds + 108544);
    { const int i4 = tid * 4; *(f32x4*)(cwl + i4) = (i4 < 512) ? *(const f32x4*)(p.convb + i4) : *(const f32x4*)(p.convw + (i4 - 512)); }
    { const int tok = tid >> 3, i = tid & 7, row = row0 + tok;
      const float x = bf2f(p.proj[(size_t)row * INWP + C_DT + i]) + p.dtb[i];
      const float dt = softplusf(x), A = -expf(p.alog[i]);
      dtl[tid] = dt; al[tid] = dt * A; p.dtv[(size_t)row * 8 + i] = dt; }
    unsigned* kml = (unsigned*)(tot + 8);
    if (tid < 8) kml[tid] = 0u;
    LDS_BARRIER();
    { const int tok = tid >> 3, hm = tid & 7; const bf16_t* kp = p.proj + (size_t)(row0 + tok) * INWP + C_K + hm * 64; float ss = 0.f;
#pragma unroll
      for (int q = 0; q < 8; ++q) { float f[8]; unpack8(*(const u32x4*)(kp + q * 8), f);
#pragma unroll
          for (int e = 0; e < 8; ++e) ss += f[e] * f[e]; }
      atomicMax(&kml[hm], __float_as_uint(ss)); }
    { const int i = wave, dir = i >> 2; const float c = wave_scan(al[lane * 8 + i], lane, dir != 0);
      cuml[lane * 8 + i] = c; if (lane == (dir ? 0 : 63)) { tot[i] = c; p.cds[ch * 8 + i] = __expf(c); } }
    LDS_BARRIER();
    if (tid < 8) atomicMax(p.kmax2 + (lat ? (row0 >> 13) : ((row0 - TLAT) >> 8)) * 8 + tid, kml[tid]);
    { const int tok = tid >> 3, i = tid & 7, row = row0 + tok; const float cmv = cuml[tid];
      wgt[tid] = __expf(tot[i] - cmv) * dtl[tid]; p.cumv[(size_t)row * 8 + i] = cmv; }
    LDS_BARRIER();
#pragma unroll
    for (int hb = 0; hb < 2; ++hb) {
        u32x4 n0[4], nm[4], np[4];
        if (hb == 0) {
#pragma unroll
            for (int q = 0; q < 4; ++q) { const bf16_t* pp = cbase + (wave + 8 * (4 + q)) * 8; n0[q] = *(const u32x4*)pp; nm[q] = *(const u32x4*)(pp + dm); np[q] = *(const u32x4*)(pp + dp); } }
#pragma unroll
        for (int q = 0; q < 4; ++q) { const int cg = wave + 8 * (hb * 4 + q), row = row0 + lane;
            float xm[8], x0[8], xp[8], o[8];
            unpack8(c0[q], x0); unpack8(cm[q], xm); unpack8(cp[q], xp);
            const float zm = spos > 0 ? 1.f : 0.f, zp = spos < slen - 1 ? 1.f : 0.f;
#pragma unroll
            for (int e = 0; e < 8; ++e) { const int c = cg * 8 + e; o[e] = siluf(cwl[c] + cwl[512 + c] * (xm[e] * zm) + cwl[1024 + c] * x0[e] + cwl[1536 + c] * (xp[e] * zp)); }
            const u32x4 pk = pack8(o);
            *(u32x4*)(p.xbcs + (size_t)row * 512 + cg * 8) = pk;
            if (cg < 32) { float ob[8]; unpack8(pk, ob); const float wf = wgt[lane * 8 + (cg >> 3)], wb = wgt[lane * 8 + 4 + (cg >> 3)];
#pragma unroll
                for (int e = 0; e < 8; ++e) { XwT[(cg * 8 + e) * 72 + lane] = (bf16_t)f2bf(ob[e] * wf); XwT[(256 + cg * 8 + e) * 72 + lane] = (bf16_t)f2bf(ob[e] * wb); } }
            else if (cg < 48) { const unsigned wv[4] = {pk.x, pk.y, pk.z, pk.w};
#pragma unroll
                for (int e = 0; e < 8; ++e) BT[((cg - 32) * 8 + e) * 72 + lane] = (bf16_t)((wv[e >> 1] >> ((e & 1) * 16)) & 0xffffu); } }
        if (hb == 0) {
#pragma unroll
            for (int q = 0; q < 4; ++q) { c0[q] = n0[q]; cm[q] = nm[q]; cp[q] = np[q]; } }
    }
    LDS_BARRIER();
#pragma unroll 1
    for (int q = 0; q < 4; ++q) {
        const int t = wave * 4 + q, dir = t >> 4, hh = (t >> 2) & 3, pt = (t >> 1) & 1, nt = t & 1;
        f32x16 acc = {};
        acc = mma32<64>(XwT + (dir * 256 + hh * 64 + pt * 32) * 72, 72, BT + ((hh >> 1) * 64 + nt * 32) * 72, 72, acc, r32, hi);
        bf16_t* dst = p.ssd_st + ((size_t)(ch * 2 + dir) * 4 + hh) * 4096 + nt * 32 + r32;
#pragma unroll
        for (int r = 0; r < 16; ++r) dst[(pt * 32 + crow(r, hi)) * 64] = (bf16_t)f2bf(acc[r]);
    }
    LDS_BARRIER();
    }
    if (sect & 12) {
    float* gkd = (float*)lds; float* bendl = (float*)(lds + 33792); bf16_t* KeT = (bf16_t*)(lds + 34816); bf16_t* VT = (bf16_t*)(lds + 71680);
    u32x4 vpk[4], kpk[2], cd[2][2];
    const bf16_t* rowp = p.proj + (size_t)(row0 + lane) * INWP;
#pragma unroll
    for (int it = 0; it < 4; ++it) vpk[it] = *(const u32x4*)(rowp + C_GV + (wave + 8 * it) * 8);
#pragma unroll
    for (int it = 0; it < 2; ++it) kpk[it] = *(const u32x4*)(rowp + C_GK + (wave + 8 * it) * 8);
    { const bf16_t* cpp = p.proj + (size_t)(row0 + (tid >> 3)) * INWP + C_CODE;
#pragma unroll
      for (int d = 0; d < 2; ++d) { cd[d][0] = *(const u32x4*)(cpp + d * 16); cd[d][1] = *(const u32x4*)(cpp + d * 16 + 8); } }
#pragma unroll
    for (int it = 0; it < 4; ++it) { const int vg = wave + 8 * it; const unsigned wv[4] = {vpk[it].x, vpk[it].y, vpk[it].z, vpk[it].w};
#pragma unroll
        for (int e = 0; e < 8; ++e) VT[(vg * 8 + e) * 72 + lane] = (bf16_t)((wv[e >> 1] >> ((e & 1) * 16)) & 0xffffu); }
    float* upl = (float*)(lds + 108544); float* gbl = upl + 4096;
    { *(f32x4*)(upl + tid * 4) = *(const f32x4*)(p.gkup + tid * 4); *(f32x4*)(upl + 2048 + tid * 4) = *(const f32x4*)(p.gkup + 2048 + tid * 4);
      if (tid < 64) *(f32x4*)(gbl + tid * 4) = *(const f32x4*)(p.gkb + tid * 4); }
    LDS_BARRIER();
#pragma unroll
    for (int dir = 0; dir < 2; ++dir) {
        if (!(sect & (4 << dir))) continue;
        { const int tok = tid >> 3, s8 = tid & 7, c0 = s8 * 16;
          float code[16]; { float t8[8]; unpack8(cd[dir][0], t8);
#pragma unroll
              for (int e = 0; e < 8; ++e) code[e] = t8[e];
              unpack8(cd[dir][1], t8);
#pragma unroll
              for (int e = 0; e < 8; ++e) code[8 + e] = t8[e]; }
          const float* up = upl + dir * 16 * 128 + c0; const float* gb = gbl + dir * 128 + c0;
#pragma unroll 1
          for (int q = 0; q < 4; ++q) { f32x4 a = *(const f32x4*)(gb + 4 * q); f32x4 w[16];
#pragma unroll
              for (int r = 0; r < 16; ++r) w[r] = *(const f32x4*)(up + r * 128 + 4 * q);
              __builtin_amdgcn_sched_barrier(0);
#pragma unroll
              for (int r = 0; r < 16; ++r) a += w[r] * code[r];
              f32x4 o; o.x = logsigmoidf(a.x) * 0.0625f; o.y = logsigmoidf(a.y) * 0.0625f; o.z = logsigmoidf(a.z) * 0.0625f; o.w = logsigmoidf(a.w) * 0.0625f;
              *(f32x4*)(gkd + tok * 132 + c0 + 4 * q) = o; } }
        LDS_BARRIER();
#pragma unroll 4
        for (int q = 0; q < 16; ++q) { const int c = wave * 16 + q; const float acc = wave_scan(gkd[lane * 132 + c], lane, dir != 0);
            gkd[lane * 132 + c] = acc; if (lane == (dir ? 0 : 63)) { bendl[c] = acc; p.cdg[ch * 256 + dir * 128 + c] = __expf(acc); } }
        LDS_BARRIER();
        for (int it = 0; it < 4; ++it) { const int idx = tid + 512 * it, tok = idx >> 5, q4 = idx & 31;
            *(f32x4*)(p.gkv + (size_t)(row0 + tok) * 256 + dir * 128 + q4 * 4) = *(const f32x4*)(gkd + tok * 132 + q4 * 4); }
#pragma unroll
        for (int it = 0; it < 2; ++it) { const int kg = wave + 8 * it;
            float kv[8]; unpack8(kpk[it], kv);
            const f32x4 b0 = *(const f32x4*)(gkd + lane * 132 + kg * 8), b1 = *(const f32x4*)(gkd + lane * 132 + kg * 8 + 4);
            const f32x4 e0 = *(const f32x4*)(bendl + kg * 8), e1 = *(const f32x4*)(bendl + kg * 8 + 4);
            const float bb[8] = {b0.x, b0.y, b0.z, b0.w, b1.x, b1.y, b1.z, b1.w}, be[8] = {e0.x, e0.y, e0.z, e0.w, e1.x, e1.y, e1.z, e1.w};
#pragma unroll
            for (int e = 0; e < 8; ++e) KeT[(dir * 128 + kg * 8 + e) * 72 + lane] = (bf16_t)f2bf(kv[e] * __expf(be[e] - bb[e])); }
        LDS_BARRIER();
    }
#pragma unroll 1
    for (int q = 0; q < 2; ++q) {
        const int t = wave * 2 + q, dir = t >> 3, hh = (t >> 1) & 3, vt = t & 1;
        if (!(sect & (4 << dir))) continue;
        f32x16 acc = {};
        acc = mma32<64>(VT + (hh * 64 + vt * 32) * 72, 72, KeT + (dir * 128 + hh * 32) * 72, 72, acc, r32, hi);
        bf16_t* dst = p.gla_st + ((size_t)(ch * 2 + dir) * 4 + hh) * 2048 + r32;
#pragma unroll
        for (int r = 0; r < 16; ++r) dst[(vt * 32 + crow(r, hi)) * 32] = (bf16_t)f2bf(acc[r]);
    }
    LDS_BARRIER();
    }
}

__device__ __forceinline__ void scan_phase(const P& p, int bx) {
    const int tid = fresh_tid();
    if (tid >= 384) return;
    const int e0 = bx * 384 + tid; const bool ssd = e0 < 65536; const int e = ssd ? e0 : e0 - 65536;
    const int b = ssd ? e >> 15 : e >> 14, dir = ssd ? (e >> 14) & 1 : (e >> 13) & 1, hh = ssd ? (e >> 12) & 3 : (e >> 11) & 3, el = ssd ? e & 4095 : e & 2047;
    const bf16_t* st = ssd ? p.ssd_st : p.gla_st; bf16_t* ho = ssd ? p.hins : p.hing; const int esz = ssd ? 4096 : 2048;
    const float* dcp = ssd ? p.cds + dir * 4 + hh : p.cdg + dir * 128 + hh * 32 + (el & 31); const int dst = ssd ? 8 : 256;
    float hst = 0.f;
#pragma unroll 1
    for (int kb = 0; kb < 132; kb += 22) {
        float sv[22], dv[22]; int ci[22];
#pragma unroll
        for (int u = 0; u < 22; ++u) { const int k = kb + u; ci[u] = k < 4 ? 256 + 4 * b + (dir ? 3 - k : k) : 128 * b + (dir ? 127 - (k - 4) : (k - 4));
            sv[u] = bf2f(st[((size_t)(ci[u] * 2 + dir) * 4 + hh) * esz + el]); dv[u] = dcp[ci[u] * dst]; }
#pragma unroll
        for (int u = 0; u < 22; ++u) { ho[((size_t)(ci[u] * 2 + dir) * 4 + hh) * esz + el] = (bf16_t)f2bf(hst); hst = hst * dv[u] + sv[u]; }
    }
}

__device__ __forceinline__ void finish_chunk(const P& p, int ch, unsigned char* lds, int sect) {
    const int tid = fresh_tid(), lane = tid & 63, wave = __builtin_amdgcn_readfirstlane(tid >> 6), r32 = lane & 31, hi = lane >> 5;
    const int row0 = ch * 64;
    float* cml = (float*)lds; float* dtl = cml + 512; float* psum = dtl + 512;
    const float cm0_ = p.cumv[(size_t)row0 * 8 + tid], dt0_ = p.dtv[(size_t)row0 * 8 + tid]; bool first_ = true;
    bf16_t* Cn = (bf16_t*)(lds + 8192); bf16_t* Bn = (bf16_t*)(lds + 17408); bf16_t* XT = (bf16_t*)(lds + 26624); bf16_t* Mb = (bf16_t*)(lds + 45056); bf16_t* hin = (bf16_t*)(lds + 63488); bf16_t* Zs = (bf16_t*)(lds + 100352);
    const int hl = wave >> 2, rt = (wave >> 1) & 1, ct = wave & 1;
#pragma unroll 1
    for (int g = 0; g < 2; ++g) {
        if (!(sect & (1 << g))) continue;
        { u32x4 sA[2], sZ[2], sX[2], sH[4];
#pragma unroll
          for (int it = 0; it < 2; ++it) { const int idx = tid + 512 * it, arr = idx >> 9, r = idx & 511, tok = r >> 3, pc = r & 7;
              sA[it] = *(const u32x4*)(p.xbcs + (size_t)(row0 + tok) * 512 + (arr ? 384 : 256) + g * 64 + pc * 8); }
#pragma unroll
          for (int it = 0; it < 2; ++it) { const int idx = tid + 512 * it, tok = idx >> 4, pc = idx & 15;
              sZ[it] = *(const u32x4*)(p.proj + (size_t)(row0 + tok) * INWP + C_Z + g * 128 + pc * 8); }
#pragma unroll
          for (int it = 0; it < 2; ++it) { const int idx = tid + 512 * it, tok = idx & 63, cg = idx >> 6;
              sX[it] = *(const u32x4*)(p.xbcs + (size_t)(row0 + tok) * 512 + g * 128 + cg * 8); }
#pragma unroll
          for (int it = 0; it < 4; ++it) { const int idx = tid + 512 * it, dq = idx >> 9, r = idx & 511, pp = r >> 3, q8 = r & 7;
              sH[it] = *(const u32x4*)(p.hins + ((size_t)(ch * 2 + (dq >> 1)) * 4 + 2 * g + (dq & 1)) * 4096 + pp * 64 + q8 * 8); }
          __builtin_amdgcn_sched_barrier(0);
          if (first_) { cml[tid] = cm0_; dtl[tid] = dt0_; first_ = false; }
#pragma unroll
          for (int it = 0; it < 2; ++it) { const int idx = tid + 512 * it, arr = idx >> 9, r = idx & 511, tok = r >> 3, pc = r & 7;
              *(u32x4*)((arr ? Cn : Bn) + tok * 72 + pc * 8) = sA[it]; }
#pragma unroll
          for (int it = 0; it < 2; ++it) { const int idx = tid + 512 * it, tok = idx >> 4, pc = idx & 15;
              *(u32x4*)(Zs + tok * 136 + pc * 8) = sZ[it]; }
#pragma unroll
          for (int it = 0; it < 2; ++it) { const int idx = tid + 512 * it, tok = idx & 63, cg = idx >> 6;
              const u32x4 pk = sX[it]; const unsigned wv[4] = {pk.x, pk.y, pk.z, pk.w};
#pragma unroll
              for (int e = 0; e < 8; ++e) XT[(cg * 8 + e) * 72 + tok] = (bf16_t)((wv[e >> 1] >> ((e & 1) * 16)) & 0xffffu); }
#pragma unroll
          for (int it = 0; it < 4; ++it) { const int idx = tid + 512 * it, dq = idx >> 9, r = idx & 511, pp = r >> 3, q8 = r & 7;
              *(u32x4*)(hin + (dq * 64 + pp) * 72 + q8 * 8) = sH[it]; } }
        LDS_BARRIER();
        const int hh = 2 * g + hl;
        { f32x16 acc = {}; acc = mma32<64>(Cn + rt * 32 * 72, 72, Bn + ct * 32 * 72, 72, acc, r32, hi);
          const int j = ct * 32 + r32; const float cfj = cml[j * 8 + hh], cbj = cml[j * 8 + 4 + hh], dfj = dtl[j * 8 + hh], dbj = dtl[j * 8 + 4 + hh];
#pragma unroll
          for (int r = 0; r < 16; ++r) { const int i = rt * 32 + crow(r, hi); const float cfi = cml[i * 8 + hh], cbi = cml[i * 8 + 4 + hh];
              const float lf = (j <= i) ? __expf(cfi - cfj) * dfj : 0.f, lb = (j >= i) ? __expf(cbi - cbj) * dbj : 0.f;
              Mb[(hl * 64 + i) * 72 + j] = (bf16_t)f2bf(acc[r] * (lf + lb)); } }
        LDS_BARRIER();
        { const int c = hh * 64 + ct * 32 + r32; const float dsk = p.ssdd[hh], wn = p.ssdnw[c];
          f32x16 y;
          { f32x16 t = {}; t = mma32<64>(Cn + rt * 32 * 72, 72, hin + ((0 * 2 + hl) * 64 + ct * 32) * 72, 72, t, r32, hi);
#pragma unroll
            for (int r = 0; r < 16; ++r) y[r] = __expf(cml[(rt * 32 + crow(r, hi)) * 8 + hh]) * t[r]; }
          { f32x16 t = {}; t = mma32<64>(Cn + rt * 32 * 72, 72, hin + ((1 * 2 + hl) * 64 + ct * 32) * 72, 72, t, r32, hi);
#pragma unroll
            for (int r = 0; r < 16; ++r) y[r] += __expf(cml[(rt * 32 + crow(r, hi)) * 8 + 4 + hh]) * t[r]; }
          y = mma32<64>(Mb + (hl * 64 + rt * 32) * 72, 72, XT + (hl * 64 + ct * 32) * 72, 72, y, r32, hi);
          const bf16_t* xcol = XT + (hl * 64 + ct * 32 + r32) * 72;
          bf16_t* zcol = Zs + hl * 64 + ct * 32 + r32;
#pragma unroll
          for (int r = 0; r < 16; ++r) { const int i = rt * 32 + crow(r, hi);
              y[r] = (y[r] + dsk * bf2f(xcol[i])) * siluf(bf2f(zcol[i * 136]));
              const float s = sum32(y[r] * y[r]); if (r32 == 0) psum[i * 8 + hl * 2 + ct] = s; }
          LDS_BARRIER();
#pragma unroll
          for (int r = 0; r < 16; ++r) { const int i = rt * 32 + crow(r, hi);
              const float rn = rsqrtf(((psum[i * 8] + psum[i * 8 + 1]) + (psum[i * 8 + 2] + psum[i * 8 + 3])) * (1.0f / 128.0f) + EPS);
              zcol[i * 136] = (bf16_t)f2bf(y[r] * rn * wn); } }
        LDS_BARRIER();
        for (int it = 0; it < 2; ++it) { const int idx = tid + 512 * it, tok = idx >> 4, pc = idx & 15;
            *(u32x4*)(p.mix + (size_t)(row0 + tok) * DM + 512 + g * 128 + pc * 8) = *(const u32x4*)(Zs + tok * 136 + pc * 8); }
        LDS_BARRIER();
    }
    float* bfl = (float*)lds; bf16_t* att = (bf16_t*)lds; float* psg = (float*)(lds + 34816);
    bf16_t* Qf = (bf16_t*)(lds + 36864); bf16_t* Kf = (bf16_t*)(lds + 57344); bf16_t* VTg = (bf16_t*)(lds + 77824); bf16_t* hing = (bf16_t*)(lds + 96256);
#pragma unroll 1
    for (int hp = 0; hp < 2; ++hp) {
        if (!(sect & (4 << hp))) continue;
        u32x4 qk4[4];
        { f32x4 sB[4]; u32x4 sV[2], sH[2];
#pragma unroll
          for (int it = 0; it < 4; ++it) { const int idx = tid + 512 * it, tok = idx >> 5, r = idx & 31, dir = r >> 4, q4 = r & 15;
              sB[it] = *(const f32x4*)(p.gkv + (size_t)(row0 + tok) * 256 + dir * 128 + hp * 64 + q4 * 4); }
#pragma unroll
          for (int it = 0; it < 2; ++it) { const int idx = tid + 512 * it, tok = idx & 63, vg = idx >> 6;
              sV[it] = *(const u32x4*)(p.proj + (size_t)(row0 + tok) * INWP + C_GV + hp * 128 + vg * 8); }
#pragma unroll
          for (int it = 0; it < 2; ++it) { const int idx = tid + 512 * it, dq = idx >> 8, r = idx & 255, vv = r >> 2, q8 = r & 3;
              sH[it] = *(const u32x4*)(p.hing + ((size_t)(ch * 2 + (dq >> 1)) * 4 + 2 * hp + (dq & 1)) * 2048 + vv * 32 + q8 * 8); }
          { const int tok = tid >> 3, s_ = tid & 7, h2 = (s_ >> 1) & 1, half = s_ & 1; const size_t row = (size_t)(row0 + tok); const int hcol = (2 * hp + h2) * 32 + half * 16;
            qk4[0] = *(const u32x4*)(p.proj + row * INWP + C_GQ + hcol); qk4[1] = *(const u32x4*)(p.proj + row * INWP + C_GQ + hcol + 8);
            qk4[2] = *(const u32x4*)(p.proj + row * INWP + C_GK + hcol); qk4[3] = *(const u32x4*)(p.proj + row * INWP + C_GK + hcol + 8); }
          __builtin_amdgcn_sched_barrier(0);
#pragma unroll
          for (int it = 0; it < 4; ++it) { const int idx = tid + 512 * it, tok = idx >> 5, r = idx & 31, dir = r >> 4, q4 = r & 15;
              *(f32x4*)(bfl + tok * 132 + dir * 64 + q4 * 4) = sB[it]; }
#pragma unroll
          for (int it = 0; it < 2; ++it) { const int idx = tid + 512 * it, tok = idx & 63, vg = idx >> 6;
              const u32x4 pk = sV[it]; const unsigned wv[4] = {pk.x, pk.y, pk.z, pk.w};
#pragma unroll
              for (int e = 0; e < 8; ++e) VTg[(vg * 8 + e) * 72 + tok] = (bf16_t)((wv[e >> 1] >> ((e & 1) * 16)) & 0xffffu); }
#pragma unroll
          for (int it = 0; it < 2; ++it) { const int idx = tid + 512 * it, dq = idx >> 8, r = idx & 255, vv = r >> 2, q8 = r & 3;
              *(u32x4*)(hing + (dq * 64 + vv) * 40 + q8 * 8) = sH[it]; } }
        LDS_BARRIER();
        { const int tok = tid >> 3, s = tid & 7, dir = s >> 2, h2 = (s >> 1) & 1, half = s & 1;
          float qv[16], kv[16];
          { float t8[8]; unpack8(qk4[0], t8);
#pragma unroll
            for (int e = 0; e < 8; ++e) qv[e] = t8[e];
            unpack8(qk4[1], t8);
#pragma unroll
            for (int e = 0; e < 8; ++e) qv[8 + e] = t8[e];
            unpack8(qk4[2], t8);
#pragma unroll
            for (int e = 0; e < 8; ++e) kv[e] = t8[e];
            unpack8(qk4[3], t8);
#pragma unroll
            for (int e = 0; e < 8; ++e) kv[8 + e] = t8[e]; }
          const float* bp = bfl + tok * 132 + dir * 64 + h2 * 32 + half * 16;
          float oq[16], ok[16];
#pragma unroll
          for (int q = 0; q < 4; ++q) { const f32x4 bv = *(const f32x4*)(bp + 4 * q); const float bb[4] = {bv.x, bv.y, bv.z, bv.w};
#pragma unroll
              for (int e = 0; e < 4; ++e) { const float ex = __expf(bb[e]), exi = __expf(-bb[e]); oq[q * 4 + e] = qv[q * 4 + e] * ex * 0.17677669529663687f; ok[q * 4 + e] = kv[q * 4 + e] * exi; } }
          bf16_t* qd = Qf + ((dir * 2 + h2) * 64 + tok) * 40 + half * 16; bf16_t* kd = Kf + ((dir * 2 + h2) * 64 + tok) * 40 + half * 16;
          u32x4 w; w.x = pk2(oq[0], oq[1]); w.y = pk2(oq[2], oq[3]); w.z = pk2(oq[4], oq[5]); w.w = pk2(oq[6], oq[7]); *(u32x4*)qd = w;
          w.x = pk2(oq[8], oq[9]); w.y = pk2(oq[10], oq[11]); w.z = pk2(oq[12], oq[13]); w.w = pk2(oq[14], oq[15]); *(u32x4*)(qd + 8) = w;
          w.x = pk2(ok[0], ok[1]); w.y = pk2(ok[2], ok[3]); w.z = pk2(ok[4], ok[5]); w.w = pk2(ok[6], ok[7]); *(u32x4*)kd = w;
          w.x = pk2(ok[8], ok[9]); w.y = pk2(ok[10], ok[11]); w.z = pk2(ok[12], ok[13]); w.w = pk2(ok[14], ok[15]); *(u32x4*)(kd + 8) = w; }
        LDS_BARRIER();
        { f32x16 af = {}, ab = {};
          af = mma32<32>(Qf + ((0 * 2 + hl) * 64 + rt * 32) * 40, 40, Kf + ((0 * 2 + hl) * 64 + ct * 32) * 40, 40, af, r32, hi);
          ab = mma32<32>(Qf + ((1 * 2 + hl) * 64 + rt * 32) * 40, 40, Kf + ((1 * 2 + hl) * 64 + ct * 32) * 40, 40, ab, r32, hi);
          const int j = ct * 32 + r32;
#pragma unroll
          for (int r = 0; r < 16; ++r) { const int i = rt * 32 + crow(r, hi);
              att[(hl * 64 + i) * 72 + j] = (bf16_t)f2bf(((j <= i) ? af[r] : 0.f) + ((j >= i) ? ab[r] : 0.f)); } }
        LDS_BARRIER();
        { f32x16 acc = {};
          bf16_t ggr[16];
          { const int c_ = (2 * hp + hl) * 64 + ct * 32 + r32;
#pragma unroll
            for (int r = 0; r < 16; ++r) ggr[r] = p.proj[(size_t)(row0 + rt * 32 + crow(r, hi)) * INWP + C_GG + c_]; }
          acc = mma32<64>(att + (hl * 64 + rt * 32) * 72, 72, VTg + (hl * 64 + ct * 32) * 72, 72, acc, r32, hi);
          acc = mma32<32>(Qf + ((0 * 2 + hl) * 64 + rt * 32) * 40, 40, hing + ((0 * 2 + hl) * 64 + ct * 32) * 40, 40, acc, r32, hi);
          acc = mma32<32>(Qf + ((1 * 2 + hl) * 64 + rt * 32) * 40, 40, hing + ((1 * 2 + hl) * 64 + ct * 32) * 40, 40, acc, r32, hi);
          const int hh = 2 * hp + hl, v = ct * 32 + r32, c = hh * 64 + v; const float wn = p.glanw[v];
#pragma unroll
          for (int r = 0; r < 16; ++r) { const int i = rt * 32 + crow(r, hi); const float s = sum32(acc[r] * acc[r]); if (r32 == 0) psg[i * 4 + hl * 2 + ct] = s; }
          LDS_BARRIER();
#pragma unroll
          for (int r = 0; r < 16; ++r) { const int i = rt * 32 + crow(r, hi); const size_t row = (size_t)(row0 + i);
              const float rn = rsqrtf((psg[i * 4 + hl * 2] + psg[i * 4 + hl * 2 + 1]) * (1.0f / 64.0f) + EPS);
              const float gg = bf2f(ggr[r]);
              p.mix[row * DM + 768 + c] = (bf16_t)f2bf(acc[r] * rn * wn * siluf(gg)); } }
        LDS_BARRIER();
    }
}
}

#define XB_TMO      128
#define XB_XCNT(j)  (256  + 64 * (j))
#define XB_XSUB(j)  (1280 + 64 * (j))
#define XB_XGEN(j)  (2304 + 64 * (j))
#define XB_TOP      3328
#define XB_TOPGEN   3392
#define XCD_BAR_WORDS 3456
#define XB_SPIN_CAP (1u << 20)
__device__ __forceinline__ unsigned xb_ld(unsigned* p)              { return __hip_atomic_load(p, __ATOMIC_RELAXED, __HIP_MEMORY_SCOPE_AGENT); }
__device__ __forceinline__ unsigned xb_add(unsigned* p, unsigned v) { return __hip_atomic_fetch_add(p, v, __ATOMIC_RELAXED, __HIP_MEMORY_SCOPE_AGENT); }
__device__ __forceinline__ unsigned xb_xcc_id() { return (unsigned)__builtin_amdgcn_s_getreg((3 << 11) | 20) & 0xFu; }
#define XB_SPIN(cond, bar) do { unsigned _sp = 0; while (cond) { __builtin_amdgcn_s_sleep(1); \
    if ((++_sp & 255u) == 0u) { if (xb_ld(&(bar)[XB_TMO])) break; if (_sp > XB_SPIN_CAP) { atomicAdd(&(bar)[XB_TMO], 1u); break; } } } } while (0)
struct XcdBarrier { unsigned* bar; unsigned x; volatile LAS unsigned* st; };
__device__ __forceinline__ XcdBarrier xcd_barrier_post(unsigned* bar, volatile LAS unsigned* st) {
    XcdBarrier b; b.bar = bar; b.x = xb_xcc_id(); b.st = st;
    if (threadIdx.x == 0) (void)xb_add(&bar[XB_XCNT(b.x)], 1u);
    return b;
}
__device__ __forceinline__ void xcd_barrier_complete(unsigned* bar, unsigned x, unsigned& nloc, unsigned& nx) {
    const unsigned G = gridDim.x * gridDim.y * gridDim.z;
    unsigned sum, cnt, mine, sp = 0u;
    for (;;) {
        sum = 0u; cnt = 0u; mine = 0u;
#pragma unroll
        for (unsigned j = 0; j < 16; ++j) { const unsigned c = xb_ld(&bar[XB_XCNT(j)]); sum += c; cnt += (c > 0u) ? 1u : 0u; mine = (j == x) ? c : mine; }
        if (sum == G) break;
        __builtin_amdgcn_s_sleep(1);
        if ((++sp & 255u) == 0u) { if (xb_ld(&bar[XB_TMO])) break; if (sp > XB_SPIN_CAP) { atomicAdd(&bar[XB_TMO], 1u); break; } }
    }
    nloc = mine > 0u ? mine : 1u; nx = cnt > 0u ? cnt : 1u;
}
__device__ __forceinline__ void xcd_barrier(const XcdBarrier& b) {
    asm volatile("s_waitcnt vmcnt(0)" ::: "memory");
    __syncthreads();
    if (threadIdx.x == 0) {
        GAS unsigned* barg_ = (GAS unsigned*)b.bar; asm volatile("" : "+s"(barg_)); unsigned* bar = (unsigned*)barg_;
        __builtin_amdgcn_s_waitcnt(0);
        unsigned nloc = b.st[0], nx = b.st[1];
        if (nloc == 0u) { xcd_barrier_complete(bar, b.x, nloc, nx); b.st[0] = nloc; b.st[1] = nx; }
        const unsigned old = xb_add(&bar[XB_XSUB(b.x)], 1u);
        const unsigned gen = old / nloc;
        if (old + 1u == (gen + 1u) * nloc) {
            __builtin_amdgcn_fence(__ATOMIC_RELEASE, "agent");
            asm volatile("s_waitcnt vmcnt(0)" ::: "memory");
            const unsigned og = xb_add(&bar[XB_TOP], 1u);
            const unsigned tg = og / nx;
            if (og + 1u == (tg + 1u) * nx) xb_add(&bar[XB_TOPGEN], 1u);
            else XB_SPIN(xb_ld(&bar[XB_TOPGEN]) == tg, bar);
            __builtin_amdgcn_fence(__ATOMIC_ACQUIRE, "agent");
            xb_add(&bar[XB_XGEN(b.x)], 1u);
            asm volatile("s_waitcnt vmcnt(0)" ::: "memory");
        } else {
            XB_SPIN(xb_ld(&bar[XB_XGEN(b.x)]) == gen, bar);
            __builtin_amdgcn_fence(__ATOMIC_ACQUIRE, "agent");
            asm volatile("s_waitcnt vmcnt(0)" ::: "memory");
        }
    }
    __syncthreads();
}

struct Args { const float* in[28]; float* out; unsigned char* ws; int ph_lo, ph_hi; };
enum { I_X = 0, I_C, I_CTX, I_CCTX, I_WADA, I_BADA, I_N1W, I_WIN, I_DALAM, I_SUBW, I_CONVW, I_CONVB, I_ALOG, I_DTB, I_SSDD, I_SSDNW, I_GKUP, I_GKB, I_GLANW, I_WOUT, I_N2W,
       I_WR, I_BR, I_WGU, I_BGU, I_WDN, I_BDN, I_FNW };

__device__ __forceinline__ void transpose_item(const float* __restrict__ W, int K, int Nsrc, bf16_t* __restrict__ WT, int n0, int dst_row0, int k0, unsigned* scr, int lane) {
    const bool ok = (n0 + lane) < Nsrc; const float* src = W + (size_t)k0 * Nsrc + n0 + lane;
#pragma unroll
    for (int hb = 0; hb < 2; ++hb) { float v[32];
#pragma unroll
        for (int i = 0; i < 32; ++i) v[i] = ok ? __builtin_nontemporal_load(src + (size_t)(hb * 32 + i) * Nsrc) : 0.f;
#pragma unroll
        for (int i = 0; i < 16; ++i) scr[lane * 33 + hb * 16 + i] = pk2(v[2 * i], v[2 * i + 1]); }
    LDS_WAIT();
    const int c = lane & 7;
#pragma unroll
    for (int j = 0; j < 8; ++j) { const int nn = (lane >> 3) + 8 * j; const unsigned* t = scr + nn * 33 + 4 * c;
        u32x4 o; o.x = t[0]; o.y = t[1]; o.z = t[2]; o.w = t[3];
        __builtin_nontemporal_store(o, (u32x4*)(WT + (size_t)(dst_row0 + nn) * K + k0 + 8 * c)); }
    LDS_WAIT();
}

__device__ __forceinline__ void norm_mod_store(const f32x4 (&v)[4], const float* __restrict__ nw, const float* __restrict__ sh, const float* __restrict__ sc, bf16_t* __restrict__ orow, int lane) {
    float ss = 0.f;
#pragma unroll
    for (int j = 0; j < 4; ++j) ss += (v[j].x * v[j].x + v[j].y * v[j].y) + (v[j].z * v[j].z + v[j].w * v[j].w);
    const float r = rsqrtf(wave_sum(ss) * (1.0f / DM) + EPS);
#pragma unroll
    for (int j = 0; j < 4; ++j) { const int c = 4 * lane + 256 * j;
        const f32x4 w = *(const f32x4*)(nw + c), a = *(const f32x4*)(sc + c), b = *(const f32x4*)(sh + c);
        const f32x4 y = (v[j] * r) * w * (a + 1.0f) + b;
        u32x2 o; o.x = pk2(y.x, y.y); o.y = pk2(y.z, y.w); *(u32x2*)(orow + c) = o; }
}

__device__ __forceinline__ int moe_tables(const unsigned* cnt, int* tile_e, int* pstart, int* cntl) {
    const int t = fresh_tid();
    if (t < NE) { int c = (int)cnt[t]; if (c > LISTCAP) c = LISTCAP; cntl[t] = c; }
    __syncthreads();
    if (t <= NE) { int acc = 0; for (int e = 0; e < t; ++e) acc += ((cntl[e] + 255) >> 8) << 8; pstart[t] = acc;
        if (t < NE) { const int nt = (cntl[t] + 255) >> 8; for (int q = 0; q < nt; ++q) tile_e[(acc >> 8) + q] = t; } }
    __syncthreads();
    return __builtin_amdgcn_readfirstlane(pstart[NE] >> 8);
}

__device__ __forceinline__ const float* inp_ptr(const unsigned char* ldsl, int i) {
    const unsigned long long v = ((const unsigned long long*)(ldsl + PTAB_OFF))[i];
    const unsigned lo = __builtin_amdgcn_readfirstlane((unsigned)v), hi = __builtin_amdgcn_readfirstlane((unsigned)(v >> 32));
    return (const float*)(const GAS float*)(((unsigned long long)hi << 32) | lo);
}

__device__ __forceinline__ void titem_load(f32x4 (&v)[16], const float* mbase, unsigned off, int pitchB, int lane) {
    const __amdgpu_buffer_rsrc_t rs = __builtin_amdgcn_make_buffer_rsrc((void*)mbase, 0, 0x7fffffff, 0x00020000);
    const int vo = (lane >> 4) * 2 * pitchB + (lane & 15) * 16;
#pragma unroll
    for (int i = 0; i < 16; ++i) v[i] = __builtin_bit_cast(f32x4, __builtin_amdgcn_raw_buffer_load_b128(rs, vo, (int)off + ((i >> 1) * 8 + (i & 1)) * pitchB, 2));
}
__device__ __forceinline__ void titem_store(const f32x4 (&v)[16], bf16_t* __restrict__ dst, unsigned* scr, int lane) {
    { unsigned* wp = scr + (lane & 15) * 4 * 33 + (lane >> 4);
#pragma unroll
      for (int i = 0; i < 8; ++i)
#pragma unroll
          for (int nn = 0; nn < 4; ++nn) wp[nn * 33 + 4 * i] = pk2(v[2 * i][nn], v[2 * i + 1][nn]); }
    LDS_WAIT();
    const int c = lane & 7;
#pragma unroll
    for (int j = 0; j < 8; ++j) { const int nn = (lane >> 3) + 8 * j; const unsigned* t = scr + nn * 33 + 4 * c;
        u32x4 o; o.x = t[0]; o.y = t[1]; o.z = t[2]; o.w = t[3];
        __builtin_nontemporal_store(o, (u32x4*)(dst + (size_t)nn * DM + 8 * c)); }
    LDS_WAIT();
}
__device__ __forceinline__ void moe_item(int it, int l, const float* wgu, const float* wdn, bf16_t* bgu, bf16_t* bdn, const float*& mbase, unsigned& off, int& pitchB, bf16_t*& dst) {
    constexpr int I_GU = 16 * 32, I_DN = 16 * 16, N_GU = 32 * I_GU;
    if (it < N_GU) { const int e = it / I_GU, r = it % I_GU, kb = r / 32, n0 = (r % 32) * 64;
        const int drow = n0 < 1024 ? (n0 >> 7) * 256 + (n0 & 127) : ((n0 - 1024) >> 7) * 256 + 128 + ((n0 - 1024) & 127);
        mbase = wgu + (size_t)l * NE * DM * 2048; off = (unsigned)((e * DM + kb * 64) * 2048 + n0) * 4u; pitchB = 2048 * 4;
        dst = bgu + (size_t)(l * NE + e) * 2048 * DM + (size_t)drow * DM + kb * 64; }
    else { const int q = it - N_GU, e = q / I_DN, r = q % I_DN, kb = r / 16, n0 = (r % 16) * 64;
        mbase = wdn + (size_t)l * NE * DE * DM; off = (unsigned)((e * DE + kb * 64) * DM + n0) * 4u; pitchB = DM * 4;
        dst = bdn + (size_t)(l * NE + e) * DM * DE + (size_t)n0 * DE + kb * 64; }
}

__device__ __forceinline__ void ctx_outproj_block(const bf16_t* __restrict__ mixc, const bf16_t* __restrict__ wout, const float* __restrict__ base, bf16_t* __restrict__ out,
                                                  const float* __restrict__ gate, int blk, unsigned char* lds) {
    const int tid = fresh_tid(), lane = tid & 63, wave = __builtin_amdgcn_readfirstlane(tid >> 6), r32 = lane & 31, hi = lane >> 5;
    const int rb = blk >> 4, cb = blk & 15;
    const bf16_t* Ap = mixc + (size_t)(rb * 32 + r32) * DM + wave * 128 + 8 * hi;
    const bf16_t* Bp = wout + (size_t)(cb * 64 + r32) * DM + wave * 128 + 8 * hi;
    bf16x8 af[8], b0f[8], b1f[8];
#pragma unroll
    for (int ks = 0; ks < 8; ++ks) { af[ks] = *(const bf16x8*)(Ap + ks * 16); b0f[ks] = *(const bf16x8*)(Bp + ks * 16); b1f[ks] = *(const bf16x8*)(Bp + (size_t)32 * DM + ks * 16); }
    f32x16 a0 = {}, a1 = {};
#pragma unroll
    for (int ks = 0; ks < 8; ++ks) { a0 = __builtin_amdgcn_mfma_f32_32x32x16_bf16(af[ks], b0f[ks], a0, 0, 0, 0); a1 = __builtin_amdgcn_mfma_f32_32x32x16_bf16(af[ks], b1f[ks], a1, 0, 0, 0); }
    float* red = (float*)lds;
#pragma unroll
    for (int r = 0; r < 16; ++r) { red[((wave * 2 + 0) * 16 + r) * 64 + lane] = a0[r]; red[((wave * 2 + 1) * 16 + r) * 64 + lane] = a1[r]; }
    __syncthreads();
#pragma unroll
    for (int q = 0; q < 4; ++q) { const int idx = tid + 512 * q, t = idx >> 10, r = (idx >> 6) & 15, ln = idx & 63; float sum = 0.f;
#pragma unroll
        for (int w = 0; w < 8; ++w) sum += red[((w * 2 + t) * 16 + r) * 64 + ln];
        const int row = rb * 32 + (r & 3) + 8 * (r >> 2) + 4 * (ln >> 5), col = cb * 64 + t * 32 + (ln & 31);
        out[(size_t)row * DM + col] = (bf16_t)f2bf(base[(size_t)row * DM + col] + gate[col] * sum); }
    __syncthreads();
}

#ifndef GSPLIT
#define GSPLIT 144
#endif
constexpr int PH_PRO = 0, PH_NORM0 = 1, PH_L0 = 2, NPH_LAYER = 9, NPH = PH_L0 + NLAYER * NPH_LAYER;

__global__ void __launch_bounds__(NWAVES * 64, 2) fwd(Args args) {
    extern __shared__ __attribute__((aligned(16))) unsigned char lds[];
    const int G = gridDim.x, bx = blockIdx.x;
    const int vcu = (G % 8 == 0) ? (bx % 8) * (G / 8) + bx / 8 : bx;
    const int NGW = G * NWAVES;
#define PH_TID() const int tid = fresh_tid(), lane = tid & 63, wave = __builtin_amdgcn_readfirstlane(tid >> 6), gw = vcu * NWAVES + wave; (void)lane; (void)wave; (void)gw; \
    GAS unsigned char* wsg_ = (GAS unsigned char*)ws0; asm volatile("" : "+s"(wsg_)); unsigned char* ws = (unsigned char*)wsg_; \
    LAS const unsigned char* ldl_ = (LAS const unsigned char*)lds; asm volatile("" : "+v"(ldl_)); const unsigned char* ldsl = (const unsigned char*)ldl_
    unsigned char* const ws0 = args.ws;
#define G_ctl   ((unsigned*)(ws + WS_CTL))
#define G_modb  ((float*)(ws + WS_MOD))
#define G_ropet ((f32x2*)(ws + WS_ROPE))
#define G_scal  ((float*)(ws + WS_SCAL))
#define G_wb_in ((bf16_t*)(ws + WS_WIN))
#define G_wb_out ((bf16_t*)(ws + WS_WOUT))
#define G_wb_gu ((bf16_t*)(ws + WS_WGU))
#define G_wb_dn ((bf16_t*)(ws + WS_WDN))
#define G_hbuf  ((bf16_t*)(ws + WS_H))
#define G_proj  ((bf16_t*)(ws + WS_PROJ))
#define G_xbcs  ((bf16_t*)(ws + WS_XBC))
#define G_dtv   ((float*)(ws + WS_DT))
#define G_av    ((float*)(ws + WS_AV))
#define G_gkv   ((float*)(ws + WS_GKV))
#define G_ydir  ((bf16_t*)(ws + WS_YDIR))
#define G_odir  ((bf16_t*)(ws + WS_ODIR))
#define G_mix   ((bf16_t*)(ws + WS_MIX))
#define G_xw    ((bf16_t*)(ws + WS_XW))
#define G_list  ((int*)(ws + WS_LIST))
#define G_gatev ((float*)(ws + WS_GATE))
#define G_actb  ((bf16_t*)(ws + WS_ACT))
#define G_yk    ((bf16_t*)(ws + WS_YK))

    volatile LAS unsigned* MISC = (volatile LAS unsigned*)((LAS unsigned char*)lds + MISC_OFF);
    for (int u = threadIdx.x; u < 64; u += NWAVES * 64) MISC[u] = 0u;
    if (threadIdx.x < 28) ((const float**)(lds + PTAB_OFF))[threadIdx.x] = args.in[threadIdx.x];
#define INP(i) inp_ptr(ldsl, (i))
    __syncthreads();
    const int lo = args.ph_lo, hi = args.ph_hi;
    XcdBarrier bar; bar.bar = (unsigned*)(ws0 + WS_CTL) + CW_BAR; bar.x = 0; bar.st = nullptr;
    if (hi - lo > 1) bar = xcd_barrier_post((unsigned*)(ws0 + WS_CTL) + CW_BAR, MISC + 8);
#ifndef PH_MASK
#define PH_MASK 0xFFF
#endif
#define KIND(k) ((k) < PH_L0 ? (k) : 2 + ((k) - PH_L0) % NPH_LAYER)
#define IN(k) (lo <= (k) && (k) < hi)
#define INK(k, kind) (((PH_MASK >> (kind)) & 1) && IN(k))
#ifndef DUP_MASK
#define DUP_MASK 0
#endif
#define REPS(kind) for (int rep_ = 0; rep_ < 1 + ((DUP_MASK >> (kind)) & 1); ++rep_)
#ifndef BAR_REPS
#define BAR_REPS 1
#endif
#define SEAM(k) do { if (IN(k) && IN((k) + 1)) for (int br_ = 0; br_ < BAR_REPS; ++br_) xcd_barrier(bar); } while (0)

    if (INK(PH_PRO, 0)) REPS(0) { PH_TID();
        unsigned* scr = (unsigned*)(lds + RING_OFF + wave * 16384);
        constexpr int I_IN = 16 * 52, I_OUT = 16 * 16;
        constexpr int N_IN = 2 * I_IN, N_OUT = 2 * I_OUT, NITEMS = N_IN + N_OUT;
        for (int it = gw; it < NITEMS; it += NGW) {
            int r = it;
            if (r < N_IN) { const int l = r / I_IN; r %= I_IN; const int kb = r / 52, nb = r % 52;
                transpose_item(INP(I_WIN) + (size_t)l * DM * INW, DM, INW, G_wb_in + (size_t)l * INWP * DM, nb * 64, nb * 64, kb * 64, scr, lane); continue; }
            r -= N_IN;
            { const int l = r / I_OUT; r %= I_OUT; const int kb = r / 16, nb = r % 16;
                transpose_item(INP(I_WOUT) + (size_t)l * DM * DM, DM, DM, G_wb_out + (size_t)l * DM * DM, nb * 64, nb * 64, kb * 64, scr, lane); }
        }
        __syncthreads();
        for (int it = bx; it < 192; it += G) {
            const int l = it / 96, j0 = (it % 96) * 64;
            float* sc = (float*)(lds + RING_OFF);
            float* red = sc + 3072;
            for (int i = tid; i < 3072; i += 512) { const int v = i >> 10, k = i & 1023; const float cv = v < 2 ? INP(I_C)[v * DM + k] : INP(I_CCTX)[k]; sc[i] = siluf(cv); }
            __syncthreads();
            const int sub = lane >> 4, q = lane & 15, sl = (tid >> 6) * 4 + sub;
            f32x4 a0 = {0.f, 0.f, 0.f, 0.f}, a1 = a0, a2 = a0;
            const float* wp = INP(I_WADA) + (size_t)l * DM * 6144 + (size_t)((tid >> 6) * 128 + sub) * 6144 + j0 + 4 * q;
#pragma unroll 1
            for (int kb = 0; kb < 32; kb += 16) { f32x4 w[16];
#pragma unroll
                for (int i = 0; i < 16; ++i) w[i] = *(const f32x4*)(wp + (size_t)((kb + i) * 4) * 6144);
                __builtin_amdgcn_sched_barrier(0);
#pragma unroll
                for (int i = 0; i < 16; ++i) { const int k = (tid >> 6) * 128 + (kb + i) * 4 + sub; a0 += w[i] * sc[k]; a1 += w[i] * sc[1024 + k]; a2 += w[i] * sc[2048 + k]; } }
            *(f32x4*)(red + (sl * 3 + 0) * 64 + 4 * q) = a0; *(f32x4*)(red + (sl * 3 + 1) * 64 + 4 * q) = a1; *(f32x4*)(red + (sl * 3 + 2) * 64 + 4 * q) = a2;
            __syncthreads();
            if (tid < 192) { const int v = tid >> 6, jj = tid & 63; float s_ = INP(I_BADA)[l * 6144 + j0 + jj];
                for (int q2 = 0; q2 < 32; ++q2) s_ += red[(q2 * 3 + v) * 64 + jj];
                G_modb[(size_t)(l * 3 + v) * 6144 + j0 + jj] = s_; }
            __syncthreads();
        }
        if (tid < 256) { float* wrt = (float*)(ws + WS_WRT); const float* wr = INP(I_WR);
            for (int g = bx * 256 + tid; g < 2 * 32768; g += G * 256) { const int l = g >> 15, i = g & 32767; wrt[l * 32768 + (i & 31) * 1024 + (i >> 5)] = wr[g]; } }
        if (bx == (48 % G)) {
            for (int i = tid; i < 2048; i += 512) { const int pos = i >> 4, j = i & 15; const float inv = exp2f(-0.25f * (float)j * 3.3219280948873623f);
                const float ang = (float)pos * inv; G_ropet[i] = (f32x2){cosf(ang), sinf(ang)}; }
        }
        if (bx == (49 % G) && tid < NLAYER) {
            const float* lp = INP(I_DALAM) + tid * 256; float s01 = 0.f, s23 = 0.f;
            for (int i = 0; i < 64; ++i) { s01 += lp[i] * lp[64 + i]; s23 += lp[128 + i] * lp[192 + i]; }
            const float li = 0.8f - 0.6f * expf(-0.3f * (float)tid);
            G_scal[tid * 2 + 0] = expf(s01) - expf(s23) + li; G_scal[tid * 2 + 1] = 1.0f - li;
        }
    }
    SEAM(PH_PRO);
    if (INK(PH_NORM0, 1)) { PH_TID();
        for (int row = gw; row < TALL; row += NGW) {
            const int bidx = row < SEQ ? 0 : (row < TLAT ? 1 : 2);
            const float* xr = row < TLAT ? INP(I_X) + (size_t)row * DM : INP(I_CTX) + (size_t)(row - TLAT) * DM;
            f32x4 v[4];
#pragma unroll
            for (int j = 0; j < 4; ++j) v[j] = *(const f32x4*)(xr + 4 * lane + 256 * j);
            const float* mp = G_modb + (size_t)bidx * 6144;
            norm_mod_store(v, INP(I_N1W), mp, mp + 1024, G_hbuf + (size_t)row * DM, lane);
        }
    }
    SEAM(PH_NORM0);

    for (int l = 0; l < NLAYER; ++l) {
        const int P = PH_L0 + l * NPH_LAYER;
        const bool last = (l == NLAYER - 1);
#define modl (G_modb + (size_t)l * 3 * 6144)
        if (INK(P + 0, 2)) REPS(2) { PH_TID();
            int bxp = bx; asm volatile("" : "+s"(bxp));
            const bool split = G > GSPLIT; const int Gg = split ? GSPLIT : G;
            if (bxp < Gg) {
            pg8::Gemm g{G_hbuf, G_wb_in + (size_t)l * INWP * DM, TALL, INWP, DM, 0};
            pg8::StaticOrder S; S.init(TALL, INWP, Gg, bxp);
            pg8::EpiBf16 E{G_proj, INWP, (const float*)G_ropet, TLAT / 256};
            pg8::gemm_phase<pg8::EpiBf16, pg8::StaticOrder, true, true>((LAS unsigned char*)lds + RING_OFF, g, S, E);
            }
            if (bxp >= Gg || !split) {
                const int lane = fresh_tid() & 63;
                unsigned* scr = (unsigned*)(lds + RING_OFF + wave * 16384);
                constexpr int NIT = 32 * (16 * 32 + 16 * 16);
                const int ncw = (split ? G - GSPLIT : G) * NWAVES; int it = (split ? bxp - GSPLIT : bxp) * NWAVES + wave;
                const float* wgu = INP(I_WGU); const float* wdn = INP(I_WDN);
                if (it < NIT) {
                    f32x4 va[16], vb[16]; const float* mb; unsigned off; int pb; bf16_t* da; bf16_t* db;
                    moe_item(it, l, wgu, wdn, G_wb_gu, G_wb_dn, mb, off, pb, da); titem_load(va, mb, off, pb, lane);
                    for (;;) {
                        int nx = it + ncw;
                        moe_item(nx < NIT ? nx : NIT - 1, l, wgu, wdn, G_wb_gu, G_wb_dn, mb, off, pb, db); titem_load(vb, mb, off, pb, lane);
                        titem_store(va, da, scr, lane);
                        if (nx >= NIT) break;
                        it = nx; nx = it + ncw;
                        moe_item(nx < NIT ? nx : NIT - 1, l, wgu, wdn, G_wb_gu, G_wb_dn, mb, off, pb, da); titem_load(va, mb, off, pb, lane);
                        titem_store(vb, db, scr, lane);
                        if (nx >= NIT) break;
                        it = nx;
                    }
                }
            }
        }
        SEAM(P + 0);
#define CP_INIT()         ck::P cp; \
        cp.proj = G_proj; cp.xbcs = G_xbcs; cp.dtv = G_dtv; cp.cumv = G_av; cp.gkv = G_gkv; cp.ssd_st = G_ydir; cp.gla_st = G_odir; cp.cds = (float*)(ws + WS_CDS); cp.cdg = (float*)(ws + WS_CDG); cp.mix = G_mix; cp.ropet = G_ropet; \
        cp.convw = INP(I_CONVW) + l * 3 * 512; cp.convb = INP(I_CONVB) + l * 512; cp.dtb = INP(I_DTB) + l * 8; cp.alog = INP(I_ALOG) + l * 8; \
        cp.gkup = INP(I_GKUP) + (size_t)l * 2 * 16 * 128; cp.gkb = INP(I_GKB) + l * 2 * 128; cp.ssdd = INP(I_SSDD) + l * 4; cp.ssdnw = INP(I_SSDNW) + l * 256; cp.glanw = INP(I_GLANW) + l * 64; cp.kmax2 = G_ctl + CW_KMAX + l * 16; cp.hins = (bf16_t*)(ws + WS_HINS); cp.hing = (bf16_t*)(ws + WS_HING);
        if (INK(P + 1, 3)) REPS(3) { PH_TID(); CP_INIT();
            for (int ui = 0; ui < 2; ++ui) { int ch, sect;
                if (ui == 0) { if (bx >= TLAT / 64) continue; ch = bx; sect = 14; }
                else { if ((bx & 7) != 4 || (bx >> 3) >= 24) continue; const int u = bx >> 3; ch = TLAT / 64 + u / 3; sect = 2 << (u % 3); }
#ifndef PREP_DUP_SECT
#define PREP_DUP_SECT 15
#endif
                ck::prep_chunk(cp, ch, lds + RING_OFF, rep_ > 0 ? (sect & PREP_DUP_SECT) : sect, rep_ > 0); }
        }
        SEAM(P + 1);
        if (INK(P + 2, 4)) { PH_TID(); CP_INIT();
            for (int vb = bx; vb < 256; vb += G) ck::scan_phase(cp, vb);
        }
        SEAM(P + 2);
        if (INK(P + 3, 5)) REPS(5) { PH_TID(); CP_INIT();
            const float lam = __uint_as_float(__builtin_amdgcn_readfirstlane(__float_as_uint(G_scal[l * 2 + 0]))), osc = __uint_as_float(__builtin_amdgcn_readfirstlane(__float_as_uint(G_scal[l * 2 + 1])));
            const float* subw = INP(I_SUBW) + l * 128;
#ifndef ATT_DUP_PART
#define ATT_DUP_PART 3
#endif
#ifndef NO_ATT
            if (rep_ == 0 || (ATT_DUP_PART & 1)) for (int i = 0; i < 3; ++i) {
                int bh, qrow0, nkeys;
                if (i < 2) { bh = bx & 7; const int qb = i * 32 + (bx >> 3); qrow0 = (bh >> 2) * SEQ + qb * 128; nkeys = LCTX + SEQ; if ((bx >> 3) >= 32) continue; }
                else { if (last || (bx & 15) != 2 || (bx >> 4) >= 16) continue; const int u = bx >> 4; bh = u >> 1; qrow0 = TLAT + (bh >> 2) * LCTX + (u & 1) * 128; nkeys = LCTX; }
                att::attn_unit(G_proj, G_mix, subw, lam, osc, G_ctl + CW_KMAX + l * 16 + (bh >> 2) * 8, bh >> 2, bh & 3, qrow0, nkeys, (char*)lds + RING_OFF);
            }
#endif
#ifndef NO_FIN
            if (rep_ == 0 || (ATT_DUP_PART & 2)) for (int ui = 0; ui < 2; ++ui) { int ch, sect;
                if (ui == 0) { if (bx >= TLAT / 64) continue; ch = bx; sect = 15; }
                else { if (last || (bx & 7) != 4) continue; const int u = bx >> 3; ch = TLAT / 64 + (u >> 2); sect = 1 << (u & 3); }
                ck::finish_chunk(cp, ch, lds + RING_OFF, sect); }
#endif
        }
        SEAM(P + 3);
        if (INK(P + 4, 6)) REPS(6) { PH_TID();
            const int M = TLAT;
            pg8::Gemm g{G_mix, G_wb_out + (size_t)l * DM * DM, M, DM, DM, 0};
            pg8::StaticOrder S; S.init(M, DM, G, bx);
            pg8::EpiRes E{INP(I_X), INP(I_CTX), l == 0 ? (const bf16_t*)nullptr : (const bf16_t*)G_xw, G_xw, modl + 2 * 1024, 6144};
            pg8::gemm_phase<pg8::EpiRes, pg8::StaticOrder, true, true>((LAS unsigned char*)lds + RING_OFF, g, S, E);
            if (!last && bx < 256) ctx_outproj_block(G_mix + (size_t)TLAT * DM, G_wb_out + (size_t)l * DM * DM, INP(I_CTX), G_xw + (size_t)TLAT * DM, modl + 2 * 6144 + 2 * 1024, bx, lds + RING_OFF);
        }
        SEAM(P + 4);
        if (INK(P + 5, 7)) REPS(7) { PH_TID(); const bool dry = rep_ > 0;
            const int ntok = last ? TLAT : TALL, TPW = ntok / G;
            float* wT = (float*)(lds + RING_OFF);
            int* selE = (int*)(lds + RT_OFF); int* selP = selE + 272; int* lcnt = selP + 272; int* basep = lcnt + 32;
            { const float* wrt = (const float*)(ws + WS_WRT) + l * 32768;
              f32x4 wr_[16];
#pragma unroll
              for (int q = 0; q < 16; ++q) wr_[q] = *(const f32x4*)(wrt + 4 * (tid + 512 * q));
              __builtin_amdgcn_sched_barrier(0);
#pragma unroll
              for (int q = 0; q < 16; ++q) *(f32x4*)(wT + 4 * (tid + 512 * q)) = wr_[q]; }
            if (tid < 32 && !dry) lcnt[tid] = 0;
            __syncthreads();
            const int tok0 = bx * TPW;
            const float* n2w = INP(I_N2W) + l * DM;
            if (TPW * G == ntok && TPW <= 68 && (TPW & 1) == 0) {
            float* wsc = (float*)(lds + RT_OFF + 2560) + wave * 80;
            const float brl = INP(I_BR)[l * NE + (lane >> 1)];
            u32x2 rawn[2][4];
#pragma unroll
            for (int t = 0; t < 2; ++t)
#pragma unroll
                for (int j = 0; j < 4; ++j) rawn[t][j] = *(const u32x2*)(G_xw + (size_t)(tok0 + wave * 2 + t) * DM + 4 * lane + 256 * j);
            for (int tl = wave * 2; tl < TPW; tl += 2 * NWAVES) {
                const int row0 = tok0 + tl;
                f32x4 v[2][4]; float ss[2] = {0.f, 0.f};
#pragma unroll
                for (int t = 0; t < 2; ++t)
#pragma unroll
                    for (int j = 0; j < 4; ++j) { const u32x2 w = rawn[t][j];
                        v[t][j] = (f32x4){__uint_as_float(w.x << 16), __uint_as_float(w.x & 0xffff0000u), __uint_as_float(w.y << 16), __uint_as_float(w.y & 0xffff0000u)};
                        ss[t] += (v[t][j].x * v[t][j].x + v[t][j].y * v[t][j].y) + (v[t][j].z * v[t][j].z + v[t][j].w * v[t][j].w); }
                { ss[0] = wave_sum(ss[0]); ss[1] = wave_sum(ss[1]); }
                { f32x4 wn[4];
#pragma unroll
                  for (int j = 0; j < 4; ++j) wn[j] = *(const f32x4*)(n2w + 4 * lane + 256 * j);
#pragma unroll
                  for (int t = 0; t < 2; ++t) { const int row = row0 + t, bidx = row < SEQ ? 0 : (row < TLAT ? 1 : 2); const float* mp = modl + (size_t)bidx * 6144;
                    const float r = rsqrtf(ss[t] * (1.0f / DM) + EPS);
                    f32x4 ma[4], mb[4];
#pragma unroll
                    for (int j = 0; j < 4; ++j) { const int c = 4 * lane + 256 * j; ma[j] = *(const f32x4*)(mp + 4 * 1024 + c); mb[j] = *(const f32x4*)(mp + 3 * 1024 + c); }
                    __builtin_amdgcn_sched_barrier(0);
#pragma unroll
                    for (int j = 0; j < 4; ++j) { const int c = 4 * lane + 256 * j;
                        v[t][j] = (v[t][j] * r) * wn[j] * (ma[j] + 1.0f) + mb[j];
                        u32x2 o; o.x = pk2(v[t][j].x, v[t][j].y); o.y = pk2(v[t][j].z, v[t][j].w); *(u32x2*)(G_hbuf + (size_t)row * DM + c) = o; } } }
                if (tl + 2 * NWAVES < TPW) {
#pragma unroll
                    for (int t = 0; t < 2; ++t)
#pragma unroll
                        for (int j = 0; j < 4; ++j) rawn[t][j] = *(const u32x2*)(G_xw + (size_t)(row0 + 2 * NWAVES + t) * DM + 4 * lane + 256 * j); }
                float pa[32], pb[32];
                { f32x2 vv[4][4];
#pragma unroll
                  for (int j = 0; j < 4; ++j) { vv[j][0] = (f32x2){v[0][j].x, v[1][j].x}; vv[j][1] = (f32x2){v[0][j].y, v[1][j].y}; vv[j][2] = (f32x2){v[0][j].z, v[1][j].z}; vv[j][3] = (f32x2){v[0][j].w, v[1][j].w}; }
                  f32x4 wb[2][8];
#pragma unroll
                  for (int q = 0; q < 8; ++q) wb[0][q] = *(const f32x4*)(wT + (q >> 2) * 1024 + 4 * lane + 256 * (q & 3));
#pragma unroll
                  for (int bt = 0; bt < 16; ++bt) {
                      if (bt + 1 < 16) {
#pragma unroll
                          for (int q = 0; q < 8; ++q) wb[(bt + 1) & 1][q] = *(const f32x4*)(wT + (2 * (bt + 1) + (q >> 2)) * 1024 + 4 * lane + 256 * (q & 3)); }
#pragma unroll
                      for (int ee = 0; ee < 2; ++ee) { f32x2 acc = {0.f, 0.f};
#pragma unroll
                          for (int j = 0; j < 4; ++j) { const f32x4 w = wb[bt & 1][ee * 4 + j];
                              acc = __builtin_elementwise_fma(vv[j][0], (f32x2){w.x, w.x}, acc); acc = __builtin_elementwise_fma(vv[j][1], (f32x2){w.y, w.y}, acc);
                              acc = __builtin_elementwise_fma(vv[j][2], (f32x2){w.z, w.z}, acc); acc = __builtin_elementwise_fma(vv[j][3], (f32x2){w.w, w.w}, acc); }
                          pa[2 * bt + ee] = acc.x; pb[2 * bt + ee] = acc.y; } } }
                float qa[16], qb[16], ra[8], rb[8], sa_[4], sb_[4], ta[2], tb[2];
#pragma unroll
                for (int i = 0; i < 16; ++i) { auto r0 = __builtin_amdgcn_permlane32_swap(__float_as_uint(pa[i]), __float_as_uint(pa[16 + i]), false, false);
                    auto r1 = __builtin_amdgcn_permlane32_swap(__float_as_uint(pb[i]), __float_as_uint(pb[16 + i]), false, false);
                    qa[i] = __uint_as_float(r0[0]) + __uint_as_float(r0[1]); qb[i] = __uint_as_float(r1[0]) + __uint_as_float(r1[1]); }
                { const bool up = (lane & 16) != 0;
#pragma unroll
                  for (int i = 0; i < 8; ++i) { const float s0 = up ? qa[i] : qa[8 + i], k0 = up ? qa[8 + i] : qa[i], s1 = up ? qb[i] : qb[8 + i], k1 = up ? qb[8 + i] : qb[i];
                      ra[i] = k0 + __shfl_xor(s0, 16); rb[i] = k1 + __shfl_xor(s1, 16); } }
                { const bool up = (lane & 8) != 0;
#pragma unroll
                  for (int i = 0; i < 4; ++i) { const float s0 = up ? ra[i] : ra[4 + i], k0 = up ? ra[4 + i] : ra[i], s1 = up ? rb[i] : rb[4 + i], k1 = up ? rb[4 + i] : rb[i];
                      sa_[i] = k0 + dpp_perm<0x128>(s0); sb_[i] = k1 + dpp_perm<0x128>(s1); } }
                { const bool up = (lane & 4) != 0;
#pragma unroll
                  for (int i = 0; i < 2; ++i) { const float s0 = up ? sa_[i] : sa_[2 + i], k0 = up ? sa_[2 + i] : sa_[i], s1 = up ? sb_[i] : sb_[2 + i], k1 = up ? sb_[2 + i] : sb_[i];
                      ta[i] = k0 + dpp_perm<0x1B>(dpp_perm<0x141>(s0)); tb[i] = k1 + dpp_perm<0x1B>(dpp_perm<0x141>(s1)); } }
                float la, lb;
                { const bool up = (lane & 2) != 0; const float s0 = up ? ta[0] : ta[1], k0 = up ? ta[1] : ta[0], s1 = up ? tb[0] : tb[1], k1 = up ? tb[1] : tb[0];
                  la = k0 + dpp_perm<0x4E>(s0); lb = k1 + dpp_perm<0x4E>(s1); }
                la += dpp_perm<0xB1>(la); lb += dpp_perm<0xB1>(lb);
                if ((lane & 1) == 0) { wsc[lane >> 1] = la + brl; wsc[32 + (lane >> 1)] = lb + brl; }
                LDS_WAIT();
                const int t = lane >> 5, e = lane & 31; const float* lg = wsc + t * 32; const float mine = lg[e]; int rank = 0;
#pragma unroll
                for (int q = 0; q < 8; ++q) { const f32x4 o4 = *(const f32x4*)(lg + 4 * q); const float ov[4] = {o4.x, o4.y, o4.z, o4.w};
#pragma unroll
                    for (int i = 0; i < 4; ++i) { const int j = 4 * q + i; rank += (ov[i] > mine || (ov[i] == mine && j < e)) ? 1 : 0; } }
                if (rank < 4) wsc[64 + t * 4 + rank] = mine;
                LDS_WAIT();
                if (rank < 4) { const f32x4 sv = *(const f32x4*)(wsc + 64 + t * 4);
                    const float e0 = __expf(sv.x - sv.x), e1 = __expf(sv.y - sv.x), e2 = __expf(sv.z - sv.x), e3 = __expf(sv.w - sv.x);
                    const float gk = __expf(mine - sv.x) / ((e0 + e1) + (e2 + e3));
                    const int lp = dry ? 0 : atomicAdd(&lcnt[e], 1);
                    if (!dry) { selE[(tl + t) * 4 + rank] = e; selP[(tl + t) * 4 + rank] = lp; } G_gatev[(size_t)(row0 + t) * 4 + rank] = gk; }
                LDS_WAIT();
            }
            }
            __syncthreads();
            if (tid < 32 && !dry) basep[tid] = (int)atomicAdd(&G_ctl[CW_CNT + l * 32 + tid], (unsigned)lcnt[tid]);
            __syncthreads();
            if (!dry) for (int i = tid; i < TPW * 4; i += 512) { const int e = selE[i]; const int pos = basep[e] + selP[i]; if (pos < LISTCAP) G_list[(size_t)e * LISTCAP + pos] = tok0 * 4 + i; }
        }
        SEAM(P + 5);
        if (INK(P + 6, 9)) REPS(9) { PH_TID();
            int* tile_e = (int*)(lds + TAB_OFF); int* pstart = tile_e + 304; int* cntl = pstart + 40;
            const int nrt = moe_tables(G_ctl + CW_CNT + l * 32, tile_e, pstart, cntl);
            pg8::Gemm g{G_hbuf, G_wb_gu + (size_t)l * NE * 2048 * DM, nrt * 256, 2048, DM, (size_t)2048 * DM * 2};
            pg8::MoeOrderT<true> S{(const LAS int*)((LAS unsigned char*)lds + TAB_OFF), (const LAS int*)((LAS unsigned char*)lds + TAB_OFF) + 304, (const LAS int*)((LAS unsigned char*)lds + TAB_OFF) + 344, G_list, nrt, 8, 3, G, vcu};
            pg8::EpiAct E{G_actb, INP(I_BGU) + (size_t)l * NE * 2048};
            pg8::gemm_phase<pg8::EpiAct, pg8::MoeOrderT<true>, true, true>((LAS unsigned char*)lds + RING_OFF, g, S, E);
        }
        SEAM(P + 6);
        if (INK(P + 7, 10)) REPS(10) { PH_TID();
            int* tile_e = (int*)(lds + TAB_OFF); int* pstart = tile_e + 304; int* cntl = pstart + 40;
            const int nrt = (IN(P + 6) && ((PH_MASK >> 9) & 1)) ? __builtin_amdgcn_readfirstlane(pstart[NE] >> 8) : moe_tables(G_ctl + CW_CNT + l * 32, tile_e, pstart, cntl);
            pg8::Gemm g{G_actb, G_wb_dn + (size_t)l * NE * DM * DE, nrt * 256, DM, DE, (size_t)DM * DE * 2};
            pg8::MoeOrderT<false> S{(const LAS int*)((LAS unsigned char*)lds + TAB_OFF), (const LAS int*)((LAS unsigned char*)lds + TAB_OFF) + 304, (const LAS int*)((LAS unsigned char*)lds + TAB_OFF) + 344, G_list, nrt, 4, 2, G, vcu};
            pg8::EpiDown E{G_yk, INP(I_BDN) + (size_t)l * NE * DM, &S, G_gatev};
            pg8::gemm_phase<pg8::EpiDown, pg8::MoeOrderT<false>, true, true>((LAS unsigned char*)lds + RING_OFF, g, S, E);
        }
        SEAM(P + 7);
        if (INK(P + 8, 11)) REPS(11) { PH_TID(); const bool dry = rep_ > 0;
            const int ntok = last ? TLAT : TALL;
            f32x4 nwv[4];
            { const float* nwp = last ? INP(I_FNW) : INP(I_N1W) + (l + 1) * DM;
#pragma unroll
              for (int q = 0; q < 4; ++q) nwv[q] = *(const f32x4*)(nwp + 8 * lane + 512 * (q >> 1) + 4 * (q & 1)); }
            for (int rowa = gw; rowa < ntok; rowa += 2 * NGW) {
                f32x4 v[2][4]; int rw[2]; bool ok[2];
#pragma unroll
                for (int t = 0; t < 2; ++t) { const int rr = rowa + t * NGW; ok[t] = rr < ntok; rw[t] = ok[t] ? rr : rowa; }
                u32x4 yv[2][2][4]; u32x4 xr[2][2];
#pragma unroll
                for (int t = 0; t < 2; ++t)
#pragma unroll
                    for (int jj = 0; jj < 2; ++jj) { const int c = 8 * lane + 512 * jj;
#pragma unroll
                        for (int k = 0; k < 4; ++k) yv[t][jj][k] = *(const u32x4*)(G_yk + ((size_t)rw[t] * 4 + k) * DM + c);
                        xr[t][jj] = *(const u32x4*)(G_xw + (size_t)rw[t] * DM + c); }
#pragma unroll
                for (int t = 0; t < 2; ++t) { const int row = rw[t], bidx = row < SEQ ? 0 : (row < TLAT ? 1 : 2); const float* mp = modl + (size_t)bidx * 6144;
                    const float* mn = G_modb + (size_t)((last ? l : l + 1) * 3 + bidx) * 6144;
                    f32x4 g2[4];
#pragma unroll
                    for (int q = 0; q < 4; ++q) g2[q] = *(const f32x4*)(mp + 5 * 1024 + 8 * lane + 512 * (q >> 1) + 4 * (q & 1));
                    __builtin_amdgcn_sched_barrier(0);
                    const float gsc = (dry && !last) ? 0.f : 1.f;
#pragma unroll
                    for (int jj = 0; jj < 2; ++jj) { const int c = 8 * lane + 512 * jj; float ff[8] = {0.f, 0.f, 0.f, 0.f, 0.f, 0.f, 0.f, 0.f};
#pragma unroll
                        for (int k = 0; k < 4; ++k) { float f8[8]; unpack8(yv[t][jj][k], f8);
#pragma unroll
                            for (int e = 0; e < 8; ++e) ff[e] += f8[e]; }
                        const f32x4 g2a = g2[jj * 2] * gsc, g2b = g2[jj * 2 + 1] * gsc;
                        float x8[8]; unpack8(xr[t][jj], x8);
                        v[t][jj * 2] = (f32x4){x8[0], x8[1], x8[2], x8[3]} + g2a * (f32x4){ff[0], ff[1], ff[2], ff[3]}; v[t][jj * 2 + 1] = (f32x4){x8[4], x8[5], x8[6], x8[7]} + g2b * (f32x4){ff[4], ff[5], ff[6], ff[7]};
                        if (!last && !dry && ok[t]) { const float o8[8] = {v[t][jj * 2].x, v[t][jj * 2].y, v[t][jj * 2].z, v[t][jj * 2].w, v[t][jj * 2 + 1].x, v[t][jj * 2 + 1].y, v[t][jj * 2 + 1].z, v[t][jj * 2 + 1].w};
                            *(u32x4*)(G_xw + (size_t)row * DM + c) = pack8(o8); } }
                    f32x4 ma[4], mb[4];
#pragma unroll
                    for (int q = 0; q < 4; ++q) { const int c = 8 * lane + 512 * (q >> 1) + 4 * (q & 1); ma[q] = *(const f32x4*)(mn + 1024 + c); mb[q] = *(const f32x4*)(mn + c); }
                    __builtin_amdgcn_sched_barrier(0);
                    float ss = 0.f;
#pragma unroll
                    for (int j = 0; j < 4; ++j) ss += (v[t][j].x * v[t][j].x + v[t][j].y * v[t][j].y) + (v[t][j].z * v[t][j].z + v[t][j].w * v[t][j].w);
                    const float r = rsqrtf(wave_sum(ss) * (1.0f / DM) + EPS);
                    if (ok[t]) {
                        if (!last) {
#pragma unroll
                            for (int jj = 0; jj < 2; ++jj) { const int c = 8 * lane + 512 * jj; float o8[8];
#pragma unroll
                                for (int hh = 0; hh < 2; ++hh) { const int q = jj * 2 + hh;
                                    const f32x4 y = (v[t][q] * r) * nwv[q] * (ma[q] + 1.0f) + mb[q]; o8[4 * hh] = y.x; o8[4 * hh + 1] = y.y; o8[4 * hh + 2] = y.z; o8[4 * hh + 3] = y.w; }
                                *(u32x4*)(G_hbuf + (size_t)row * DM + c) = pack8(o8); }
                        } else {
#pragma unroll
                            for (int jj = 0; jj < 2; ++jj) { const int c = 8 * lane + 512 * jj;
#pragma unroll
                                for (int hh = 0; hh < 2; ++hh) *(f32x4*)(args.out + (size_t)row * DM + c + 4 * hh) = (v[t][jj * 2 + hh] * r) * nwv[jj * 2 + hh]; }
                        }
                    }
                }
            }
        }
        SEAM(P + 8);
    }
#undef IN
#undef SEAM
}

extern "C" void kernel_launch(void* const* d_in, const int* in_sizes, int n_in, void* d_out, int out_size, void* d_ws, size_t ws_size, hipStream_t stream) {
    static int grid = 0;
    if (grid == 0) {
        if (n_in != 28 || out_size != TLAT * DM || ws_size < WS_END) { fprintf(stderr, "kernel_launch: unexpected shapes: n_in %d out %d ws %zu (need %zu)\n", n_in, out_size, ws_size, (size_t)WS_END); grid = -1; return; }
        int dev = 0, cus = 0, per_cu = 0;
        if (hipGetDevice(&dev) != hipSuccess || hipDeviceGetAttribute(&cus, hipDeviceAttributeMultiprocessorCount, dev) != hipSuccess) { grid = -1; return; }
        if (hipFuncSetAttribute((const void*)fwd, hipFuncAttributeMaxDynamicSharedMemorySize, LDS_BYTES) != hipSuccess) { fprintf(stderr, "kernel_launch: hipFuncSetAttribute failed\n"); grid = -1; return; }
        if (hipOccupancyMaxActiveBlocksPerMultiprocessor(&per_cu, (const void*)fwd, NWAVES * 64, LDS_BYTES) != hipSuccess || per_cu < 1) fprintf(stderr, "kernel_launch: occupancy query reports %d\n", per_cu);
        (void)hipGetLastError();
        grid = cus;
        if (grid != 256) fprintf(stderr, "kernel_launch: %d CUs (built for 256)\n", grid);
    }
    if (grid < 0) return;
    if (hipMemsetAsync((char*)d_ws + WS_CTL, 0, CTL_ZERO_BYTES, stream) != hipSuccess) return;
    Args a{};
    for (int i = 0; i < 28; ++i) a.in[i] = (const float*)d_in[i];
    a.out = (float*)d_out; a.ws = (unsigned char*)d_ws;
#if MK_N_LAUNCHES == 1
    a.ph_lo = 0; a.ph_hi = NPH;
    hipLaunchKernelGGL(fwd, dim3(grid), dim3(NWAVES * 64), LDS_BYTES, stream, a);
#else
    for (int p = 0; p < NPH; ++p) { a.ph_lo = p; a.ph_hi = p + 1; hipLaunchKernelGGL(fwd, dim3(grid), dim3(NWAVES * 64), LDS_BYTES, stream, a); }
#endif
    const hipError_t le = hipPeekAtLastError();
    if (le != hipSuccess) fprintf(stderr, "kernel_launch: launch failed: %s\n", hipGetErrorName(le));
}
```
